# Optimizing an MI355X kernel written in HIP

```python
import math
import jax
import jax.numpy as jnp
from jax import lax
import numpy as np

D_MODEL = 1024
BATCH = 4
SEQ = 4096
DEPTH = 4

HEAD_DIM = 64
R_HEADS = 4
R_WIDTH = R_HEADS * HEAD_DIM
R_LORA_W = 32
R_LORA_A = 32
R_LORA_G = 64
R_COLS = 3 * R_WIDTH + R_LORA_W + R_LORA_A + R_LORA_G
R_GN_EPS = 64e-5
DF_HEADS = 4
DF_QK = HEAD_DIM
DF_V = 2 * HEAD_DIM
DF_WIDTH = DF_HEADS * DF_V
DF_QCOLS = DF_HEADS * 2 * DF_QK
DF_COLS = 2 * DF_QCOLS + DF_WIDTH
MB_HEADS = 4
MB_WIDTH = MB_HEADS * HEAD_DIM
MB_COLS = 3 * MB_WIDTH
MB_BLOCK = 256
MB_TOPK = 3
MB_Q_CHUNK = 64
ATT_Q_CHUNK = 128
IN_COLS = R_COLS + DF_COLS + MB_COLS
MIX_WIDTH = R_WIDTH + DF_WIDTH + MB_WIDTH
NUM_BUCKETS = 32
MAX_DISTANCE = 1024
N_BIAS_HEADS = DF_HEADS + MB_HEADS
N_GROUPS = 4
EXPERTS_PER_GROUP = 8
N_EXPERTS = N_GROUPS * EXPERTS_PER_GROUP
TOP_K_INNER = 2
EXPERT_HIDDEN = 512
MOE_BLOCK = 256
RMS_EPS = 1e-6

kernel_name = 'hybrid_rwkv7_diffattn_moba_hmoe'

F32 = jnp.float32


def rmsnorm(x, g, eps=RMS_EPS):
    xf = x.astype(F32)
    y = xf * lax.rsqrt(jnp.mean(xf * xf, -1, keepdims=True) + eps)
    return (y * g.astype(F32)).astype(x.dtype)


def t5_bucket(dist):
    n = jnp.maximum(dist, 0)
    max_exact = NUM_BUCKETS // 2
    nf = jnp.maximum(n, 1).astype(F32)
    large = max_exact + (jnp.log(nf / max_exact) / math.log(MAX_DISTANCE / max_exact)
                         * (NUM_BUCKETS - max_exact)).astype(jnp.int32)
    large = jnp.minimum(large, NUM_BUCKETS - 1)
    return jnp.where(n < max_exact, n, large)


def rwkv7_mix(p, mu, w0, w2, a0, a2, g2, k_k, k_a, r_k, ln_g, ln_b):
    B, S, _ = p.shape
    p_prev = jnp.pad(p, ((0, 0), (1, 0), (0, 0)))[:, :-1]
    p = p + (p_prev - p) * mu
    c1 = R_WIDTH
    c2 = 2 * R_WIDTH
    c3 = 3 * R_WIDTH
    c4 = c3 + R_LORA_W
    c5 = c4 + R_LORA_A
    r, k, v, wd, ad, gd = jnp.split(p, [c1, c2, c3, c4, c5], axis=-1)
    w = -jax.nn.softplus(-(w0 + jnp.tanh(wd) @ w2)) - 0.5
    decay = jnp.exp(-jnp.exp(w.astype(F32)))
    a = jax.nn.sigmoid(a0 + ad @ a2)
    g = jax.nn.sigmoid(gd) @ g2
    heads = lambda t: t.astype(F32).reshape(B, S, R_HEADS, HEAD_DIM)
    kk = heads(k * k_k)
    kk = kk / jnp.maximum(jnp.sqrt(jnp.sum(kk * kk, -1, keepdims=True)), 1e-12)
    k = k * (1 + (a - 1) * k_a)
    r_h, k_h, v_h, a_h, w_h = heads(r), heads(k), heads(v), heads(a), heads(decay)

    def step(state, inp):
        r_t, w_t, k_t, v_t, kk_t, a_t = inp
        sa = jnp.einsum('bhvk,bhk->bhv', state, -kk_t)
        state = (state * w_t[:, :, None, :]
                 + jnp.einsum('bhv,bhk->bhvk', sa, kk_t * a_t)
                 + jnp.einsum('bhv,bhk->bhvk', v_t, k_t))
        return state, jnp.einsum('bhvk,bhk->bhv', state, r_t)

    xs = tuple(jnp.moveaxis(t, 1, 0) for t in (r_h, w_h, k_h, v_h, kk, a_h))
    s0 = jnp.zeros((B, R_HEADS, HEAD_DIM, HEAD_DIM), F32)
    _, y = lax.scan(step, s0, xs)
    y = jnp.moveaxis(y, 0, 1)
    mean = jnp.mean(y, -1, keepdims=True)
    var = jnp.mean(jnp.square(y - mean), -1, keepdims=True)
    y = ((y - mean) * lax.rsqrt(var + R_GN_EPS)).reshape(B, S, R_WIDTH)
    y = y * ln_g.astype(F32) + ln_b.astype(F32)
    bonus = jnp.sum(r_h * k_h * r_k.astype(F32), -1, keepdims=True) * v_h
    y = y + bonus.reshape(B, S, R_WIDTH)
    return (y * g.astype(F32)).astype(p.dtype)


def diff_attention(p, q_gain, k_gain, lam, subln_g, bias_tbl, lambda_init):
    B, S, _ = p.shape
    q, k, v = jnp.split(p, [DF_QCOLS, 2 * DF_QCOLS], axis=-1)
    q = rmsnorm(q.reshape(B, S, DF_HEADS, 2, DF_QK), q_gain)
    k = rmsnorm(k.reshape(B, S, DF_HEADS, 2, DF_QK), k_gain)
    v = v.reshape(B, S, DF_HEADS, DF_V).astype(F32)
    lamf = lam.astype(F32)
    lam_full = (jnp.exp(jnp.sum(lamf[0] * lamf[1])) - jnp.exp(jnp.sum(lamf[2] * lamf[3]))
                + lambda_init)
    scale = DF_QK ** -0.5
    nqb = S // ATT_Q_CHUNK
    qb = q.reshape(B, nqb, ATT_Q_CHUNK, DF_HEADS, 2, DF_QK).transpose(1, 0, 3, 4, 2, 5)
    kpos = jnp.arange(S)
    tbl = bias_tbl.astype(F32)

    def block(args):
        qc, i = args
        qpos = i * ATT_Q_CHUNK + jnp.arange(ATT_Q_CHUNK)
        dist = qpos[:, None] - kpos[None, :]
        bias = tbl[t5_bucket(dist)][..., :DF_HEADS].transpose(2, 0, 1)
        logits = jnp.einsum('bhcqd,bkhcd->bhcqk', qc, k).astype(F32) * scale + bias[None, :, None]
        logits = jnp.where(dist >= 0, logits, -jnp.inf)
        probs = jax.nn.softmax(logits, axis=-1)
        attn = probs[:, :, 0] - lam_full * probs[:, :, 1]
        return jnp.einsum('bhqk,bkhe->bqhe', attn, v)

    out = lax.map(block, (qb, jnp.arange(nqb)))
    out = out.transpose(1, 0, 2, 3, 4).reshape(B, S, DF_HEADS, DF_V)
    out = rmsnorm(out, subln_g) * (1.0 - lambda_init)
    return out.reshape(B, S, DF_WIDTH).astype(p.dtype)


def moba_attention(p, q_gain, k_gain, bias_tbl):
    B, S, _ = p.shape
    q, k, v = jnp.split(p, 3, axis=-1)
    q = rmsnorm(q.reshape(B, S, MB_HEADS, HEAD_DIM), q_gain).transpose(0, 2, 1, 3)
    k = rmsnorm(k.reshape(B, S, MB_HEADS, HEAD_DIM), k_gain).transpose(0, 2, 1, 3)
    v = v.reshape(B, S, MB_HEADS, HEAD_DIM).transpose(0, 2, 1, 3)
    nb = -(-S // MB_BLOCK)
    pad = nb * MB_BLOCK - S
    k = jnp.pad(k, ((0, 0), (0, 0), (0, pad), (0, 0)))
    v = jnp.pad(v, ((0, 0), (0, 0), (0, pad), (0, 0)))
    kb = k.reshape(B, MB_HEADS, nb, MB_BLOCK, HEAD_DIM)
    vb = v.reshape(B, MB_HEADS, nb, MB_BLOCK, HEAD_DIM)
    kmean = jnp.mean(kb.astype(F32), axis=3)
    topk = min(MB_TOPK, nb)
    scale = HEAD_DIM ** -0.5
    tbl = bias_tbl[:, DF_HEADS:].T.astype(F32)
    nqc = S // MB_Q_CHUNK
    qc_all = q.reshape(B, MB_HEADS, nqc, MB_Q_CHUNK, HEAD_DIM).transpose(2, 0, 1, 3, 4)
    bi = jnp.arange(B)[:, None, None, None]
    hi = jnp.arange(MB_HEADS)[None, :, None, None]
    blk_ids = jnp.arange(nb)
    offs = jnp.arange(MB_BLOCK)

    def chunk(args):
        qc, i = args
        qpos = i * MB_Q_CHUNK + jnp.arange(MB_Q_CHUNK)
        own = (i * MB_Q_CHUNK) // MB_BLOCK
        gate = jnp.einsum('bhqd,bhnd->bhqn', qc.astype(F32), kmean)
        gate = jnp.where(blk_ids < own, gate, -jnp.inf)
        _, idx = lax.top_k(gate, topk)
        valid = jnp.arange(topk) < own
        kg = kb[bi, hi, idx]
        vg = vb[bi, hi, idx]
        dist_sel = qpos[:, None, None] - (idx[..., None] * MB_BLOCK + offs)
        logit_sel = (jnp.einsum('bhqd,bhqnkd->bhqnk', qc, kg).astype(F32) * scale
                     + tbl[hi[..., None], t5_bucket(dist_sel)])
        logit_sel = jnp.where(valid[:, None], logit_sel, -jnp.inf)
        ko = lax.dynamic_index_in_dim(kb, own, axis=2, keepdims=False)
        vo = lax.dynamic_index_in_dim(vb, own, axis=2, keepdims=False)
        dist_own = qpos[:, None] - (own * MB_BLOCK + offs)[None, :]
        logit_own = (jnp.einsum('bhqd,bhkd->bhqk', qc, ko).astype(F32) * scale
                     + tbl[:, t5_bucket(dist_own)][None])
        logit_own = jnp.where(dist_own >= 0, logit_own, -jnp.inf)
        nq = qc.shape[2]
        logits = jnp.concatenate([logit_sel.reshape(B, MB_HEADS, nq, topk * MB_BLOCK), logit_own], -1)
        probs = jax.nn.softmax(logits, axis=-1)
        p_sel = probs[..., :topk * MB_BLOCK].reshape(B, MB_HEADS, nq, topk, MB_BLOCK)
        p_own = probs[..., topk * MB_BLOCK:]
        return (jnp.einsum('bhqnk,bhqnkd->bhqd', p_sel, vg.astype(F32))
                + jnp.einsum('bhqk,bhkd->bhqd', p_own, vo.astype(F32)))

    out = lax.map(chunk, (qc_all, jnp.arange(nqc)))
    out = out.transpose(1, 0, 3, 2, 4).reshape(B, S, MB_WIDTH)
    return out.astype(p.dtype)


def hier_moe(h, wg, bg, we, be, w1, w3, w2):
    B, S, Dm = h.shape
    T = B * S
    hf = h.reshape(T, Dm)
    g_logits = (hf @ wg + bg).astype(F32)
    pg = jax.nn.softmax(g_logits, axis=-1)
    g_idx = jnp.argmax(g_logits, axis=-1)
    pg_top = jnp.take_along_axis(pg, g_idx[:, None], axis=-1)
    e_logits = (hf @ we + be).astype(F32).reshape(T, N_GROUPS, EXPERTS_PER_GROUP)
    e_logits = jnp.take_along_axis(e_logits, g_idx[:, None, None], axis=1)[:, 0]
    pe = jax.nn.softmax(e_logits, axis=-1)
    pe_top, e_local = lax.top_k(pe, TOP_K_INNER)
    gates = pg_top * pe_top / jnp.sum(pe_top, -1, keepdims=True)
    experts = g_idx[:, None] * EXPERTS_PER_GROUP + e_local
    A = T * TOP_K_INNER
    flat_e = experts.reshape(A)
    order = jnp.argsort(flat_e)
    se = flat_e[order]
    tok = order // TOP_K_INNER
    counts = jnp.zeros((N_EXPERTS,), jnp.int32).at[flat_e].add(1)
    padded = (counts + MOE_BLOCK - 1) // MOE_BLOCK * MOE_BLOCK
    pad_end = jnp.cumsum(padded)
    pad_start = pad_end - padded
    start = jnp.cumsum(counts) - counts
    dest = pad_start[se] + jnp.arange(A) - start[se]
    n_blocks = -(-(A + N_EXPERTS * (MOE_BLOCK - 1)) // MOE_BLOCK)
    buf = jnp.zeros((n_blocks * MOE_BLOCK, Dm), h.dtype).at[dest].set(hf[tok])
    blk_e = jnp.minimum(jnp.searchsorted(pad_end, jnp.arange(n_blocks) * MOE_BLOCK, side='right'),
                        N_EXPERTS - 1)

    def expert_block(args):
        xb, e = args
        return (jax.nn.silu(xb @ w1[e]) * (xb @ w3[e])) @ w2[e]

    yb = lax.map(expert_block, (buf.reshape(n_blocks, MOE_BLOCK, Dm), blk_e))
    y_assign = yb.reshape(-1, Dm)[dest] * gates.reshape(A)[order][:, None].astype(h.dtype)
    y = jnp.zeros((T, Dm), h.dtype).at[tok].add(y_assign)
    return y.reshape(B, S, Dm)


def setup_inputs(seed: int = 0) -> dict:
    key = jax.random.key(seed)
    ks = iter(jax.random.split(key, 40))
    nrm = lambda shape, s: jax.random.normal(next(ks), shape, F32) * s
    uni = lambda shape, lo, hi: jax.random.uniform(next(ks), shape, F32, lo, hi)
    L = DEPTH
    return {
        'x': nrm((BATCH, SEQ, D_MODEL), 1.0),
        'c': nrm((BATCH, D_MODEL), 1.0),
        'ada_w': nrm((L, D_MODEL, 6 * D_MODEL), 0.5 * D_MODEL ** -0.5),
        'ada_b': nrm((L, 6 * D_MODEL), 0.01),
        'norm1_g': 1.0 + nrm((L, D_MODEL), 0.02),
        'norm2_g': 1.0 + nrm((L, D_MODEL), 0.02),
        'w_in': nrm((L, D_MODEL, IN_COLS), D_MODEL ** -0.5),
        'w_out': nrm((L, MIX_WIDTH, D_MODEL), MIX_WIDTH ** -0.5),
        'rwkv_mu': uni((L, R_COLS), 0.0, 1.0),
        'rwkv_w0': uni((L, R_WIDTH), -6.5, -1.5),
        'rwkv_w2': nrm((L, R_LORA_W, R_WIDTH), 0.1 * R_LORA_W ** -0.5),
        'rwkv_a0': nrm((L, R_WIDTH), 0.1),
        'rwkv_a2': nrm((L, R_LORA_A, R_WIDTH), 0.1 * R_LORA_A ** -0.5),
        'rwkv_g2': nrm((L, R_LORA_G, R_WIDTH), R_LORA_G ** -0.5),
        'rwkv_kk': 0.85 + nrm((L, R_WIDTH), 0.02),
        'rwkv_ka': 1.0 + nrm((L, R_WIDTH), 0.02),
        'rwkv_rk': nrm((L, R_HEADS, HEAD_DIM), 0.1),
        'rwkv_ln_g': 1.0 + nrm((L, R_WIDTH), 0.02),
        'rwkv_ln_b': nrm((L, R_WIDTH), 0.01),
        'diff_q_gain': 1.0 + nrm((L, DF_QK), 0.02),
        'diff_k_gain': 1.0 + nrm((L, DF_QK), 0.02),
        'diff_lambda': nrm((L, 4, DF_QK), 0.1),
        'diff_subln_g': 1.0 + nrm((L, DF_V), 0.02),
        'moba_q_gain': 1.0 + nrm((L, HEAD_DIM), 0.02),
        'moba_k_gain': 1.0 + nrm((L, HEAD_DIM), 0.02),
        'rel_bias': nrm((NUM_BUCKETS, N_BIAS_HEADS), 0.5),
        'router_g_w': nrm((L, D_MODEL, N_GROUPS), D_MODEL ** -0.5),
        'router_g_b': nrm((L, N_GROUPS), 0.01),
        'router_e_w': nrm((L, D_MODEL, N_EXPERTS), D_MODEL ** -0.5),
        'router_e_b': nrm((L, N_EXPERTS), 0.01),
        'moe_w1': nrm((L, N_EXPERTS, D_MODEL, EXPERT_HIDDEN), D_MODEL ** -0.5),
        'moe_w3': nrm((L, N_EXPERTS, D_MODEL, EXPERT_HIDDEN), D_MODEL ** -0.5),
        'moe_w2': nrm((L, N_EXPERTS, EXPERT_HIDDEN, D_MODEL), EXPERT_HIDDEN ** -0.5),
    }


def reference(x, c, ada_w, ada_b, norm1_g, norm2_g, w_in, w_out, rwkv_mu, rwkv_w0, rwkv_w2,
              rwkv_a0, rwkv_a2, rwkv_g2, rwkv_kk, rwkv_ka, rwkv_rk, rwkv_ln_g, rwkv_ln_b,
              diff_q_gain, diff_k_gain, diff_lambda, diff_subln_g, moba_q_gain, moba_k_gain,
              rel_bias, router_g_w, router_g_b, router_e_w, router_e_b, moe_w1, moe_w3, moe_w2):
    cs = jax.nn.silu(c)
    for l in range(DEPTH):
        mod = cs @ ada_w[l] + ada_b[l]
        sh1, sc1, g1, sh2, sc2, g2 = jnp.split(mod[:, None, :], 6, axis=-1)
        h = rmsnorm(x, norm1_g[l]) * (1 + sc1) + sh1
        proj = h @ w_in[l]
        p_r, p_d, p_m = jnp.split(proj, [R_COLS, R_COLS + DF_COLS], axis=-1)
        y_r = rwkv7_mix(p_r, rwkv_mu[l], rwkv_w0[l], rwkv_w2[l], rwkv_a0[l], rwkv_a2[l],
                        rwkv_g2[l], rwkv_kk[l], rwkv_ka[l], rwkv_rk[l], rwkv_ln_g[l], rwkv_ln_b[l])
        lambda_init = 0.8 - 0.6 * math.exp(-0.3 * l)
        y_d = diff_attention(p_d, diff_q_gain[l], diff_k_gain[l], diff_lambda[l],
                             diff_subln_g[l], rel_bias, lambda_init)
        y_m = moba_attention(p_m, moba_q_gain[l], moba_k_gain[l], rel_bias)
        mix = jnp.concatenate([y_r, y_d, y_m], axis=-1) @ w_out[l]
        x = x + g1 * mix
        h2 = rmsnorm(x, norm2_g[l]) * (1 + sc2) + sh2
        x = x + g2 * hier_moe(h2, router_g_w[l], router_g_b[l], router_e_w[l], router_e_b[l],
                              moe_w1[l], moe_w3[l], moe_w2[l])
    return x
```

```cpp
#include <hip/hip_runtime.h>
#include <cstdio>
#include <cstdint>
namespace pg8 {
#define PG8_LAS __attribute__((address_space(3)))
typedef unsigned short bf16_t;
typedef short bf16x8 __attribute__((ext_vector_type(8)));
typedef float f32x4 __attribute__((ext_vector_type(4)));
typedef unsigned u32x4 __attribute__((ext_vector_type(4)));
constexpr int BM = 256, BK = 64, HALF = 128, HTB = HALF * BK * 2  , STAGE_BYTES = 8 * HTB, NXCD = 8, WGM = 8;

__host__ __device__ __forceinline__ int lds_byte(int r, int c) { const int st = (r >> 4) * 2 + (c >> 5), rr = r & 15, cc = c & 31, ob = rr * 64 + cc * 2; return st * 1024 + (ob ^ (((ob >> 9) & 1) << 5)); }
__host__ __device__ __forceinline__ void stage_rc(int b, int& R, int& C) { const int st = b / 1024, sb = b % 1024, swz = sb ^ (((sb >> 9) & 1) << 5); R = (st >> 1) * 16 + swz / 64; C = (st & 1) * 32 + (swz % 64) / 2; }
__host__ __device__ __forceinline__ int perm32(int rho) { const int n = rho >> 4, i = rho & 15; return 8 * (i >> 2) + 4 * n + (i & 3); }

struct Unit { int pm, pn, e; };
struct Gemm { const bf16_t* A; const bf16_t* Bt; int M, N, K; size_t estride; };

struct StaticOrder {
    int nM, nN, nwg, G, c;
    __host__ __device__ void init(int M, int N, int G_, int c_) { nM = M / BM; nN = N / BM; nwg = nM * nN; G = G_; c = c_; }
    __host__ __device__ bool next(int i, Unit& u) const {
        const long L = (long)i * G + c; if (L >= nwg) return false;
        int wgid = (int)L; { const int q = nwg / NXCD, r = nwg % NXCD, xcd = wgid % NXCD, off = wgid / NXCD; wgid = (xcd < r ? xcd * (q + 1) : r * (q + 1) + (xcd - r) * q) + off; }
        const int nig = WGM * nN, gid = wgid / nig, fm = gid * WGM, gsz = (nM - fm) < WGM ? (nM - fm) : WGM;
        u.pm = fm + ((wgid % nig) % gsz); u.pn = (wgid % nig) / gsz; u.e = 0; return true;
    }
    __device__ __forceinline__ void a_ready(const Unit&) const {}
    __device__ __forceinline__ void done(const Unit&) const {}
};

__device__ __forceinline__ unsigned cvt_pk_bf16(float lo, float hi) { unsigned r; asm volatile("v_cvt_pk_bf16_f32 %0, %1, %2" : "=v"(r) : "v"(lo), "v"(hi)); return r; }
typedef unsigned u32x2 __attribute__((ext_vector_type(2)));
constexpr size_t EPI_MiB = 1u << 20, EPI_WS_QD = 656 * EPI_MiB, EPI_WS_KD = 672 * EPI_MiB, EPI_WS_VD = 688 * EPI_MiB, EPI_WS_QM = 704 * EPI_MiB, EPI_WS_KM = 712 * EPI_MiB, EPI_WS_VM = 720 * EPI_MiB, EPI_WS_PR = 728 * EPI_MiB;

struct EpiInProj {
    static constexpr bool PERM = true, AFTER_DRAIN = false;
    unsigned char* ws; const float* const* gains; int l; float c2;
    __device__ __forceinline__ void operator()(const f32x4 (&acc)[2][2][4][2], const Unit& u, int wr, int wc, int fr, int fq) const {
        const int pn = u.pn; const int row0 = u.pm * BM + wr * 64 + fr;
        if (pn >= 9) {
            float* PR = (float*)(ws + EPI_WS_PR);
            const int cb = (pn - 9) * 256 + 64 * wc + 8 * fq;
#pragma unroll
            for (int ai = 0; ai < 2; ++ai)
#pragma unroll
                for (int m = 0; m < 4; ++m) { float* rowp = PR + (size_t)(row0 + ai * HALF + m * 16) * 896;
#pragma unroll
                    for (int bj = 0; bj < 2; ++bj)
#pragma unroll
                        for (int n = 0; n < 2; ++n) { const int c = cb + 32 * bj + 4 * n; if (c < 896) *(f32x4*)(rowp + c) = acc[ai][bj][m][n]; } }
            return;
        }
        bf16_t* dst; int ld, cbase; const float* gain = nullptr; float sc = 1.f;
        if (pn < 2) { dst = (bf16_t*)(ws + EPI_WS_QD); ld = 512; cbase = pn * 256; gain = gains[19] + l * 64; sc = c2; }
        else if (pn < 4) { dst = (bf16_t*)(ws + EPI_WS_KD); ld = 512; cbase = (pn - 2) * 256; gain = gains[20] + l * 64; }
        else if (pn < 6) { dst = (bf16_t*)(ws + EPI_WS_VD); ld = 512; cbase = (pn - 4) * 256; }
        else if (pn == 6) { dst = (bf16_t*)(ws + EPI_WS_QM); ld = 256; cbase = 0; gain = gains[23] + l * 64; sc = c2; }
        else if (pn == 7) { dst = (bf16_t*)(ws + EPI_WS_KM); ld = 256; cbase = 0; gain = gains[24] + l * 64; }
        else { dst = (bf16_t*)(ws + EPI_WS_VM); ld = 256; cbase = 0; }
        f32x4 gv[2][2];
#pragma unroll
        for (int bj = 0; bj < 2; ++bj)
#pragma unroll
            for (int n = 0; n < 2; ++n) gv[bj][n] = gain ? *(const f32x4*)(gain + 32 * bj + 8 * fq + 4 * n) * sc : (f32x4){1.f, 1.f, 1.f, 1.f};
        const int col0 = cbase + 64 * wc + 8 * fq;
#pragma unroll
        for (int ai = 0; ai < 2; ++ai)
#pragma unroll
            for (int m = 0; m < 4; ++m) {
                float rs = 1.f;
                if (gain) { float ss = 0.f;
#pragma unroll
                    for (int bj = 0; bj < 2; ++bj)
#pragma unroll
                        for (int n = 0; n < 2; ++n) { const f32x4 x = acc[ai][bj][m][n]; ss += (x[0] * x[0] + x[1] * x[1]) + (x[2] * x[2] + x[3] * x[3]); }
                    ss += __shfl_xor(ss, 16); ss += __shfl_xor(ss, 32);
                    rs = 1.0f / sqrtf(ss * (1.0f / 64.0f) + 1e-6f); }
                bf16_t* rowp = dst + (size_t)(row0 + ai * HALF + m * 16) * ld + col0;
#pragma unroll
                for (int bj = 0; bj < 2; ++bj) { const f32x4 v0 = acc[ai][bj][m][0] * rs * gv[bj][0], v1 = acc[ai][bj][m][1] * rs * gv[bj][1];
                    u32x4 w; w.x = cvt_pk_bf16(v0[0], v0[1]); w.y = cvt_pk_bf16(v0[2], v0[3]); w.z = cvt_pk_bf16(v1[0], v1[1]); w.w = cvt_pk_bf16(v1[2], v1[3]);
                    *(u32x4*)(rowp + 32 * bj) = w; } }
    }
};
struct EpiResid {
    static constexpr bool PERM = false, AFTER_DRAIN = false;
    float* X; const float* gate; int seq, gstride;
    __device__ __forceinline__ void operator()(const f32x4 (&acc)[2][2][4][2], const Unit& u, int wr, int wc, int fr, int fq) const {
        const int row0 = u.pm * BM + wr * 64 + fr, col0 = u.pn * BM + wc * 32 + 4 * fq;
        const float* gp = gate + (size_t)((u.pm * BM) / seq) * gstride + col0;
        f32x4 gv[2][2];
#pragma unroll
        for (int bj = 0; bj < 2; ++bj)
#pragma unroll
            for (int n = 0; n < 2; ++n) gv[bj][n] = *(const f32x4*)(gp + bj * HALF + n * 16);
#pragma unroll
        for (int ai = 0; ai < 2; ++ai)
#pragma unroll
            for (int m = 0; m < 4; ++m) { float* rowp = X + (size_t)(row0 + ai * HALF + m * 16) * 1024 + col0;
#pragma unroll
                for (int bj = 0; bj < 2; ++bj)
#pragma unroll
                    for (int n = 0; n < 2; ++n) { f32x4* p = (f32x4*)(rowp + bj * HALF + n * 16); *p = *p + gv[bj][n] * acc[ai][bj][m][n]; } }
    }
};
struct EpiSwiGLU {
    static constexpr bool PERM = true, AFTER_DRAIN = false;
    bf16_t* HS;
    __device__ __forceinline__ void operator()(const f32x4 (&acc)[2][2][4][2], const Unit& u, int wr, int wc, int fr, int fq) const {
        const int row0 = u.pm * BM + wr * 64 + fr;
#pragma unroll
        for (int ai = 0; ai < 2; ++ai)
#pragma unroll
            for (int m = 0; m < 4; ++m) { bf16_t* rowp = HS + (size_t)(row0 + ai * HALF + m * 16) * 512;
#pragma unroll
                for (int bj = 0; bj < 2; ++bj) { const int g = 32 * u.pn + 16 * bj + 4 * wc + fq; const f32x4 a = acc[ai][bj][m][0], b = acc[ai][bj][m][1]; f32x4 o;
#pragma unroll
                    for (int e = 0; e < 4; ++e) o[e] = a[e] / (1.0f + __expf(-a[e])) * b[e];
                    u32x2 w; w.x = cvt_pk_bf16(o[0], o[1]); w.y = cvt_pk_bf16(o[2], o[3]); *(u32x2*)(rowp + 4 * g) = w; } }
    }
};
struct EpiMoeOut {
    static constexpr bool PERM = true, AFTER_DRAIN = false;
    bf16_t* YS; const float* gs;
    __device__ __forceinline__ void operator()(const f32x4 (&acc)[2][2][4][2], const Unit& u, int wr, int wc, int fr, int fq) const {
        const int row0 = u.pm * BM + wr * 64 + fr, col0 = u.pn * BM + wc * 32 + 8 * fq;
#pragma unroll
        for (int ai = 0; ai < 2; ++ai)
#pragma unroll
            for (int m = 0; m < 4; ++m) { const int r = row0 + ai * HALF + m * 16; const float gt = gs[r]; bf16_t* rowp = YS + (size_t)r * 1024 + col0;
#pragma unroll
                for (int bj = 0; bj < 2; ++bj) { const f32x4 v0 = acc[ai][bj][m][0] * gt, v1 = acc[ai][bj][m][1] * gt;
                    u32x4 w; w.x = cvt_pk_bf16(v0[0], v0[1]); w.y = cvt_pk_bf16(v0[2], v0[3]); w.z = cvt_pk_bf16(v1[0], v1[1]); w.w = cvt_pk_bf16(v1[2], v1[3]);
                    *(u32x4*)(rowp + bj * HALF) = w; } }
    }
};
struct MoeOrder {
    const __attribute__((address_space(3))) int* t2e; int ntiles, nN, G, c;
    __device__ bool next(int i, Unit& u) const { const int L = i * G + c; if (L >= ntiles * nN) return false; u.pm = L / nN; u.pn = L % nN; u.e = t2e[u.pm]; return true; }
    __device__ __forceinline__ void a_ready(const Unit&) const {}
    __device__ __forceinline__ void done(const Unit&) const {}
};
template <class Epi, class Sched, bool ALIGN_EPI = false, bool SP2 = false>
__device__ __forceinline__ void gemm_phase(PG8_LAS unsigned char* lds, const Gemm g, const Sched& S, const Epi& E) {
    int tid_ = threadIdx.x; asm volatile("" : "+v"(tid_));
    const int tid = tid_, wid = __builtin_amdgcn_readfirstlane(tid >> 6), lane = tid & 63, wr = wid >> 2, wc = wid & 3, fr = lane & 15, fq = lane >> 4;
    const int K = g.K, nt = K / BK;
    unsigned voffA[2], voffB[2];
#pragma unroll
    for (int i = 0; i < 2; ++i) { int R, C; stage_rc(tid * 16 + i * 8192, R, C); const int Rb = Epi::PERM ? ((R & ~31) + perm32(R & 31)) : R;
        voffA[i] = (unsigned)(R * K + C) * 2u; voffB[i] = (unsigned)(Rb * K + C) * 2u; }
    const size_t kstep = (size_t)(BK * 2);
    const size_t hstep = (size_t)HALF * K * 2;
    const size_t tstep = 2 * hstep;
    const unsigned ldsw = (unsigned)wid * 1024u;
    const int aoff = lds_byte(wr * 64 + fr, fq * 8), boff = lds_byte(wc * 32 + fr, fq * 8);
#define PG8_SA(b, h) (((b) * 2 + (h)) * HTB)
#define PG8_SB(b, h) ((4 + (b) * 2 + (h)) * HTB)
#define PG8_STAGE(bufoff, gbase, voff) do { _Pragma("unroll") for (int _i = 0; _i < 2; ++_i) \
        __builtin_amdgcn_global_load_lds((const unsigned*)((const char*)(gbase) + (voff)[_i]), (PG8_LAS unsigned*)(lds + (bufoff) + ldsw + _i * 8192), 16, 0, 0); } while (0)
#define PG8_LDA(dst, b, h) do { _Pragma("unroll") for (int m = 0; m < 4; ++m) _Pragma("unroll") for (int k = 0; k < 2; ++k) dst[m][k] = *(const PG8_LAS bf16x8*)(lds + PG8_SA(b, h) + aoff + m * 2048 + k * 1024); } while (0)
#define PG8_LDB(dst, b, h) do { _Pragma("unroll") for (int n = 0; n < 2; ++n) _Pragma("unroll") for (int k = 0; k < 2; ++k) dst[n][k] = *(const PG8_LAS bf16x8*)(lds + PG8_SB(b, h) + boff + n * 2048 + k * 1024); } while (0)
#define PG8_MMA(ai, bj, At, Bt) do { __builtin_amdgcn_s_setprio(1); _Pragma("unroll") for (int m = 0; m < 4; ++m) _Pragma("unroll") for (int n = 0; n < 2; ++n) _Pragma("unroll") for (int k = 0; k < 2; ++k) \
        acc[ai][bj][m][n] = __builtin_amdgcn_mfma_f32_16x16x32_bf16(Bt[n][k], At[m][k], acc[ai][bj][m][n], 0, 0, 0); __builtin_amdgcn_s_setprio(0); } while (0)
#define PG8_WAIT_V(n) asm volatile("s_waitcnt vmcnt(" #n ")" ::: "memory")
#define PG8_WAIT_L(n) asm volatile("s_waitcnt lgkmcnt(" #n ")" ::: "memory")
#define PG8_BAR __builtin_amdgcn_s_barrier()
#define PG8_SCHED __builtin_amdgcn_sched_barrier(0)
    Unit cur, nxt; int ui = 0;
    if (!S.next(0, cur)) return;
    f32x4 acc[2][2][4][2];
#pragma unroll
    for (int a = 0; a < 2; ++a)
#pragma unroll
        for (int b = 0; b < 2; ++b)
#pragma unroll
            for (int m = 0; m < 4; ++m)
#pragma unroll
                for (int n = 0; n < 2; ++n) acc[a][b][m][n] = (f32x4){0.f, 0.f, 0.f, 0.f};
    bf16x8 At[4][2], B0[2][2], B1[2][2];
    const char* cA = (const char*)g.A + (size_t)cur.pm * tstep; const char* cB = (const char*)g.Bt + (size_t)cur.e * g.estride + (size_t)cur.pn * tstep;
    S.a_ready(cur);
    if constexpr (SP2) {
        PG8_STAGE(PG8_SB(0, 0), cB, voffB); PG8_STAGE(PG8_SB(0, 1), cB + hstep, voffB); PG8_STAGE(PG8_SA(0, 0), cA, voffA); PG8_STAGE(PG8_SA(0, 1), cA + hstep, voffA);
        if (wr == 1) PG8_BAR;
        PG8_WAIT_V(2); PG8_BAR;
        PG8_STAGE(PG8_SB(1, 0), cB + kstep, voffB); PG8_STAGE(PG8_SA(1, 0), cA + kstep, voffA); PG8_STAGE(PG8_SB(1, 1), cB + hstep + kstep, voffB);
        PG8_WAIT_V(6); PG8_BAR;
    } else {
        PG8_STAGE(PG8_SB(0, 0), cB, voffB); PG8_STAGE(PG8_SA(0, 0), cA, voffA); PG8_STAGE(PG8_SB(0, 1), cB + hstep, voffB); PG8_STAGE(PG8_SA(0, 1), cA + hstep, voffA);
        if (wr == 1) PG8_BAR;
        PG8_WAIT_V(4); PG8_BAR;
        PG8_STAGE(PG8_SB(1, 0), cB + kstep, voffB); PG8_STAGE(PG8_SA(1, 0), cA + kstep, voffA); PG8_STAGE(PG8_SB(1, 1), cB + hstep + kstep, voffB);
        PG8_WAIT_V(6); PG8_BAR;
    }
    for (;;) {
        const bool has_next = S.next(ui + 1, nxt);
        const char* nA = has_next ? (const char*)g.A + (size_t)nxt.pm * tstep : cA; const char* nB = has_next ? (const char*)g.Bt + (size_t)nxt.e * g.estride + (size_t)nxt.pn * tstep : cB;
        for (int t = 0; t < nt; t += 2) {
            const bool last = (t == nt - 2);
            const char* a1 = cA + (size_t)(t + 1) * kstep;
            const char* a2 = last ? nA : cA + (size_t)(t + 2) * kstep; const char* b2 = last ? nB : cB + (size_t)(t + 2) * kstep;
            const char* a3 = a2 + kstep; const char* b3 = b2 + kstep;
            if (last && has_next) S.a_ready(nxt);
            if constexpr (SP2) {
            PG8_LDB(B0, 0, 0); PG8_LDB(B1, 0, 1); PG8_SCHED; PG8_LDA(At, 0, 0); PG8_STAGE(PG8_SA(1, 1), a1 + hstep, voffA);
            PG8_WAIT_V(8); PG8_WAIT_L(0); PG8_BAR; PG8_MMA(0, 0, At, B0); PG8_MMA(0, 1, At, B1); PG8_BAR; PG8_SCHED;
            PG8_LDA(At, 0, 1); PG8_STAGE(PG8_SB(0, 0), b2, voffB); PG8_STAGE(PG8_SB(0, 1), b2 + hstep, voffB); PG8_STAGE(PG8_SA(0, 0), a2, voffA);
            PG8_WAIT_V(8); PG8_WAIT_L(0); PG8_BAR; PG8_MMA(1, 0, At, B0); PG8_MMA(1, 1, At, B1); PG8_BAR; PG8_SCHED;
            PG8_LDB(B0, 1, 0); PG8_LDB(B1, 1, 1); PG8_SCHED; PG8_LDA(At, 1, 0); PG8_STAGE(PG8_SA(0, 1), a2 + hstep, voffA);
            PG8_WAIT_V(8); PG8_WAIT_L(0); PG8_BAR; PG8_MMA(0, 0, At, B0); PG8_MMA(0, 1, At, B1); PG8_BAR; PG8_SCHED;
            PG8_LDA(At, 1, 1); PG8_STAGE(PG8_SB(1, 0), b3, voffB); PG8_STAGE(PG8_SB(1, 1), b3 + hstep, voffB); PG8_STAGE(PG8_SA(1, 0), a3, voffA);
            PG8_WAIT_V(8); PG8_WAIT_L(0); PG8_BAR; PG8_MMA(1, 0, At, B0); PG8_MMA(1, 1, At, B1); PG8_BAR; PG8_SCHED;
            } else {
            PG8_LDB(B0, 0, 0); PG8_SCHED; PG8_LDA(At, 0, 0); PG8_STAGE(PG8_SA(1, 1), a1 + hstep, voffA);
            PG8_WAIT_L(8); PG8_BAR; PG8_WAIT_L(0); PG8_MMA(0, 0, At, B0); PG8_BAR; PG8_SCHED;
            PG8_LDB(B1, 0, 1); PG8_STAGE(PG8_SB(0, 0), b2, voffB);
            PG8_BAR; PG8_WAIT_L(0); PG8_MMA(0, 1, At, B1); PG8_BAR;
            PG8_LDA(At, 0, 1); PG8_STAGE(PG8_SA(0, 0), a2, voffA);
            PG8_BAR; PG8_WAIT_L(0); PG8_MMA(1, 0, At, B0); PG8_BAR; PG8_SCHED;
            PG8_STAGE(PG8_SB(0, 1), b2 + hstep, voffB);
            PG8_WAIT_V(6); PG8_BAR; PG8_MMA(1, 1, At, B1); PG8_BAR;
            PG8_LDB(B0, 1, 0); PG8_SCHED; PG8_LDA(At, 1, 0); PG8_STAGE(PG8_SA(0, 1), a2 + hstep, voffA);
            PG8_WAIT_L(8); PG8_BAR; PG8_WAIT_L(0); PG8_MMA(0, 0, At, B0); PG8_BAR; PG8_SCHED;
            PG8_LDB(B1, 1, 1); PG8_STAGE(PG8_SB(1, 0), b3, voffB);
            PG8_BAR; PG8_WAIT_L(0); PG8_MMA(0, 1, At, B1); PG8_BAR;
            PG8_LDA(At, 1, 1); PG8_STAGE(PG8_SA(1, 0), a3, voffA);
            PG8_BAR; PG8_WAIT_L(0); PG8_MMA(1, 0, At, B0); PG8_BAR; PG8_SCHED;
            PG8_STAGE(PG8_SB(1, 1), b3 + hstep, voffB);
            PG8_WAIT_V(6); PG8_BAR; PG8_MMA(1, 1, At, B1); PG8_BAR;
            }
        }
        if constexpr (ALIGN_EPI) { if (wr == 0) PG8_BAR; }
        if constexpr (!Epi::AFTER_DRAIN) { E(acc, cur, wr, wc, fr, fq); S.done(cur); }
        if (!has_next) break;
#pragma unroll
        for (int a = 0; a < 2; ++a)
#pragma unroll
            for (int b = 0; b < 2; ++b)
#pragma unroll
                for (int m = 0; m < 4; ++m)
#pragma unroll
                    for (int n = 0; n < 2; ++n) acc[a][b][m][n] = (f32x4){0.f, 0.f, 0.f, 0.f};
        cur = nxt; cA = nA; cB = nB; ++ui;
        if constexpr (ALIGN_EPI) { if (wr == 1) PG8_BAR; }
    }
    PG8_WAIT_V(0);
    if constexpr (!ALIGN_EPI) { if (wr == 0) PG8_BAR; }
    PG8_BAR;
    if constexpr (Epi::AFTER_DRAIN) { E.fused(acc, cur, wr, wc, fr, fq, lds, wid, lane); S.done(cur); }
#undef PG8_SA
#undef PG8_SB
#undef PG8_STAGE
#undef PG8_LDA
#undef PG8_LDB
#undef PG8_MMA
#undef PG8_WAIT_V
#undef PG8_WAIT_L
#undef PG8_BAR
#undef PG8_SCHED
}
}
#define GAS __attribute__((address_space(1)))
#define LAS __attribute__((address_space(3)))
typedef unsigned short bf16;
typedef unsigned v4u __attribute__((ext_vector_type(4)));
typedef float f32x4 __attribute__((ext_vector_type(4)));
typedef short bf16x8 __attribute__((ext_vector_type(8)));
typedef GAS unsigned gu32;
typedef GAS unsigned long long gu64;
#define RLX_AGENT __ATOMIC_RELAXED, __HIP_MEMORY_SCOPE_AGENT
#define LDS_WAIT() asm volatile("s_waitcnt lgkmcnt(0)" ::: "memory")
#define VM_WAIT() asm volatile("s_waitcnt vmcnt(0)" ::: "memory")
__device__ __forceinline__ unsigned long long rt() { return __builtin_amdgcn_s_memrealtime(); }
__device__ __forceinline__ unsigned f2bf(float f) { unsigned u = __builtin_bit_cast(unsigned, f); return (u + 0x7fffu + ((u >> 16) & 1u)) >> 16; }
__device__ __forceinline__ unsigned pk2(float lo, float hi) { return f2bf(lo) | (f2bf(hi) << 16); }

#define XB_TMO      128
#define XB_XCNT(j)  (256  + 64 * (j))
#define XB_XSUB(j)  (1280 + 64 * (j))
#define XB_XGEN(j)  (2304 + 64 * (j))
#define XB_TOP      3328
#define XB_TOPGEN   3392
#define XCD_BAR_WORDS 3456
#define XB_SPIN_CAP (1u << 25)

__device__ __forceinline__ unsigned xb_ld(unsigned* p)              { return __hip_atomic_load(p, __ATOMIC_RELAXED, __HIP_MEMORY_SCOPE_AGENT); }
__device__ __forceinline__ unsigned xb_add(unsigned* p, unsigned v) { return __hip_atomic_fetch_add(p, v, __ATOMIC_RELAXED, __HIP_MEMORY_SCOPE_AGENT); }
__device__ __forceinline__ unsigned xb_xcc_id() { return (unsigned)__builtin_amdgcn_s_getreg((3 << 11) | 20) & 0xFu; }
#define XB_SPIN(cond, bar) do { unsigned _sp = 0; while (cond) { __builtin_amdgcn_s_sleep(1); \
    if ((++_sp & 255u) == 0u) { if (xb_ld(&(bar)[XB_TMO])) break; if (_sp > XB_SPIN_CAP) { atomicAdd(&(bar)[XB_TMO], 1u); break; } } } } while (0)

struct XcdBarrier {
    unsigned* bar; unsigned x;
    volatile LAS unsigned* st;
};

__device__ __forceinline__ XcdBarrier xcd_barrier_post(unsigned* bar, volatile LAS unsigned* st) {
    XcdBarrier b; b.bar = bar; b.x = xb_xcc_id(); b.st = st;
    if (threadIdx.x == 0) (void)xb_add(&bar[XB_XCNT(b.x)], 1u);
    return b;
}
__device__ __forceinline__ void xcd_barrier_complete(unsigned* bar, unsigned x, unsigned& nloc, unsigned& nx) {
    const unsigned G = gridDim.x * gridDim.y * gridDim.z;
    unsigned sum, cnt, mine, sp = 0u;
    for (;;) {
        sum = 0u; cnt = 0u; mine = 0u;
#pragma unroll
        for (unsigned j = 0; j < 16; ++j) { const unsigned c = xb_ld(&bar[XB_XCNT(j)]); sum += c; cnt += (c > 0u) ? 1u : 0u; mine = (j == x) ? c : mine; }
        if (sum == G) break;
        __builtin_amdgcn_s_sleep(1);
        if ((++sp & 255u) == 0u) { if (xb_ld(&bar[XB_TMO])) break; if (sp > XB_SPIN_CAP) { atomicAdd(&bar[XB_TMO], 1u); break; } }
    }
    nloc = mine > 0u ? mine : 1u; nx = cnt > 0u ? cnt : 1u;
}

__device__ __forceinline__ void xcd_barrier(const XcdBarrier& b) {
    asm volatile("s_waitcnt vmcnt(0)" ::: "memory");
    __syncthreads();
    if (threadIdx.x == 0) {
        unsigned* bar = b.bar;
        __builtin_amdgcn_s_waitcnt(0);
        unsigned nloc = b.st[0], nx = b.st[1];
        if (nloc == 0u) { xcd_barrier_complete(bar, b.x, nloc, nx); b.st[0] = nloc; b.st[1] = nx; }
        const unsigned old = xb_add(&bar[XB_XSUB(b.x)], 1u);
        const unsigned gen = old / nloc;
        if (old + 1u == (gen + 1u) * nloc) {
            __builtin_amdgcn_fence(__ATOMIC_RELEASE, "agent");
            asm volatile("s_waitcnt vmcnt(0)" ::: "memory");
            const unsigned og = xb_add(&bar[XB_TOP], 1u);
            const unsigned tg = og / nx;
            if (og + 1u == (tg + 1u) * nx) xb_add(&bar[XB_TOPGEN], 1u);
            else XB_SPIN(xb_ld(&bar[XB_TOPGEN]) == tg, bar);
            __builtin_amdgcn_fence(__ATOMIC_ACQUIRE, "agent");
            xb_add(&bar[XB_XGEN(b.x)], 1u);
            asm volatile("s_waitcnt vmcnt(0)" ::: "memory");
        } else {
            XB_SPIN(xb_ld(&bar[XB_XGEN(b.x)]) == gen, bar);
            __builtin_amdgcn_fence(__ATOMIC_ACQUIRE, "agent");
            asm volatile("s_waitcnt vmcnt(0)" ::: "memory");
        }
    }
    __syncthreads();
}
constexpr int NB = 4, SEQ = 4096, DM = 1024, M = NB * SEQ, NL = 4;
constexpr int NIN = 3328;
constexpr int NWAVES = 8;
#ifndef PG8_SP2
#define PG8_SP2 false
#endif
constexpr float LOG2E = 1.4426950408889634f;
constexpr float C2 = 0.125f * LOG2E;
constexpr int MOE_ROWS = 40960;
constexpr size_t MiB = 1u << 20;
constexpr size_t WS_CTL = 0, CTL_ZERO_BYTES = 1 * MiB;
constexpr size_t WS_MOD = 1 * MiB;
constexpr size_t WS_TB = WS_MOD + 512 * 1024;
constexpr size_t WS_LAM = WS_TB + 64 * 1024;
constexpr size_t WS_KMEAN = WS_LAM + 4096;
constexpr size_t WS_WIN = 2 * MiB;
constexpr size_t WS_WOUT = 28 * MiB;
constexpr size_t WS_W13 = 36 * MiB;
constexpr size_t WS_W2 = 292 * MiB;
constexpr size_t WS_HB = 420 * MiB;
constexpr size_t WS_XS = 452 * MiB, WS_HS = 532 * MiB, WS_YS = 572 * MiB;
constexpr size_t WS_SMALL = 652 * MiB;
constexpr size_t WS_QD = 656 * MiB, WS_KD = 672 * MiB, WS_VD = 688 * MiB, WS_QM = 704 * MiB, WS_KM = 712 * MiB, WS_VM = 720 * MiB;
constexpr size_t WS_PR = 728 * MiB;
constexpr size_t WS_MIX = 784 * MiB;
constexpr size_t WS_OD = 816 * MiB;
constexpr size_t WS_RW = 848 * MiB;
constexpr size_t WS_END = 960 * MiB;
constexpr int CW_BAR = 4096;
constexpr int CW_CNT = 16384;
constexpr int CW_CUR = 16384 + 1024;
constexpr int RING_BYTES = 131072, LDSCTL_OFF = RING_BYTES, MISC_OFF = LDSCTL_OFF + 320, TAB_OFF = LDSCTL_OFF + 1024;
constexpr int LDS_BYTES = 147456;
static_assert(WS_QD == pg8::EPI_WS_QD && WS_KD == pg8::EPI_WS_KD && WS_VD == pg8::EPI_WS_VD && WS_QM == pg8::EPI_WS_QM && WS_KM == pg8::EPI_WS_KM && WS_VM == pg8::EPI_WS_VM && WS_PR == pg8::EPI_WS_PR, "epilogue workspace map");
__device__ __forceinline__ float wave_sum(float v) {
#pragma unroll
    for (int o = 1; o < 64; o <<= 1) v += __shfl_xor(v, o);
    return v;
}
__device__ __forceinline__ float wave_max(float v) {
#pragma unroll
    for (int o = 1; o < 64; o <<= 1) v = fmaxf(v, __shfl_xor(v, o));
    return v;
}
__device__ __forceinline__ float bf_lo(unsigned u) { return __uint_as_float(u << 16); }
__device__ __forceinline__ float bf_hi(unsigned u) { return __uint_as_float(u & 0xffff0000u); }
__device__ __forceinline__ float bf2f(bf16 h) { return __uint_as_float((unsigned)h << 16); }
__device__ __forceinline__ float rl(float v, int i) { return __uint_as_float(__builtin_amdgcn_readlane(__float_as_uint(v), i)); }
__device__ __forceinline__ float sigmoidf_(float x) { return 1.0f / (1.0f + __expf(-x)); }

struct Args { const float* in[33]; float* out; unsigned char* ws; };
struct Frame {
    LAS unsigned char* lds; volatile LAS unsigned* MISC; gu32* ctl;
    int tid, lane, wave, vcu, G, gw, NGW;
    float* out; unsigned char* ws;
};
__device__ __forceinline__ unsigned char* launder_ptr(unsigned char* p) { asm volatile("" : "+s"(p)); return p; }
#define WSP(T, off) ((T*)(launder_ptr(F.ws) + (off)))

template <class RowMap>
__device__ __forceinline__ void tr_item(const float* W, int N, int K, bf16* WT, LAS float* scr, int k0, int n0, int lane, RowMap rm) {
#pragma unroll 8
    for (int i = 0; i < 32; ++i) { const int kk = 2 * i + (lane >> 5); scr[kk * 33 + (lane & 31)] = W[(size_t)(k0 + kk) * N + n0 + (lane & 31)]; }
    LDS_WAIT(); asm volatile("" ::: "memory");
    const int c = lane & 7;
#pragma unroll
    for (int j = 0; j < 4; ++j) { const int n = (lane >> 3) + 8 * j; const LAS float* s = scr + (8 * c) * 33 + n;
        v4u o; o.x = pk2(s[0 * 33], s[1 * 33]); o.y = pk2(s[2 * 33], s[3 * 33]); o.z = pk2(s[4 * 33], s[5 * 33]); o.w = pk2(s[6 * 33], s[7 * 33]);
        *(GAS v4u*)(WT + (size_t)rm(n0 + n) * K + k0 + 8 * c) = o; }
    LDS_WAIT(); asm volatile("" ::: "memory");
}
__device__ __forceinline__ int inproj_row(int n) {
    const int L = n < 896 ? 2304 + n : n - 896;
    const int l = L & 255;
    return (L & ~255) | (((l >> 5) & 1) << 7) | ((l >> 6) << 5) | (l & 31);
}
__device__ __forceinline__ int t5_bucket(int n) {
    if (n < 16) return n;
    const float x = (8.0f * __log2f((float)n) - 32.0f) * (1.0f / 3.0f) + 1e-4f;
    int b = 16 + (int)x; return b > 31 ? 31 : b;
}
__device__ __forceinline__ void p0_prologue(Frame& F, const Args& A) {
    LAS float* scr = (LAS float*)(F.lds + F.wave * 16384);
    {
        constexpr int I_IN = 16 * 100, I_OUT = 16 * 32, I_W1 = 16 * 16, I_W2 = 8 * 32;
        constexpr int N_IN = NL * I_IN, N_OUT = NL * I_OUT, N_W1 = NL * 32 * I_W1, N_W2 = NL * 32 * I_W2;
        constexpr int NITEMS = N_IN + N_OUT + 2 * N_W1 + N_W2;
        for (int it = F.gw; it < NITEMS; it += F.NGW) {
            int r = it;
            if (r < N_IN) { const int l = r / I_IN, q = r % I_IN, kb = q / 100, nb = q % 100;
                tr_item(A.in[6] + (size_t)l * 1024 * 3200, 3200, 1024, WSP(bf16, WS_WIN) + (size_t)l * NIN * 1024, scr, 64 * kb, 32 * nb, F.lane, [](int n) { return inproj_row(n); }); continue; }
            r -= N_IN;
            if (r < N_OUT) { const int l = r / I_OUT, q = r % I_OUT, kb = q / 32, nb = q % 32;
                tr_item(A.in[7] + (size_t)l * 1024 * 1024, 1024, 1024, WSP(bf16, WS_WOUT) + (size_t)l * 1024 * 1024, scr, 64 * kb, 32 * nb, F.lane, [](int n) { return n; }); continue; }
            r -= N_OUT;
            if (r < 2 * N_W1) { const int which = r / N_W1; r %= N_W1; const int le = r / I_W1, q = r % I_W1, kb = q / 16, nb = q % 16;
                const float* W = A.in[which ? 31 : 30] + (size_t)le * 1024 * 512; bf16* WT = WSP(bf16, WS_W13) + (size_t)le * 1024 * 1024;
                if (which == 0) tr_item(W, 512, 1024, WT, scr, 64 * kb, 32 * nb, F.lane, [](int n) { return 8 * (n >> 2) + (n & 3); });
                else            tr_item(W, 512, 1024, WT, scr, 64 * kb, 32 * nb, F.lane, [](int n) { return 8 * (n >> 2) + 4 + (n & 3); });
                continue; }
            r -= 2 * N_W1;
            { const int le = r / I_W2, q = r % I_W2, kb = q / 32, nb = q % 32;
                tr_item(A.in[32] + (size_t)le * 512 * 1024, 1024, 512, WSP(bf16, WS_W2) + (size_t)le * 1024 * 512, scr, 64 * kb, 32 * nb, F.lane, [](int n) { return n; }); }
        }
    }
    __syncthreads();
    {
        LAS float* cs = (LAS float*)F.lds;
        LAS float* red = cs + 4096;
        for (int i = F.tid; i < 4096; i += 512) { const float v = A.in[1][i]; cs[i] = v / (1.0f + __expf(-v)); }
        __syncthreads();
        const int kp = F.tid >> 6, jj = F.tid & 63;
        for (int it = F.vcu; it < NL * 96; it += F.G) {
            const int l = it / 96, j = (it % 96) * 64 + jj;
            const float* w = A.in[2] + (size_t)l * 1024 * 6144 + j;
            float a0 = 0.f, a1 = 0.f, a2 = 0.f, a3 = 0.f;
#pragma unroll 4
            for (int k = kp * 128; k < kp * 128 + 128; ++k) { const float wv = w[(size_t)k * 6144]; a0 += cs[k] * wv; a1 += cs[1024 + k] * wv; a2 += cs[2048 + k] * wv; a3 += cs[3072 + k] * wv; }
            red[(kp * 4 + 0) * 64 + jj] = a0; red[(kp * 4 + 1) * 64 + jj] = a1; red[(kp * 4 + 2) * 64 + jj] = a2; red[(kp * 4 + 3) * 64 + jj] = a3;
            __syncthreads();
            if (F.tid < 256) { const int b = F.tid >> 6; float s = A.in[3][l * 6144 + j];
#pragma unroll
                for (int q = 0; q < 8; ++q) s += red[(q * 4 + b) * 64 + jj];
                WSP(float, WS_MOD)[((size_t)l * NB + b) * 6144 + j] = s; }
            __syncthreads();
        }
    }
    for (int i = F.gw * 64 + F.lane; i < 8 * 1024; i += F.NGW * 64) { const int hh = i >> 10, d = i & 1023; WSP(float, WS_TB)[i] = A.in[25][t5_bucket(d) * 8 + hh] * LOG2E; }
    if (F.vcu == 0 && F.tid < NL) { const int l = F.tid; const float* lm = A.in[21] + l * 256; float s01 = 0.f, s23 = 0.f;
        for (int i = 0; i < 64; ++i) { s01 += lm[i] * lm[64 + i]; s23 += lm[128 + i] * lm[192 + i]; }
        WSP(float, WS_LAM)[l] = __expf(s01) - __expf(s23) + (0.8f - 0.6f * __expf(-0.3f * (float)l)); }
}

__device__ __forceinline__ void phase_norm1(Frame& F, const Args& A, int l) {
    const float* xin = (l == 0) ? A.in[0] : F.out;
    const bf16* YS = WSP(bf16, WS_YS); const int* POS = WSP(int, WS_SMALL) + 4 * M;
    for (int m = F.gw; m < M; m += F.NGW) {
        const int b = m / SEQ;
        f32x4 v[4];
#pragma unroll
        for (int j = 0; j < 4; ++j) v[j] = *((const GAS f32x4*)(xin + (size_t)m * DM) + F.lane + 64 * j);
        if (l > 0) {
            const int p0 = POS[2 * m], p1 = POS[2 * m + 1];
            const float* g2 = WSP(float, WS_MOD) + ((size_t)(l - 1) * NB + b) * 6144 + 5 * 1024;
#pragma unroll
            for (int j = 0; j < 4; ++j) { const int c = 4 * (F.lane + 64 * j);
                const uint2 ya = *(const uint2*)(YS + (size_t)p0 * DM + c), yb = *(const uint2*)(YS + (size_t)p1 * DM + c);
                const f32x4 gg = *(const f32x4*)(g2 + c);
                v[j].x += gg.x * (bf_lo(ya.x) + bf_lo(yb.x)); v[j].y += gg.y * (bf_hi(ya.x) + bf_hi(yb.x));
                v[j].z += gg.z * (bf_lo(ya.y) + bf_lo(yb.y)); v[j].w += gg.w * (bf_hi(ya.y) + bf_hi(yb.y)); }
        }
        if (l == 0 || l > 0) {
#pragma unroll
            for (int j = 0; j < 4; ++j) *((GAS f32x4*)(F.out + (size_t)m * DM) + F.lane + 64 * j) = v[j];
        }
        if (l == NL) continue;
        float ss = 0.f;
#pragma unroll
        for (int j = 0; j < 4; ++j) ss += (v[j].x * v[j].x + v[j].y * v[j].y) + (v[j].z * v[j].z + v[j].w * v[j].w);
        const float rstd = 1.0f / sqrtf(wave_sum(ss) * (1.0f / DM) + 1e-6f);
        const float* mod = WSP(float, WS_MOD) + ((size_t)l * NB + b) * 6144;
        const float* ng = A.in[4] + l * DM;
        bf16* hrow = WSP(bf16, WS_HB) + (size_t)m * DM;
#pragma unroll
        for (int j = 0; j < 4; ++j) { const int c = 4 * (F.lane + 64 * j);
            const f32x4 g = *(const f32x4*)(ng + c), sh = *(const f32x4*)(mod + c), sc = *(const f32x4*)(mod + 1024 + c);
            const float h0 = v[j].x * rstd * g.x * (1.f + sc.x) + sh.x, h1 = v[j].y * rstd * g.y * (1.f + sc.y) + sh.y;
            const float h2 = v[j].z * rstd * g.z * (1.f + sc.z) + sh.z, h3 = v[j].w * rstd * g.w * (1.f + sc.w) + sh.w;
            uint2 o; o.x = pk2(h0, h1); o.y = pk2(h2, h3); *(uint2*)(hrow + c) = o; }
    }
}
__device__ __forceinline__ void phase_postproj(Frame& F, const Args& A, int l) {
    const float* PR = WSP(float, WS_PR);
    float* RW = WSP(float, WS_RW); constexpr size_t RS = (size_t)M * 256;
    const float* mu = A.in[8] + l * 896; const float* w0 = A.in[9] + l * 256; const float* w2 = A.in[10] + l * 32 * 256;
    const float* a0 = A.in[11] + l * 256; const float* a2 = A.in[12] + l * 32 * 256; const float* g2 = A.in[13] + l * 64 * 256;
    const float* kkw = A.in[14] + l * 256; const float* kaw = A.in[15] + l * 256;
    for (int m = F.gw; m < M; m += F.NGW) {
        asm volatile("" : "+s"(w2), "+s"(a2), "+s"(g2));
        const int t = m % SEQ; const float* cur = PR + (size_t)m * 896; const float* prv = cur - 896;
        float ps[14];
#pragma unroll
        for (int q = 0; q < 14; ++q) { const int c = F.lane + 64 * q; const float x = cur[c]; const float xp = t > 0 ? prv[c] : 0.f; ps[q] = x + (xp - x) * mu[c]; }
        const float twd = tanhf(ps[12]);
        const float adv = ps[12];
        const float sgd = sigmoidf_(ps[13]);
        float wp[4], ap[4], gp[4];
#pragma unroll
        for (int q = 0; q < 4; ++q) { wp[q] = w0[F.lane + 64 * q]; ap[q] = a0[F.lane + 64 * q]; gp[q] = 0.f; }
#pragma unroll 2
        for (int i = 0; i < 32; ++i) { const float tw = rl(twd, i), av = rl(adv, 32 + i);
#pragma unroll
            for (int q = 0; q < 4; ++q) { wp[q] += tw * w2[i * 256 + F.lane + 64 * q]; ap[q] += av * a2[i * 256 + F.lane + 64 * q]; } }
#pragma unroll 4
        for (int i = 0; i < 64; ++i) { const float gv = rl(sgd, i);
#pragma unroll
            for (int q = 0; q < 4; ++q) gp[q] += gv * g2[i * 256 + F.lane + 64 * q]; }
#pragma unroll
        for (int q = 0; q < 4; ++q) {
            const int c = F.lane + 64 * q; const size_t o = (size_t)m * 256 + c;
            const float r = ps[q], k = ps[4 + q], v = ps[8 + q];
            const float xw = -wp[q];
            const float sp = xw > 15.f ? xw : log1pf(__expf(xw));
            const float w = -sp - 0.5f;
            const float dec = __expf(-__expf(w));
            const float a = sigmoidf_(ap[q]);
            const float kk = k * kkw[c];
            const float nrm = sqrtf(wave_sum(kk * kk));
            const float kkn = kk / fmaxf(nrm, 1e-12f);
            const float k2 = k * (1.f + (a - 1.f) * kaw[c]);
            RW[0 * RS + o] = r; RW[1 * RS + o] = dec; RW[2 * RS + o] = k2; RW[3 * RS + o] = v; RW[4 * RS + o] = kkn; RW[5 * RS + o] = kkn * a; RW[6 * RS + o] = gp[q];
        }
    }
    { const bf16* KM = WSP(bf16, WS_KM); float* KMEAN = WSP(float, WS_KMEAN);
      for (int i = F.gw * 64 + F.lane; i < NB * 16 * 256; i += F.NGW * 64) { const int c = i & 255, n = (i >> 8) & 15, b = i >> 12;
          const bf16* p = KM + ((size_t)b * SEQ + n * 256) * 256 + c; float s = 0.f;
          for (int t = 0; t < 256; ++t) s += bf2f(p[(size_t)t * 256]);
          KMEAN[(((size_t)b * 4 + (c >> 6)) * 16 + n) * 64 + (c & 63)] = s * (1.0f / 256.0f); } }
}

__device__ __forceinline__ void rwkv_scan_naive(Frame& F, const Args& A, int l, int b, int h) {
    const float* RW = WSP(const float, WS_RW); constexpr size_t RS = (size_t)M * 256;
    bf16* MIX = WSP(bf16, WS_MIX);
    const float lng = A.in[17][l * 256 + h * 64 + F.lane], lnb = A.in[18][l * 256 + h * 64 + F.lane], rk = A.in[16][l * 256 + h * 64 + F.lane];
    float S[64];
#pragma unroll
    for (int i = 0; i < 64; ++i) S[i] = 0.f;
    size_t o = ((size_t)b * SEQ) * 256 + h * 64 + F.lane;
    float r = RW[o], dec = RW[RS + o], k = RW[2 * RS + o], v = RW[3 * RS + o], kk = RW[4 * RS + o], bb = RW[5 * RS + o], g = RW[6 * RS + o];
    for (int t = 0; t < SEQ; ++t) {
        const size_t on = (t + 1 < SEQ) ? o + 256 : o;
        const float rn = RW[on], decn = RW[RS + on], kn = RW[2 * RS + on], vn = RW[3 * RS + on], kkn = RW[4 * RS + on], bbn = RW[5 * RS + on], gn = RW[6 * RS + on];
        float sa = 0.f;
#pragma unroll
        for (int i = 0; i < 64; ++i) sa -= S[i] * rl(kk, i);
        float y = 0.f;
#pragma unroll
        for (int i = 0; i < 64; ++i) { S[i] = S[i] * rl(dec, i) + sa * rl(bb, i) + v * rl(k, i); y += S[i] * rl(r, i); }
        const float mean = wave_sum(y) * (1.0f / 64.0f); const float d = y - mean; const float var = wave_sum(d * d) * (1.0f / 64.0f);
        const float bonus = wave_sum(r * k * rk) * v;
        const float outv = (d * (1.0f / sqrtf(var + 64e-5f)) * lng + lnb + bonus) * g;
        MIX[((size_t)b * SEQ + t) * 1024 + h * 64 + F.lane] = (bf16)f2bf(outv);
        o = on; r = rn; dec = decn; k = kn; v = vn; kk = kkn; bb = bbn; g = gn;
    }
}
template <int NMAP, int DV>
__device__ __forceinline__ void attn_chunk_naive(const unsigned (&qpk)[NMAP][32], const bf16* Kp, int kpitch, int kmapstride, const bf16* Vp, int vpitch,
                                                 int key0, int q, bool causal, const float* tb, float (&mrun)[NMAP], float (&lrun)[NMAP], float (&O)[NMAP][DV / 64], int lane) {
    const int key = key0 + lane; const int dist = q - key;
    const float bias = tb[dist < 0 ? 0 : (dist > 1023 ? 1023 : dist)];
    const bool valid = !causal || dist >= 0;
    float p[NMAP];
#pragma unroll
    for (int mp = 0; mp < NMAP; ++mp) {
        const uint4* kr = (const uint4*)(Kp + (size_t)key * kpitch + mp * kmapstride); float s = 0.f;
#pragma unroll
        for (int c = 0; c < 8; ++c) { const uint4 kv = kr[c];
            s += bf_lo(kv.x) * bf_lo(qpk[mp][4 * c]) + bf_hi(kv.x) * bf_hi(qpk[mp][4 * c]) + bf_lo(kv.y) * bf_lo(qpk[mp][4 * c + 1]) + bf_hi(kv.y) * bf_hi(qpk[mp][4 * c + 1])
               + bf_lo(kv.z) * bf_lo(qpk[mp][4 * c + 2]) + bf_hi(kv.z) * bf_hi(qpk[mp][4 * c + 2]) + bf_lo(kv.w) * bf_lo(qpk[mp][4 * c + 3]) + bf_hi(kv.w) * bf_hi(qpk[mp][4 * c + 3]); }
        s = valid ? s + bias : -INFINITY;
        const float mn = fmaxf(mrun[mp], wave_max(s));
        const float alpha = exp2f(mrun[mp] - mn);
        p[mp] = exp2f(s - mn);
        lrun[mp] = lrun[mp] * alpha + wave_sum(p[mp]); mrun[mp] = mn;
#pragma unroll
        for (int j = 0; j < DV / 64; ++j) O[mp][j] *= alpha;
    }
    const bf16* vb = Vp + (size_t)key0 * vpitch + lane;
#pragma unroll 16
    for (int kx = 0; kx < 64; ++kx) {
        float vv[DV / 64];
#pragma unroll
        for (int j = 0; j < DV / 64; ++j) vv[j] = bf2f(vb[(size_t)kx * vpitch + 64 * j]);
#pragma unroll
        for (int mp = 0; mp < NMAP; ++mp) { const float pk = __shfl(p[mp], kx);
#pragma unroll
            for (int j = 0; j < DV / 64; ++j) O[mp][j] += pk * vv[j]; }
    }
}
__device__ __forceinline__ void diff_row_naive(Frame& F, const Args& A, int l, int b, int h, int q) {
    const size_t row = (size_t)b * SEQ + q;
    const bf16* Q = WSP(bf16, WS_QD) + row * 512 + h * 128; const bf16* K = WSP(bf16, WS_KD) + (size_t)b * SEQ * 512 + h * 128; const bf16* V = WSP(bf16, WS_VD) + (size_t)b * SEQ * 512 + h * 128;
    unsigned qpk[2][32];
#pragma unroll
    for (int mp = 0; mp < 2; ++mp)
#pragma unroll
        for (int i = 0; i < 32; ++i) qpk[mp][i] = ((const unsigned*)(Q + mp * 64))[i];
    float mrun[2] = {-INFINITY, -INFINITY}, lrun[2] = {0.f, 0.f}, O[2][2] = {{0.f, 0.f}, {0.f, 0.f}};
    const float* tb = WSP(float, WS_TB) + h * 1024;
    for (int c = 0; c * 64 <= q; ++c) attn_chunk_naive<2, 128>(qpk, K, 512, 64, V, 512, c * 64, q, true, tb, mrun, lrun, O, F.lane);
    const float lam = WSP(float, WS_LAM)[l]; const float li = 0.8f - 0.6f * __expf(-0.3f * (float)l);
    float o0 = O[0][0] / lrun[0] - lam * O[1][0] / lrun[1], o1 = O[0][1] / lrun[0] - lam * O[1][1] / lrun[1];
    const float rs = 1.0f / sqrtf(wave_sum(o0 * o0 + o1 * o1) * (1.0f / 128.0f) + 1e-6f);
    const float* sg = A.in[22] + l * 128;
    bf16* mx = WSP(bf16, WS_MIX) + row * 1024 + 256 + h * 128;
    mx[F.lane] = (bf16)f2bf(o0 * rs * sg[F.lane] * (1.f - li)); mx[64 + F.lane] = (bf16)f2bf(o1 * rs * sg[64 + F.lane] * (1.f - li));
}
__device__ __forceinline__ void moba_row_naive(Frame& F, const Args& A, int l, int b, int h, int q) {
    const size_t row = (size_t)b * SEQ + q;
    const bf16* Q = WSP(bf16, WS_QM) + row * 256 + h * 64; const bf16* K = WSP(bf16, WS_KM) + (size_t)b * SEQ * 256 + h * 64; const bf16* V = WSP(bf16, WS_VM) + (size_t)b * SEQ * 256 + h * 64;
    unsigned qpk[1][32];
#pragma unroll
    for (int i = 0; i < 32; ++i) qpk[0][i] = ((const unsigned*)Q)[i];
    const int own = q >> 8;
    float gate = -INFINITY;
    if (F.lane < own) { const float* km = WSP(float, WS_KMEAN) + (((size_t)b * 4 + h) * 16 + F.lane) * 64; float s = 0.f;
#pragma unroll
        for (int i = 0; i < 32; ++i) s += bf_lo(qpk[0][i]) * km[2 * i] + bf_hi(qpk[0][i]) * km[2 * i + 1];
        gate = s; }
    unsigned sel = 0u;
    for (int it = 0; it < 3; ++it) { const float mx = wave_max(gate); if (mx == -INFINITY) break;
        const unsigned long long bal = __ballot(gate == mx); const int idx = __ffsll((long long)bal) - 1; sel |= 1u << idx; if (F.lane == idx) gate = -INFINITY; }
    float mrun[1] = {-INFINITY}, lrun[1] = {0.f}, O[1][1] = {{0.f}};
    const float* tb = WSP(float, WS_TB) + (4 + h) * 1024;
    for (int c = 0; c * 64 <= q - own * 256; ++c) attn_chunk_naive<1, 64>(qpk, K, 256, 0, V, 256, own * 256 + c * 64, q, true, tb, mrun, lrun, O, F.lane);
    for (int n = 0; n < own; ++n) if ((sel >> n) & 1u)
        for (int c = 0; c < 4; ++c) attn_chunk_naive<1, 64>(qpk, K, 256, 0, V, 256, n * 256 + c * 64, q, false, tb, mrun, lrun, O, F.lane);
    WSP(bf16, WS_MIX)[row * 1024 + 768 + h * 64 + F.lane] = (bf16)f2bf(O[0][0] / lrun[0]);
}
__device__ __forceinline__ void phase_mixer_naive(Frame& F, const Args& A, int l) {
    constexpr int N_SCAN = NB * 4, N_ROWS = NB * 4 * SEQ;
    for (int it = F.gw; it < N_SCAN + 2 * N_ROWS; it += F.NGW) {
        if (it < N_SCAN) { rwkv_scan_naive(F, A, l, it >> 2, it & 3); continue; }
        int r = it - N_SCAN;
        if (r < N_ROWS) { const int q = SEQ - 1 - (r >> 4), bh = r & 15; diff_row_naive(F, A, l, bh >> 2, bh & 3, q); continue; }
        r -= N_ROWS;
        { const int q = SEQ - 1 - (r >> 4), bh = r & 15; moba_row_naive(F, A, l, bh >> 2, bh & 3, q); }
    }
}
__device__ __forceinline__ void phase_router(Frame& F, const Args& A, int l) {
    const float* wg = A.in[26] + (size_t)l * 1024 * 4; const float* bg = A.in[27] + l * 4;
    const float* we = A.in[28] + (size_t)l * 1024 * 32; const float* be = A.in[29] + l * 32;
    int* EID = WSP(int, WS_SMALL); float* GT = WSP(float, WS_SMALL) + 2 * M;
    unsigned* cnt = (unsigned*)(F.ctl + CW_CNT + l * 64);
    for (int m = F.gw; m < M; m += F.NGW) {
        const int b = m / SEQ;
        f32x4 v[4];
#pragma unroll
        for (int j = 0; j < 4; ++j) v[j] = *((const GAS f32x4*)(F.out + (size_t)m * DM) + F.lane + 64 * j);
        float ss = 0.f;
#pragma unroll
        for (int j = 0; j < 4; ++j) ss += (v[j].x * v[j].x + v[j].y * v[j].y) + (v[j].z * v[j].z + v[j].w * v[j].w);
        const float rstd = 1.0f / sqrtf(wave_sum(ss) * (1.0f / DM) + 1e-6f);
        const float* mod = WSP(float, WS_MOD) + ((size_t)l * NB + b) * 6144;
        const float* ng = A.in[5] + l * DM;
        bf16* hrow = WSP(bf16, WS_HB) + (size_t)m * DM;
        float gl[4] = {0.f, 0.f, 0.f, 0.f};
#pragma unroll
        for (int j = 0; j < 4; ++j) { const int c = 4 * (F.lane + 64 * j);
            const f32x4 g = *(const f32x4*)(ng + c), sh = *(const f32x4*)(mod + 3072 + c), sc = *(const f32x4*)(mod + 4096 + c);
            v[j].x = v[j].x * rstd * g.x * (1.f + sc.x) + sh.x; v[j].y = v[j].y * rstd * g.y * (1.f + sc.y) + sh.y;
            v[j].z = v[j].z * rstd * g.z * (1.f + sc.z) + sh.z; v[j].w = v[j].w * rstd * g.w * (1.f + sc.w) + sh.w;
            uint2 o; o.x = pk2(v[j].x, v[j].y); o.y = pk2(v[j].z, v[j].w); *(uint2*)(hrow + c) = o;
#pragma unroll
            for (int e = 0; e < 4; ++e) { const f32x4 w4 = *(const f32x4*)(wg + (size_t)(c + e) * 4); const float hv = v[j][e];
                gl[0] += hv * w4.x; gl[1] += hv * w4.y; gl[2] += hv * w4.z; gl[3] += hv * w4.w; } }
#pragma unroll
        for (int g = 0; g < 4; ++g) gl[g] = wave_sum(gl[g]) + bg[g];
        int gs = 0; float gm = gl[0];
#pragma unroll
        for (int g = 1; g < 4; ++g) if (gl[g] > gm) { gm = gl[g]; gs = g; }
        float den = 0.f;
#pragma unroll
        for (int g = 0; g < 4; ++g) den += __expf(gl[g] - gm);
        const float pg_top = 1.0f / den;
        float el[8] = {0.f, 0.f, 0.f, 0.f, 0.f, 0.f, 0.f, 0.f};
#pragma unroll
        for (int j = 0; j < 4; ++j) { const int c = 4 * (F.lane + 64 * j);
#pragma unroll
            for (int e = 0; e < 4; ++e) { const float* wr_ = we + (size_t)(c + e) * 32 + gs * 8; const f32x4 wa = *(const f32x4*)wr_, wb = *(const f32x4*)(wr_ + 4); const float hv = v[j][e];
                el[0] += hv * wa.x; el[1] += hv * wa.y; el[2] += hv * wa.z; el[3] += hv * wa.w; el[4] += hv * wb.x; el[5] += hv * wb.y; el[6] += hv * wb.z; el[7] += hv * wb.w; } }
#pragma unroll
        for (int e = 0; e < 8; ++e) el[e] = wave_sum(el[e]) + be[gs * 8 + e];
        int e1 = 0; float m1 = el[0];
#pragma unroll
        for (int e = 1; e < 8; ++e) if (el[e] > m1) { m1 = el[e]; e1 = e; }
        int e2 = -1; float m2 = -INFINITY;
#pragma unroll
        for (int e = 0; e < 8; ++e) if (e != e1 && el[e] > m2) { m2 = el[e]; e2 = e; }
        const float ex = __expf(m2 - m1);
        const float g1 = pg_top / (1.f + ex), g2 = pg_top * ex / (1.f + ex);
        if (F.lane == 0) { const int E1 = gs * 8 + e1, E2 = gs * 8 + e2; EID[2 * m] = E1; EID[2 * m + 1] = E2; GT[2 * m] = g1; GT[2 * m + 1] = g2;
            atomicAdd(cnt + E1, 1u); atomicAdd(cnt + E2, 1u); }
    }
}
__device__ __forceinline__ void moe_tables(Frame& F, const Args& A, int l) {
    LAS int* base = (LAS int*)(F.lds + TAB_OFF); LAS int* t2e = base + 64;
    const unsigned* cnt = (const unsigned*)(F.ctl + CW_CNT + l * 64);
    if (F.tid == 0) { int acc = 0; for (int e = 0; e < 32; ++e) { base[e] = acc; const int c = (int)__hip_atomic_load(cnt + e, __ATOMIC_RELAXED, __HIP_MEMORY_SCOPE_AGENT); acc += (c + 255) / 256 * 256; } base[32] = acc; }
    __syncthreads();
    if (F.tid < 160) { const int r0 = F.tid * 256; int e = 31; for (int x = 0; x < 32; ++x) if (r0 >= base[x] && r0 < base[x + 1]) e = x; t2e[F.tid] = e; }
    __syncthreads();
}
__device__ __forceinline__ void phase_scatter(Frame& F, const Args& A, int l) {
    moe_tables(F, A, l);
    LAS int* base = (LAS int*)(F.lds + TAB_OFF);
    const int* EID = WSP(int, WS_SMALL); const float* GT = WSP(float, WS_SMALL) + 2 * M; int* POS = WSP(int, WS_SMALL) + 4 * M; float* GS = WSP(float, WS_SMALL) + 6 * M;
    unsigned* cur = (unsigned*)(F.ctl + CW_CUR + l * 64); const unsigned* cnt = (const unsigned*)(F.ctl + CW_CNT + l * 64);
    const bf16* HB = WSP(bf16, WS_HB); bf16* XS = WSP(bf16, WS_XS);
    for (int m = F.gw; m < M; m += F.NGW) {
        v4u hv[2];
#pragma unroll
        for (int j = 0; j < 2; ++j) hv[j] = *((const GAS v4u*)(HB + (size_t)m * DM) + F.lane + 64 * j);
#pragma unroll
        for (int k = 0; k < 2; ++k) {
            int pos = 0;
            if (F.lane == 0) { const int e = EID[2 * m + k]; pos = base[e] + (int)atomicAdd(cur + e, 1u); POS[2 * m + k] = pos; GS[pos] = GT[2 * m + k]; }
            pos = __builtin_amdgcn_readfirstlane(pos);
#pragma unroll
            for (int j = 0; j < 2; ++j) *((GAS v4u*)(XS + (size_t)pos * DM) + F.lane + 64 * j) = hv[j];
        }
    }
    for (int it = F.gw; it < 32 * 256; it += F.NGW) { const int e = it >> 8, i = it & 255; const int c = (int)cnt[e]; const int npad = (c + 255) / 256 * 256 - c;
        if (i < npad) { const int pos = base[e] + c + i; const v4u z = {0u, 0u, 0u, 0u};
#pragma unroll
            for (int j = 0; j < 2; ++j) *((GAS v4u*)(XS + (size_t)pos * DM) + F.lane + 64 * j) = z;
            if (F.lane == 0) GS[pos] = 0.f; } }
}
__global__ void __launch_bounds__(NWAVES * 64, 2) mega_fwd(Args A) {
    extern __shared__ __attribute__((aligned(16))) unsigned char lds[];
    Frame F;
    F.lds = (LAS unsigned char*)lds; F.MISC = (volatile LAS unsigned*)(F.lds + MISC_OFF);
    F.tid = threadIdx.x; F.lane = F.tid & 63; F.wave = __builtin_amdgcn_readfirstlane(F.tid >> 6);
    F.G = gridDim.x; { const int bx = blockIdx.x; F.vcu = (F.G % 8 == 0) ? (bx % 8) * (F.G / 8) + bx / 8 : bx; }
    F.gw = F.vcu * NWAVES + F.wave; F.NGW = F.G * NWAVES;
    F.out = A.out; F.ws = A.ws; F.ctl = (gu32*)(A.ws + WS_CTL);
    for (int u = F.tid; u < (LDS_BYTES - LDSCTL_OFF) / 4; u += NWAVES * 64) ((LAS unsigned*)(F.lds + LDSCTL_OFF))[u] = 0u;
    __syncthreads();
    XcdBarrier bar = xcd_barrier_post((unsigned*)(F.ctl + CW_BAR), F.MISC + 8);
#define GRID_BAR() xcd_barrier(bar)

    constexpr int NSTEP = 1 + NL * 10 + 1;
    for (int step = 0; step < NSTEP; ++step) {
        const int l = (step - 1) / 10, ph = (step == 0) ? -1 : ((step == NSTEP - 1) ? 10 : (step - 1) % 10);
        { int t_ = threadIdx.x; asm volatile("" : "+v"(t_)); F.tid = t_; F.lane = t_ & 63; F.wave = __builtin_amdgcn_readfirstlane(t_ >> 6); F.gw = F.vcu * NWAVES + F.wave; }
        switch (ph) {
        case -1:
#ifndef SK_P0
            p0_prologue(F, A);
#endif
            break;
        case 0:
#ifndef SK_N1
            phase_norm1(F, A, l);
#endif
            break;
        case 1: {
#ifndef SK_GIN
            pg8::Gemm g{WSP(bf16, WS_HB), WSP(bf16, WS_WIN) + (size_t)l * NIN * 1024, M, NIN, DM, 0};
            pg8::StaticOrder S; S.init(M, NIN, F.G, (int)blockIdx.x);
            pg8::EpiInProj E{F.ws, A.in, l, C2};
            pg8::gemm_phase<pg8::EpiInProj, pg8::StaticOrder, true, PG8_SP2>(F.lds, g, S, E);
#endif
            break; }
        case 2:
#ifndef SK_PP
            phase_postproj(F, A, l);
#endif
            break;
        case 3:
#ifndef SK_MX
            phase_mixer_naive(F, A, l);
#endif
            break;
        case 4: {
#ifndef SK_GOUT
            pg8::Gemm g{WSP(bf16, WS_MIX), WSP(bf16, WS_WOUT) + (size_t)l * 1024 * 1024, M, DM, DM, 0};
            pg8::StaticOrder S; S.init(M, DM, F.G, (int)blockIdx.x);
            pg8::EpiResid E{F.out, WSP(float, WS_MOD) + (size_t)l * NB * 6144 + 2048, SEQ, 6144};
            pg8::gemm_phase<pg8::EpiResid, pg8::StaticOrder, true, PG8_SP2>(F.lds, g, S, E);
#endif
            break; }
        case 5:
#ifndef SK_R1
            phase_router(F, A, l);
#endif
            break;
        case 6:
#ifndef SK_R2
            phase_scatter(F, A, l);
#endif
            break;
        case 7: {
#ifndef SK_MOE
            moe_tables(F, A, l);
            const LAS int* base = (const LAS int*)(F.lds + TAB_OFF);
            pg8::MoeOrder S{base + 64, base[32] / 256, 4, F.G, (int)blockIdx.x};
            pg8::Gemm g1{WSP(bf16, WS_XS), WSP(bf16, WS_W13) + (size_t)l * 32 * 1024 * 1024, MOE_ROWS, 1024, 1024, (size_t)1024 * 1024 * 2};
            pg8::EpiSwiGLU E1{WSP(bf16, WS_HS)};
            pg8::gemm_phase<pg8::EpiSwiGLU, pg8::MoeOrder, true, PG8_SP2>(F.lds, g1, S, E1);
#endif
            break; }
        case 8: {
#ifndef SK_MOE
            moe_tables(F, A, l);
            const LAS int* base = (const LAS int*)(F.lds + TAB_OFF);
            pg8::MoeOrder S{base + 64, base[32] / 256, 4, F.G, (int)blockIdx.x};
            pg8::Gemm g2{WSP(bf16, WS_HS), WSP(bf16, WS_W2) + (size_t)l * 32 * 1024 * 512, MOE_ROWS, 1024, 512, (size_t)1024 * 512 * 2};
            pg8::EpiMoeOut E2{WSP(bf16, WS_YS), WSP(float, WS_SMALL) + 6 * M};
            pg8::gemm_phase<pg8::EpiMoeOut, pg8::MoeOrder, true, PG8_SP2>(F.lds, g2, S, E2);
#endif
            break; }
        case 9: break;
        default:
            phase_norm1(F, A, NL);
            break;
        }
        if (step + 1 < NSTEP) GRID_BAR();
    }
}

extern "C" void kernel_launch(void* const* d_in, const int* in_sizes, int n_in, void* d_out, int out_size, void* d_ws, size_t ws_size, hipStream_t stream) {
    static int grid = 0;
    if (grid == 0) {
        if (n_in != 33 || out_size != M * DM || ws_size < WS_END) { fprintf(stderr, "kernel_launch: unexpected shapes (n_in %d, out %d, ws %zu < %zu)\n", n_in, out_size, ws_size, (size_t)WS_END); grid = -1; return; }
        int dev = 0, cus = 0;
        if (hipGetDevice(&dev) != hipSuccess || hipDeviceGetAttribute(&cus, hipDeviceAttributeMultiprocessorCount, dev) != hipSuccess) { grid = -1; return; }
        if (hipFuncSetAttribute((const void*)mega_fwd, hipFuncAttributeMaxDynamicSharedMemorySize, LDS_BYTES) != hipSuccess) { fprintf(stderr, "kernel_launch: hipFuncSetAttribute failed\n"); grid = -1; return; }
        int per_cu = 0;
        if (hipOccupancyMaxActiveBlocksPerMultiprocessor(&per_cu, (const void*)mega_fwd, NWAVES * 64, LDS_BYTES) != hipSuccess || per_cu < 1) fprintf(stderr, "kernel_launch: occupancy query says %d\n", per_cu);
        (void)hipGetLastError();
        grid = cus;
    }
    if (grid < 0) return;
    if (hipMemsetAsync((char*)d_ws + WS_CTL, 0, CTL_ZERO_BYTES, stream) != hipSuccess) { fprintf(stderr, "kernel_launch: memset failed\n"); return; }
    Args a{};
    for (int i = 0; i < 33; ++i) a.in[i] = (const float*)d_in[i];
    a.out = (float*)d_out; a.ws = (unsigned char*)d_ws;
    hipLaunchKernelGGL(mega_fwd, dim3(grid), dim3(NWAVES * 64), LDS_BYTES, stream, a);
}
```

```cpp
#include <hip/hip_runtime.h>
#include <cstdio>
#include <cstdint>
struct Args { const float* in[33]; float* out; unsigned char* ws; };
typedef const __attribute__((address_space(4))) Args KArgs;
namespace pg8 {
#define PG8_LAS __attribute__((address_space(3)))
typedef unsigned short bf16_t;
typedef short bf16x8 __attribute__((ext_vector_type(8)));
typedef float f32x4 __attribute__((ext_vector_type(4)));
typedef unsigned u32x4 __attribute__((ext_vector_type(4)));
constexpr int BM = 256, BK = 64, HALF = 128, HTB = HALF * BK * 2  , STAGE_BYTES = 8 * HTB, NXCD = 8, WGM = 8;

__host__ __device__ __forceinline__ int lds_byte(int r, int c) { const int st = (r >> 4) * 2 + (c >> 5), rr = r & 15, cc = c & 31, ob = rr * 64 + cc * 2; return st * 1024 + (ob ^ (((ob >> 9) & 1) << 5)); }
__host__ __device__ __forceinline__ void stage_rc(int b, int& R, int& C) { const int st = b / 1024, sb = b % 1024, swz = sb ^ (((sb >> 9) & 1) << 5); R = (st >> 1) * 16 + swz / 64; C = (st & 1) * 32 + (swz % 64) / 2; }
__host__ __device__ __forceinline__ int perm32(int rho) { const int n = rho >> 4, i = rho & 15; return 8 * (i >> 2) + 4 * n + (i & 3); }

struct Unit { int pm, pn, e; };
struct Gemm { const bf16_t* A; const bf16_t* Bt; int M, N, K; size_t estride; };

struct StaticOrder {
    int nM, nN, nwg, G, c;
    __host__ __device__ void init(int M, int N, int G_, int c_) { nM = M / BM; nN = N / BM; nwg = nM * nN; G = G_; c = c_; }
    __host__ __device__ bool next(int i, Unit& u) const {
        const long L = (long)i * G + c; if (L >= nwg) return false;
        int wgid = (int)L; { const int q = nwg / NXCD, r = nwg % NXCD, xcd = wgid % NXCD, off = wgid / NXCD; wgid = (xcd < r ? xcd * (q + 1) : r * (q + 1) + (xcd - r) * q) + off; }
        const int nig = WGM * nN, gid = wgid / nig, fm = gid * WGM, gsz = (nM - fm) < WGM ? (nM - fm) : WGM;
        u.pm = fm + ((wgid % nig) % gsz); u.pn = (wgid % nig) / gsz; u.e = 0; return true;
    }
    __device__ __forceinline__ void a_ready(const Unit&) const {}
    __device__ __forceinline__ void done(const Unit&) const {}
};

__device__ __forceinline__ unsigned cvt_pk_bf16(float lo, float hi) { unsigned r; asm volatile("v_cvt_pk_bf16_f32 %0, %1, %2" : "=v"(r) : "v"(lo), "v"(hi)); return r; }
typedef unsigned u32x2 __attribute__((ext_vector_type(2)));
constexpr size_t EPI_MiB = 1u << 20, EPI_WS_QD = 656 * EPI_MiB, EPI_WS_KD = 672 * EPI_MiB, EPI_WS_VD = 688 * EPI_MiB, EPI_WS_QM = 704 * EPI_MiB, EPI_WS_KM = 712 * EPI_MiB, EPI_WS_VM = 720 * EPI_MiB, EPI_WS_PR = 728 * EPI_MiB;

struct EpiInProj {
    static constexpr bool PERM = true, AFTER_DRAIN = false;
    unsigned char* ws; KArgs* ka; int l; float c2;
    __device__ __forceinline__ void operator()(const f32x4 (&acc)[2][2][4][2], const Unit& u, int wr, int wc, int fr, int fq) const {
        const int pn = u.pn; const int row0 = u.pm * BM + wr * 64 + fr;
        if (pn >= 9) {
            float* PR = (float*)(ws + EPI_WS_PR);
            const int cb = (pn - 9) * 256 + 64 * wc + 8 * fq;
#pragma unroll
            for (int ai = 0; ai < 2; ++ai)
#pragma unroll
                for (int m = 0; m < 4; ++m) { float* rowp = PR + (size_t)(row0 + ai * HALF + m * 16) * 896;
#pragma unroll
                    for (int bj = 0; bj < 2; ++bj)
#pragma unroll
                        for (int n = 0; n < 2; ++n) { const int c = cb + 32 * bj + 4 * n; if (c < 896) *(f32x4*)(rowp + c) = acc[ai][bj][m][n]; } }
            return;
        }
        bf16_t* dst; int ld, cbase; const float* gain = nullptr; float sc = 1.f;
        if (pn < 2) { dst = (bf16_t*)(ws + EPI_WS_QD); ld = 512; cbase = pn * 256; gain = ((const float*)(const __attribute__((address_space(1))) float*)ka->in[19]) + l * 64; sc = c2; }
        else if (pn < 4) { dst = (bf16_t*)(ws + EPI_WS_KD); ld = 512; cbase = (pn - 2) * 256; gain = ((const float*)(const __attribute__((address_space(1))) float*)ka->in[20]) + l * 64; }
        else if (pn < 6) { dst = (bf16_t*)(ws + EPI_WS_VD); ld = 512; cbase = (pn - 4) * 256; }
        else if (pn == 6) { dst = (bf16_t*)(ws + EPI_WS_QM); ld = 256; cbase = 0; gain = ((const float*)(const __attribute__((address_space(1))) float*)ka->in[23]) + l * 64; sc = c2; }
        else if (pn == 7) { dst = (bf16_t*)(ws + EPI_WS_KM); ld = 256; cbase = 0; gain = ((const float*)(const __attribute__((address_space(1))) float*)ka->in[24]) + l * 64; }
        else { dst = (bf16_t*)(ws + EPI_WS_VM); ld = 256; cbase = 0; }
        f32x4 gv[2][2];
#pragma unroll
        for (int bj = 0; bj < 2; ++bj)
#pragma unroll
            for (int n = 0; n < 2; ++n) gv[bj][n] = gain ? *(const f32x4*)(gain + 32 * bj + 8 * fq + 4 * n) * sc : (f32x4){1.f, 1.f, 1.f, 1.f};
        const int col0 = cbase + 64 * wc + 8 * fq;
#pragma unroll
        for (int ai = 0; ai < 2; ++ai)
#pragma unroll
            for (int m = 0; m < 4; ++m) {
                float rs = 1.f;
                if (gain) { float ss = 0.f;
#pragma unroll
                    for (int bj = 0; bj < 2; ++bj)
#pragma unroll
                        for (int n = 0; n < 2; ++n) { const f32x4 x = acc[ai][bj][m][n]; ss += (x[0] * x[0] + x[1] * x[1]) + (x[2] * x[2] + x[3] * x[3]); }
                    ss += __shfl_xor(ss, 16); ss += __shfl_xor(ss, 32);
                    rs = 1.0f / sqrtf(ss * (1.0f / 64.0f) + 1e-6f); }
                bf16_t* rowp = dst + (size_t)(row0 + ai * HALF + m * 16) * ld + col0;
#pragma unroll
                for (int bj = 0; bj < 2; ++bj) { const f32x4 v0 = acc[ai][bj][m][0] * rs * gv[bj][0], v1 = acc[ai][bj][m][1] * rs * gv[bj][1];
                    u32x4 w; w.x = cvt_pk_bf16(v0[0], v0[1]); w.y = cvt_pk_bf16(v0[2], v0[3]); w.z = cvt_pk_bf16(v1[0], v1[1]); w.w = cvt_pk_bf16(v1[2], v1[3]);
                    *(u32x4*)(rowp + 32 * bj) = w; } }
    }
};
struct EpiResid {
    static constexpr bool PERM = false, AFTER_DRAIN = false;
    float* X; const float* gate; int seq, gstride;
    __device__ __forceinline__ void operator()(const f32x4 (&acc)[2][2][4][2], const Unit& u, int wr, int wc, int fr, int fq) const {
        const int row0 = u.pm * BM + wr * 64 + fr, col0 = u.pn * BM + wc * 32 + 4 * fq;
        const float* gp = gate + (size_t)((u.pm * BM) / seq) * gstride + col0;
        f32x4 gv[2][2];
#pragma unroll
        for (int bj = 0; bj < 2; ++bj)
#pragma unroll
            for (int n = 0; n < 2; ++n) gv[bj][n] = *(const f32x4*)(gp + bj * HALF + n * 16);
#pragma unroll
        for (int ai = 0; ai < 2; ++ai)
#pragma unroll
            for (int m = 0; m < 4; ++m) { float* rowp = X + (size_t)(row0 + ai * HALF + m * 16) * 1024 + col0;
#pragma unroll
                for (int bj = 0; bj < 2; ++bj)
#pragma unroll
                    for (int n = 0; n < 2; ++n) { f32x4* p = (f32x4*)(rowp + bj * HALF + n * 16); *p = *p + gv[bj][n] * acc[ai][bj][m][n]; } }
    }
};
struct EpiSwiGLU {
    static constexpr bool PERM = true, AFTER_DRAIN = false;
    bf16_t* HS;
    __device__ __forceinline__ void operator()(const f32x4 (&acc)[2][2][4][2], const Unit& u, int wr, int wc, int fr, int fq) const {
        const int row0 = u.pm * BM + wr * 64 + fr;
#pragma unroll
        for (int ai = 0; ai < 2; ++ai)
#pragma unroll
            for (int m = 0; m < 4; ++m) { bf16_t* rowp = HS + (size_t)(row0 + ai * HALF + m * 16) * 512;
#pragma unroll
                for (int bj = 0; bj < 2; ++bj) { const int g = 32 * u.pn + 16 * bj + 4 * wc + fq; const f32x4 a = acc[ai][bj][m][0], b = acc[ai][bj][m][1]; f32x4 o;
#pragma unroll
                    for (int e = 0; e < 4; ++e) o[e] = a[e] / (1.0f + __expf(-a[e])) * b[e];
                    u32x2 w; w.x = cvt_pk_bf16(o[0], o[1]); w.y = cvt_pk_bf16(o[2], o[3]); *(u32x2*)(rowp + 4 * g) = w; } }
    }
};
struct EpiMoeOut {
    static constexpr bool PERM = true, AFTER_DRAIN = false;
    bf16_t* YS; const float* gs;
    __device__ __forceinline__ void operator()(const f32x4 (&acc)[2][2][4][2], const Unit& u, int wr, int wc, int fr, int fq) const {
        const int row0 = u.pm * BM + wr * 64 + fr, col0 = u.pn * BM + wc * 32 + 8 * fq;
#pragma unroll
        for (int ai = 0; ai < 2; ++ai)
#pragma unroll
            for (int m = 0; m < 4; ++m) { const int r = row0 + ai * HALF + m * 16; const float gt = gs[r]; bf16_t* rowp = YS + (size_t)r * 1024 + col0;
#pragma unroll
                for (int bj = 0; bj < 2; ++bj) { const f32x4 v0 = acc[ai][bj][m][0] * gt, v1 = acc[ai][bj][m][1] * gt;
                    u32x4 w; w.x = cvt_pk_bf16(v0[0], v0[1]); w.y = cvt_pk_bf16(v0[2], v0[3]); w.z = cvt_pk_bf16(v1[0], v1[1]); w.w = cvt_pk_bf16(v1[2], v1[3]);
                    *(u32x4*)(rowp + bj * HALF) = w; } }
    }
};
struct MoeOrder {
    const __attribute__((address_space(3))) int* t2e; int ntiles, nN, G, c;
    __device__ bool next(int i, Unit& u) const { const int L = i * G + c; if (L >= ntiles * nN) return false; u.pm = L / nN; u.pn = L % nN; u.e = t2e[u.pm]; return true; }
    __device__ __forceinline__ void a_ready(const Unit&) const {}
    __device__ __forceinline__ void done(const Unit&) const {}
};
template <class Epi, class Sched, bool ALIGN_EPI = false, bool SP2 = false>
__device__ __forceinline__ void gemm_phase(PG8_LAS unsigned char* lds, const Gemm g, const Sched& S, const Epi& E) {
    int tid_ = threadIdx.x; asm volatile("" : "+v"(tid_));
    const int tid = tid_, wid = __builtin_amdgcn_readfirstlane(tid >> 6), lane = tid & 63, wr = wid >> 2, wc = wid & 3, fr = lane & 15, fq = lane >> 4;
    const int K = g.K, nt = K / BK;
    unsigned voffA[2], voffB[2];
#pragma unroll
    for (int i = 0; i < 2; ++i) { int R, C; stage_rc(tid * 16 + i * 8192, R, C); const int Rb = Epi::PERM ? ((R & ~31) + perm32(R & 31)) : R;
        voffA[i] = (unsigned)(R * K + C) * 2u; voffB[i] = (unsigned)(Rb * K + C) * 2u; }
    const size_t kstep = (size_t)(BK * 2);
    const size_t hstep = (size_t)HALF * K * 2;
    const size_t tstep = 2 * hstep;
    const unsigned ldsw = (unsigned)wid * 1024u;
    const int aoff = lds_byte(wr * 64 + fr, fq * 8), boff = lds_byte(wc * 32 + fr, fq * 8);
#define PG8_SA(b, h) (((b) * 2 + (h)) * HTB)
#define PG8_SB(b, h) ((4 + (b) * 2 + (h)) * HTB)
#define PG8_STAGE(bufoff, gbase, voff) do { _Pragma("unroll") for (int _i = 0; _i < 2; ++_i) \
        __builtin_amdgcn_global_load_lds((const unsigned*)((const char*)(gbase) + (voff)[_i]), (PG8_LAS unsigned*)(lds + (bufoff) + ldsw + _i * 8192), 16, 0, 0); } while (0)
#define PG8_LDA(dst, b, h) do { _Pragma("unroll") for (int m = 0; m < 4; ++m) _Pragma("unroll") for (int k = 0; k < 2; ++k) dst[m][k] = *(const PG8_LAS bf16x8*)(lds + PG8_SA(b, h) + aoff + m * 2048 + k * 1024); } while (0)
#define PG8_LDB(dst, b, h) do { _Pragma("unroll") for (int n = 0; n < 2; ++n) _Pragma("unroll") for (int k = 0; k < 2; ++k) dst[n][k] = *(const PG8_LAS bf16x8*)(lds + PG8_SB(b, h) + boff + n * 2048 + k * 1024); } while (0)
#define PG8_MMA(ai, bj, At, Bt) do { __builtin_amdgcn_s_setprio(1); _Pragma("unroll") for (int m = 0; m < 4; ++m) _Pragma("unroll") for (int n = 0; n < 2; ++n) _Pragma("unroll") for (int k = 0; k < 2; ++k) \
        acc[ai][bj][m][n] = __builtin_amdgcn_mfma_f32_16x16x32_bf16(Bt[n][k], At[m][k], acc[ai][bj][m][n], 0, 0, 0); __builtin_amdgcn_s_setprio(0); } while (0)
#define PG8_WAIT_V(n) asm volatile("s_waitcnt vmcnt(" #n ")" ::: "memory")
#define PG8_WAIT_L(n) asm volatile("s_waitcnt lgkmcnt(" #n ")" ::: "memory")
#define PG8_BAR __builtin_amdgcn_s_barrier()
#define PG8_SCHED __builtin_amdgcn_sched_barrier(0)
    Unit cur, nxt; int ui = 0;
    if (!S.next(0, cur)) return;
    f32x4 acc[2][2][4][2];
#pragma unroll
    for (int a = 0; a < 2; ++a)
#pragma unroll
        for (int b = 0; b < 2; ++b)
#pragma unroll
            for (int m = 0; m < 4; ++m)
#pragma unroll
                for (int n = 0; n < 2; ++n) acc[a][b][m][n] = (f32x4){0.f, 0.f, 0.f, 0.f};
    bf16x8 At[4][2], B0[2][2], B1[2][2];
    const char* cA = (const char*)g.A + (size_t)cur.pm * tstep; const char* cB = (const char*)g.Bt + (size_t)cur.e * g.estride + (size_t)cur.pn * tstep;
    S.a_ready(cur);
    if constexpr (SP2) {
        PG8_STAGE(PG8_SB(0, 0), cB, voffB); PG8_STAGE(PG8_SB(0, 1), cB + hstep, voffB); PG8_STAGE(PG8_SA(0, 0), cA, voffA); PG8_STAGE(PG8_SA(0, 1), cA + hstep, voffA);
        if (wr == 1) PG8_BAR;
        PG8_WAIT_V(2); PG8_BAR;
        PG8_STAGE(PG8_SB(1, 0), cB + kstep, voffB); PG8_STAGE(PG8_SA(1, 0), cA + kstep, voffA); PG8_STAGE(PG8_SB(1, 1), cB + hstep + kstep, voffB);
        PG8_WAIT_V(6); PG8_BAR;
    } else {
        PG8_STAGE(PG8_SB(0, 0), cB, voffB); PG8_STAGE(PG8_SA(0, 0), cA, voffA); PG8_STAGE(PG8_SB(0, 1), cB + hstep, voffB); PG8_STAGE(PG8_SA(0, 1), cA + hstep, voffA);
        if (wr == 1) PG8_BAR;
        PG8_WAIT_V(4); PG8_BAR;
        PG8_STAGE(PG8_SB(1, 0), cB + kstep, voffB); PG8_STAGE(PG8_SA(1, 0), cA + kstep, voffA); PG8_STAGE(PG8_SB(1, 1), cB + hstep + kstep, voffB);
        PG8_WAIT_V(6); PG8_BAR;
    }
    for (;;) {
        const bool has_next = S.next(ui + 1, nxt);
        const char* nA = has_next ? (const char*)g.A + (size_t)nxt.pm * tstep : cA; const char* nB = has_next ? (const char*)g.Bt + (size_t)nxt.e * g.estride + (size_t)nxt.pn * tstep : cB;
        for (int t = 0; t < nt; t += 2) {
            const bool last = (t == nt - 2);
            const char* a1 = cA + (size_t)(t + 1) * kstep;
            const char* a2 = last ? nA : cA + (size_t)(t + 2) * kstep; const char* b2 = last ? nB : cB + (size_t)(t + 2) * kstep;
            const char* a3 = a2 + kstep; const char* b3 = b2 + kstep;
            if (last && has_next) S.a_ready(nxt);
            if constexpr (SP2) {
            PG8_LDB(B0, 0, 0); PG8_LDB(B1, 0, 1); PG8_SCHED; PG8_LDA(At, 0, 0); PG8_STAGE(PG8_SA(1, 1), a1 + hstep, voffA);
            PG8_WAIT_V(8); PG8_WAIT_L(0); PG8_BAR; PG8_MMA(0, 0, At, B0); PG8_MMA(0, 1, At, B1); PG8_BAR; PG8_SCHED;
            PG8_LDA(At, 0, 1); PG8_STAGE(PG8_SB(0, 0), b2, voffB); PG8_STAGE(PG8_SB(0, 1), b2 + hstep, voffB); PG8_STAGE(PG8_SA(0, 0), a2, voffA);
            PG8_WAIT_V(8); PG8_WAIT_L(0); PG8_BAR; PG8_MMA(1, 0, At, B0); PG8_MMA(1, 1, At, B1); PG8_BAR; PG8_SCHED;
            PG8_LDB(B0, 1, 0); PG8_LDB(B1, 1, 1); PG8_SCHED; PG8_LDA(At, 1, 0); PG8_STAGE(PG8_SA(0, 1), a2 + hstep, voffA);
            PG8_WAIT_V(8); PG8_WAIT_L(0); PG8_BAR; PG8_MMA(0, 0, At, B0); PG8_MMA(0, 1, At, B1); PG8_BAR; PG8_SCHED;
            PG8_LDA(At, 1, 1); PG8_STAGE(PG8_SB(1, 0), b3, voffB); PG8_STAGE(PG8_SB(1, 1), b3 + hstep, voffB); PG8_STAGE(PG8_SA(1, 0), a3, voffA);
            PG8_WAIT_V(8); PG8_WAIT_L(0); PG8_BAR; PG8_MMA(1, 0, At, B0); PG8_MMA(1, 1, At, B1); PG8_BAR; PG8_SCHED;
            } else {
            PG8_LDB(B0, 0, 0); PG8_SCHED; PG8_LDA(At, 0, 0); PG8_STAGE(PG8_SA(1, 1), a1 + hstep, voffA);
            PG8_WAIT_L(8); PG8_BAR; PG8_WAIT_L(0); PG8_MMA(0, 0, At, B0); PG8_BAR; PG8_SCHED;
            PG8_LDB(B1, 0, 1); PG8_STAGE(PG8_SB(0, 0), b2, voffB);
            PG8_BAR; PG8_WAIT_L(0); PG8_MMA(0, 1, At, B1); PG8_BAR;
            PG8_LDA(At, 0, 1); PG8_STAGE(PG8_SA(0, 0), a2, voffA);
            PG8_BAR; PG8_WAIT_L(0); PG8_MMA(1, 0, At, B0); PG8_BAR; PG8_SCHED;
            PG8_STAGE(PG8_SB(0, 1), b2 + hstep, voffB);
            PG8_WAIT_V(6); PG8_BAR; PG8_MMA(1, 1, At, B1); PG8_BAR;
            PG8_LDB(B0, 1, 0); PG8_SCHED; PG8_LDA(At, 1, 0); PG8_STAGE(PG8_SA(0, 1), a2 + hstep, voffA);
            PG8_WAIT_L(8); PG8_BAR; PG8_WAIT_L(0); PG8_MMA(0, 0, At, B0); PG8_BAR; PG8_SCHED;
            PG8_LDB(B1, 1, 1); PG8_STAGE(PG8_SB(1, 0), b3, voffB);
            PG8_BAR; PG8_WAIT_L(0); PG8_MMA(0, 1, At, B1); PG8_BAR;
            PG8_LDA(At, 1, 1); PG8_STAGE(PG8_SA(1, 0), a3, voffA);
            PG8_BAR; PG8_WAIT_L(0); PG8_MMA(1, 0, At, B0); PG8_BAR; PG8_SCHED;
            PG8_STAGE(PG8_SB(1, 1), b3 + hstep, voffB);
            PG8_WAIT_V(6); PG8_BAR; PG8_MMA(1, 1, At, B1); PG8_BAR;
            }
        }
        if constexpr (ALIGN_EPI) { if (wr == 0) PG8_BAR; }
        if constexpr (!Epi::AFTER_DRAIN) { E(acc, cur, wr, wc, fr, fq); S.done(cur); }
        if (!has_next) break;
#pragma unroll
        for (int a = 0; a < 2; ++a)
#pragma unroll
            for (int b = 0; b < 2; ++b)
#pragma unroll
                for (int m = 0; m < 4; ++m)
#pragma unroll
                    for (int n = 0; n < 2; ++n) acc[a][b][m][n] = (f32x4){0.f, 0.f, 0.f, 0.f};
        cur = nxt; cA = nA; cB = nB; ++ui;
        if constexpr (ALIGN_EPI) { if (wr == 1) PG8_BAR; }
    }
    PG8_WAIT_V(0);
    if constexpr (!ALIGN_EPI) { if (wr == 0) PG8_BAR; }
    PG8_BAR;
    if constexpr (Epi::AFTER_DRAIN) { E.fused(acc, cur, wr, wc, fr, fq, lds, wid, lane); S.done(cur); }
#undef PG8_SA
#undef PG8_SB
#undef PG8_STAGE
#undef PG8_LDA
#undef PG8_LDB
#undef PG8_MMA
#undef PG8_WAIT_V
#undef PG8_WAIT_L
#undef PG8_BAR
#undef PG8_SCHED
}
}
#include <hip/hip_bf16.h>
#include <cmath>
namespace attn_body {
using bf16=__hip_bfloat16;
using bf16x8=__attribute__((ext_vector_type(8)))short;
using s16x4=__attribute__((ext_vector_type(4)))short;
using f32x16=__attribute__((ext_vector_type(16)))float;
using u32x4=__attribute__((ext_vector_type(4)))unsigned;
constexpr int D=64;
#ifndef TBATCH
#define TBATCH 16
#endif
constexpr int NW=8,QBLK=32,QB=QBLK*NW,KVBLK=64;
constexpr int ATTN_UNIT_ROWS=QB;
__device__ __forceinline__ int crow(int r,int hi){return (r&3)+8*(r>>2)+4*hi;}
#define SBAR() __builtin_amdgcn_sched_barrier(0)
__device__ __forceinline__ void cmask(f32x16&p0,f32x16&p1,int jb,int qrel,int hi){
  const float NEG=-INFINITY; int kb=64*jb+4*hi;
  #pragma unroll
  for(int r=0;r<16;++r){int kv=kb+(r&3)+8*(r>>2); if(kv>qrel)p0[r]=NEG; if(kv+32>qrel)p1[r]=NEG;}
}

constexpr int NSLOT=3, SLOTB=8192;
constexpr int LDS_K=0, LDS_V=NSLOT*SLOTB, LDS_WS=2*NSLOT*SLOTB, LDS_OST=LDS_WS+NW*64*4, LDS_TBL=LDS_OST+NW*4096, TBL_N=1344, LDS_BYTES=LDS_TBL+8*TBL_N*4;
constexpr float C2=0.125f*1.4426950408889634f;
__device__ __forceinline__ void glds16(const void*gsrc,unsigned lds_dst){unsigned keep;
  asm volatile("s_mov_b32 %0, m0\n\ts_mov_b32 m0, %2\n\ts_nop 0\n\tglobal_load_lds_dwordx4 %1, off\n\ts_mov_b32 m0, %0":"=&s"(keep):"v"(gsrc),"s"(lds_dst):"memory");}
__device__ __forceinline__ float max3f(float a,float b,float c){float r;asm("v_max3_f32 %0, %1, %2, %3":"=v"(r):"v"(a),"v"(b),"v"(c));return r;}
__device__ __forceinline__ float max2f(float a,float b){float r;asm("v_max_f32_e32 %0, %1, %2":"=v"(r):"v"(a),"v"(b));return r;}
__device__ __forceinline__ float fadd_s(float a,float b){float r;asm("v_add_f32_e32 %0, %1, %2":"=v"(r):"v"(a),"v"(b));return r;}
__device__ __forceinline__ float fsub_s(float a,float b){float r;asm("v_sub_f32_e32 %0, %1, %2":"=v"(r):"v"(a),"v"(b));return r;}
typedef float f32x2_t __attribute__((ext_vector_type(2))); typedef __bf16 bf16x2_t __attribute__((ext_vector_type(2)));
__device__ __forceinline__ unsigned cvtpk_s(float lo,float hi){f32x2_t v={lo,hi};bf16x2_t b=__builtin_convertvector(v,bf16x2_t);return __builtin_bit_cast(unsigned,b);}
#define WAIT_BAR(N) asm volatile("s_waitcnt vmcnt(" #N ") lgkmcnt(0)\n\ts_barrier":::"memory")

__device__ __forceinline__ void qkt(f32x16&p0,f32x16&p1,const char*Kslot,const bf16x8*qr,const f32x16&negm,int r32,int hi){
  const char*kb=Kslot+hi*1024+r32*16;
  #pragma unroll
  for(int d0=0;d0<4;++d0){
    const bf16x8 b0=*reinterpret_cast<const bf16x8*>(kb+d0*2048);
    const bf16x8 b1=*reinterpret_cast<const bf16x8*>(kb+d0*2048+512);
    if(d0==0){p0=__builtin_amdgcn_mfma_f32_32x32x16_bf16(b0,qr[0],negm,0,0,0);p1=__builtin_amdgcn_mfma_f32_32x32x16_bf16(b1,qr[0],negm,0,0,0);}
    else{p0=__builtin_amdgcn_mfma_f32_32x32x16_bf16(b0,qr[d0],p0,0,0,0);p1=__builtin_amdgcn_mfma_f32_32x32x16_bf16(b1,qr[d0],p1,0,0,0);}}
}
typedef __attribute__((address_space(3))) const char* lds_cptr;
typedef short v4i16_t __attribute__((ext_vector_type(4)));
__device__ __forceinline__ void kload8(bf16x8*kf,lds_cptr kp){
  kf[0]=*(const __attribute__((address_space(3))) bf16x8*)(kp);      kf[1]=*(const __attribute__((address_space(3))) bf16x8*)(kp+512);
  kf[2]=*(const __attribute__((address_space(3))) bf16x8*)(kp+2048); kf[3]=*(const __attribute__((address_space(3))) bf16x8*)(kp+2560);
  kf[4]=*(const __attribute__((address_space(3))) bf16x8*)(kp+4096); kf[5]=*(const __attribute__((address_space(3))) bf16x8*)(kp+4608);
  kf[6]=*(const __attribute__((address_space(3))) bf16x8*)(kp+6144); kf[7]=*(const __attribute__((address_space(3))) bf16x8*)(kp+6656);
}
__device__ __forceinline__ void kload2(bf16x8*kf,lds_cptr kp,int j){ kf[2*j]=*(const __attribute__((address_space(3))) bf16x8*)(kp+j*2048); kf[2*j+1]=*(const __attribute__((address_space(3))) bf16x8*)(kp+j*2048+512); }
__device__ __forceinline__ s16x4 vtr(lds_cptr p){ return __builtin_bit_cast(s16x4,__builtin_amdgcn_ds_read_tr16_b64_v4i16((__attribute__((address_space(3))) v4i16_t*)p)); }
__device__ __forceinline__ float rowmax(const f32x16&p0,const f32x16&p1){
  float a=max3f(p0[0],p0[1],p1[0]),b=max3f(p0[2],p0[3],p1[1]);a=max3f(a,p1[2],p1[3]);
  #pragma unroll
  for(int r=4;r<16;r+=4){a=max3f(a,p0[r],p0[r+1]);b=max3f(b,p0[r+2],p0[r+3]);a=max3f(a,p1[r],p1[r+1]);b=max3f(b,p1[r+2],p1[r+3]);}
  const float m=max2f(a,b);
  auto rr=__builtin_amdgcn_permlane32_swap(__float_as_uint(m),__float_as_uint(m),false,false);
  return max2f(__uint_as_float(rr[0]),__uint_as_float(rr[1]));
}
__device__ __forceinline__ void pv(f32x16*o,int vb,bf16x8 pa0,bf16x8 pa1,bf16x8 pa2,bf16x8 pa3){
  #pragma unroll
  for(int d0=0;d0<2;++d0){s16x4 lo[4],hi[4];
    #pragma unroll
    for(int ks=0;ks<4;++ks){
      asm volatile("ds_read_b64_tr_b16 %0,%1 offset:%c2":"=&v"(lo[ks]):"v"(vb),"i"(d0*4096+ks*1024):"memory");
      asm volatile("ds_read_b64_tr_b16 %0,%1 offset:%c2":"=&v"(hi[ks]):"v"(vb),"i"(d0*4096+ks*1024+512):"memory");}
    asm volatile("s_waitcnt lgkmcnt(0)":::"memory");SBAR();
    #define PK(k) (bf16x8){lo[k][0],lo[k][1],lo[k][2],lo[k][3],hi[k][0],hi[k][1],hi[k][2],hi[k][3]}
    o[d0]=__builtin_amdgcn_mfma_f32_32x32x16_bf16(pa0,PK(0),o[d0],0,0,0);
    o[d0]=__builtin_amdgcn_mfma_f32_32x32x16_bf16(pa1,PK(1),o[d0],0,0,0);
    o[d0]=__builtin_amdgcn_mfma_f32_32x32x16_bf16(pa2,PK(2),o[d0],0,0,0);
    o[d0]=__builtin_amdgcn_mfma_f32_32x32x16_bf16(pa3,PK(3),o[d0],0,0,0);
    #undef PK
  }
}

#ifndef ATTN_STORE16
#define ATTN_STORE16(p,v) __builtin_nontemporal_store((v),(u32x4*)(p))
#endif
__device__ __forceinline__ void attn_build_tables(int tid,const float*tb,char*shm){
  typedef __attribute__((address_space(3))) float lds_f32;
  lds_f32*T=(lds_f32*)((__attribute__((address_space(3))) char*)shm+LDS_TBL);
  for(int i=tid;i<8*TBL_N;i+=NW*64){ const int hh=i/TBL_N, d=i-hh*TBL_N-256; float v=0.f; if(d<0)v=-INFINITY; else if(d<1024)v=tb[hh*1024+d]-tb[hh*1024+1023]; T[i]=v; }
}
template<int THRL,bool MOBA,bool USE_NEGM> __device__ __forceinline__ void attn_unit(int tid,int qb,const bf16*Qb,int qpitch,const bf16*__restrict__ Kb,int kpitch,const bf16*__restrict__ Vb,int vpitch,bf16*Ob,int opitch,int hh,const float*kmean,char*shm){
  const int lane=tid&63,r32=lane&31,hi=lane>>5; const int wid=__builtin_amdgcn_readfirstlane(tid>>6);
  const int q0=qb*QB;
  const bf16*Qw=Qb+(long)(q0+wid*QBLK)*qpitch;
  const bf16*Kh=Kb,*Vh=Vb;
  const int qpos=q0+wid*QBLK+r32;
  typedef __attribute__((address_space(3))) float lds_f32;
  const lds_f32*Tl=(const lds_f32*)((__attribute__((address_space(3))) char*)shm+LDS_TBL)+hh*TBL_N;
  unsigned selmask=0xffffffffu;
  if(MOBA){
    float qf[64];
    { const uint4*qp=(const uint4*)(Qw+(long)r32*qpitch);
      _Pragma("unroll") for(int c=0;c<8;++c){ const uint4 u=qp[c]; qf[8*c]=__uint_as_float(u.x<<16);qf[8*c+1]=__uint_as_float(u.x&0xffff0000u);qf[8*c+2]=__uint_as_float(u.y<<16);qf[8*c+3]=__uint_as_float(u.y&0xffff0000u);
        qf[8*c+4]=__uint_as_float(u.z<<16);qf[8*c+5]=__uint_as_float(u.z&0xffff0000u);qf[8*c+6]=__uint_as_float(u.w<<16);qf[8*c+7]=__uint_as_float(u.w&0xffff0000u);} }
    float v1=-INFINITY,v2=-INFINITY,v3=-INFINITY; int i1=31,i2=31,i3=31;
    for(int n=0;n<qb;++n){ const float*km=kmean+n*64; float g=0.f;
      _Pragma("unroll") for(int i=0;i<64;++i)g+=qf[i]*km[i];
      if(g>v1){v3=v2;i3=i2;v2=v1;i2=i1;v1=g;i1=n;} else if(g>v2){v3=v2;i3=i2;v2=g;i2=n;} else if(g>v3){v3=g;i3=n;} }
    selmask=(1u<<qb); if(i1<31)selmask|=1u<<i1; if(i2<31)selmask|=1u<<i2; if(i3<31)selmask|=1u<<i3; }
  #define TMAP(t) (MOBA?(((t)<4)?(NT-4+(t)):((t)-4)):(t))
  const unsigned lds0=(unsigned)(uintptr_t)shm;
  float*wsf=(float*)(shm+LDS_WS)+wid*64;
  const bf16*ksrc=Kh+(long)lane*kpitch+wid*8;
  const bf16*vsrc=Vh+(long)(16*(wid&3)+(lane>>2))*vpitch+(wid>>2)*32+(lane&3)*8;
  const unsigned kdst=lds0+LDS_K+wid*1024, vdst=lds0+LDS_V+wid*1024;
  #define DMA_K(t,slot) glds16(ksrc+(long)TMAP(t)*KVBLK*kpitch,(unsigned)__builtin_amdgcn_readfirstlane(kdst+(slot)))
  #define DMA_V(t,slot) glds16(vsrc+(long)TMAP(t)*KVBLK*vpitch,(unsigned)__builtin_amdgcn_readfirstlane(vdst+(slot)))
  const int vb0=(int)(lds0+LDS_V)+((lane>>4)&1)*32+(lane&3)*8+(4*hi+((lane&15)>>2))*64;
  const char*Kbase=shm+LDS_K; bf16x8 kf[8];
  const lds_cptr shm3=(lds_cptr)shm; const lds_cptr kp0=shm3+LDS_K+hi*1024+r32*16; const lds_cptr vp0=shm3+LDS_V+((lane>>4)&1)*32+(lane&3)*8+(4*hi+((lane&15)>>2))*64;
  const int NT=(q0+QB)/KVBLK;
  DMA_K(0,0);DMA_V(0,0);DMA_K(1,SLOTB);
  bf16x8 qr[4];
  #pragma unroll
  for(int d0=0;d0<4;++d0)qr[d0]=*reinterpret_cast<const bf16x8*>(&Qw[(long)r32*qpitch+d0*16+hi*8]);
  float mhat=0.f,l_reg=0.f;f32x16 o[2];o[0]=f32x16{};o[1]=f32x16{};f32x16 negm=f32x16{}; if(USE_NEGM){asm volatile("":"+v"(negm));}
  #define NEGMC (USE_NEGM?negm:f32x16{})
  #define CMASK(P0,P1,t) do{ int D0_=qpos-64*TMAP(t)-4*hi; D0_=D0_<1083?D0_:1083; int bi_=D0_+(256-59); \
      if(MOBA){ if(!((selmask>>(TMAP(t)>>2))&1u))bi_=64; } const volatile lds_f32*tp_=Tl+bi_; \
      { float tb_[TBATCH]; _Pragma("unroll") for(int b0_=0;b0_<16;b0_+=TBATCH){ _Pragma("unroll") for(int r=0;r<TBATCH;++r)tb_[r]=tp_[59-(((b0_+r)&3)+8*((b0_+r)>>2))]; _Pragma("unroll") for(int r=0;r<TBATCH;++r)P0[b0_+r]=fadd_s(P0[b0_+r],tb_[r]); } \
        _Pragma("unroll") for(int b0_=0;b0_<16;b0_+=TBATCH){ _Pragma("unroll") for(int r=0;r<TBATCH;++r)tb_[r]=tp_[27-(((b0_+r)&3)+8*((b0_+r)>>2))]; _Pragma("unroll") for(int r=0;r<TBATCH;++r)P1[b0_+r]=fadd_s(P1[b0_+r],tb_[r]); } } }while(0)
  bool resc=false,mnz=false;
  #define START(P0,P1) do{ const float rm=rowmax(P0,P1); resc=false; \
    if(__any(rm>(float)THRL)){ const float dl=__builtin_fmaxf(rm,0.f); mhat=fadd_s(mhat,dl); mnz=true; \
      _Pragma("unroll") for(int r=0;r<16;++r){P0[r]=fsub_s(P0[r],dl);P1[r]=fsub_s(P1[r],dl);} \
      if(USE_NEGM){ _Pragma("unroll") for(int r=0;r<16;++r)negm[r]=-mhat; asm volatile("":"+v"(negm)); } } \
    _Pragma("unroll") for(int r=0;r<16;++r)P0[r]=__builtin_amdgcn_exp2f(P0[r]); }while(0)
  #define RESC() do{ if(resc){ asm volatile("s_waitcnt lgkmcnt(0)":::"memory"); \
      _Pragma("unroll") for(int d_=0;d_<2;++d_) _Pragma("unroll") for(int r=0;r<16;++r)o[d_][r]*=wsf[crow(r,hi)]; } }while(0)
  f32x16 pA0,pA1,pB0,pB1;
  int sl_prev=0,sl_cur=0,sl_next=SLOTB;
  #define ROT() do{sl_prev=sl_cur;sl_cur=sl_next;sl_next=(sl_next==(NSLOT-1)*SLOTB)?0:sl_next+SLOTB;}while(0)
  DMA_K(2,2*SLOTB);
  WAIT_BAR(3);
  qkt(pA0,pA1,Kbase,qr,negm,r32,hi);asm volatile("s_nop 15\n\ts_nop 7":"+v"(pA0),"+v"(pA1));CMASK(pA0,pA1,0);
  START(pA0,pA1);
  _Pragma("unroll") for(int r=0;r<16;++r)pA1[r]=__builtin_amdgcn_exp2f(pA1[r]);
  WAIT_BAR(0);
  DMA_K(3,0);DMA_V(1,SLOTB);
  ROT();
  kload8(kf,kp0+sl_cur);
  WAIT_BAR(2);
  s16x4 vlo[8],vhi[8]; u32x4 pw0,pw1,pw2,pw3;
  #define PKW(P,B) cvtpk_s(P[B],P[B+1])
  #define PAF(k) __builtin_bit_cast(bf16x8,pw##k)
  #define VFR(i) (bf16x8){vlo[i][0],vlo[i][1],vlo[i][2],vlo[i][3],vhi[i][0],vhi[i][1],vhi[i][2],vhi[i][3]}
  #define PIN(x) asm volatile("":"+v"(x))
  #define MX3(a,b,c) __builtin_fmaxf(__builtin_fmaxf((a),(b)),(c))
  #define GAPA(MF,A0,A1,A2,A3,W0,W1,PW) do{ MF; sacc+=A0; sacc+=A1; sacc+=A2; sacc+=A3; PIN(sacc); W0; W1; PIN(PW); SBAR(); }while(0)
  #define EX(v) __builtin_amdgcn_exp2f(v)
  #define GAPB(MF,X,B) do{ MF; X[B]=EX(X[B]); X[B+1]=EX(X[B+1]); X[B+2]=EX(X[B+2]); X[B+3]=EX(X[B+3]); PIN(X); SBAR(); }while(0)
  #define VRD(i) do{ vlo[i]=vtr(vp_+(((i)>>2)*4096+((i)&3)*1024)); vhi[i]=vtr(vp_+(((i)>>2)*4096+((i)&3)*1024+512)); }while(0)
  #define KRD(G,j) do{ if(G){ kload2(kf,kp0+sl_next,j); SBAR(); } }while(0)
  #define STEP(C0,C1,P0,P1,t,GK,GV,GL) do{ SBAR(); \
    const lds_cptr vp_=vp0+sl_prev; \
    VRD(0); SBAR(); float sacc=(P0[0]+P0[1]); \
    GAPA(C0=__builtin_amdgcn_mfma_f32_32x32x16_bf16(kf[0],qr[0],NEGMC,0,0,0), P0[2],P0[3],P0[4],P0[5],     pw0[0]=PKW(P0,0), pw0[1]=PKW(P0,2), pw0); \
    VRD(4); SBAR(); GAPA(C1=__builtin_amdgcn_mfma_f32_32x32x16_bf16(kf[1],qr[0],NEGMC,0,0,0), P0[6],P0[7],P0[8],P0[9],     pw0[2]=PKW(P0,4), pw0[3]=PKW(P0,6), pw0); \
    VRD(1); SBAR(); GAPA(C0=__builtin_amdgcn_mfma_f32_32x32x16_bf16(kf[2],qr[1],C0,0,0,0),   P0[10],P0[11],P0[12],P0[13], pw1[0]=PKW(P0,8), pw1[1]=PKW(P0,10), pw1); \
    VRD(5); SBAR(); GAPA(C1=__builtin_amdgcn_mfma_f32_32x32x16_bf16(kf[3],qr[1],C1,0,0,0),   P0[14],P0[15],P1[0],P1[1],   pw1[2]=PKW(P0,12),pw1[3]=PKW(P0,14), pw1); \
    VRD(2); SBAR(); GAPA(C0=__builtin_amdgcn_mfma_f32_32x32x16_bf16(kf[4],qr[2],C0,0,0,0),   P1[2],P1[3],P1[4],P1[5],     pw2[0]=PKW(P1,0), pw2[1]=PKW(P1,2), pw2); \
    VRD(6); SBAR(); GAPA(C1=__builtin_amdgcn_mfma_f32_32x32x16_bf16(kf[5],qr[2],C1,0,0,0),   P1[6],P1[7],P1[8],P1[9],     pw2[2]=PKW(P1,4), pw2[3]=PKW(P1,6), pw2); \
    VRD(3); SBAR(); GAPA(C0=__builtin_amdgcn_mfma_f32_32x32x16_bf16(kf[6],qr[3],C0,0,0,0),   P1[10],P1[11],P1[12],P1[13], pw3[0]=PKW(P1,8), pw3[1]=PKW(P1,10), pw3); \
    VRD(7); SBAR(); GAPA(C1=__builtin_amdgcn_mfma_f32_32x32x16_bf16(kf[7],qr[3],C1,0,0,0),   P1[14],P1[15],0.f,0.f,       pw3[2]=PKW(P1,12),pw3[3]=PKW(P1,14), pw3); \
    l_reg+=sacc; \
    if(GK){DMA_K((t)+3,sl_cur);} if(GV){DMA_V((t)+1,sl_next);} \
    { const float d_=__builtin_fmaxf(C0[15],C1[15]); asm volatile(""::"v"(d_)); asm volatile("":"+v"(C0),"+v"(C1)); } \
    if(!USE_NEGM&&mnz){ _Pragma("unroll") for(int r=0;r<16;++r){C0[r]=fsub_s(C0[r],mhat);C1[r]=fsub_s(C1[r],mhat);} } \
    CMASK(C0,C1,t); \
    { float a=MX3(C0[0],C0[1],C1[0]),b=MX3(C0[2],C0[3],C1[1]); a=MX3(a,C1[2],C1[3]); \
      _Pragma("unroll") for(int r=4;r<16;r+=4){a=MX3(a,C0[r],C0[r+1]);b=MX3(b,C0[r+2],C0[r+3]);a=MX3(a,C1[r],C1[r+1]);b=MX3(b,C1[r+2],C1[r+3]);} \
      float rm=__builtin_fmaxf(a,b); { auto rr=__builtin_amdgcn_permlane32_swap(__float_as_uint(rm),__float_as_uint(rm),false,false); rm=__builtin_fmaxf(__uint_as_float(rr[0]),__uint_as_float(rr[1])); } \
      resc=false; \
      if(__builtin_expect(__any(rm>(float)THRL),0)){ const float dl=__builtin_fmaxf(rm,0.f); mhat+=dl; mnz=true; \
        _Pragma("unroll") for(int r=0;r<16;++r){C0[r]=fsub_s(C0[r],dl);C1[r]=fsub_s(C1[r],dl);} \
        if(USE_NEGM){ _Pragma("unroll") for(int r=0;r<16;++r)negm[r]=-mhat; asm volatile("":"+v"(negm)); } \
        const float f=__builtin_amdgcn_exp2f(-dl); l_reg*=f; if(hi==0)wsf[r32]=f; resc=true; } } \
    SBAR(); \
    GAPB(o[0]=__builtin_amdgcn_mfma_f32_32x32x16_bf16(PAF(0),VFR(0),o[0],0,0,0), C0,0); \
    GAPB(o[1]=__builtin_amdgcn_mfma_f32_32x32x16_bf16(PAF(0),VFR(4),o[1],0,0,0), C0,4); \
    KRD(GL,0); GAPB(o[0]=__builtin_amdgcn_mfma_f32_32x32x16_bf16(PAF(1),VFR(1),o[0],0,0,0), C0,8); \
    KRD(GL,1); GAPB(o[1]=__builtin_amdgcn_mfma_f32_32x32x16_bf16(PAF(1),VFR(5),o[1],0,0,0), C0,12); \
    KRD(GL,2); GAPB(o[0]=__builtin_amdgcn_mfma_f32_32x32x16_bf16(PAF(2),VFR(2),o[0],0,0,0), C1,0); \
    KRD(GL,3); GAPB(o[1]=__builtin_amdgcn_mfma_f32_32x32x16_bf16(PAF(2),VFR(6),o[1],0,0,0), C1,4); \
    GAPB(o[0]=__builtin_amdgcn_mfma_f32_32x32x16_bf16(PAF(3),VFR(3),o[0],0,0,0), C1,8); \
    GAPB(o[1]=__builtin_amdgcn_mfma_f32_32x32x16_bf16(PAF(3),VFR(7),o[1],0,0,0), C1,12); \
    }while(0)
  int t=1;
  #undef CMASK
  #define CMASK(P0,P1,t) do{}while(0)
  const int t_tbl=MOBA?0:((q0>=853)?((q0-853)/64+1):0);
  for(;t+5<NT&&t+1<t_tbl;t+=2){
    STEP(pB0,pB1,pA0,pA1,t,true,true,true);     WAIT_BAR(2); RESC(); ROT();
    STEP(pA0,pA1,pB0,pB1,t+1,true,true,true);   WAIT_BAR(2); RESC(); ROT();
  }
  #undef CMASK
  #define CMASK(P0,P1,t) do{ int D0_=qpos-64*TMAP(t)-4*hi; D0_=D0_<1083?D0_:1083; int bi_=D0_+(256-59); \
      if(MOBA){ if(!((selmask>>(TMAP(t)>>2))&1u))bi_=64; } const volatile lds_f32*tp_=Tl+bi_; \
      { float tb_[TBATCH]; _Pragma("unroll") for(int b0_=0;b0_<16;b0_+=TBATCH){ _Pragma("unroll") for(int r=0;r<TBATCH;++r)tb_[r]=tp_[59-(((b0_+r)&3)+8*((b0_+r)>>2))]; _Pragma("unroll") for(int r=0;r<TBATCH;++r)P0[b0_+r]=fadd_s(P0[b0_+r],tb_[r]); } \
        _Pragma("unroll") for(int b0_=0;b0_<16;b0_+=TBATCH){ _Pragma("unroll") for(int r=0;r<TBATCH;++r)tb_[r]=tp_[27-(((b0_+r)&3)+8*((b0_+r)>>2))]; _Pragma("unroll") for(int r=0;r<TBATCH;++r)P1[b0_+r]=fadd_s(P1[b0_+r],tb_[r]); } } }while(0)
  #define ENDW(tt) do{ if((tt)+3<NT){WAIT_BAR(2);} else if((tt)+2<NT){WAIT_BAR(1);} else {WAIT_BAR(0);} }while(0)
  for(;t+1<NT;t+=2){
    STEP(pB0,pB1,pA0,pA1,t,(t+3<NT),(t+1<NT),(t+1<NT));       ENDW(t);   RESC(); ROT();
    STEP(pA0,pA1,pB0,pB1,t+1,(t+4<NT),(t+2<NT),(t+2<NT));     ENDW(t+1); RESC(); ROT();
  }
  STEP(pB0,pB1,pA0,pA1,NT-1,false,false,false); RESC();
  { float sacc=pB0[0]+pB0[1]; _Pragma("unroll") for(int r=2;r<16;++r)sacc+=pB0[r]; _Pragma("unroll") for(int r=0;r<16;++r)sacc+=pB1[r]; l_reg+=sacc;
    pw0=(u32x4){PKW(pB0,0),PKW(pB0,2),PKW(pB0,4),PKW(pB0,6)};pw1=(u32x4){PKW(pB0,8),PKW(pB0,10),PKW(pB0,12),PKW(pB0,14)};pw2=(u32x4){PKW(pB1,0),PKW(pB1,2),PKW(pB1,4),PKW(pB1,6)};pw3=(u32x4){PKW(pB1,8),PKW(pB1,10),PKW(pB1,12),PKW(pB1,14)};
    SBAR(); pv(o,vb0+sl_cur,PAF(0),PAF(1),PAF(2),PAF(3)); }
  #undef PKW
  #undef PAF
  #undef VFR
  #undef PIN
  #undef MX3
  #undef GAPA
  #undef GAPB
  #undef EX
  #undef VRD
  #undef KRD
  #undef STEP
  #undef ENDW
  {auto rr=__builtin_amdgcn_permlane32_swap(__float_as_uint(l_reg),__float_as_uint(l_reg),false,false);l_reg=__uint_as_float(rr[0])+__uint_as_float(rr[1]);}
  if(hi==0)wsf[32+r32]=l_reg;asm volatile("s_waitcnt lgkmcnt(0)":::"memory");
  float rli[16];
  #pragma unroll
  for(int r=0;r<16;++r)rli[r]=__builtin_amdgcn_rcpf(wsf[32+crow(r,hi)]);
  bf16*Ow=Ob+(long)(q0+wid*QBLK)*opitch;
  { bf16*stg=(bf16*)(shm+LDS_OST)+wid*2048;
    #pragma unroll
    for(int r=0;r<16;++r){const int orow=crow(r,hi);
      #pragma unroll
      for(int d0=0;d0<2;++d0)stg[orow*64+d0*32+r32]=__float2bfloat16(o[d0][r]*rli[r]);}
    asm volatile("s_waitcnt lgkmcnt(0)":::"memory");
    #pragma unroll
    for(int i=0;i<4;++i){const int row=i*8+(lane>>3),ch=lane&7; const u32x4 v=*(const u32x4*)(stg+row*64+ch*8); ATTN_STORE16(Ow+(long)row*opitch+ch*8,v);} }
  asm volatile("s_waitcnt lgkmcnt(0)\n\ts_barrier":::"memory");
  #undef DMA_K
  #undef DMA_V
  #undef TMAP
  #undef NEGMC
  #undef CMASK
  #undef START
  #undef RESC
  #undef ROT
}

constexpr int DV_K=0, DV_V=NSLOT*SLOTB, DV_VSLOT=2*SLOTB, DV_WS=DV_V+NSLOT*DV_VSLOT, DV_OST=0;
static_assert(DV_WS+NW*64*4<=LDS_TBL && NW*8192<=DV_WS, "dv unit LDS layout");
template<int THRL> __device__ __forceinline__ void attn_unit_dv(int tid,int qb,const bf16*Qb,int qpitch,const bf16*__restrict__ Kb,int kpitch,const bf16*__restrict__ Vb,int vpitch,bf16*Ob,int opitch,int hh,char*shm){
  const int lane=tid&63,r32=lane&31,hi=lane>>5; const int wid=__builtin_amdgcn_readfirstlane(tid>>6);
  const int q0=qb*QB;
  const bf16*Qw=Qb+(long)(q0+wid*QBLK)*qpitch;
  const int qpos=q0+wid*QBLK+r32;
  typedef __attribute__((address_space(3))) float lds_f32;
  const lds_cptr shm3=(lds_cptr)shm;
  const lds_f32*Tl=(const lds_f32*)(shm3+LDS_TBL)+hh*TBL_N;
  lds_f32*wsf=(lds_f32*)(shm3+DV_WS)+wid*64;
  const unsigned lds0=(unsigned)(uintptr_t)shm;
  const bf16*ksrc=Kb+(long)lane*kpitch+wid*8;
  const bf16*vsrc=Vb+(long)(16*(wid&3)+(lane>>2))*vpitch+(wid>>2)*32+(lane&3)*8;
  const unsigned kdst=lds0+DV_K+wid*1024, vdst=lds0+DV_V+wid*1024;
  #define DVK(t,slot) glds16(ksrc+(long)(t)*KVBLK*kpitch,(unsigned)__builtin_amdgcn_readfirstlane(kdst+(slot)))
  #define DVV(t,slot) do{ glds16(vsrc+(long)(t)*KVBLK*vpitch,(unsigned)__builtin_amdgcn_readfirstlane(vdst+2*(slot))); glds16(vsrc+(long)(t)*KVBLK*vpitch+64,(unsigned)__builtin_amdgcn_readfirstlane(vdst+2*(slot)+8192)); }while(0)
  const lds_cptr kp0=shm3+DV_K+hi*1024+r32*16; const lds_cptr vp0=shm3+DV_V+((lane>>4)&1)*32+(lane&3)*8+(4*hi+((lane&15)>>2))*64;
  const int NT=(q0+QB)/KVBLK;
  DVK(0,0);DVV(0,0);DVK(1,SLOTB);
  bf16x8 qr[4];
  #pragma unroll
  for(int d0=0;d0<4;++d0)qr[d0]=*reinterpret_cast<const bf16x8*>(&Qw[(long)r32*qpitch+d0*16+hi*8]);
  float mhat=0.f,l_reg=0.f; f32x16 o[4]; o[0]=f32x16{};o[1]=f32x16{};o[2]=f32x16{};o[3]=f32x16{};
  const int t_tbl=(q0>=853)?((q0-853)/64+1):0;
  #define DV_CMASK(P0,P1,t) do{ int D0_=qpos-64*(t)-4*hi; D0_=D0_<1083?D0_:1083; const volatile lds_f32*tp_=Tl+(D0_+(256-59)); \
      { float tb_[8]; _Pragma("unroll") for(int b0_=0;b0_<16;b0_+=8){ _Pragma("unroll") for(int r=0;r<8;++r)tb_[r]=tp_[59-(((b0_+r)&3)+8*((b0_+r)>>2))]; _Pragma("unroll") for(int r=0;r<8;++r)P0[b0_+r]=fadd_s(P0[b0_+r],tb_[r]); } \
        _Pragma("unroll") for(int b0_=0;b0_<16;b0_+=8){ _Pragma("unroll") for(int r=0;r<8;++r)tb_[r]=tp_[27-(((b0_+r)&3)+8*((b0_+r)>>2))]; _Pragma("unroll") for(int r=0;r<8;++r)P1[b0_+r]=fadd_s(P1[b0_+r],tb_[r]); } } }while(0)
  #define DV_MX3(a,b,c) __builtin_fmaxf(__builtin_fmaxf((a),(b)),(c))
  #define DV_ROWMAX(rm,C0,C1) do{ float a=DV_MX3(C0[0],C0[1],C1[0]),b=DV_MX3(C0[2],C0[3],C1[1]); a=DV_MX3(a,C1[2],C1[3]); \
      _Pragma("unroll") for(int r=4;r<16;r+=4){a=DV_MX3(a,C0[r],C0[r+1]);b=DV_MX3(b,C0[r+2],C0[r+3]);a=DV_MX3(a,C1[r],C1[r+1]);b=DV_MX3(b,C1[r+2],C1[r+3]);} \
      rm=__builtin_fmaxf(a,b); { auto rr=__builtin_amdgcn_permlane32_swap(__float_as_uint(rm),__float_as_uint(rm),false,false); rm=__builtin_fmaxf(__uint_as_float(rr[0]),__uint_as_float(rr[1])); } }while(0)
  u32x4 pw0,pw1,pw2,pw3;
  #define DV_PKW(P,B) cvtpk_s(P[B],P[B+1])
  #define DV_SUM_PACK(C0,C1) do{ float sa_=fadd_s(C0[0],C0[1]),sb_=fadd_s(C1[0],C1[1]); _Pragma("unroll") for(int r=2;r<16;++r){ sa_=fadd_s(sa_,C0[r]); sb_=fadd_s(sb_,C1[r]); } l_reg+=fadd_s(sa_,sb_); \
      pw0=(u32x4){DV_PKW(C0,0),DV_PKW(C0,2),DV_PKW(C0,4),DV_PKW(C0,6)};pw1=(u32x4){DV_PKW(C0,8),DV_PKW(C0,10),DV_PKW(C0,12),DV_PKW(C0,14)}; \
      pw2=(u32x4){DV_PKW(C1,0),DV_PKW(C1,2),DV_PKW(C1,4),DV_PKW(C1,6)};pw3=(u32x4){DV_PKW(C1,8),DV_PKW(C1,10),DV_PKW(C1,12),DV_PKW(C1,14)}; }while(0)
  #define DV_PAF(k) __builtin_bit_cast(bf16x8,pw##k)
  #define DV_VFR(i) (bf16x8){vlo[i][0],vlo[i][1],vlo[i][2],vlo[i][3],vhi[i][0],vhi[i][1],vhi[i][2],vhi[i][3]}
  #define DV_VRD(n) do{ vlo[(n)&3]=vtr(vp_+((2*((n)>>3)+((n)&1))*4096+(((n)&7)>>1)*1024)); vhi[(n)&3]=vtr(vp_+((2*((n)>>3)+((n)&1))*4096+(((n)&7)>>1)*1024+512)); }while(0)
  #define DV_PIN(x) asm volatile("":"+v"(x))
  #define DV_KRD(j) do{ if(gv){ kload2(kf,kp0+sl_next,j); } }while(0)
  #define DV_EX(v) __builtin_amdgcn_exp2f(v)
  #define DV_GAP(n,X,B,RD) do{ o[2*((n)>>3)+((n)&1)]=__builtin_amdgcn_mfma_f32_32x32x16_bf16((((n)&7)>>1)==0?DV_PAF(0):((((n)&7)>>1)==1?DV_PAF(1):((((n)&7)>>1)==2?DV_PAF(2):DV_PAF(3))),DV_VFR((n)&3),o[2*((n)>>3)+((n)&1)],0,0,0); \
      X[B]=DV_EX(X[B]); X[B+1]=DV_EX(X[B+1]); DV_PIN(X); RD; SBAR(); }while(0)
  #define DV_SOFT1(C0,C1,t) do{ { const float d_=__builtin_fmaxf(C0[15],C1[15]); asm volatile(""::"v"(d_)); asm volatile("":"+v"(C0),"+v"(C1)); }     \
      if(mnz){ _Pragma("unroll") for(int r=0;r<16;++r){C0[r]=fsub_s(C0[r],mhat);C1[r]=fsub_s(C1[r],mhat);} } \
      if((t)>=t_tbl) DV_CMASK(C0,C1,t); \
      { float rm; DV_ROWMAX(rm,C0,C1); resc=false; \
        if(__builtin_expect(__any(rm>(float)THRL),0)){ const float dl=__builtin_fmaxf(rm,0.f); mhat+=dl; \
          _Pragma("unroll") for(int r=0;r<16;++r){C0[r]=fsub_s(C0[r],dl);C1[r]=fsub_s(C1[r],dl);} \
          const float f=__builtin_amdgcn_exp2f(-dl); l_reg*=f; if(hi==0)wsf[r32]=f; resc=true; mnz=true; } } }while(0)
  #define DV_RESC() do{ if(resc){ asm volatile("s_waitcnt lgkmcnt(0)":::"memory"); \
      _Pragma("unroll") for(int r=0;r<16;++r){ const float fr_=wsf[crow(r,hi)]; o[0][r]*=fr_;o[1][r]*=fr_;o[2][r]*=fr_;o[3][r]*=fr_; } asm volatile("s_waitcnt lgkmcnt(0)":::"memory"); } }while(0)
  int sl_prev=0,sl_cur=0,sl_next=SLOTB;
  #define DV_ROT() do{sl_prev=sl_cur;sl_cur=sl_next;sl_next=(sl_next==(NSLOT-1)*SLOTB)?0:sl_next+SLOTB;}while(0)
  DVK(2,2*SLOTB);
  WAIT_BAR(3);
  f32x16 pA0,pA1,pB0,pB1; bf16x8 kf[8]; s16x4 vlo[4],vhi[4]; bool resc=false,mnz=false;
  { const f32x16 z=f32x16{}; qkt(pA0,pA1,shm+DV_K,qr,z,r32,hi);
    DV_SOFT1(pA0,pA1,0);
    _Pragma("unroll") for(int r=0;r<16;++r){pA0[r]=DV_EX(pA0[r]);pA1[r]=DV_EX(pA1[r]);} }
  WAIT_BAR(0);
  DVK(3,0);DVV(1,SLOTB);
  DV_ROT();
  kload8(kf,kp0+sl_cur);
  WAIT_BAR(3);
  #define DV_GAPA(MF,A0,A1,A2,A3,W0,W1,PW) do{ MF; sacc+=A0; sacc+=A1; sacc+=A2; sacc+=A3; DV_PIN(sacc); W0; W1; DV_PIN(PW); SBAR(); }while(0)
  #define DV_Z f32x16{}
  #define DV_STEP(C0,C1,P0,P1,t) do{ const bool gk=((t)+3<NT), gv=((t)+1<NT); const lds_cptr vp_=vp0+2*sl_prev; SBAR(); \
    float sacc=(P0[0]+P0[1]); \
    DV_VRD(0); SBAR(); DV_GAPA(C0=__builtin_amdgcn_mfma_f32_32x32x16_bf16(kf[0],qr[0],DV_Z,0,0,0), P0[2],P0[3],P0[4],P0[5],     pw0[0]=DV_PKW(P0,0), pw0[1]=DV_PKW(P0,2), pw0); \
    DV_VRD(1); SBAR(); DV_GAPA(C1=__builtin_amdgcn_mfma_f32_32x32x16_bf16(kf[1],qr[0],DV_Z,0,0,0), P0[6],P0[7],P0[8],P0[9],     pw0[2]=DV_PKW(P0,4), pw0[3]=DV_PKW(P0,6), pw0); \
    DV_VRD(2); SBAR(); DV_GAPA(C0=__builtin_amdgcn_mfma_f32_32x32x16_bf16(kf[2],qr[1],C0,0,0,0),   P0[10],P0[11],P0[12],P0[13], pw1[0]=DV_PKW(P0,8), pw1[1]=DV_PKW(P0,10), pw1); \
    DV_VRD(3); SBAR(); DV_GAPA(C1=__builtin_amdgcn_mfma_f32_32x32x16_bf16(kf[3],qr[1],C1,0,0,0),   P0[14],P0[15],P1[0],P1[1],   pw1[2]=DV_PKW(P0,12),pw1[3]=DV_PKW(P0,14), pw1); \
    DV_GAPA(C0=__builtin_amdgcn_mfma_f32_32x32x16_bf16(kf[4],qr[2],C0,0,0,0),   P1[2],P1[3],P1[4],P1[5],     pw2[0]=DV_PKW(P1,0), pw2[1]=DV_PKW(P1,2), pw2); \
    DV_GAPA(C1=__builtin_amdgcn_mfma_f32_32x32x16_bf16(kf[5],qr[2],C1,0,0,0),   P1[6],P1[7],P1[8],P1[9],     pw2[2]=DV_PKW(P1,4), pw2[3]=DV_PKW(P1,6), pw2); \
    DV_GAPA(C0=__builtin_amdgcn_mfma_f32_32x32x16_bf16(kf[6],qr[3],C0,0,0,0),   P1[10],P1[11],P1[12],P1[13], pw3[0]=DV_PKW(P1,8), pw3[1]=DV_PKW(P1,10), pw3); \
    DV_GAPA(C1=__builtin_amdgcn_mfma_f32_32x32x16_bf16(kf[7],qr[3],C1,0,0,0),   P1[14],P1[15],0.f,0.f,       pw3[2]=DV_PKW(P1,12),pw3[3]=DV_PKW(P1,14), pw3); \
    l_reg+=sacc; \
    if(gk){DVK((t)+3,sl_cur);} if(gv){DVV((t)+1,sl_next);} \
    DV_SOFT1(C0,C1,t); \
    SBAR(); \
    DV_GAP(0,C0,0,  DV_VRD(4));   DV_GAP(1,C0,2,  DV_VRD(5));   DV_GAP(2,C0,4,  DV_VRD(6));   DV_GAP(3,C0,6,  DV_VRD(7)); \
    DV_GAP(4,C0,8,  DV_VRD(8));   DV_GAP(5,C0,10, DV_VRD(9));   DV_GAP(6,C0,12, DV_VRD(10));  DV_GAP(7,C0,14, DV_VRD(11)); \
    DV_GAP(8,C1,0,  DV_VRD(12));  DV_GAP(9,C1,2,  DV_VRD(13));  DV_GAP(10,C1,4, DV_VRD(14));  DV_GAP(11,C1,6, DV_VRD(15)); \
    DV_GAP(12,C1,8, DV_KRD(0));   DV_GAP(13,C1,10,DV_KRD(1));   DV_GAP(14,C1,12,DV_KRD(2));   DV_GAP(15,C1,14,DV_KRD(3)); \
    DV_RESC(); \
    if((t)+1<NT){ if((t)+3<NT){WAIT_BAR(3);} else if((t)+2<NT){WAIT_BAR(2);} else {WAIT_BAR(0);} DV_ROT(); } }while(0)
  { int t=1;
    for(;t+1<NT;t+=2){ DV_STEP(pB0,pB1,pA0,pA1,t); DV_STEP(pA0,pA1,pB0,pB1,t+1); }
    DV_STEP(pB0,pB1,pA0,pA1,t); }
  #undef DV_GAPA
  #undef DV_Z
  #undef DV_STEP
  DV_SUM_PACK(pB0,pB1);
  { const lds_cptr vp_=vp0+2*sl_cur;
    _Pragma("unroll") for(int n0=0;n0<16;n0+=4){
      _Pragma("unroll") for(int q=0;q<4;++q) DV_VRD(n0+q);
      _Pragma("unroll") for(int q=0;q<4;++q){ const int n=n0+q, kg=(n&7)>>1; const bf16x8 pa_=kg==0?DV_PAF(0):(kg==1?DV_PAF(1):(kg==2?DV_PAF(2):DV_PAF(3)));
        o[2*(n>>3)+(n&1)]=__builtin_amdgcn_mfma_f32_32x32x16_bf16(pa_,DV_VFR(n&3),o[2*(n>>3)+(n&1)],0,0,0); } } }
  asm volatile("s_waitcnt lgkmcnt(0)\n\ts_barrier":::"memory");
  {auto rr=__builtin_amdgcn_permlane32_swap(__float_as_uint(l_reg),__float_as_uint(l_reg),false,false);l_reg=__uint_as_float(rr[0])+__uint_as_float(rr[1]);}
  if(hi==0)wsf[32+r32]=l_reg;asm volatile("s_waitcnt lgkmcnt(0)":::"memory");
  float rli[16];
  #pragma unroll
  for(int r=0;r<16;++r)rli[r]=__builtin_amdgcn_rcpf(wsf[32+crow(r,hi)]);
  bf16*Ow=Ob+(long)(q0+wid*QBLK)*opitch;
  { bf16*stg=(bf16*)(shm+DV_OST)+wid*4096;
    #pragma unroll
    for(int r=0;r<16;++r){const int orow=crow(r,hi);
      #pragma unroll
      for(int d0=0;d0<4;++d0)stg[orow*128+d0*32+r32]=__float2bfloat16(o[d0][r]*rli[r]);}
    asm volatile("s_waitcnt lgkmcnt(0)":::"memory");
    #pragma unroll
    for(int i=0;i<8;++i){const int row=i*4+(lane>>4),ch=lane&15; const u32x4 v=*(const u32x4*)(stg+row*128+ch*8); ATTN_STORE16(Ow+(long)row*opitch+ch*8,v);} }
  asm volatile("s_waitcnt lgkmcnt(0)\n\ts_barrier":::"memory");
  #undef DVK
  #undef DVV
  #undef DV_CMASK
  #undef DV_MX3
  #undef DV_ROWMAX
  #undef DV_PKW
  #undef DV_SUM_PACK
  #undef DV_VFR
  #undef DV_VRD
  #undef DV_PIN
  #undef DV_EX
  #undef DV_GAP
  #undef DV_KRD
  #undef DV_SOFT1
  #undef DV_RESC
  #undef DV_PAF
  #undef DV_ROT
}
constexpr int ATTN_LDS_BYTES=LDS_BYTES;
#undef SBAR
#undef WAIT_BAR
}
#define GAS __attribute__((address_space(1)))
#define LAS __attribute__((address_space(3)))
typedef unsigned short bf16;
typedef unsigned v4u __attribute__((ext_vector_type(4)));
typedef float f32x4 __attribute__((ext_vector_type(4)));
typedef short bf16x8 __attribute__((ext_vector_type(8)));
typedef GAS unsigned gu32;
typedef GAS unsigned long long gu64;
#define RLX_AGENT __ATOMIC_RELAXED, __HIP_MEMORY_SCOPE_AGENT
#define LDS_WAIT() asm volatile("s_waitcnt lgkmcnt(0)" ::: "memory")
#define VM_WAIT() asm volatile("s_waitcnt vmcnt(0)" ::: "memory")
__device__ __forceinline__ unsigned long long rt() { return __builtin_amdgcn_s_memrealtime(); }
__device__ __forceinline__ unsigned f2bf(float f) { unsigned u = __builtin_bit_cast(unsigned, f); return (u + 0x7fffu + ((u >> 16) & 1u)) >> 16; }
__device__ __forceinline__ unsigned pk2(float lo, float hi) { return f2bf(lo) | (f2bf(hi) << 16); }

#define XB_TMO      128
#define XB_XCNT(j)  (256  + 64 * (j))
#define XB_XSUB(j)  (1280 + 64 * (j))
#define XB_XGEN(j)  (2304 + 64 * (j))
#define XB_TOP      3328
#define XB_TOPGEN   3392
#define XCD_BAR_WORDS 3456
#define XB_SPIN_CAP (1u << 25)

__device__ __forceinline__ unsigned xb_ld(unsigned* p)              { return __hip_atomic_load(p, __ATOMIC_RELAXED, __HIP_MEMORY_SCOPE_AGENT); }
__device__ __forceinline__ unsigned xb_add(unsigned* p, unsigned v) { return __hip_atomic_fetch_add(p, v, __ATOMIC_RELAXED, __HIP_MEMORY_SCOPE_AGENT); }
__device__ __forceinline__ unsigned xb_xcc_id() { return (unsigned)__builtin_amdgcn_s_getreg((3 << 11) | 20) & 0xFu; }
#define XB_SPIN(cond, bar) do { unsigned _sp = 0; while (cond) { __builtin_amdgcn_s_sleep(1); \
    if ((++_sp & 255u) == 0u) { if (xb_ld(&(bar)[XB_TMO])) break; if (_sp > XB_SPIN_CAP) { atomicAdd(&(bar)[XB_TMO], 1u); break; } } } } while (0)

struct XcdBarrier {
    unsigned* bar; unsigned x;
    volatile LAS unsigned* st;
};

__device__ __forceinline__ XcdBarrier xcd_barrier_post(unsigned* bar, volatile LAS unsigned* st) {
    XcdBarrier b; b.bar = bar; b.x = xb_xcc_id(); b.st = st;
    if (threadIdx.x == 0) (void)xb_add(&bar[XB_XCNT(b.x)], 1u);
    return b;
}
__device__ __forceinline__ void xcd_barrier_complete(unsigned* bar, unsigned x, unsigned& nloc, unsigned& nx) {
    const unsigned G = gridDim.x * gridDim.y * gridDim.z;
    unsigned sum, cnt, mine, sp = 0u;
    for (;;) {
        sum = 0u; cnt = 0u; mine = 0u;
#pragma nounroll
        for (unsigned j = 0; j < 16; ++j) { const unsigned c = xb_ld(&bar[XB_XCNT(j)]); sum += c; cnt += (c > 0u) ? 1u : 0u; mine = (j == x) ? c : mine; }
        if (sum == G) break;
        __builtin_amdgcn_s_sleep(1);
        if ((++sp & 255u) == 0u) { if (xb_ld(&bar[XB_TMO])) break; if (sp > XB_SPIN_CAP) { atomicAdd(&bar[XB_TMO], 1u); break; } }
    }
    nloc = mine > 0u ? mine : 1u; nx = cnt > 0u ? cnt : 1u;
}

__device__ __forceinline__ void xcd_barrier(const XcdBarrier& b) {
    asm volatile("s_waitcnt vmcnt(0)" ::: "memory");
    __syncthreads();
    if (threadIdx.x == 0) {
        unsigned* bar; { GAS unsigned* bl_ = (GAS unsigned*)b.bar; asm volatile("" : "+s"(bl_)); bar = (unsigned*)bl_; } unsigned bx_ = b.x; asm volatile("" : "+s"(bx_));
        __builtin_amdgcn_s_waitcnt(0);
        unsigned nloc = b.st[0], nx = b.st[1];
        if (nloc == 0u) { xcd_barrier_complete(bar, bx_, nloc, nx); b.st[0] = nloc; b.st[1] = nx; }
        const unsigned old = xb_add(&bar[XB_XSUB(bx_)], 1u);
        const unsigned gen = old / nloc;
        if (old + 1u == (gen + 1u) * nloc) {
            __builtin_amdgcn_fence(__ATOMIC_RELEASE, "agent");
            asm volatile("s_waitcnt vmcnt(0)" ::: "memory");
            const unsigned og = xb_add(&bar[XB_TOP], 1u);
            const unsigned tg = og / nx;
            if (og + 1u == (tg + 1u) * nx) xb_add(&bar[XB_TOPGEN], 1u);
            else XB_SPIN(xb_ld(&bar[XB_TOPGEN]) == tg, bar);
            __builtin_amdgcn_fence(__ATOMIC_ACQUIRE, "agent");
            xb_add(&bar[XB_XGEN(bx_)], 1u);
            asm volatile("s_waitcnt vmcnt(0)" ::: "memory");
        } else {
            XB_SPIN(xb_ld(&bar[XB_XGEN(bx_)]) == gen, bar);
            __builtin_amdgcn_fence(__ATOMIC_ACQUIRE, "agent");
            asm volatile("s_waitcnt vmcnt(0)" ::: "memory");
        }
    }
    __syncthreads();
}
constexpr int NB = 4, SEQ = 4096, DM = 1024, M = NB * SEQ, NL = 4;
constexpr int NIN = 3328;
constexpr int NWAVES = 8;
#ifndef PG8_SP2
#define PG8_SP2 true
#endif
constexpr float LOG2E = 1.4426950408889634f;
constexpr float C2 = 0.125f * LOG2E;
constexpr int MOE_ROWS = 40960;
constexpr size_t MiB = 1u << 20;
constexpr size_t WS_CTL = 0, CTL_ZERO_BYTES = 1 * MiB;
constexpr size_t WS_MOD = 1 * MiB;
constexpr size_t WS_TB = WS_MOD + 512 * 1024;
constexpr size_t WS_LAM = WS_TB + 64 * 1024;
constexpr size_t WS_KMEAN = WS_LAM + 4096;
constexpr size_t WS_WIN = 2 * MiB;
constexpr size_t WS_WOUT = 28 * MiB;
constexpr size_t WS_W13 = 36 * MiB;
constexpr size_t WS_W2 = 292 * MiB;
constexpr size_t WS_HB = 420 * MiB;
constexpr size_t WS_XS = 452 * MiB, WS_HS = 532 * MiB, WS_YS = 572 * MiB;
constexpr size_t WS_SMALL = 652 * MiB;
constexpr size_t WS_QD = 656 * MiB, WS_KD = 672 * MiB, WS_VD = 688 * MiB, WS_QM = 704 * MiB, WS_KM = 712 * MiB, WS_VM = 720 * MiB;
constexpr size_t WS_PR = 728 * MiB;
constexpr size_t WS_MIX = 784 * MiB;
constexpr size_t WS_OD = 816 * MiB;
constexpr size_t WS_RW = 848 * MiB;
constexpr size_t WS_END = 960 * MiB;
constexpr int CW_BAR = 4096;
constexpr int CW_CNT = 16384;
constexpr int CW_CUR = 16384 + 1024;
constexpr int RING_BYTES = 131072, LDSCTL_OFF = RING_BYTES, MISC_OFF = LDSCTL_OFF + 320, TAB_OFF = LDSCTL_OFF + 1024;
constexpr int LDS_BYTES = 147456;
static_assert(WS_QD == pg8::EPI_WS_QD && WS_KD == pg8::EPI_WS_KD && WS_VD == pg8::EPI_WS_VD && WS_QM == pg8::EPI_WS_QM && WS_KM == pg8::EPI_WS_KM && WS_VM == pg8::EPI_WS_VM && WS_PR == pg8::EPI_WS_PR, "epilogue workspace map");
__device__ __forceinline__ float rl63(float v) { return __uint_as_float(__builtin_amdgcn_readlane(__float_as_uint(v), 63)); }
template <int CTRL, int ROWMASK> __device__ __forceinline__ float dpp_f(float oldv, float v) { return __int_as_float(__builtin_amdgcn_update_dpp(__float_as_int(oldv), __float_as_int(v), CTRL, ROWMASK, 0xf, false)); }
__device__ __forceinline__ float wave_sum(float v) {
    v += dpp_f<0xB1, 0xf>(0.f, v);
    v += dpp_f<0x4E, 0xf>(0.f, v);
    v += dpp_f<0x141, 0xf>(0.f, v);
    v += dpp_f<0x140, 0xf>(0.f, v);
    v += dpp_f<0x142, 0xa>(0.f, v);
    v += dpp_f<0x143, 0xc>(0.f, v);
    return rl63(v);
}
__device__ __forceinline__ float wave_max(float v) {
    v = fmaxf(v, dpp_f<0xB1, 0xf>(v, v)); v = fmaxf(v, dpp_f<0x4E, 0xf>(v, v)); v = fmaxf(v, dpp_f<0x141, 0xf>(v, v)); v = fmaxf(v, dpp_f<0x140, 0xf>(v, v));
    v = fmaxf(v, dpp_f<0x142, 0xa>(v, v)); v = fmaxf(v, dpp_f<0x143, 0xc>(v, v));
    return rl63(v);
}
__device__ __forceinline__ float bf_lo(unsigned u) { return __uint_as_float(u << 16); }
__device__ __forceinline__ float bf_hi(unsigned u) { return __uint_as_float(u & 0xffff0000u); }
__device__ __forceinline__ float bf2f(bf16 h) { return __uint_as_float((unsigned)h << 16); }
__device__ __forceinline__ float rl(float v, int i) { return __uint_as_float(__builtin_amdgcn_readlane(__float_as_uint(v), i)); }
__device__ __forceinline__ float sigmoidf_(float x) { return 1.0f / (1.0f + __expf(-x)); }

struct Frame {
    LAS unsigned char* lds; volatile LAS unsigned* MISC; gu32* ctl;
    int tid, lane, wave, vcu, G, gw, NGW;
    float* out; unsigned char* ws;
};
__device__ __forceinline__ unsigned char* launder_ptr(unsigned char* p) {
    GAS unsigned char* g = (GAS unsigned char*)p; asm volatile("" : "+s"(g)); return (unsigned char*)g; }
#define GIN(i) ((const float*)(const GAS float*)A.in[i])
#define WSP(T, off) ((T*)(launder_ptr(F.ws) + (off)))

template <class RowMap>
__device__ __forceinline__ void tr_item(const float* W, int N, int K, bf16* WT, LAS float* scr, int k0, int n0, int lane, RowMap rm) {
#pragma unroll
    for (int i = 0; i < 8; ++i) { const int kk = 8 * i + (lane >> 3), c4 = lane & 7; const f32x4 x = *(const GAS f32x4*)(W + (size_t)(k0 + kk) * N + n0 + 4 * c4);
        LAS float* d = scr + kk * 33 + 4 * c4; d[0] = x.x; d[1] = x.y; d[2] = x.z; d[3] = x.w; }
    LDS_WAIT(); asm volatile("" ::: "memory");
    const int c = lane & 7;
#pragma unroll
    for (int j = 0; j < 4; ++j) { const int n = (lane >> 3) + 8 * j; const LAS float* s = scr + (8 * c) * 33 + n;
        v4u o; o.x = pk2(s[0 * 33], s[1 * 33]); o.y = pk2(s[2 * 33], s[3 * 33]); o.z = pk2(s[4 * 33], s[5 * 33]); o.w = pk2(s[6 * 33], s[7 * 33]);
        *(GAS v4u*)(WT + (size_t)rm(n0 + n) * K + k0 + 8 * c) = o; }
    LDS_WAIT(); asm volatile("" ::: "memory");
}
__device__ __forceinline__ int inproj_row(int n) {
    const int L = n < 896 ? 2304 + n : n - 896;
    const int l = L & 255;
    return (L & ~255) | (((l >> 5) & 1) << 7) | ((l >> 6) << 5) | (l & 31);
}
__device__ __forceinline__ int t5_bucket(int n) {
    if (n < 16) return n;
    const float x = (8.0f * __log2f((float)n) - 32.0f) * (1.0f / 3.0f) + 1e-4f;
    int b = 16 + (int)x; return b > 31 ? 31 : b;
}
struct TrDesc { const float* src; bf16* dst; int N, K, n0, kind; };
__device__ __forceinline__ TrDesc moe_tr_desc(KArgs& A, unsigned char* ws, int l, int r) {
    constexpr int I_W1 = 16 * 16, I_W2 = 8 * 32, N_W1 = 32 * I_W1;
    TrDesc d;
    if (r < 2 * N_W1) { const int which = r / N_W1; r %= N_W1; const int le = l * 32 + r / I_W1, q = r % I_W1, kb = q / 16, nb = q % 16;
        d.N = 512; d.K = 1024; d.n0 = 32 * nb; d.kind = which;
        d.src = (const float*)(const GAS float*)A.in[which ? 31 : 30] + (size_t)le * 1024 * 512 + (size_t)(64 * kb) * 512 + 32 * nb; d.dst = (bf16*)(ws + WS_W13) + (size_t)le * 1024 * 1024 + 64 * kb; }
    else { r -= 2 * N_W1; const int le = l * 32 + r / I_W2, q = r % I_W2, kb = q / 32, nb = q % 32;
        d.N = 1024; d.K = 512; d.n0 = 32 * nb; d.kind = 2;
        d.src = (const float*)(const GAS float*)A.in[32] + (size_t)le * 512 * 1024 + (size_t)(64 * kb) * 1024 + 32 * nb; d.dst = (bf16*)(ws + WS_W2) + (size_t)le * 1024 * 512 + 64 * kb; }
    return d;
}
__device__ __forceinline__ void moe_tr_load(const TrDesc& d, int lane, f32x4 (&x)[8]) {
#pragma unroll
    for (int i = 0; i < 8; ++i) x[i] = __builtin_nontemporal_load((const GAS f32x4*)(d.src + (size_t)(8 * i + (lane >> 3)) * d.N + 4 * (lane & 7)));
}
__device__ __forceinline__ void moe_tr_store(const TrDesc& d, int lane, const f32x4 (&x)[8], LAS float* scr) {
#pragma unroll
    for (int i = 0; i < 8; ++i) { const int kk = 8 * i + (lane >> 3), c4 = lane & 7; LAS float* p = scr + kk * 33 + 4 * c4; p[0] = x[i].x; p[1] = x[i].y; p[2] = x[i].z; p[3] = x[i].w; }
    LDS_WAIT(); asm volatile("" ::: "memory");
    const int c = lane & 7;
#pragma unroll
    for (int j = 0; j < 4; ++j) { const int n = (lane >> 3) + 8 * j; const LAS float* s = scr + (8 * c) * 33 + n;
        v4u o; o.x = pk2(s[0 * 33], s[1 * 33]); o.y = pk2(s[2 * 33], s[3 * 33]); o.z = pk2(s[4 * 33], s[5 * 33]); o.w = pk2(s[6 * 33], s[7 * 33]);
        const int nn = d.n0 + n, row = d.kind == 2 ? nn : 8 * (nn >> 2) + 4 * d.kind + (nn & 3);
        __builtin_nontemporal_store(o, (GAS v4u*)(d.dst + (size_t)row * d.K + 8 * c)); }
    LDS_WAIT(); asm volatile("" ::: "memory");
}
__device__ __forceinline__ void moe_convert_ticket(Frame& F, KArgs& A, int l, int ct) {
    int lane_ = F.lane, wv_ = F.wave; asm volatile("" : "+v"(lane_), "+s"(wv_));
    LAS float* scr = (LAS float*)(F.lds + wv_ * 8448);
    const int r0 = ct * 64 + wv_ * 8;
    f32x4 x0[8], x1[8], x2[8], x3[8];
    TrDesc d0 = moe_tr_desc(A, F.ws, l, r0), d1 = moe_tr_desc(A, F.ws, l, r0 + 1), d2 = moe_tr_desc(A, F.ws, l, r0 + 2), d3 = moe_tr_desc(A, F.ws, l, r0 + 3);
    moe_tr_load(d0, lane_, x0); moe_tr_load(d1, lane_, x1); moe_tr_load(d2, lane_, x2); moe_tr_load(d3, lane_, x3);
    moe_tr_store(d0, lane_, x0, scr); d0 = moe_tr_desc(A, F.ws, l, r0 + 4); moe_tr_load(d0, lane_, x0);
    moe_tr_store(d1, lane_, x1, scr); d1 = moe_tr_desc(A, F.ws, l, r0 + 5); moe_tr_load(d1, lane_, x1);
    moe_tr_store(d2, lane_, x2, scr); d2 = moe_tr_desc(A, F.ws, l, r0 + 6); moe_tr_load(d2, lane_, x2);
    moe_tr_store(d3, lane_, x3, scr); d3 = moe_tr_desc(A, F.ws, l, r0 + 7); moe_tr_load(d3, lane_, x3);
    moe_tr_store(d0, lane_, x0, scr); moe_tr_store(d1, lane_, x1, scr); moe_tr_store(d2, lane_, x2, scr); moe_tr_store(d3, lane_, x3, scr);
}
__device__ __forceinline__ void p0_prologue(Frame& F, KArgs& A) {
    LAS float* scr = (LAS float*)(F.lds + F.wave * 16384);
    {
        constexpr int I_IN = 16 * 100, I_OUT = 16 * 32, I_W1 = 16 * 16, I_W2 = 8 * 32;
        constexpr int N_IN = NL * I_IN, N_OUT = NL * I_OUT, N_W1 = NL * 32 * I_W1, N_W2 = NL * 32 * I_W2;
        constexpr int NITEMS = N_IN + N_OUT + 2 * N_W1 + N_W2;
        for (int it = F.gw; it < N_IN + N_OUT; it += F.NGW) {
            int r = it;
            if (r < N_IN) { const int l = r / I_IN, q = r % I_IN, kb = q / 100, nb = q % 100;
                tr_item(GIN(6) + (size_t)l * 1024 * 3200, 3200, 1024, WSP(bf16, WS_WIN) + (size_t)l * NIN * 1024, scr, 64 * kb, 32 * nb, F.lane, [](int n) { return inproj_row(n); }); continue; }
            r -= N_IN;
            if (r < N_OUT) { const int l = r / I_OUT, q = r % I_OUT, kb = q / 32, nb = q % 32;
                tr_item(GIN(7) + (size_t)l * 1024 * 1024, 1024, 1024, WSP(bf16, WS_WOUT) + (size_t)l * 1024 * 1024, scr, 64 * kb, 32 * nb, F.lane, [](int n) { return n; }); continue; }
            r -= N_OUT;
            if (r < 2 * N_W1) { const int which = r / N_W1; r %= N_W1; const int le = r / I_W1, q = r % I_W1, kb = q / 16, nb = q % 16;
                const float* W = A.in[which ? 31 : 30] + (size_t)le * 1024 * 512; bf16* WT = WSP(bf16, WS_W13) + (size_t)le * 1024 * 1024;
                if (which == 0) tr_item(W, 512, 1024, WT, scr, 64 * kb, 32 * nb, F.lane, [](int n) { return 8 * (n >> 2) + (n & 3); });
                else            tr_item(W, 512, 1024, WT, scr, 64 * kb, 32 * nb, F.lane, [](int n) { return 8 * (n >> 2) + 4 + (n & 3); });
                continue; }
            r -= 2 * N_W1;
            { const int le = r / I_W2, q = r % I_W2, kb = q / 32, nb = q % 32;
                tr_item(GIN(32) + (size_t)le * 512 * 1024, 1024, 512, WSP(bf16, WS_W2) + (size_t)le * 1024 * 512, scr, 64 * kb, 32 * nb, F.lane, [](int n) { return n; }); }
        }
    }
    __syncthreads();
    {
        LAS float* cs = (LAS float*)F.lds;
        for (int i = F.tid; i < 4096; i += 512) { const float v = GIN(1)[i]; cs[i] = v / (1.0f + __expf(-v)); }
        __syncthreads();
        const int kp = F.tid >> 5, jj = F.tid & 31;
        LAS float* red = cs + 4096;
        for (int it = F.vcu; it < NL * 192; it += F.G) {
            const int l = it / 192, j = (it % 192) * 32 + jj;
            const float* w = GIN(2) + (size_t)l * 1024 * 6144 + j;
            float a0 = 0.f, a1 = 0.f, a2 = 0.f, a3 = 0.f;
#pragma unroll 16
            for (int k = kp * 64; k < kp * 64 + 64; ++k) { const float wv = w[(size_t)k * 6144]; a0 += cs[k] * wv; a1 += cs[1024 + k] * wv; a2 += cs[2048 + k] * wv; a3 += cs[3072 + k] * wv; }
            red[(kp * 4 + 0) * 32 + jj] = a0; red[(kp * 4 + 1) * 32 + jj] = a1; red[(kp * 4 + 2) * 32 + jj] = a2; red[(kp * 4 + 3) * 32 + jj] = a3;
            __syncthreads();
            if (F.tid < 128) { const int b = F.tid >> 5; float s = GIN(3)[l * 6144 + j];
#pragma unroll
                for (int q = 0; q < 16; ++q) s += red[(q * 4 + b) * 32 + jj];
                WSP(float, WS_MOD)[((size_t)l * NB + b) * 6144 + j] = s; }
            __syncthreads();
        }
    }
    for (int i = F.gw * 64 + F.lane; i < 8 * 1024; i += F.NGW * 64) { const int hh = i >> 10, d = i & 1023; WSP(float, WS_TB)[i] = GIN(25)[t5_bucket(d) * 8 + hh] * LOG2E; }
    for (int i = F.gw * 64 + F.lane; i < NL * 1024 * 48; i += F.NGW * 64) { const int c = i % 48, lk = i / 48; float v = 0.f; if (c < 4) v = GIN(26)[(size_t)lk * 4 + c]; else if (c >= 16) v = GIN(28)[(size_t)lk * 32 + (c - 16)]; WSP(float, WS_SMALL + 2 * MiB)[i] = v; }
    for (int i = F.gw * 64 + F.lane; i < NL * 4 * 9728; i += F.NGW * 64) { const int lh = i / 9728, x = i % 9728, l = lh >> 2, h = lh & 3; float v = 0.f;
        if (x < 5120) { const int mtx = x / 2560, y = x % 2560, ch = y / 40, j = y % 40; if (j < 32) v = GIN(mtx ? 12 : 10)[((size_t)l * 32 + j) * 256 + h * 64 + ch]; }
        else { const int y = x - 5120, ch = y / 72, j = y % 72; if (j < 64) v = GIN(13)[((size_t)l * 64 + j) * 256 + h * 64 + ch]; }
        WSP(bf16, WS_SMALL + 3 * MiB)[i] = (bf16)f2bf(v); }
    if (F.vcu == 0 && F.tid < NL) { const int l = F.tid; const float* lm = GIN(21) + l * 256; float s01 = 0.f, s23 = 0.f;
        for (int i = 0; i < 64; ++i) { s01 += lm[i] * lm[64 + i]; s23 += lm[128 + i] * lm[192 + i]; }
        WSP(float, WS_LAM)[l] = __expf(s01) - __expf(s23) + (0.8f - 0.6f * __expf(-0.3f * (float)l)); }
}

__device__ __forceinline__ void phase_norm1(Frame& F, KArgs& A, int l) {
    const float* xin = (l == 0) ? GIN(0) : F.out;
    const bf16* YS = WSP(bf16, WS_YS); const int* POS = WSP(int, WS_SMALL) + 4 * M;
    for (int m = F.gw; m < M; m += F.NGW) {
        const int b = m / SEQ;
        f32x4 v[4];
#pragma unroll
        for (int j = 0; j < 4; ++j) v[j] = __builtin_nontemporal_load((const GAS f32x4*)(xin + (size_t)m * DM) + F.lane + 64 * j);
        if (l > 0) {
            const int p0 = POS[2 * m], p1 = POS[2 * m + 1];
            const float* g2 = WSP(float, WS_MOD) + ((size_t)(l - 1) * NB + b) * 6144 + 5 * 1024;
#pragma unroll
            for (int j = 0; j < 4; ++j) { const int c = 4 * (F.lane + 64 * j);
                const uint2 ya = *(const uint2*)(YS + (size_t)p0 * DM + c), yb = *(const uint2*)(YS + (size_t)p1 * DM + c);
                const f32x4 gg = *(const f32x4*)(g2 + c);
                v[j].x += gg.x * (bf_lo(ya.x) + bf_lo(yb.x)); v[j].y += gg.y * (bf_hi(ya.x) + bf_hi(yb.x));
                v[j].z += gg.z * (bf_lo(ya.y) + bf_lo(yb.y)); v[j].w += gg.w * (bf_hi(ya.y) + bf_hi(yb.y)); }
        }
        if (l == 0 || l > 0) {
#pragma unroll
            for (int j = 0; j < 4; ++j) __builtin_nontemporal_store(v[j], (GAS f32x4*)(F.out + (size_t)m * DM) + F.lane + 64 * j);
        }
        if (l == NL) continue;
        float ss = 0.f;
#pragma unroll
        for (int j = 0; j < 4; ++j) ss += (v[j].x * v[j].x + v[j].y * v[j].y) + (v[j].z * v[j].z + v[j].w * v[j].w);
        const float rstd = 1.0f / sqrtf(wave_sum(ss) * (1.0f / DM) + 1e-6f);
        const float* mod = WSP(float, WS_MOD) + ((size_t)l * NB + b) * 6144;
        const float* ng = GIN(4) + l * DM;
        bf16* hrow = WSP(bf16, WS_HB) + (size_t)m * DM;
#pragma unroll
        for (int j = 0; j < 4; ++j) { const int c = 4 * (F.lane + 64 * j);
            const f32x4 g = *(const f32x4*)(ng + c), sh = *(const f32x4*)(mod + c), sc = *(const f32x4*)(mod + 1024 + c);
            const float h0 = v[j].x * rstd * g.x * (1.f + sc.x) + sh.x, h1 = v[j].y * rstd * g.y * (1.f + sc.y) + sh.y;
            const float h2 = v[j].z * rstd * g.z * (1.f + sc.z) + sh.z, h3 = v[j].w * rstd * g.w * (1.f + sc.w) + sh.w;
            uint2 o; o.x = pk2(h0, h1); o.y = pk2(h2, h3); *(uint2*)(hrow + c) = o; }
    }
}
constexpr size_t WS_WEG = WS_SMALL + 2 * MiB;
__device__ __forceinline__ void moe_tables(Frame& F, KArgs& A, int l) {
    LAS int* base = (LAS int*)(F.lds + TAB_OFF); LAS int* t2e = base + 64;
    const unsigned* cnt = (const unsigned*)(F.ctl + CW_CNT + l * 64);
    if (F.tid == 0) { int acc = 0; for (int e = 0; e < 32; ++e) { base[e] = acc; const int c = (int)__hip_atomic_load(cnt + e, __ATOMIC_RELAXED, __HIP_MEMORY_SCOPE_AGENT); acc += (c + 255) / 256 * 256; } base[32] = acc; }
    __syncthreads();
    if (F.tid < 160) { const int r0 = F.tid * 256; int e = 31; for (int x = 0; x < 32; ++x) if (r0 >= base[x] && r0 < base[x + 1]) e = x; t2e[F.tid] = e; }
    __syncthreads();
}
__device__ __forceinline__ void phase_router(Frame& F, KArgs& A, int l, const XcdBarrier& bar) {
    typedef float f32x4_ __attribute__((ext_vector_type(4)));
    const float* bg = GIN(27) + l * 4; const float* be = GIN(29) + l * 32;
    const float* Wc = WSP(float, WS_WEG) + (size_t)l * 1024 * 48;
    int* SLT = WSP(int, WS_SMALL) + 4 * M; float* GS = WSP(float, WS_SMALL) + 6 * M;
    unsigned* cnt = (unsigned*)(F.ctl + CW_CNT + l * 64);
    constexpr int HP = 1028;
    LAS float* H = (LAS float*)F.lds; LAS float* part = (LAS float*)(F.lds + 65792); LAS float* LG = (LAS float*)(F.lds + 90368);
    LAS int* el_ = (LAS int*)(F.lds + 93440); LAS float* gl_ = (LAS float*)(F.lds + 93440 + 512); LAS int* off_ = (LAS int*)(F.lds + 93440 + 1024); LAS int* slot_ = (LAS int*)(F.lds + 93440 + 1536);
    const float* ng = GIN(5) + l * DM;
    const int t = F.lane & 15, kq = F.lane >> 4;
    float breg[3][32];
#pragma unroll
    for (int kk = 0; kk < 32; ++kk)
#pragma unroll
        for (int ct = 0; ct < 3; ++ct) breg[ct][kk] = Wc[(size_t)(128 * F.wave + 4 * kk + kq) * 48 + 16 * ct + t];
    const int vb = F.vcu; const bool hasvb = vb < M / 64;
    typedef unsigned v2u_ __attribute__((ext_vector_type(2)));
    v2u_ hk[8][4];
#pragma unroll
    for (int r = 0; r < 8; ++r)
#pragma unroll
        for (int j = 0; j < 4; ++j) { hk[r][j].x = 0u; hk[r][j].y = 0u; }
    if (hasvb) {
        for (int grp = 0; grp < 4; ++grp) {
            f32x4 v[2][4];
#pragma unroll
            for (int u = 0; u < 2; ++u) { const int m = vb * 64 + grp * 16 + 2 * F.wave + u;
#pragma unroll
                for (int j = 0; j < 4; ++j) v[u][j] = __builtin_nontemporal_load((const GAS f32x4*)(F.out + (size_t)m * DM) + F.lane + 64 * j); }
#pragma unroll
            for (int u = 0; u < 2; ++u) {
                const int tg = 2 * F.wave + u, m = vb * 64 + grp * 16 + tg, b = m / SEQ;
                float ss = 0.f;
#pragma unroll
                for (int j = 0; j < 4; ++j) ss += (v[u][j].x * v[u][j].x + v[u][j].y * v[u][j].y) + (v[u][j].z * v[u][j].z + v[u][j].w * v[u][j].w);
                const float rstd = 1.0f / sqrtf(wave_sum(ss) * (1.0f / DM) + 1e-6f);
                const float* mod = WSP(float, WS_MOD) + ((size_t)l * NB + b) * 6144;
#pragma unroll
                for (int j = 0; j < 4; ++j) { const int c = 4 * (F.lane + 64 * j);
                    const f32x4 g = *(const GAS f32x4*)(ng + c), sh = *(const GAS f32x4*)(mod + 3072 + c), sc = *(const GAS f32x4*)(mod + 4096 + c);
                    f32x4 h; h.x = v[u][j].x * rstd * g.x * (1.f + sc.x) + sh.x; h.y = v[u][j].y * rstd * g.y * (1.f + sc.y) + sh.y; h.z = v[u][j].z * rstd * g.z * (1.f + sc.z) + sh.z; h.w = v[u][j].w * rstd * g.w * (1.f + sc.w) + sh.w;
                    v2u_ o; o.x = pk2(h.x, h.y); o.y = pk2(h.z, h.w);
#pragma unroll
                    for (int g = 0; g < 4; ++g) if (grp == g) hk[2 * g + u][j] = o;
                    *(LAS f32x4*)(H + tg * HP + c) = h; }
            }
            LDS_WAIT(); __syncthreads();
            {
                f32x4_ acc0 = {0.f, 0.f, 0.f, 0.f}, acc1 = acc0, acc2 = acc0;
                const LAS float* hp = H + t * HP + 128 * F.wave + kq;
#pragma unroll
                for (int kk = 0; kk < 32; ++kk) { const float a = hp[4 * kk];
                    acc0 = __builtin_amdgcn_mfma_f32_16x16x4f32(a, breg[0][kk], acc0, 0, 0, 0); acc1 = __builtin_amdgcn_mfma_f32_16x16x4f32(a, breg[1][kk], acc1, 0, 0, 0); acc2 = __builtin_amdgcn_mfma_f32_16x16x4f32(a, breg[2][kk], acc2, 0, 0, 0); }
#pragma unroll
                for (int r = 0; r < 4; ++r) { LAS float* pp = part + (F.wave * 16 + 4 * kq + r) * 48 + t; pp[0] = acc0[r]; pp[16] = acc1[r]; pp[32] = acc2[r]; }
            }
            LDS_WAIT(); __syncthreads();
            for (int i = F.tid; i < 16 * 48; i += NWAVES * 64) { float sum = 0.f;
#pragma unroll
                for (int q = 0; q < 8; ++q) sum += part[q * 768 + i];
                LG[i] = sum; }
            LDS_WAIT(); __syncthreads();
            if (F.tid < 16) { const LAS float* lg = LG + F.tid * 48;
                float gl[4];
#pragma unroll
                for (int g = 0; g < 4; ++g) gl[g] = lg[g] + bg[g];
                int gs = 0; float gm = gl[0];
#pragma unroll
                for (int g = 1; g < 4; ++g) if (gl[g] > gm) { gm = gl[g]; gs = g; }
                float den = 0.f;
#pragma unroll
                for (int g = 0; g < 4; ++g) den += __expf(gl[g] - gm);
                const float pg = 1.0f / den;
                float el[8];
#pragma unroll
                for (int e = 0; e < 8; ++e) el[e] = lg[16 + gs * 8 + e] + be[gs * 8 + e];
                int e1 = 0; float m1 = el[0];
#pragma unroll
                for (int e = 1; e < 8; ++e) if (el[e] > m1) { m1 = el[e]; e1 = e; }
                int e2 = -1; float m2 = -INFINITY;
#pragma unroll
                for (int e = 0; e < 8; ++e) if (e != e1 && el[e] > m2) { m2 = el[e]; e2 = e; }
                const float ex = __expf(m2 - m1); const int tl = grp * 16 + F.tid;
                el_[2 * tl] = gs * 8 + e1; el_[2 * tl + 1] = gs * 8 + e2; gl_[2 * tl] = pg / (1.f + ex); gl_[2 * tl + 1] = pg * ex / (1.f + ex); }
            LDS_WAIT(); __syncthreads();
        }
        int rank = 0, mye = 0;
        if (F.tid < 128) { mye = el_[F.tid]; for (int a = 0; a < F.tid; ++a) rank += (el_[a] == mye) ? 1 : 0; }
        else if (F.tid < 160) { const int e = F.tid - 128; int c = 0; for (int a = 0; a < 128; ++a) c += (el_[a] == e) ? 1 : 0; off_[e] = c ? (int)atomicAdd(cnt + e, (unsigned)c) : 0; }
        LDS_WAIT(); __syncthreads();
        if (F.tid < 128) slot_[F.tid] = off_[mye] + rank;
        LDS_WAIT(); __syncthreads();
    }
    xcd_barrier(bar);
    moe_tables(F, A, l);
    {
        const LAS int* base = (const LAS int*)(F.lds + TAB_OFF);
        bf16* XS = WSP(bf16, WS_XS);
        if (hasvb) {
#pragma unroll
            for (int r = 0; r < 8; ++r) { const int tl = (r >> 1) * 16 + 2 * F.wave + (r & 1), m = vb * 64 + tl;
#pragma unroll
                for (int k = 0; k < 2; ++k) { const int pos = base[el_[2 * tl + k]] + slot_[2 * tl + k];
#pragma unroll
                    for (int j = 0; j < 4; ++j) __builtin_nontemporal_store(hk[r][j], (GAS v2u_*)(XS + (size_t)pos * DM + 4 * (F.lane + 64 * j)));
                    if (F.lane == 0) { SLT[2 * m + k] = pos; GS[pos] = gl_[2 * tl + k]; } } }
        }
        for (int it = F.gw; it < 32 * 256; it += F.NGW) { const int e = it >> 8, i = it & 255; const int c = (int)cnt[e]; const int npad = (c + 255) / 256 * 256 - c;
            if (i < npad) { const int pos = base[e] + c + i; const v4u z = {0u, 0u, 0u, 0u};
#pragma unroll
                for (int j = 0; j < 2; ++j) *((GAS v4u*)(XS + (size_t)pos * DM) + F.lane + 64 * j) = z;
                if (F.lane == 0) GS[pos] = 0.f; } }
    }
}
namespace rw {
typedef short bf16x8 __attribute__((ext_vector_type(8)));
typedef float f32x16 __attribute__((ext_vector_type(16)));
constexpr int PITCH = 144;
constexpr int SLOT = 64 * PITCH;
constexpr int GAM_OFF = 14 * SLOT;
constexpr size_t ITEM_BYTES = 49152;
__device__ __forceinline__ int crow(int r, int hi) { return (r & 3) + 8 * (r >> 2) + 4 * hi; }
__device__ __forceinline__ unsigned short f2b(float f) { unsigned u = __builtin_bit_cast(unsigned, f); return (unsigned short)((u + 0x7fffu + ((u >> 16) & 1u)) >> 16); }
__device__ __forceinline__ unsigned pk(float lo, float hi) { return (unsigned)f2b(lo) | ((unsigned)f2b(hi) << 16); }
__device__ __forceinline__ f32x16 tile_nt(LAS const unsigned char* A, int arow0, LAS const unsigned char* B, int brow0, f32x16 acc, int lane) {
    const int r = lane & 31, h = lane >> 5;
    LAS const unsigned char* ap = A + (arow0 + r) * PITCH + h * 16; LAS const unsigned char* bp = B + (brow0 + r) * PITCH + h * 16;
#pragma unroll
    for (int ks = 0; ks < 4; ++ks) { const bf16x8 a = *(LAS const bf16x8*)(ap + ks * 32), b = *(LAS const bf16x8*)(bp + ks * 32); acc = __builtin_amdgcn_mfma_f32_32x32x16_bf16(a, b, acc, 0, 0, 0); }
    return acc;
}
template <int MASK> __device__ __forceinline__ float maskv(float v, int row, int col) { if (MASK == 1) return row > col ? v : 0.f; if (MASK == 2) return row >= col ? v : 0.f; return v; }
template <int MASK> __device__ __forceinline__ void store_nat(LAS unsigned char* S, int r0, int c0, const f32x16& acc, float sc, int lane) {
    const int col = c0 + (lane & 31), hi = lane >> 5;
#pragma unroll
    for (int g = 0; g < 16; ++g) { const int row = r0 + crow(g, hi); *(LAS unsigned short*)(S + row * PITCH + col * 2) = f2b(maskv<MASK>(acc[g], row, col) * sc); }
}
template <int MASK> __device__ __forceinline__ void store_tr(LAS unsigned char* S, int r0, int c0, const f32x16& acc, int lane) {
    const int col = c0 + (lane & 31), hi = lane >> 5;
#pragma unroll
    for (int g = 0; g < 16; ++g) { const int row = r0 + crow(g, hi); *(LAS unsigned short*)(S + col * PITCH + row * 2) = f2b(maskv<MASK>(acc[g], row, col)); }
}
__device__ __forceinline__ f32x16 load_nat(LAS const unsigned char* S, int r0, int c0, int lane) {
    const int col = c0 + (lane & 31), hi = lane >> 5; f32x16 a;
#pragma unroll
    for (int g = 0; g < 16; ++g) a[g] = __uint_as_float((unsigned)*(LAS const unsigned short*)(S + (r0 + crow(g, hi)) * PITCH + col * 2) << 16);
    return a;
}
}

constexpr size_t WS_LW = WS_SMALL + 3 * MiB;
constexpr int LW_BYTES = 19456, ACT_PITCH = 272, ACT_BYTES = 64 * ACT_PITCH, RES_OFF = 8 * rw::SLOT, RES_PITCH = 65, SSBUF_OFF = 131072 + 2048;
template <int CTRL, int RM> __device__ __forceinline__ float dpp0(float v) { return __int_as_float(__builtin_amdgcn_update_dpp(0, __float_as_int(v), CTRL, RM, 0xf, false)); }
__device__ __forceinline__ float wave_scan_incl(float x) {
    x += dpp0<0x111, 0xf>(x); x += dpp0<0x112, 0xf>(x); x += dpp0<0x114, 0xf>(x); x += dpp0<0x118, 0xf>(x);
    x += dpp0<0x142, 0xa>(x); x += dpp0<0x143, 0xc>(x);
    return x;
}
__device__ __forceinline__ float fast_tanh(float x) { const float e = __expf(2.f * x); return 1.f - 2.f / (1.f + e); }
__device__ __forceinline__ void phase_chunkprep(Frame& F, KArgs& A, int l) {
    using namespace rw;
    const float* PR = WSP(const float, WS_PR);
    float* RW = WSP(float, WS_RW); constexpr size_t RS = (size_t)M * 256;
    LAS unsigned char* L = F.lds;
#define SL(n) (L + (n) * SLOT)
    const int w = F.wave;
    for (int it = F.vcu; it < NB * 4 * 64; it += F.G) {
        int lane = F.lane; asm volatile("" : "+v"(lane));
        { unsigned lb_ = 0u; asm volatile("" : "+s"(lb_)); L = F.lds + lb_; }
        const int c = it & 63, bh = it >> 6, b = bh >> 2, h = bh & 3;
        unsigned char* gout = F.ws + WS_XS + (size_t)it * ITEM_BYTES;
        const size_t m0 = (size_t)b * SEQ + c * 64;
        f32x4 s1r[2], s1k[2], s1v[2], s1pr[2], s1pk[2], s1pv[2];
        { const float* cur = PR + (m0 + lane) * 896 + h * 64 + 8 * w; const bool first = (c == 0 && lane == 0);
#pragma unroll
          for (int q = 0; q < 2; ++q) { s1r[q] = *(const GAS f32x4*)(cur + 4 * q); s1k[q] = *(const GAS f32x4*)(cur + 256 + 4 * q); s1v[q] = *(const GAS f32x4*)(cur + 512 + 4 * q);
              s1pr[q] = (f32x4){0.f, 0.f, 0.f, 0.f}; s1pk[q] = s1pr[q]; s1pv[q] = s1pr[q];
              if (!first) { s1pr[q] = *(const GAS f32x4*)(cur - 896 + 4 * q); s1pk[q] = *(const GAS f32x4*)(cur - 896 + 256 + 4 * q); s1pv[q] = *(const GAS f32x4*)(cur - 896 + 512 + 4 * q); } } }
        {
            const int tid = w * 64 + lane, t = tid >> 3, jg = tid & 7;
            const float* cur = PR + (m0 + t) * 896 + 768 + 16 * jg; const float* mup = GIN(8) + l * 896 + 768 + 16 * jg;
            const bool first = (c == 0 && t == 0);
            unsigned o8[8];
#pragma unroll
            for (int q = 0; q < 4; ++q) { f32x4 x = *(const GAS f32x4*)(cur + 4 * q); const f32x4 mu = *(const GAS f32x4*)(mup + 4 * q);
                f32x4 xp = {0.f, 0.f, 0.f, 0.f}; if (!first) xp = *(const GAS f32x4*)(cur - 896 + 4 * q);
                x = x + (xp - x) * mu;
#pragma unroll
                for (int e = 0; e < 4; ++e) x[e] = jg < 2 ? fast_tanh(x[e]) : (jg < 4 ? x[e] : 1.f / (1.f + __expf(-x[e])));
                o8[2 * q] = pk(x[0], x[1]); o8[2 * q + 1] = pk(x[2], x[3]); }
            LAS v4u* dst = (LAS v4u*)(L + t * ACT_PITCH + jg * 32);
            dst[0] = (v4u){o8[0], o8[1], o8[2], o8[3]}; dst[1] = (v4u){o8[4], o8[5], o8[6], o8[7]};
            const GAS v4u* lw = (const GAS v4u*)(F.ws + WS_LW + (size_t)(l * 4 + h) * LW_BYTES);
            for (int i = tid; i < LW_BYTES / 16; i += NWAVES * 64) *(LAS v4u*)(L + ACT_BYTES + i * 16) = lw[i];
        }
        LDS_WAIT(); __syncthreads();
        for (int id = w; id < 12; id += 8) {
            const int mtx = id >> 2, tr = (id >> 1) & 1, tc = id & 1, r = lane & 31, hh = lane >> 5;
            const int koff = mtx == 0 ? 0 : (mtx == 1 ? 64 : 128), nks = mtx == 2 ? 4 : 2, bp = mtx == 2 ? 144 : 80, boff = mtx == 0 ? 0 : (mtx == 1 ? 5120 : 10240);
            LAS const unsigned char* ap = L + (32 * tr + r) * ACT_PITCH + koff + hh * 16; LAS const unsigned char* bpp = L + ACT_BYTES + boff + (32 * tc + r) * bp + hh * 16;
            f32x16 acc = f32x16{};
            for (int ks = 0; ks < nks; ++ks) { const bf16x8 a = *(LAS const bf16x8*)(ap + ks * 32), bb = *(LAS const bf16x8*)(bpp + ks * 32); acc = __builtin_amdgcn_mfma_f32_32x32x16_bf16(a, bb, acc, 0, 0, 0); }
            LAS float* res = (LAS float*)(L + RES_OFF) + mtx * 64 * RES_PITCH + (32 * tc + r) * RES_PITCH + 32 * tr;
#pragma unroll
            for (int g = 0; g < 16; ++g) res[crow(g, hh)] = acc[g];
        }
        LDS_WAIT(); __syncthreads();
        {
            const int ch0 = h * 64 + 8 * w; const size_t m = m0 + lane;
            float r_[8], k_[8], v_[8], a_[8], lw_[8], kk_[8]; float ss = 0.f;
            const LAS float* res = (const LAS float*)(L + RES_OFF) + (8 * w) * RES_PITCH + lane;
#pragma unroll
            for (int q = 0; q < 2; ++q) {
                f32x4 xr = s1r[q], xk = s1k[q], xv = s1v[q]; const f32x4 pr = s1pr[q], pk_ = s1pk[q], pv = s1pv[q];
                const float* mu = GIN(8) + l * 896 + ch0 + 4 * q;
                const f32x4 mr = *(const GAS f32x4*)mu, mk = *(const GAS f32x4*)(mu + 256), mv = *(const GAS f32x4*)(mu + 512);
                xr = xr + (pr - xr) * mr; xk = xk + (pk_ - xk) * mk; xv = xv + (pv - xv) * mv;
                const f32x4 w0 = *(const GAS f32x4*)(GIN(9) + l * 256 + ch0 + 4 * q), a0 = *(const GAS f32x4*)(GIN(11) + l * 256 + ch0 + 4 * q);
                const f32x4 kkw = *(const GAS f32x4*)(GIN(14) + l * 256 + ch0 + 4 * q), kaw = *(const GAS f32x4*)(GIN(15) + l * 256 + ch0 + 4 * q);
                f32x4 gg, k2;
#pragma unroll
                for (int e = 0; e < 4; ++e) { const int i = 4 * q + e;
                    const float xw = -(w0[e] + res[i * RES_PITCH]); const float sp = xw > 15.f ? xw : __logf(1.f + __expf(xw)); const float wv = -sp - 0.5f;
                    lw_[i] = -__expf(wv);
                    const float a = 1.f / (1.f + __expf(-(a0[e] + res[(64 + i) * RES_PITCH]))); a_[i] = a;
                    gg[e] = res[(128 + i) * RES_PITCH];
                    r_[i] = xr[e]; v_[i] = xv[e]; kk_[i] = xk[e] * kkw[e]; ss += kk_[i] * kk_[i];
                    k2[e] = xk[e] * (1.f + (a - 1.f) * kaw[e]); k_[i] = k2[e]; }
                const size_t o = m * 256 + ch0 + 4 * q;
                *(GAS f32x4*)(RW + o) = xr; *(GAS f32x4*)(RW + 2 * RS + o) = k2; *(GAS f32x4*)(RW + 3 * RS + o) = xv; *(GAS f32x4*)(RW + 6 * RS + o) = gg;
            }
            *(LAS float*)(L + SSBUF_OFF + (w * 64 + lane) * 4) = ss;
            LDS_WAIT(); __syncthreads();
            float tot = 0.f;
#pragma unroll
            for (int q = 0; q < 8; ++q) tot += *(LAS const float*)(L + SSBUF_OFF + (q * 64 + lane) * 4);
            const float inv = 1.0f / fmaxf(sqrtf(tot), 1e-12f);
            unsigned nat[4][4];
#pragma unroll
            for (int e = 0; e < 8; ++e) {
                const float kkn = kk_[e] * inv, bbv = kkn * a_[e];
                const float cum = wave_scan_incl(lw_[e]);
                const float cl = rl(cum, 63), gam = __expf(cl);
                const float e1 = __expf(cum - lw_[e]), e2 = __expf(cum), e3 = __expf(-cum);
                const float kkf = kkn * e1, rf = r_[e] * e2, bi = bbv * e3, ki = k_[e] * e3, bend = bi * gam, kend = ki * gam;
                const int i = 8 * w + e;
                if (lane == 63) *(LAS float*)(L + GAM_OFF + i * 4) = gam;
                *(LAS unsigned short*)(SL(4) + i * PITCH + lane * 2) = f2b(kkf); *(LAS unsigned short*)(SL(5) + i * PITCH + lane * 2) = f2b(v_[e]);
                *(LAS unsigned short*)(SL(6) + i * PITCH + lane * 2) = f2b(bend); *(LAS unsigned short*)(SL(7) + i * PITCH + lane * 2) = f2b(kend);
                const unsigned short q0 = f2b(kkf), q1 = f2b(rf), q2 = f2b(bi), q3 = f2b(ki);
                if (e & 1) { nat[0][e >> 1] |= (unsigned)q0 << 16; nat[1][e >> 1] |= (unsigned)q1 << 16; nat[2][e >> 1] |= (unsigned)q2 << 16; nat[3][e >> 1] |= (unsigned)q3 << 16; }
                else { nat[0][e >> 1] = q0; nat[1][e >> 1] = q1; nat[2][e >> 1] = q2; nat[3][e >> 1] = q3; }
            }
#pragma unroll
            for (int mm = 0; mm < 4; ++mm) { v4u x; x.x = nat[mm][0]; x.y = nat[mm][1]; x.z = nat[mm][2]; x.w = nat[mm][3]; *(LAS v4u*)(SL(mm) + lane * PITCH + w * 16) = x; }
        }
        LDS_WAIT(); __syncthreads();
        const f32x16 Z = f32x16{};
#pragma unroll
        for (int q = 0; q < 2; ++q) { const int tile = 2 * w + q, p = tile >> 2, tr = (tile >> 1) & 1, tc = tile & 1;
            f32x16 acc = Z;
            if (!(tr == 0 && tc == 1)) acc = tile_nt(SL(p < 2 ? 0 : 1), 32 * tr, SL((p & 1) ? 3 : 2), 32 * tc, Z, lane);
            if (p == 0) { store_nat<1>(SL(8), 32 * tr, 32 * tc, acc, 1.f, lane); store_tr<1>(SL(12), 32 * tr, 32 * tc, acc, lane);
                const int col = 32 * tc + (lane & 31), hi = lane >> 5;
#pragma unroll
                for (int g = 0; g < 16; ++g) { const int row = 32 * tr + crow(g, hi); const float v = (row == col ? 1.f : 0.f) - (row > col ? acc[g] : 0.f); *(LAS unsigned short*)(SL(13) + row * PITCH + col * 2) = f2b(v); } }
            else if (p == 1) store_nat<1>(SL(9), 32 * tr, 32 * tc, acc, 1.f, lane);
            else if (p == 2) store_nat<2>(SL(10), 32 * tr, 32 * tc, acc, 1.f, lane);
            else store_nat<2>(SL(11), 32 * tr, 32 * tc, acc, 1.f, lane); }
        LDS_WAIT(); __syncthreads();
        const int tr = (w >> 1) & 1, tc = w & 1;
        {
            if (w < 4) { f32x16 acc = Z; if (!(tr == 0 && tc == 1)) acc = tile_nt(SL(8), 32 * tr, SL(12), 32 * tc, Z, lane); store_nat<0>(SL(0), 32 * tr, 32 * tc, acc, 1.f, lane); store_tr<0>(SL(2), 32 * tr, 32 * tc, acc, lane); }
            LDS_WAIT(); __syncthreads();
        }
#pragma nounroll
        for (int k = 1; k <= 5; ++k) {
            const int lpn = (k & 1) ? 0 : 8, lpt = (k & 1) ? 2 : 12, lpn2 = (k & 1) ? 8 : 0, lpt2 = (k & 1) ? 12 : 2, pin = (k & 1) ? 13 : 3, pout = (k & 1) ? 3 : 13;
            if (w < 4) { f32x16 acc = load_nat(SL(pin), 32 * tr, 32 * tc, lane); if (!(tr == 0 && tc == 1)) acc = tile_nt(SL(pin), 32 * tr, SL(lpt), 32 * tc, acc, lane); store_nat<0>(SL(pout), 32 * tr, 32 * tc, acc, 1.f, lane); }
            else if (k < 5) { f32x16 acc = Z; if (!(tr == 0 && tc == 1)) acc = tile_nt(SL(lpn), 32 * tr, SL(lpt), 32 * tc, Z, lane); store_nat<0>(SL(lpn2), 32 * tr, 32 * tc, acc, 1.f, lane); store_tr<0>(SL(lpt2), 32 * tr, 32 * tc, acc, lane); }
            LDS_WAIT(); __syncthreads();
        }
        if (w < 4) { const f32x16 acc = tile_nt(SL(4), 32 * tr, SL(3), 32 * tc, Z, lane); store_nat<0>(SL(0), 32 * tr, 32 * tc, acc, 1.f, lane); }
        else { const f32x16 acc = tile_nt(SL(5), 32 * tr, SL(9), 32 * tc, Z, lane); store_nat<0>(SL(2), 32 * tr, 32 * tc, acc, 1.f, lane); }
        LDS_WAIT(); __syncthreads();
        if (w < 4) { const f32x16 acc = tile_nt(SL(2), 32 * tr, SL(3), 32 * tc, Z, lane); store_nat<0>(SL(8), 32 * tr, 32 * tc, acc, -1.f, lane); }
        else {
            const int hi = lane >> 5, cl = lane & 31;
            { const f32x16 acc = tile_nt(SL(0), 32 * tr, SL(6), 32 * tc, Z, lane);
              const float gam = *(LAS const float*)(L + GAM_OFF + (32 * tc + cl) * 4);
#pragma unroll
              for (int sp = 0; sp < 2; ++sp) { float o[8];
#pragma unroll
                  for (int j = 0; j < 8; ++j) { const int g = 8 * sp + j; o[j] = ((tr == tc && crow(g, hi) == cl) ? gam : 0.f) - acc[g]; }
                  v4u x; x.x = pk(o[0], o[1]); x.y = pk(o[2], o[3]); x.z = pk(o[4], o[5]); x.w = pk(o[6], o[7]);
                  *(GAS v4u*)(gout + ((size_t)(tc * 4 + 2 * tr + sp) * 64 + lane) * 16) = x; } }
            { const f32x16 acc = tile_nt(SL(0), 32 * tr, SL(10), 32 * tc, Z, lane);
#pragma unroll
              for (int sp = 0; sp < 2; ++sp) { float o[8];
#pragma unroll
                  for (int j = 0; j < 8; ++j) { const int g = 8 * sp + j; const int i = 32 * tr + crow(g, hi), t = 32 * tc + cl;
                      o[j] = __uint_as_float((unsigned)*(LAS const unsigned short*)(SL(1) + t * PITCH + i * 2) << 16) - acc[g]; }
                  v4u x; x.x = pk(o[0], o[1]); x.y = pk(o[2], o[3]); x.z = pk(o[4], o[5]); x.w = pk(o[6], o[7]);
                  *(GAS v4u*)(gout + 8192 + ((size_t)(tc * 4 + 2 * tr + sp) * 64 + lane) * 16) = x; } }
        }
        LDS_WAIT(); __syncthreads();
        {
            f32x16 acc;
            if (w < 4) { acc = tile_nt(SL(7), 32 * tr, SL(5), 32 * tc, Z, lane); acc = tile_nt(SL(6), 32 * tr, SL(8), 32 * tc, acc, lane); }
            else { acc = tile_nt(SL(11), 32 * tr, SL(5), 32 * tc, Z, lane); acc = tile_nt(SL(10), 32 * tr, SL(8), 32 * tc, acc, lane); }
            float* o = (float*)(gout + (w < 4 ? 16384 : 32768)) + (size_t)(tr * 2 + tc) * 1024 + lane;
#pragma unroll
            for (int g = 0; g < 16; ++g) *(GAS float*)(o + g * 64) = acc[g];
        }
        LDS_WAIT(); __syncthreads();
    }
#undef SL
    if (F.wave == 0) { const bf16* KM = WSP(bf16, WS_KM); float* KMEAN = WSP(float, WS_KMEAN);
      for (int it = F.vcu; it < NB * 16 * 4; it += F.G) { const int hh = it & 3, n = (it >> 2) & 15, b = it >> 6; const int co = F.lane >> 3, rg = F.lane & 7;
          const bf16* p = KM + ((size_t)b * SEQ + n * 256 + rg * 32) * 256 + hh * 64 + co * 8; float s[8] = {0.f, 0.f, 0.f, 0.f, 0.f, 0.f, 0.f, 0.f};
#pragma unroll 16
          for (int t = 0; t < 32; ++t) { const v4u x = *(const GAS v4u*)(p + (size_t)t * 256);
              s[0] += bf_lo(x.x); s[1] += bf_hi(x.x); s[2] += bf_lo(x.y); s[3] += bf_hi(x.y); s[4] += bf_lo(x.z); s[5] += bf_hi(x.z); s[6] += bf_lo(x.w); s[7] += bf_hi(x.w); }
#pragma unroll
          for (int e = 0; e < 8; ++e) { float x = s[e]; x += dpp0<0xB1, 0xf>(x); x += dpp0<0x4E, 0xf>(x); x += dpp0<0x141, 0xf>(x); s[e] = x * (1.0f / 256.0f); }
          if (rg == 0) { float* o = KMEAN + (((size_t)b * 4 + hh) * 16 + n) * 64 + co * 8; *(GAS f32x4*)o = (f32x4){s[0], s[1], s[2], s[3]}; *(GAS f32x4*)(o + 4) = (f32x4){s[4], s[5], s[6], s[7]}; } } }
}

constexpr size_t WS_SB = WS_HS;
__device__ __forceinline__ void rwkv_chain_wave(Frame& F, int bh, int tv) {
    using namespace rw;
    const int lane = F.lane;
    f32x16 S0 = f32x16{}, S1 = f32x16{};
    const unsigned char* gin = F.ws + WS_XS + (size_t)bh * 64 * ITEM_BYTES;
    unsigned char* sb = F.ws + WS_SB + ((size_t)bh * 64 * 2 + tv) * 4096 + lane * 16;
    bf16x8 Ga[8]; f32x16 H0, H1;
#define RW_LOAD(G_, H0_, H1_, gp_) do { _Pragma("unroll") for (int q_ = 0; q_ < 8; ++q_) G_[q_] = *(const GAS bf16x8*)((gp_) + ((size_t)q_ * 64 + lane) * 16); \
        const float* hp_ = (const float*)((gp_) + 16384) + (size_t)tv * 1024 + lane; _Pragma("unroll") for (int g_ = 0; g_ < 16; ++g_) { H0_[g_] = *(const GAS float*)(hp_ + g_ * 64); H1_[g_] = *(const GAS float*)(hp_ + 2048 + g_ * 64); } } while (0)
    RW_LOAD(Ga, H0, H1, gin);
    for (int c = 0; c < 64; ++c) {
        bf16x8 Gn[8]; f32x16 Hn0, Hn1;
        const unsigned char* gnx = gin + (size_t)(c < 63 ? c + 1 : c) * ITEM_BYTES;
        RW_LOAD(Gn, Hn0, Hn1, gnx);
        bf16x8 Bf[4];
#pragma unroll
        for (int s = 0; s < 4; ++s) { const f32x16& X = (s < 2) ? S0 : S1; const int o = 8 * (s & 1); v4u x; x.x = pk(X[o], X[o + 1]); x.y = pk(X[o + 2], X[o + 3]); x.z = pk(X[o + 4], X[o + 5]); x.w = pk(X[o + 6], X[o + 7]); Bf[s] = __builtin_bit_cast(bf16x8, x);
            *(GAS v4u*)(sb + (size_t)c * 8192 + s * 1024) = x; }
#pragma unroll
        for (int s = 0; s < 4; ++s) { H0 = __builtin_amdgcn_mfma_f32_32x32x16_bf16(Ga[s], Bf[s], H0, 0, 0, 0); H1 = __builtin_amdgcn_mfma_f32_32x32x16_bf16(Ga[4 + s], Bf[s], H1, 0, 0, 0); }
        S0 = H0; S1 = H1;
#pragma unroll
        for (int q = 0; q < 8; ++q) Ga[q] = Gn[q];
        H0 = Hn0; H1 = Hn1;
    }
#undef RW_LOAD
}
__device__ __forceinline__ void rwkv_y_item(Frame& F, KArgs& A, int l, int item2) {
    using namespace rw;
    const int lane = F.lane, hi = lane >> 5, cl = lane & 31;
    const int tt = item2 & 1, item = item2 >> 1, c = item & 63, bh = item >> 6, b = bh >> 2, h = bh & 3;
    const unsigned char* gin = F.ws + WS_XS + (size_t)item * ITEM_BYTES;
    const unsigned char* sb = F.ws + WS_SB + ((size_t)item * 2) * 4096 + lane * 16;
    LAS float* yl = (LAS float*)(F.lds + F.wave * 8192);
#pragma unroll
    for (int tv = 0; tv < 2; ++tv) {
        f32x16 acc; const float* y0 = (const float*)(gin + 32768) + (size_t)(tt * 2 + tv) * 1024 + lane;
#pragma unroll
        for (int g = 0; g < 16; ++g) acc[g] = *(const GAS float*)(y0 + g * 64);
#pragma unroll
        for (int s = 0; s < 4; ++s) { const bf16x8 a = *(const GAS bf16x8*)(gin + 8192 + ((size_t)(tt * 4 + s) * 64 + lane) * 16), bfr = *(const GAS bf16x8*)(sb + tv * 4096 + s * 1024);
            acc = __builtin_amdgcn_mfma_f32_32x32x16_bf16(a, bfr, acc, 0, 0, 0); }
#pragma unroll
        for (int g = 0; g < 16; ++g) yl[crow(g, hi) * 64 + 32 * tv + cl] = acc[g];
    }
    LDS_WAIT();
    const float* RWp = WSP(const float, WS_RW); constexpr size_t RS = (size_t)M * 256;
    const int ch = h * 64 + lane;
    const float rk = GIN(16)[l * 256 + ch], lng = GIN(17)[l * 256 + ch], lnb = GIN(18)[l * 256 + ch];
    const size_t row0 = (size_t)b * SEQ + c * 64 + 32 * tt;
#pragma unroll 8
    for (int t = 0; t < 32; ++t) { const size_t o = (row0 + t) * 256 + ch;
        const float y = yl[t * 64 + lane], r = RWp[o], k = RWp[2 * RS + o], v = RWp[3 * RS + o], g = RWp[6 * RS + o];
        const float mean = wave_sum(y) * (1.0f / 64.0f); const float d = y - mean; const float var = wave_sum(d * d) * (1.0f / 64.0f);
        const float bonus = wave_sum(r * k * rk) * v;
        WSP(bf16, WS_MIX)[(row0 + t) * 1024 + ch] = (bf16)f2bf((d * (1.0f / sqrtf(var + 64e-5f)) * lng + lnb + bonus) * g); }
    LDS_WAIT();
}
#ifndef ATT_NEGM
#define ATT_NEGM false
#endif
constexpr int CW_TIX = 16384 + 2048;
__device__ __forceinline__ void phase_attention(Frame& F, KArgs& A, int l, int rep) {
    constexpr int NSTREAM = 48, NUNITS = NSTREAM * 16, NCONV = 192;
    static_assert(4 * NCONV == NUNITS && 2 * NCONV * 64 == 3 * 32 * 256, "ticket interleave");
    const int NTICKETS = NUNITS + (l == 0 ? NCONV : 0);
    unsigned* ctr = (unsigned*)(F.ctl + CW_TIX + l * 64 + rep * 16);
    volatile LAS unsigned* tix = F.MISC + 16;
    attn_body::attn_build_tables(F.tid, WSP(float, WS_TB), (char*)F.lds);
    asm volatile("s_waitcnt vmcnt(0) lgkmcnt(0)\n\ts_barrier" ::: "memory");
    if (F.vcu < 4) rwkv_chain_wave(F, (F.vcu * 8 + F.wave) >> 1, F.wave & 1);
    int iter_ = 0;
    for (;;) {
#ifdef ATT_STATIC
        if (threadIdx.x == 0) tix[0] = (unsigned)(iter_ * F.G + (int)blockIdx.x);
#else
        if (threadIdx.x == 0) tix[0] = atomicAdd(ctr, 1u);
#endif
        ++iter_;
        asm volatile("s_waitcnt vmcnt(0) lgkmcnt(0)\n\ts_barrier" ::: "memory");
        const int ticket = (int)tix[0];
        asm volatile("s_waitcnt lgkmcnt(0)\n\ts_barrier" ::: "memory");
        if (ticket >= NTICKETS) break;
        if (l == 0 && ticket % 5 == 4) { moe_convert_ticket(F, A, l, ticket / 5); continue; }
        const int au = l == 0 ? 4 * (ticket / 5) + ticket % 5 : ticket;
        const int qb = 15 - au / NSTREAM, s = au % NSTREAM;
        int tid_u = threadIdx.x; asm volatile("" : "+v"(tid_u));
        if (s < 32) {
            const int b = s >> 3, h = (s >> 1) & 3, c = s & 1; const size_t r0 = (size_t)b * SEQ;
            attn_body::attn_unit_dv<16>(tid_u, qb,
                (const attn_body::bf16*)(WSP(bf16, WS_QD) + r0 * 512 + (h * 2 + c) * 64), 512,
                (const attn_body::bf16*)(WSP(bf16, WS_KD) + r0 * 512 + (h * 2 + c) * 64), 512,
                (const attn_body::bf16*)(WSP(bf16, WS_VD) + r0 * 512 + h * 128), 512,
                (attn_body::bf16*)(WSP(bf16, WS_OD) + r0 * 1024 + (h * 2 + c) * 128), 1024,
                h, (char*)F.lds);
        } else {
            const int b = (s - 32) >> 2, h = (s - 32) & 3; const size_t r0 = (size_t)b * SEQ;
            attn_body::attn_unit<16, true, ATT_NEGM>(tid_u, qb,
                (const attn_body::bf16*)(WSP(bf16, WS_QM) + r0 * 256 + h * 64), 256,
                (const attn_body::bf16*)(WSP(bf16, WS_KM) + r0 * 256 + h * 64), 256,
                (const attn_body::bf16*)(WSP(bf16, WS_VM) + r0 * 256 + h * 64), 256,
                (attn_body::bf16*)(WSP(bf16, WS_MIX) + r0 * 1024 + 768 + h * 64), 1024,
                4 + h, WSP(float, WS_KMEAN) + ((size_t)(b * 4 + h) * 16) * 64, (char*)F.lds);
        }
    }
}
__device__ __forceinline__ void phase_postmix(Frame& F, KArgs& A, int l) {
    const float lam = WSP(float, WS_LAM)[l]; const float li = 0.8f - 0.6f * __expf(-0.3f * (float)l);
    const float* sg = GIN(22) + l * 128;
    for (int it = F.gw; it < 2048 + M; it += F.NGW) {
        if (it < 2048) { rwkv_y_item(F, A, l, it); continue; }
        const int m = it - 2048; const int h = F.lane >> 4, j = F.lane & 15;
        const bf16* od = WSP(bf16, WS_OD) + (size_t)m * 1024 + h * 256 + 8 * j;
        const v4u a = __builtin_nontemporal_load((const GAS v4u*)od), b2 = __builtin_nontemporal_load((const GAS v4u*)(od + 128));
        float o[8];
        o[0] = bf_lo(a.x) - lam * bf_lo(b2.x); o[1] = bf_hi(a.x) - lam * bf_hi(b2.x); o[2] = bf_lo(a.y) - lam * bf_lo(b2.y); o[3] = bf_hi(a.y) - lam * bf_hi(b2.y);
        o[4] = bf_lo(a.z) - lam * bf_lo(b2.z); o[5] = bf_hi(a.z) - lam * bf_hi(b2.z); o[6] = bf_lo(a.w) - lam * bf_lo(b2.w); o[7] = bf_hi(a.w) - lam * bf_hi(b2.w);
        float ss = 0.f;
#pragma unroll
        for (int i = 0; i < 8; ++i) ss += o[i] * o[i];
        ss += __shfl_xor(ss, 1); ss += __shfl_xor(ss, 2); ss += __shfl_xor(ss, 4); ss += __shfl_xor(ss, 8);
        const float rs = (1.f - li) / sqrtf(ss * (1.0f / 128.0f) + 1e-6f);
        const f32x4 g0 = *(const f32x4*)(sg + 8 * j), g1 = *(const f32x4*)(sg + 8 * j + 4);
        v4u w; w.x = pk2(o[0] * rs * g0.x, o[1] * rs * g0.y); w.y = pk2(o[2] * rs * g0.z, o[3] * rs * g0.w); w.z = pk2(o[4] * rs * g1.x, o[5] * rs * g1.y); w.w = pk2(o[6] * rs * g1.z, o[7] * rs * g1.w);
        *(GAS v4u*)(WSP(bf16, WS_MIX) + (size_t)m * 1024 + 256 + h * 128 + 8 * j) = w;
    }
}
__global__ void __launch_bounds__(NWAVES * 64, 2) mega_fwd(Args Araw) {
    extern __shared__ __attribute__((aligned(16))) unsigned char lds[];
    Frame F;
    F.lds = (LAS unsigned char*)lds; F.MISC = (volatile LAS unsigned*)(F.lds + MISC_OFF);
    F.tid = threadIdx.x; F.lane = F.tid & 63; F.wave = __builtin_amdgcn_readfirstlane(F.tid >> 6);
    F.G = gridDim.x; { const int bx = blockIdx.x; F.vcu = (F.G % 8 == 0) ? (bx % 8) * (F.G / 8) + bx / 8 : bx; }
    F.gw = F.vcu * NWAVES + F.wave; F.NGW = F.G * NWAVES;
    F.out = Araw.out; F.ws = Araw.ws; F.ctl = (gu32*)(Araw.ws + WS_CTL);
    for (int u = F.tid; u < (LDS_BYTES - LDSCTL_OFF) / 4; u += NWAVES * 64) ((LAS unsigned*)(F.lds + LDSCTL_OFF))[u] = 0u;
    __syncthreads();
    XcdBarrier bar = xcd_barrier_post((unsigned*)(F.ctl + CW_BAR), F.MISC + 8);
#define GRID_BAR() xcd_barrier(bar)

    constexpr int NPH = 9; constexpr int NSTEP = 1 + NL * NPH + 1;
    int reps_ = 0;
    {
        KArgs* Ap_ = (KArgs*)__builtin_amdgcn_kernarg_segment_ptr(); asm volatile("" : "+s"(Ap_)); KArgs& A = *Ap_;
        { unsigned lb_ = 0u; asm volatile("" : "+s"(lb_)); F.lds = (LAS unsigned char*)lds + lb_; F.MISC = (volatile LAS unsigned*)(F.lds + MISC_OFF); }
        { GAS unsigned char* w_ = (GAS unsigned char*)Araw.ws; GAS float* o_ = (GAS float*)Araw.out; asm volatile("" : "+s"(w_), "+s"(o_)); F.ws = (unsigned char*)w_; F.out = (float*)o_; F.ctl = (gu32*)(w_ + WS_CTL); }
        { int t_ = threadIdx.x; asm volatile("" : "+v"(t_)); F.tid = t_; F.lane = t_ & 63; F.wave = __builtin_amdgcn_readfirstlane(t_ >> 6); F.gw = F.vcu * NWAVES + F.wave; }
#ifndef SK_P0
        p0_prologue(F, A);
#endif
        GRID_BAR();
    }
    for (int step = 1; step < NSTEP; ++step) {
        const int l = (step - 1) / NPH, idx_ = (step - 1) % NPH;
        const int ph = ((step == NSTEP - 1) ? 99 : (idx_ < 2 ? idx_ : (idx_ == 2 ? 10 : (idx_ < 7 ? idx_ : idx_ + 1))));
        KArgs* Ap_ = (KArgs*)__builtin_amdgcn_kernarg_segment_ptr(); asm volatile("" : "+s"(Ap_)); KArgs& A = *Ap_;
        { unsigned lb_ = 0u; asm volatile("" : "+s"(lb_)); F.lds = (LAS unsigned char*)lds + lb_; F.MISC = (volatile LAS unsigned*)(F.lds + MISC_OFF); }
        { GAS unsigned char* w_ = (GAS unsigned char*)Araw.ws; GAS float* o_ = (GAS float*)Araw.out; asm volatile("" : "+s"(w_), "+s"(o_)); F.ws = (unsigned char*)w_; F.out = (float*)o_; F.ctl = (gu32*)(w_ + WS_CTL); }
        { int t_ = threadIdx.x; asm volatile("" : "+v"(t_)); F.tid = t_; F.lane = t_ & 63; F.wave = __builtin_amdgcn_readfirstlane(t_ >> 6); F.gw = F.vcu * NWAVES + F.wave; }
#ifdef AMP_MASK
        const unsigned long long amp_t0 = __builtin_amdgcn_s_memrealtime();
#endif
        switch (ph) {
        case 0:
#ifndef SK_N1
            phase_norm1(F, A, l);
#endif
            break;
        case 1: {
#ifndef SK_GIN
            pg8::Gemm g{WSP(bf16, WS_HB), WSP(bf16, WS_WIN) + (size_t)l * NIN * 1024, M, NIN, DM, 0};
            pg8::StaticOrder S; S.init(M, NIN, F.G, (int)blockIdx.x);
            pg8::EpiInProj E{F.ws, Ap_, l, C2};
            pg8::gemm_phase<pg8::EpiInProj, pg8::StaticOrder, true, PG8_SP2>(F.lds, g, S, E);
            if ((int)blockIdx.x >= 64) moe_convert_ticket(F, A, l, 192 + ((int)blockIdx.x - 64) % 192);
#endif
            break; }
        case 10:
            phase_chunkprep(F, A, l);
            break;
        case 3:
#ifndef SK_MX
            phase_attention(F, A, l, reps_);
#endif
            break;
        case 4:
#ifndef SK_PM
            phase_postmix(F, A, l);
#endif
            break;
        case 5: {
#ifndef SK_GOUT
            pg8::Gemm g{WSP(bf16, WS_MIX), WSP(bf16, WS_WOUT) + (size_t)l * 1024 * 1024, M, DM, DM, 0};
            pg8::StaticOrder S; S.init(M, DM, F.G, (int)blockIdx.x);
            pg8::EpiResid E{F.out, WSP(float, WS_MOD) + (size_t)l * NB * 6144 + 2048, SEQ, 6144};
            pg8::gemm_phase<pg8::EpiResid, pg8::StaticOrder, true, PG8_SP2>(F.lds, g, S, E);
#endif
            break; }
        case 6:
#ifndef SK_R1
            phase_router(F, A, l, bar);
#endif
            break;
        case 8: {
#ifndef SK_MOE
            moe_tables(F, A, l);
            const LAS int* base = (const LAS int*)(F.lds + TAB_OFF);
            pg8::MoeOrder S{base + 64, base[32] / 256, 4, F.G, F.vcu};
            pg8::Gemm g1{WSP(bf16, WS_XS), WSP(bf16, WS_W13) + (size_t)l * 32 * 1024 * 1024, MOE_ROWS, 1024, 1024, (size_t)1024 * 1024 * 2};
            pg8::EpiSwiGLU E1{WSP(bf16, WS_HS)};
            pg8::gemm_phase<pg8::EpiSwiGLU, pg8::MoeOrder, true, PG8_SP2>(F.lds, g1, S, E1);
            if (l + 1 < NL) { const int nu = S.ntiles * 4, first = nu > 2 * F.G ? nu - 2 * F.G : 0, idle = F.G - first;
                for (int t = F.vcu - first; t >= 0 && t < 192; t += idle) moe_convert_ticket(F, A, l + 1, t); }
#endif
            break; }
        case 9: {
#ifndef SK_MOE
            moe_tables(F, A, l);
            const LAS int* base = (const LAS int*)(F.lds + TAB_OFF);
            pg8::MoeOrder S{base + 64, base[32] / 256, 4, F.G, F.vcu};
            pg8::Gemm g2{WSP(bf16, WS_HS), WSP(bf16, WS_W2) + (size_t)l * 32 * 1024 * 512, MOE_ROWS, 1024, 512, (size_t)1024 * 512 * 2};
            pg8::EpiMoeOut E2{WSP(bf16, WS_YS), WSP(float, WS_SMALL) + 6 * M};
            pg8::gemm_phase<pg8::EpiMoeOut, pg8::MoeOrder, true, PG8_SP2>(F.lds, g2, S, E2);
#endif
            break; }
        default:
            phase_norm1(F, A, NL);
            break;
        }
#ifdef AMP_MASK
        { const int bit_ = ph == -1 ? 15 : (ph == 99 ? 14 : ph); if ((AMP_MASK >> bit_) & 1) { asm volatile("s_waitcnt vmcnt(0) lgkmcnt(0)" ::: "memory"); const unsigned long long t1_ = __builtin_amdgcn_s_memrealtime(); while (__builtin_amdgcn_s_memrealtime() - t1_ < t1_ - amp_t0) __builtin_amdgcn_s_sleep(8); } }
#endif
        if (step + 1 < NSTEP) GRID_BAR();
#ifdef REP_PH
        if (ph == REP_PH && reps_ == 0) { reps_ = 1; --step; } else reps_ = 0;
#endif
    }
}

extern "C" void kernel_launch(void* const* d_in, const int* in_sizes, int n_in, void* d_out, int out_size, void* d_ws, size_t ws_size, hipStream_t stream) {
    static int grid = 0;
    if (grid == 0) {
        if (n_in != 33 || out_size != M * DM || ws_size < WS_END) { fprintf(stderr, "kernel_launch: unexpected shapes (n_in %d, out %d, ws %zu < %zu)\n", n_in, out_size, ws_size, (size_t)WS_END); grid = -1; return; }
        int dev = 0, cus = 0;
        if (hipGetDevice(&dev) != hipSuccess || hipDeviceGetAttribute(&cus, hipDeviceAttributeMultiprocessorCount, dev) != hipSuccess) { grid = -1; return; }
        if (hipFuncSetAttribute((const void*)mega_fwd, hipFuncAttributeMaxDynamicSharedMemorySize, LDS_BYTES) != hipSuccess) { fprintf(stderr, "kernel_launch: hipFuncSetAttribute failed\n"); grid = -1; return; }
        int per_cu = 0;
        if (hipOccupancyMaxActiveBlocksPerMultiprocessor(&per_cu, (const void*)mega_fwd, NWAVES * 64, LDS_BYTES) != hipSuccess || per_cu < 1) fprintf(stderr, "kernel_launch: occupancy query says %d\n", per_cu);
        (void)hipGetLastError();
        if (cus != M / 64) { fprintf(stderr, "kernel_launch: built for %d CUs (found %d)\n", M / 64, cus); grid = -1; return; }
        grid = cus;
    }
    if (grid < 0) return;
    if (hipMemsetAsync((char*)d_ws + WS_CTL, 0, CTL_ZERO_BYTES, stream) != hipSuccess) { fprintf(stderr, "kernel_launch: memset failed\n"); return; }
    Args a{};
    for (int i = 0; i < 33; ++i) a.in[i] = (const float*)d_in[i];
    a.out = (float*)d_out; a.ws = (unsigned char*)d_ws;
    hipLaunchKernelGGL(mega_fwd, dim3(grid), dim3(NWAVES * 64), LDS_BYTES, stream, a);
}
```

```cpp
#include <hip/hip_runtime.h>
#include <cstdio>
#include <cstdint>
struct Args { const float* in[33]; float* out; unsigned char* ws; };
typedef const __attribute__((address_space(4))) Args KArgs;
namespace pg8 {
#define PG8_LAS __attribute__((address_space(3)))
typedef unsigned short bf16_t;
typedef short bf16x8 __attribute__((ext_vector_type(8)));
typedef float f32x4 __attribute__((ext_vector_type(4)));
typedef unsigned u32x4 __attribute__((ext_vector_type(4)));
constexpr int BM = 256, BK = 64, HALF = 128, HTB = HALF * BK * 2  , STAGE_BYTES = 8 * HTB, NXCD = 8, WGM = 8;

__host__ __device__ __forceinline__ int lds_byte(int r, int c) { const int st = (r >> 4) * 2 + (c >> 5), rr = r & 15, cc = c & 31, ob = rr * 64 + cc * 2; return st * 1024 + (ob ^ (((ob >> 9) & 1) << 5)); }
__host__ __device__ __forceinline__ void stage_rc(int b, int& R, int& C) { const int st = b / 1024, sb = b % 1024, swz = sb ^ (((sb >> 9) & 1) << 5); R = (st >> 1) * 16 + swz / 64; C = (st & 1) * 32 + (swz % 64) / 2; }
__host__ __device__ __forceinline__ int perm32(int rho) { const int n = rho >> 4, i = rho & 15; return 8 * (i >> 2) + 4 * n + (i & 3); }

struct Unit { int pm, pn, e; };
struct Gemm { const bf16_t* A; const bf16_t* Bt; int M, N, K; size_t estride; };

struct StaticOrder {
    int nM, nN, nwg, G, c;
    __host__ __device__ void init(int M, int N, int G_, int c_) { nM = M / BM; nN = N / BM; nwg = nM * nN; G = G_; c = c_; }
    __host__ __device__ bool next(int i, Unit& u) const {
        const long L = (long)i * G + c; if (L >= nwg) return false;
        int wgid = (int)L; { const int q = nwg / NXCD, r = nwg % NXCD, xcd = wgid % NXCD, off = wgid / NXCD; wgid = (xcd < r ? xcd * (q + 1) : r * (q + 1) + (xcd - r) * q) + off; }
        const int nig = WGM * nN, gid = wgid / nig, fm = gid * WGM, gsz = (nM - fm) < WGM ? (nM - fm) : WGM;
        u.pm = fm + ((wgid % nig) % gsz); u.pn = (wgid % nig) / gsz; u.e = 0; return true;
    }
    __device__ __forceinline__ void a_ready(const Unit&) const {}
    __device__ __forceinline__ void done(const Unit&) const {}
};

__device__ __forceinline__ unsigned cvt_pk_bf16(float lo, float hi) { unsigned r; asm volatile("v_cvt_pk_bf16_f32 %0, %1, %2" : "=v"(r) : "v"(lo), "v"(hi)); return r; }
typedef unsigned u32x2 __attribute__((ext_vector_type(2)));
constexpr size_t EPI_MiB = 1u << 20, EPI_WS_QD = 656 * EPI_MiB, EPI_WS_KD = 672 * EPI_MiB, EPI_WS_VD = 688 * EPI_MiB, EPI_WS_QM = 704 * EPI_MiB, EPI_WS_KM = 712 * EPI_MiB, EPI_WS_VM = 720 * EPI_MiB, EPI_WS_PR = 728 * EPI_MiB;

struct EpiInProj {
    static constexpr bool PERM = true, AFTER_DRAIN = false;
    unsigned char* ws; KArgs* ka; int l; float c2;
    __device__ __forceinline__ void operator()(const f32x4 (&acc)[2][2][4][2], const Unit& u, int wr, int wc, int fr, int fq) const {
        const int pn = u.pn; const int row0 = u.pm * BM + wr * 64 + fr;
        if (pn >= 9) {
            float* PR = (float*)(ws + EPI_WS_PR);
            const int cb = (pn - 9) * 256 + 64 * wc + 8 * fq;
#pragma unroll
            for (int ai = 0; ai < 2; ++ai)
#pragma unroll
                for (int m = 0; m < 4; ++m) { float* rowp = PR + (size_t)(row0 + ai * HALF + m * 16) * 896;
#pragma unroll
                    for (int bj = 0; bj < 2; ++bj)
#pragma unroll
                        for (int n = 0; n < 2; ++n) { const int c = cb + 32 * bj + 4 * n; if (c < 896) *(f32x4*)(rowp + c) = acc[ai][bj][m][n]; } }
            return;
        }
        bf16_t* dst; int ld, cbase; const float* gain = nullptr; float sc = 1.f;
        if (pn < 2) { dst = (bf16_t*)(ws + EPI_WS_QD); ld = 512; cbase = pn * 256; gain = ((const float*)(const __attribute__((address_space(1))) float*)ka->in[19]) + l * 64; sc = c2; }
        else if (pn < 4) { dst = (bf16_t*)(ws + EPI_WS_KD); ld = 512; cbase = (pn - 2) * 256; gain = ((const float*)(const __attribute__((address_space(1))) float*)ka->in[20]) + l * 64; }
        else if (pn < 6) { dst = (bf16_t*)(ws + EPI_WS_VD); ld = 512; cbase = (pn - 4) * 256; }
        else if (pn == 6) { dst = (bf16_t*)(ws + EPI_WS_QM); ld = 256; cbase = 0; gain = ((const float*)(const __attribute__((address_space(1))) float*)ka->in[23]) + l * 64; sc = c2; }
        else if (pn == 7) { dst = (bf16_t*)(ws + EPI_WS_KM); ld = 256; cbase = 0; gain = ((const float*)(const __attribute__((address_space(1))) float*)ka->in[24]) + l * 64; }
        else { dst = (bf16_t*)(ws + EPI_WS_VM); ld = 256; cbase = 0; }
        f32x4 gv[2][2];
#pragma unroll
        for (int bj = 0; bj < 2; ++bj)
#pragma unroll
            for (int n = 0; n < 2; ++n) gv[bj][n] = gain ? *(const f32x4*)(gain + 32 * bj + 8 * fq + 4 * n) * sc : (f32x4){1.f, 1.f, 1.f, 1.f};
        const int col0 = cbase + 64 * wc + 8 * fq;
#pragma unroll
        for (int ai = 0; ai < 2; ++ai)
#pragma unroll
            for (int m = 0; m < 4; ++m) {
                float rs = 1.f;
                if (gain) { float ss = 0.f;
#pragma unroll
                    for (int bj = 0; bj < 2; ++bj)
#pragma unroll
                        for (int n = 0; n < 2; ++n) { const f32x4 x = acc[ai][bj][m][n]; ss += (x[0] * x[0] + x[1] * x[1]) + (x[2] * x[2] + x[3] * x[3]); }
                    ss += __shfl_xor(ss, 16); ss += __shfl_xor(ss, 32);
                    rs = 1.0f / sqrtf(ss * (1.0f / 64.0f) + 1e-6f); }
                bf16_t* rowp = dst + (size_t)(row0 + ai * HALF + m * 16) * ld + col0;
#pragma unroll
                for (int bj = 0; bj < 2; ++bj) { const f32x4 v0 = acc[ai][bj][m][0] * rs * gv[bj][0], v1 = acc[ai][bj][m][1] * rs * gv[bj][1];
                    u32x4 w; w.x = cvt_pk_bf16(v0[0], v0[1]); w.y = cvt_pk_bf16(v0[2], v0[3]); w.z = cvt_pk_bf16(v1[0], v1[1]); w.w = cvt_pk_bf16(v1[2], v1[3]);
                    *(u32x4*)(rowp + 32 * bj) = w; } }
    }
};
struct EpiResid {
    static constexpr bool PERM = false, AFTER_DRAIN = false;
    float* X; const float* gate; int seq, gstride;
    __device__ __forceinline__ void operator()(const f32x4 (&acc)[2][2][4][2], const Unit& u, int wr, int wc, int fr, int fq) const {
        const int row0 = u.pm * BM + wr * 64 + fr, col0 = u.pn * BM + wc * 32 + 4 * fq;
        const float* gp = gate + (size_t)((u.pm * BM) / seq) * gstride + col0;
        f32x4 gv[2][2];
#pragma unroll
        for (int bj = 0; bj < 2; ++bj)
#pragma unroll
            for (int n = 0; n < 2; ++n) gv[bj][n] = *(const f32x4*)(gp + bj * HALF + n * 16);
#pragma unroll
        for (int ai = 0; ai < 2; ++ai)
#pragma unroll
            for (int m = 0; m < 4; ++m) { float* rowp = X + (size_t)(row0 + ai * HALF + m * 16) * 1024 + col0;
#pragma unroll
                for (int bj = 0; bj < 2; ++bj)
#pragma unroll
                    for (int n = 0; n < 2; ++n) { f32x4* p = (f32x4*)(rowp + bj * HALF + n * 16); *p = *p + gv[bj][n] * acc[ai][bj][m][n]; } }
    }
};
struct EpiSwiGLU {
    static constexpr bool PERM = true, AFTER_DRAIN = false;
    bf16_t* HS;
    __device__ __forceinline__ void operator()(const f32x4 (&acc)[2][2][4][2], const Unit& u, int wr, int wc, int fr, int fq) const {
        const int row0 = u.pm * BM + wr * 64 + fr;
#pragma unroll
        for (int ai = 0; ai < 2; ++ai)
#pragma unroll
            for (int m = 0; m < 4; ++m) { bf16_t* rowp = HS + (size_t)(row0 + ai * HALF + m * 16) * 512;
#pragma unroll
                for (int bj = 0; bj < 2; ++bj) { const int g = 32 * u.pn + 16 * bj + 4 * wc + fq; const f32x4 a = acc[ai][bj][m][0], b = acc[ai][bj][m][1]; f32x4 o;
#pragma unroll
                    for (int e = 0; e < 4; ++e) o[e] = a[e] / (1.0f + __expf(-a[e])) * b[e];
                    u32x2 w; w.x = cvt_pk_bf16(o[0], o[1]); w.y = cvt_pk_bf16(o[2], o[3]); *(u32x2*)(rowp + 4 * g) = w; } }
    }
};
struct EpiMoeOut {
    static constexpr bool PERM = true, AFTER_DRAIN = false;
    bf16_t* YS; const float* gs;
    __device__ __forceinline__ void operator()(const f32x4 (&acc)[2][2][4][2], const Unit& u, int wr, int wc, int fr, int fq) const {
        const int row0 = u.pm * BM + wr * 64 + fr, col0 = u.pn * BM + wc * 32 + 8 * fq;
#pragma unroll
        for (int ai = 0; ai < 2; ++ai)
#pragma unroll
            for (int m = 0; m < 4; ++m) { const int r = row0 + ai * HALF + m * 16; const float gt = gs[r]; bf16_t* rowp = YS + (size_t)r * 1024 + col0;
#pragma unroll
                for (int bj = 0; bj < 2; ++bj) { const f32x4 v0 = acc[ai][bj][m][0] * gt, v1 = acc[ai][bj][m][1] * gt;
                    u32x4 w; w.x = cvt_pk_bf16(v0[0], v0[1]); w.y = cvt_pk_bf16(v0[2], v0[3]); w.z = cvt_pk_bf16(v1[0], v1[1]); w.w = cvt_pk_bf16(v1[2], v1[3]);
                    *(u32x4*)(rowp + bj * HALF) = w; } }
    }
};
struct MoeOrder {
    const __attribute__((address_space(3))) int* t2e; int ntiles, nN, G, c;
    __device__ bool next(int i, Unit& u) const { const int L = i * G + c; if (L >= ntiles * nN) return false; u.pm = L / nN; u.pn = L % nN; u.e = t2e[u.pm]; return true; }
    __device__ __forceinline__ void a_ready(const Unit&) const {}
    __device__ __forceinline__ void done(const Unit&) const {}
};
template <class Epi, class Sched, bool ALIGN_EPI = false, bool SP2 = false>
__device__ __forceinline__ void gemm_phase(PG8_LAS unsigned char* lds, const Gemm g, const Sched& S, const Epi& E) {
    int tid_ = threadIdx.x; asm volatile("" : "+v"(tid_));
    const int tid = tid_, wid = __builtin_amdgcn_readfirstlane(tid >> 6), lane = tid & 63, wr = wid >> 2, wc = wid & 3, fr = lane & 15, fq = lane >> 4;
    const int K = g.K, nt = K / BK;
    unsigned voffA[2], voffB[2];
#pragma unroll
    for (int i = 0; i < 2; ++i) { int R, C; stage_rc(tid * 16 + i * 8192, R, C); const int Rb = Epi::PERM ? ((R & ~31) + perm32(R & 31)) : R;
        voffA[i] = (unsigned)(R * K + C) * 2u; voffB[i] = (unsigned)(Rb * K + C) * 2u; }
    const size_t kstep = (size_t)(BK * 2);
    const size_t hstep = (size_t)HALF * K * 2;
    const size_t tstep = 2 * hstep;
    const unsigned ldsw = (unsigned)wid * 1024u;
    const int aoff = lds_byte(wr * 64 + fr, fq * 8), boff = lds_byte(wc * 32 + fr, fq * 8);
#define PG8_SA(b, h) (((b) * 2 + (h)) * HTB)
#define PG8_SB(b, h) ((4 + (b) * 2 + (h)) * HTB)
#define PG8_STAGE(bufoff, gbase, voff) do { _Pragma("unroll") for (int _i = 0; _i < 2; ++_i) \
        __builtin_amdgcn_global_load_lds((const unsigned*)((const char*)(gbase) + (voff)[_i]), (PG8_LAS unsigned*)(lds + (bufoff) + ldsw + _i * 8192), 16, 0, 0); } while (0)
#define PG8_LDA(dst, b, h) do { _Pragma("unroll") for (int m = 0; m < 4; ++m) _Pragma("unroll") for (int k = 0; k < 2; ++k) dst[m][k] = *(const PG8_LAS bf16x8*)(lds + PG8_SA(b, h) + aoff + m * 2048 + k * 1024); } while (0)
#define PG8_LDB(dst, b, h) do { _Pragma("unroll") for (int n = 0; n < 2; ++n) _Pragma("unroll") for (int k = 0; k < 2; ++k) dst[n][k] = *(const PG8_LAS bf16x8*)(lds + PG8_SB(b, h) + boff + n * 2048 + k * 1024); } while (0)
#define PG8_MMA(ai, bj, At, Bt) do { __builtin_amdgcn_s_setprio(1); _Pragma("unroll") for (int m = 0; m < 4; ++m) _Pragma("unroll") for (int n = 0; n < 2; ++n) _Pragma("unroll") for (int k = 0; k < 2; ++k) \
        acc[ai][bj][m][n] = __builtin_amdgcn_mfma_f32_16x16x32_bf16(Bt[n][k], At[m][k], acc[ai][bj][m][n], 0, 0, 0); __builtin_amdgcn_s_setprio(0); } while (0)
#define PG8_WAIT_V(n) asm volatile("s_waitcnt vmcnt(" #n ")" ::: "memory")
#define PG8_WAIT_L(n) asm volatile("s_waitcnt lgkmcnt(" #n ")" ::: "memory")
#define PG8_BAR __builtin_amdgcn_s_barrier()
#define PG8_SCHED __builtin_amdgcn_sched_barrier(0)
    Unit cur, nxt; int ui = 0;
    if (!S.next(0, cur)) return;
    f32x4 acc[2][2][4][2];
#pragma unroll
    for (int a = 0; a < 2; ++a)
#pragma unroll
        for (int b = 0; b < 2; ++b)
#pragma unroll
            for (int m = 0; m < 4; ++m)
#pragma unroll
                for (int n = 0; n < 2; ++n) acc[a][b][m][n] = (f32x4){0.f, 0.f, 0.f, 0.f};
    bf16x8 At[4][2], B0[2][2], B1[2][2];
    const char* cA = (const char*)g.A + (size_t)cur.pm * tstep; const char* cB = (const char*)g.Bt + (size_t)cur.e * g.estride + (size_t)cur.pn * tstep;
    S.a_ready(cur);
    if constexpr (SP2) {
        PG8_STAGE(PG8_SB(0, 0), cB, voffB); PG8_STAGE(PG8_SB(0, 1), cB + hstep, voffB); PG8_STAGE(PG8_SA(0, 0), cA, voffA); PG8_STAGE(PG8_SA(0, 1), cA + hstep, voffA);
        if (wr == 1) PG8_BAR;
        PG8_WAIT_V(2); PG8_BAR;
        PG8_STAGE(PG8_SB(1, 0), cB + kstep, voffB); PG8_STAGE(PG8_SA(1, 0), cA + kstep, voffA); PG8_STAGE(PG8_SB(1, 1), cB + hstep + kstep, voffB);
        PG8_WAIT_V(6); PG8_BAR;
    } else {
        PG8_STAGE(PG8_SB(0, 0), cB, voffB); PG8_STAGE(PG8_SA(0, 0), cA, voffA); PG8_STAGE(PG8_SB(0, 1), cB + hstep, voffB); PG8_STAGE(PG8_SA(0, 1), cA + hstep, voffA);
        if (wr == 1) PG8_BAR;
        PG8_WAIT_V(4); PG8_BAR;
        PG8_STAGE(PG8_SB(1, 0), cB + kstep, voffB); PG8_STAGE(PG8_SA(1, 0), cA + kstep, voffA); PG8_STAGE(PG8_SB(1, 1), cB + hstep + kstep, voffB);
        PG8_WAIT_V(6); PG8_BAR;
    }
    for (;;) {
        const bool has_next = S.next(ui + 1, nxt);
        const char* nA = has_next ? (const char*)g.A + (size_t)nxt.pm * tstep : cA; const char* nB = has_next ? (const char*)g.Bt + (size_t)nxt.e * g.estride + (size_t)nxt.pn * tstep : cB;
        for (int t = 0; t < nt; t += 2) {
            const bool last = (t == nt - 2);
            const char* a1 = cA + (size_t)(t + 1) * kstep;
            const char* a2 = last ? nA : cA + (size_t)(t + 2) * kstep; const char* b2 = last ? nB : cB + (size_t)(t + 2) * kstep;
            const char* a3 = a2 + kstep; const char* b3 = b2 + kstep;
            if (last && has_next) S.a_ready(nxt);
            if constexpr (SP2) {
            PG8_LDB(B0, 0, 0); PG8_LDB(B1, 0, 1); PG8_SCHED; PG8_LDA(At, 0, 0); PG8_STAGE(PG8_SA(1, 1), a1 + hstep, voffA);
            PG8_WAIT_V(8); PG8_WAIT_L(0); PG8_BAR; PG8_MMA(0, 0, At, B0); PG8_MMA(0, 1, At, B1); PG8_BAR; PG8_SCHED;
            PG8_LDA(At, 0, 1); PG8_STAGE(PG8_SB(0, 0), b2, voffB); PG8_STAGE(PG8_SB(0, 1), b2 + hstep, voffB); PG8_STAGE(PG8_SA(0, 0), a2, voffA);
            PG8_WAIT_V(8); PG8_WAIT_L(0); PG8_BAR; PG8_MMA(1, 0, At, B0); PG8_MMA(1, 1, At, B1); PG8_BAR; PG8_SCHED;
            PG8_LDB(B0, 1, 0); PG8_LDB(B1, 1, 1); PG8_SCHED; PG8_LDA(At, 1, 0); PG8_STAGE(PG8_SA(0, 1), a2 + hstep, voffA);
            PG8_WAIT_V(8); PG8_WAIT_L(0); PG8_BAR; PG8_MMA(0, 0, At, B0); PG8_MMA(0, 1, At, B1); PG8_BAR; PG8_SCHED;
            PG8_LDA(At, 1, 1); PG8_STAGE(PG8_SB(1, 0), b3, voffB); PG8_STAGE(PG8_SB(1, 1), b3 + hstep, voffB); PG8_STAGE(PG8_SA(1, 0), a3, voffA);
            PG8_WAIT_V(8); PG8_WAIT_L(0); PG8_BAR; PG8_MMA(1, 0, At, B0); PG8_MMA(1, 1, At, B1); PG8_BAR; PG8_SCHED;
            } else {
            PG8_LDB(B0, 0, 0); PG8_SCHED; PG8_LDA(At, 0, 0); PG8_STAGE(PG8_SA(1, 1), a1 + hstep, voffA);
            PG8_WAIT_L(8); PG8_BAR; PG8_WAIT_L(0); PG8_MMA(0, 0, At, B0); PG8_BAR; PG8_SCHED;
            PG8_LDB(B1, 0, 1); PG8_STAGE(PG8_SB(0, 0), b2, voffB);
            PG8_BAR; PG8_WAIT_L(0); PG8_MMA(0, 1, At, B1); PG8_BAR;
            PG8_LDA(At, 0, 1); PG8_STAGE(PG8_SA(0, 0), a2, voffA);
            PG8_BAR; PG8_WAIT_L(0); PG8_MMA(1, 0, At, B0); PG8_BAR; PG8_SCHED;
            PG8_STAGE(PG8_SB(0, 1), b2 + hstep, voffB);
            PG8_WAIT_V(6); PG8_BAR; PG8_MMA(1, 1, At, B1); PG8_BAR;
            PG8_LDB(B0, 1, 0); PG8_SCHED; PG8_LDA(At, 1, 0); PG8_STAGE(PG8_SA(0, 1), a2 + hstep, voffA);
            PG8_WAIT_L(8); PG8_BAR; PG8_WAIT_L(0); PG8_MMA(0, 0, At, B0); PG8_BAR; PG8_SCHED;
            PG8_LDB(B1, 1, 1); PG8_STAGE(PG8_SB(1, 0), b3, voffB);
            PG8_BAR; PG8_WAIT_L(0); PG8_MMA(0, 1, At, B1); PG8_BAR;
            PG8_LDA(At, 1, 1); PG8_STAGE(PG8_SA(1, 0), a3, voffA);
            PG8_BAR; PG8_WAIT_L(0); PG8_MMA(1, 0, At, B0); PG8_BAR; PG8_SCHED;
            PG8_STAGE(PG8_SB(1, 1), b3 + hstep, voffB);
            PG8_WAIT_V(6); PG8_BAR; PG8_MMA(1, 1, At, B1); PG8_BAR;
            }
        }
        if constexpr (ALIGN_EPI) { if (wr == 0) PG8_BAR; }
        if constexpr (!Epi::AFTER_DRAIN) { E(acc, cur, wr, wc, fr, fq); S.done(cur); }
        if (!has_next) break;
#pragma unroll
        for (int a = 0; a < 2; ++a)
#pragma unroll
            for (int b = 0; b < 2; ++b)
#pragma unroll
                for (int m = 0; m < 4; ++m)
#pragma unroll
                    for (int n = 0; n < 2; ++n) acc[a][b][m][n] = (f32x4){0.f, 0.f, 0.f, 0.f};
        cur = nxt; cA = nA; cB = nB; ++ui;
        if constexpr (ALIGN_EPI) { if (wr == 1) PG8_BAR; }
    }
    PG8_WAIT_V(0);
    if constexpr (!ALIGN_EPI) { if (wr == 0) PG8_BAR; }
    PG8_BAR;
    if constexpr (Epi::AFTER_DRAIN) { E.fused(acc, cur, wr, wc, fr, fq, lds, wid, lane); S.done(cur); }
#undef PG8_SA
#undef PG8_SB
#undef PG8_STAGE
#undef PG8_LDA
#undef PG8_LDB
#undef PG8_MMA
#undef PG8_WAIT_V
#undef PG8_WAIT_L
#undef PG8_BAR
#undef PG8_SCHED
}
}
#include <hip/hip_bf16.h>
#include <cmath>
namespace attn_body {
using bf16=__hip_bfloat16;
using bf16x8=__attribute__((ext_vector_type(8)))short;
using s16x4=__attribute__((ext_vector_type(4)))short;
using f32x16=__attribute__((ext_vector_type(16)))float;
using u32x4=__attribute__((ext_vector_type(4)))unsigned;
constexpr int D=64;
#ifndef TBATCH
#define TBATCH 16
#endif
constexpr int NW=8,QBLK=32,QB=QBLK*NW,KVBLK=64;
constexpr int ATTN_UNIT_ROWS=QB;
__device__ __forceinline__ int crow(int r,int hi){return (r&3)+8*(r>>2)+4*hi;}
#define SBAR() __builtin_amdgcn_sched_barrier(0)
__device__ __forceinline__ void cmask(f32x16&p0,f32x16&p1,int jb,int qrel,int hi){
  const float NEG=-INFINITY; int kb=64*jb+4*hi;
  #pragma unroll
  for(int r=0;r<16;++r){int kv=kb+(r&3)+8*(r>>2); if(kv>qrel)p0[r]=NEG; if(kv+32>qrel)p1[r]=NEG;}
}

constexpr int NSLOT=3, SLOTB=8192;
constexpr int LDS_K=0, LDS_V=NSLOT*SLOTB, LDS_WS=2*NSLOT*SLOTB, LDS_OST=LDS_WS+NW*64*4, LDS_TBL=LDS_OST+NW*4096, TBL_N=1344, LDS_BYTES=LDS_TBL+8*TBL_N*4;
constexpr float C2=0.125f*1.4426950408889634f;
__device__ __forceinline__ void glds16(const void*gsrc,unsigned lds_dst){unsigned keep;
  asm volatile("s_mov_b32 %0, m0\n\ts_mov_b32 m0, %2\n\ts_nop 0\n\tglobal_load_lds_dwordx4 %1, off\n\ts_mov_b32 m0, %0":"=&s"(keep):"v"(gsrc),"s"(lds_dst):"memory");}
__device__ __forceinline__ float max3f(float a,float b,float c){float r;asm("v_max3_f32 %0, %1, %2, %3":"=v"(r):"v"(a),"v"(b),"v"(c));return r;}
__device__ __forceinline__ float max2f(float a,float b){float r;asm("v_max_f32_e32 %0, %1, %2":"=v"(r):"v"(a),"v"(b));return r;}
__device__ __forceinline__ float fadd_s(float a,float b){float r;asm("v_add_f32_e32 %0, %1, %2":"=v"(r):"v"(a),"v"(b));return r;}
__device__ __forceinline__ float fsub_s(float a,float b){float r;asm("v_sub_f32_e32 %0, %1, %2":"=v"(r):"v"(a),"v"(b));return r;}
typedef float f32x2_t __attribute__((ext_vector_type(2))); typedef __bf16 bf16x2_t __attribute__((ext_vector_type(2)));
__device__ __forceinline__ unsigned cvtpk_s(float lo,float hi){f32x2_t v={lo,hi};bf16x2_t b=__builtin_convertvector(v,bf16x2_t);return __builtin_bit_cast(unsigned,b);}
#define WAIT_BAR(N) asm volatile("s_waitcnt vmcnt(" #N ") lgkmcnt(0)\n\ts_barrier":::"memory")

__device__ __forceinline__ void qkt(f32x16&p0,f32x16&p1,const char*Kslot,const bf16x8*qr,const f32x16&negm,int r32,int hi){
  const char*kb=Kslot+hi*1024+r32*16;
  #pragma unroll
  for(int d0=0;d0<4;++d0){
    const bf16x8 b0=*reinterpret_cast<const bf16x8*>(kb+d0*2048);
    const bf16x8 b1=*reinterpret_cast<const bf16x8*>(kb+d0*2048+512);
    if(d0==0){p0=__builtin_amdgcn_mfma_f32_32x32x16_bf16(b0,qr[0],negm,0,0,0);p1=__builtin_amdgcn_mfma_f32_32x32x16_bf16(b1,qr[0],negm,0,0,0);}
    else{p0=__builtin_amdgcn_mfma_f32_32x32x16_bf16(b0,qr[d0],p0,0,0,0);p1=__builtin_amdgcn_mfma_f32_32x32x16_bf16(b1,qr[d0],p1,0,0,0);}}
}
typedef __attribute__((address_space(3))) const char* lds_cptr;
typedef short v4i16_t __attribute__((ext_vector_type(4)));
__device__ __forceinline__ void kload8(bf16x8*kf,lds_cptr kp){
  kf[0]=*(const __attribute__((address_space(3))) bf16x8*)(kp);      kf[1]=*(const __attribute__((address_space(3))) bf16x8*)(kp+512);
  kf[2]=*(const __attribute__((address_space(3))) bf16x8*)(kp+2048); kf[3]=*(const __attribute__((address_space(3))) bf16x8*)(kp+2560);
  kf[4]=*(const __attribute__((address_space(3))) bf16x8*)(kp+4096); kf[5]=*(const __attribute__((address_space(3))) bf16x8*)(kp+4608);
  kf[6]=*(const __attribute__((address_space(3))) bf16x8*)(kp+6144); kf[7]=*(const __attribute__((address_space(3))) bf16x8*)(kp+6656);
}
__device__ __forceinline__ void kload2(bf16x8*kf,lds_cptr kp,int j){ kf[2*j]=*(const __attribute__((address_space(3))) bf16x8*)(kp+j*2048); kf[2*j+1]=*(const __attribute__((address_space(3))) bf16x8*)(kp+j*2048+512); }
__device__ __forceinline__ s16x4 vtr(lds_cptr p){ return __builtin_bit_cast(s16x4,__builtin_amdgcn_ds_read_tr16_b64_v4i16((__attribute__((address_space(3))) v4i16_t*)p)); }
__device__ __forceinline__ float rowmax(const f32x16&p0,const f32x16&p1){
  float a=max3f(p0[0],p0[1],p1[0]),b=max3f(p0[2],p0[3],p1[1]);a=max3f(a,p1[2],p1[3]);
  #pragma unroll
  for(int r=4;r<16;r+=4){a=max3f(a,p0[r],p0[r+1]);b=max3f(b,p0[r+2],p0[r+3]);a=max3f(a,p1[r],p1[r+1]);b=max3f(b,p1[r+2],p1[r+3]);}
  const float m=max2f(a,b);
  auto rr=__builtin_amdgcn_permlane32_swap(__float_as_uint(m),__float_as_uint(m),false,false);
  return max2f(__uint_as_float(rr[0]),__uint_as_float(rr[1]));
}
__device__ __forceinline__ void pv(f32x16*o,int vb,bf16x8 pa0,bf16x8 pa1,bf16x8 pa2,bf16x8 pa3){
  #pragma unroll
  for(int d0=0;d0<2;++d0){s16x4 lo[4],hi[4];
    #pragma unroll
    for(int ks=0;ks<4;++ks){
      asm volatile("ds_read_b64_tr_b16 %0,%1 offset:%c2":"=&v"(lo[ks]):"v"(vb),"i"(d0*4096+ks*1024):"memory");
      asm volatile("ds_read_b64_tr_b16 %0,%1 offset:%c2":"=&v"(hi[ks]):"v"(vb),"i"(d0*4096+ks*1024+512):"memory");}
    asm volatile("s_waitcnt lgkmcnt(0)":::"memory");SBAR();
    #define PK(k) (bf16x8){lo[k][0],lo[k][1],lo[k][2],lo[k][3],hi[k][0],hi[k][1],hi[k][2],hi[k][3]}
    o[d0]=__builtin_amdgcn_mfma_f32_32x32x16_bf16(pa0,PK(0),o[d0],0,0,0);
    o[d0]=__builtin_amdgcn_mfma_f32_32x32x16_bf16(pa1,PK(1),o[d0],0,0,0);
    o[d0]=__builtin_amdgcn_mfma_f32_32x32x16_bf16(pa2,PK(2),o[d0],0,0,0);
    o[d0]=__builtin_amdgcn_mfma_f32_32x32x16_bf16(pa3,PK(3),o[d0],0,0,0);
    #undef PK
  }
}

#ifndef ATTN_STORE16
#define ATTN_STORE16(p,v) __builtin_nontemporal_store((v),(u32x4*)(p))
#endif
__device__ __forceinline__ void attn_build_tables(int tid,const float*tb,char*shm){
  typedef __attribute__((address_space(3))) float lds_f32;
  lds_f32*T=(lds_f32*)((__attribute__((address_space(3))) char*)shm+LDS_TBL);
  for(int i=tid;i<8*TBL_N;i+=NW*64){ const int hh=i/TBL_N, d=i-hh*TBL_N-256; float v=0.f; if(d<0)v=-INFINITY; else if(d<1024)v=tb[hh*1024+d]-tb[hh*1024+1023]; T[i]=v; }
}
template<int THRL,bool MOBA,bool USE_NEGM> __device__ __forceinline__ void attn_unit(int tid,int qb,const bf16*Qb,int qpitch,const bf16*__restrict__ Kb,int kpitch,const bf16*__restrict__ Vb,int vpitch,bf16*Ob,int opitch,int hh,const float*kmean,char*shm){
  const int lane=tid&63,r32=lane&31,hi=lane>>5; const int wid=__builtin_amdgcn_readfirstlane(tid>>6);
  const int q0=qb*QB;
  const bf16*Qw=Qb+(long)(q0+wid*QBLK)*qpitch;
  const bf16*Kh=Kb,*Vh=Vb;
  const int qpos=q0+wid*QBLK+r32;
  typedef __attribute__((address_space(3))) float lds_f32;
  const lds_f32*Tl=(const lds_f32*)((__attribute__((address_space(3))) char*)shm+LDS_TBL)+hh*TBL_N;
  unsigned selmask=0xffffffffu;
  if(MOBA){
    float qf[64];
    { const uint4*qp=(const uint4*)(Qw+(long)r32*qpitch);
      _Pragma("unroll") for(int c=0;c<8;++c){ const uint4 u=qp[c]; qf[8*c]=__uint_as_float(u.x<<16);qf[8*c+1]=__uint_as_float(u.x&0xffff0000u);qf[8*c+2]=__uint_as_float(u.y<<16);qf[8*c+3]=__uint_as_float(u.y&0xffff0000u);
        qf[8*c+4]=__uint_as_float(u.z<<16);qf[8*c+5]=__uint_as_float(u.z&0xffff0000u);qf[8*c+6]=__uint_as_float(u.w<<16);qf[8*c+7]=__uint_as_float(u.w&0xffff0000u);} }
    float v1=-INFINITY,v2=-INFINITY,v3=-INFINITY; int i1=31,i2=31,i3=31;
    for(int n=0;n<qb;++n){ const float*km=kmean+n*64; float g=0.f;
      _Pragma("unroll") for(int i=0;i<64;++i)g+=qf[i]*km[i];
      if(g>v1){v3=v2;i3=i2;v2=v1;i2=i1;v1=g;i1=n;} else if(g>v2){v3=v2;i3=i2;v2=g;i2=n;} else if(g>v3){v3=g;i3=n;} }
    selmask=(1u<<qb); if(i1<31)selmask|=1u<<i1; if(i2<31)selmask|=1u<<i2; if(i3<31)selmask|=1u<<i3; }
  #define TMAP(t) (MOBA?(((t)<4)?(NT-4+(t)):((t)-4)):(t))
  const unsigned lds0=(unsigned)(uintptr_t)shm;
  float*wsf=(float*)(shm+LDS_WS)+wid*64;
  const bf16*ksrc=Kh+(long)lane*kpitch+wid*8;
  const bf16*vsrc=Vh+(long)(16*(wid&3)+(lane>>2))*vpitch+(wid>>2)*32+(lane&3)*8;
  const unsigned kdst=lds0+LDS_K+wid*1024, vdst=lds0+LDS_V+wid*1024;
  #define DMA_K(t,slot) glds16(ksrc+(long)TMAP(t)*KVBLK*kpitch,(unsigned)__builtin_amdgcn_readfirstlane(kdst+(slot)))
  #define DMA_V(t,slot) glds16(vsrc+(long)TMAP(t)*KVBLK*vpitch,(unsigned)__builtin_amdgcn_readfirstlane(vdst+(slot)))
  const int vb0=(int)(lds0+LDS_V)+((lane>>4)&1)*32+(lane&3)*8+(4*hi+((lane&15)>>2))*64;
  const char*Kbase=shm+LDS_K; bf16x8 kf[8];
  const lds_cptr shm3=(lds_cptr)shm; const lds_cptr kp0=shm3+LDS_K+hi*1024+r32*16; const lds_cptr vp0=shm3+LDS_V+((lane>>4)&1)*32+(lane&3)*8+(4*hi+((lane&15)>>2))*64;
  const int NT=(q0+QB)/KVBLK;
  DMA_K(0,0);DMA_V(0,0);DMA_K(1,SLOTB);
  bf16x8 qr[4];
  #pragma unroll
  for(int d0=0;d0<4;++d0)qr[d0]=*reinterpret_cast<const bf16x8*>(&Qw[(long)r32*qpitch+d0*16+hi*8]);
  float mhat=0.f,l_reg=0.f;f32x16 o[2];o[0]=f32x16{};o[1]=f32x16{};f32x16 negm=f32x16{}; if(USE_NEGM){asm volatile("":"+v"(negm));}
  #define NEGMC (USE_NEGM?negm:f32x16{})
  #define CMASK(P0,P1,t) do{ int D0_=qpos-64*TMAP(t)-4*hi; D0_=D0_<1083?D0_:1083; int bi_=D0_+(256-59); \
      if(MOBA){ if(!((selmask>>(TMAP(t)>>2))&1u))bi_=64; } const volatile lds_f32*tp_=Tl+bi_; \
      { float tb_[TBATCH]; _Pragma("unroll") for(int b0_=0;b0_<16;b0_+=TBATCH){ _Pragma("unroll") for(int r=0;r<TBATCH;++r)tb_[r]=tp_[59-(((b0_+r)&3)+8*((b0_+r)>>2))]; _Pragma("unroll") for(int r=0;r<TBATCH;++r)P0[b0_+r]=fadd_s(P0[b0_+r],tb_[r]); } \
        _Pragma("unroll") for(int b0_=0;b0_<16;b0_+=TBATCH){ _Pragma("unroll") for(int r=0;r<TBATCH;++r)tb_[r]=tp_[27-(((b0_+r)&3)+8*((b0_+r)>>2))]; _Pragma("unroll") for(int r=0;r<TBATCH;++r)P1[b0_+r]=fadd_s(P1[b0_+r],tb_[r]); } } }while(0)
  bool resc=false,mnz=false;
  #define START(P0,P1) do{ const float rm=rowmax(P0,P1); resc=false; \
    if(__any(rm>(float)THRL)){ const float dl=__builtin_fmaxf(rm,0.f); mhat=fadd_s(mhat,dl); mnz=true; \
      _Pragma("unroll") for(int r=0;r<16;++r){P0[r]=fsub_s(P0[r],dl);P1[r]=fsub_s(P1[r],dl);} \
      if(USE_NEGM){ _Pragma("unroll") for(int r=0;r<16;++r)negm[r]=-mhat; asm volatile("":"+v"(negm)); } } \
    _Pragma("unroll") for(int r=0;r<16;++r)P0[r]=__builtin_amdgcn_exp2f(P0[r]); }while(0)
  #define RESC() do{ if(resc){ asm volatile("s_waitcnt lgkmcnt(0)":::"memory"); \
      _Pragma("unroll") for(int d_=0;d_<2;++d_) _Pragma("unroll") for(int r=0;r<16;++r)o[d_][r]*=wsf[crow(r,hi)]; } }while(0)
  f32x16 pA0,pA1,pB0,pB1;
  int sl_prev=0,sl_cur=0,sl_next=SLOTB;
  #define ROT() do{sl_prev=sl_cur;sl_cur=sl_next;sl_next=(sl_next==(NSLOT-1)*SLOTB)?0:sl_next+SLOTB;}while(0)
  DMA_K(2,2*SLOTB);
  WAIT_BAR(3);
  qkt(pA0,pA1,Kbase,qr,negm,r32,hi);asm volatile("s_nop 15\n\ts_nop 7":"+v"(pA0),"+v"(pA1));CMASK(pA0,pA1,0);
  START(pA0,pA1);
  _Pragma("unroll") for(int r=0;r<16;++r)pA1[r]=__builtin_amdgcn_exp2f(pA1[r]);
  WAIT_BAR(0);
  DMA_K(3,0);DMA_V(1,SLOTB);
  ROT();
  kload8(kf,kp0+sl_cur);
  WAIT_BAR(2);
  s16x4 vlo[8],vhi[8]; u32x4 pw0,pw1,pw2,pw3;
  #define PKW(P,B) cvtpk_s(P[B],P[B+1])
  #define PAF(k) __builtin_bit_cast(bf16x8,pw##k)
  #define VFR(i) (bf16x8){vlo[i][0],vlo[i][1],vlo[i][2],vlo[i][3],vhi[i][0],vhi[i][1],vhi[i][2],vhi[i][3]}
  #define PIN(x) asm volatile("":"+v"(x))
  #define MX3(a,b,c) __builtin_fmaxf(__builtin_fmaxf((a),(b)),(c))
  #define GAPA(MF,A0,A1,A2,A3,W0,W1,PW) do{ MF; sacc+=A0; sacc+=A1; sacc+=A2; sacc+=A3; PIN(sacc); W0; W1; PIN(PW); SBAR(); }while(0)
  #define EX(v) __builtin_amdgcn_exp2f(v)
  #define GAPB(MF,X,B) do{ MF; X[B]=EX(X[B]); X[B+1]=EX(X[B+1]); X[B+2]=EX(X[B+2]); X[B+3]=EX(X[B+3]); PIN(X); SBAR(); }while(0)
  #define VRD(i) do{ vlo[i]=vtr(vp_+(((i)>>2)*4096+((i)&3)*1024)); vhi[i]=vtr(vp_+(((i)>>2)*4096+((i)&3)*1024+512)); }while(0)
  #define KRD(G,j) do{ if(G){ kload2(kf,kp0+sl_next,j); SBAR(); } }while(0)
  #define STEP(C0,C1,P0,P1,t,GK,GV,GL) do{ SBAR(); \
    const lds_cptr vp_=vp0+sl_prev; \
    VRD(0); SBAR(); float sacc=(P0[0]+P0[1]); \
    GAPA(C0=__builtin_amdgcn_mfma_f32_32x32x16_bf16(kf[0],qr[0],NEGMC,0,0,0), P0[2],P0[3],P0[4],P0[5],     pw0[0]=PKW(P0,0), pw0[1]=PKW(P0,2), pw0); \
    VRD(4); SBAR(); GAPA(C1=__builtin_amdgcn_mfma_f32_32x32x16_bf16(kf[1],qr[0],NEGMC,0,0,0), P0[6],P0[7],P0[8],P0[9],     pw0[2]=PKW(P0,4), pw0[3]=PKW(P0,6), pw0); \
    VRD(1); SBAR(); GAPA(C0=__builtin_amdgcn_mfma_f32_32x32x16_bf16(kf[2],qr[1],C0,0,0,0),   P0[10],P0[11],P0[12],P0[13], pw1[0]=PKW(P0,8), pw1[1]=PKW(P0,10), pw1); \
    VRD(5); SBAR(); GAPA(C1=__builtin_amdgcn_mfma_f32_32x32x16_bf16(kf[3],qr[1],C1,0,0,0),   P0[14],P0[15],P1[0],P1[1],   pw1[2]=PKW(P0,12),pw1[3]=PKW(P0,14), pw1); \
    VRD(2); SBAR(); GAPA(C0=__builtin_amdgcn_mfma_f32_32x32x16_bf16(kf[4],qr[2],C0,0,0,0),   P1[2],P1[3],P1[4],P1[5],     pw2[0]=PKW(P1,0), pw2[1]=PKW(P1,2), pw2); \
    VRD(6); SBAR(); GAPA(C1=__builtin_amdgcn_mfma_f32_32x32x16_bf16(kf[5],qr[2],C1,0,0,0),   P1[6],P1[7],P1[8],P1[9],     pw2[2]=PKW(P1,4), pw2[3]=PKW(P1,6), pw2); \
    VRD(3); SBAR(); GAPA(C0=__builtin_amdgcn_mfma_f32_32x32x16_bf16(kf[6],qr[3],C0,0,0,0),   P1[10],P1[11],P1[12],P1[13], pw3[0]=PKW(P1,8), pw3[1]=PKW(P1,10), pw3); \
    VRD(7); SBAR(); GAPA(C1=__builtin_amdgcn_mfma_f32_32x32x16_bf16(kf[7],qr[3],C1,0,0,0),   P1[14],P1[15],0.f,0.f,       pw3[2]=PKW(P1,12),pw3[3]=PKW(P1,14), pw3); \
    l_reg+=sacc; \
    if(GK){DMA_K((t)+3,sl_cur);} if(GV){DMA_V((t)+1,sl_next);} \
    { const float d_=__builtin_fmaxf(C0[15],C1[15]); asm volatile(""::"v"(d_)); asm volatile("":"+v"(C0),"+v"(C1)); } \
    if(!USE_NEGM&&mnz){ _Pragma("unroll") for(int r=0;r<16;++r){C0[r]=fsub_s(C0[r],mhat);C1[r]=fsub_s(C1[r],mhat);} } \
    CMASK(C0,C1,t); \
    { float a=MX3(C0[0],C0[1],C1[0]),b=MX3(C0[2],C0[3],C1[1]); a=MX3(a,C1[2],C1[3]); \
      _Pragma("unroll") for(int r=4;r<16;r+=4){a=MX3(a,C0[r],C0[r+1]);b=MX3(b,C0[r+2],C0[r+3]);a=MX3(a,C1[r],C1[r+1]);b=MX3(b,C1[r+2],C1[r+3]);} \
      float rm=__builtin_fmaxf(a,b); { auto rr=__builtin_amdgcn_permlane32_swap(__float_as_uint(rm),__float_as_uint(rm),false,false); rm=__builtin_fmaxf(__uint_as_float(rr[0]),__uint_as_float(rr[1])); } \
      resc=false; \
      if(__builtin_expect(__any(rm>(float)THRL),0)){ const float dl=__builtin_fmaxf(rm,0.f); mhat+=dl; mnz=true; \
        _Pragma("unroll") for(int r=0;r<16;++r){C0[r]=fsub_s(C0[r],dl);C1[r]=fsub_s(C1[r],dl);} \
        if(USE_NEGM){ _Pragma("unroll") for(int r=0;r<16;++r)negm[r]=-mhat; asm volatile("":"+v"(negm)); } \
        const float f=__builtin_amdgcn_exp2f(-dl); l_reg*=f; if(hi==0)wsf[r32]=f; resc=true; } } \
    SBAR(); \
    GAPB(o[0]=__builtin_amdgcn_mfma_f32_32x32x16_bf16(PAF(0),VFR(0),o[0],0,0,0), C0,0); \
    GAPB(o[1]=__builtin_amdgcn_mfma_f32_32x32x16_bf16(PAF(0),VFR(4),o[1],0,0,0), C0,4); \
    KRD(GL,0); GAPB(o[0]=__builtin_amdgcn_mfma_f32_32x32x16_bf16(PAF(1),VFR(1),o[0],0,0,0), C0,8); \
    KRD(GL,1); GAPB(o[1]=__builtin_amdgcn_mfma_f32_32x32x16_bf16(PAF(1),VFR(5),o[1],0,0,0), C0,12); \
    KRD(GL,2); GAPB(o[0]=__builtin_amdgcn_mfma_f32_32x32x16_bf16(PAF(2),VFR(2),o[0],0,0,0), C1,0); \
    KRD(GL,3); GAPB(o[1]=__builtin_amdgcn_mfma_f32_32x32x16_bf16(PAF(2),VFR(6),o[1],0,0,0), C1,4); \
    GAPB(o[0]=__builtin_amdgcn_mfma_f32_32x32x16_bf16(PAF(3),VFR(3),o[0],0,0,0), C1,8); \
    GAPB(o[1]=__builtin_amdgcn_mfma_f32_32x32x16_bf16(PAF(3),VFR(7),o[1],0,0,0), C1,12); \
    }while(0)
  int t=1;
  #undef CMASK
  #define CMASK(P0,P1,t) do{}while(0)
  const int t_tbl=MOBA?0:((q0>=853)?((q0-853)/64+1):0);
  for(;t+5<NT&&t+1<t_tbl;t+=2){
    STEP(pB0,pB1,pA0,pA1,t,true,true,true);     WAIT_BAR(2); RESC(); ROT();
    STEP(pA0,pA1,pB0,pB1,t+1,true,true,true);   WAIT_BAR(2); RESC(); ROT();
  }
  #undef CMASK
  #define CMASK(P0,P1,t) do{ int D0_=qpos-64*TMAP(t)-4*hi; D0_=D0_<1083?D0_:1083; int bi_=D0_+(256-59); \
      if(MOBA){ if(!((selmask>>(TMAP(t)>>2))&1u))bi_=64; } const volatile lds_f32*tp_=Tl+bi_; \
      { float tb_[TBATCH]; _Pragma("unroll") for(int b0_=0;b0_<16;b0_+=TBATCH){ _Pragma("unroll") for(int r=0;r<TBATCH;++r)tb_[r]=tp_[59-(((b0_+r)&3)+8*((b0_+r)>>2))]; _Pragma("unroll") for(int r=0;r<TBATCH;++r)P0[b0_+r]=fadd_s(P0[b0_+r],tb_[r]); } \
        _Pragma("unroll") for(int b0_=0;b0_<16;b0_+=TBATCH){ _Pragma("unroll") for(int r=0;r<TBATCH;++r)tb_[r]=tp_[27-(((b0_+r)&3)+8*((b0_+r)>>2))]; _Pragma("unroll") for(int r=0;r<TBATCH;++r)P1[b0_+r]=fadd_s(P1[b0_+r],tb_[r]); } } }while(0)
  #define ENDW(tt) do{ if((tt)+3<NT){WAIT_BAR(2);} else if((tt)+2<NT){WAIT_BAR(1);} else {WAIT_BAR(0);} }while(0)
  for(;t+1<NT;t+=2){
    STEP(pB0,pB1,pA0,pA1,t,(t+3<NT),(t+1<NT),(t+1<NT));       ENDW(t);   RESC(); ROT();
    STEP(pA0,pA1,pB0,pB1,t+1,(t+4<NT),(t+2<NT),(t+2<NT));     ENDW(t+1); RESC(); ROT();
  }
  STEP(pB0,pB1,pA0,pA1,NT-1,false,false,false); RESC();
  { float sacc=pB0[0]+pB0[1]; _Pragma("unroll") for(int r=2;r<16;++r)sacc+=pB0[r]; _Pragma("unroll") for(int r=0;r<16;++r)sacc+=pB1[r]; l_reg+=sacc;
    pw0=(u32x4){PKW(pB0,0),PKW(pB0,2),PKW(pB0,4),PKW(pB0,6)};pw1=(u32x4){PKW(pB0,8),PKW(pB0,10),PKW(pB0,12),PKW(pB0,14)};pw2=(u32x4){PKW(pB1,0),PKW(pB1,2),PKW(pB1,4),PKW(pB1,6)};pw3=(u32x4){PKW(pB1,8),PKW(pB1,10),PKW(pB1,12),PKW(pB1,14)};
    SBAR(); pv(o,vb0+sl_cur,PAF(0),PAF(1),PAF(2),PAF(3)); }
  #undef PKW
  #undef PAF
  #undef VFR
  #undef PIN
  #undef MX3
  #undef GAPA
  #undef GAPB
  #undef EX
  #undef VRD
  #undef KRD
  #undef STEP
  #undef ENDW
  {auto rr=__builtin_amdgcn_permlane32_swap(__float_as_uint(l_reg),__float_as_uint(l_reg),false,false);l_reg=__uint_as_float(rr[0])+__uint_as_float(rr[1]);}
  if(hi==0)wsf[32+r32]=l_reg;asm volatile("s_waitcnt lgkmcnt(0)":::"memory");
  float rli[16];
  #pragma unroll
  for(int r=0;r<16;++r)rli[r]=__builtin_amdgcn_rcpf(wsf[32+crow(r,hi)]);
  bf16*Ow=Ob+(long)(q0+wid*QBLK)*opitch;
  { bf16*stg=(bf16*)(shm+LDS_OST)+wid*2048;
    #pragma unroll
    for(int r=0;r<16;++r){const int orow=crow(r,hi);
      #pragma unroll
      for(int d0=0;d0<2;++d0)stg[orow*64+d0*32+r32]=__float2bfloat16(o[d0][r]*rli[r]);}
    asm volatile("s_waitcnt lgkmcnt(0)":::"memory");
    #pragma unroll
    for(int i=0;i<4;++i){const int row=i*8+(lane>>3),ch=lane&7; const u32x4 v=*(const u32x4*)(stg+row*64+ch*8); ATTN_STORE16(Ow+(long)row*opitch+ch*8,v);} }
  asm volatile("s_waitcnt lgkmcnt(0)\n\ts_barrier":::"memory");
  #undef DMA_K
  #undef DMA_V
  #undef TMAP
  #undef NEGMC
  #undef CMASK
  #undef START
  #undef RESC
  #undef ROT
}

constexpr int DV_K=0, DV_V=NSLOT*SLOTB, DV_VSLOT=2*SLOTB, DV_WS=DV_V+NSLOT*DV_VSLOT, DV_OST=0;
static_assert(DV_WS+NW*64*4<=LDS_TBL && NW*8192<=DV_WS, "dv unit LDS layout");
template<int THRL> __device__ __forceinline__ void attn_unit_dv(int tid,int qb,const bf16*Qb,int qpitch,const bf16*__restrict__ Kb,int kpitch,const bf16*__restrict__ Vb,int vpitch,bf16*Ob,int opitch,int hh,char*shm){
  const int lane=tid&63,r32=lane&31,hi=lane>>5; const int wid=__builtin_amdgcn_readfirstlane(tid>>6);
  const int q0=qb*QB;
  const bf16*Qw=Qb+(long)(q0+wid*QBLK)*qpitch;
  const int qpos=q0+wid*QBLK+r32;
  typedef __attribute__((address_space(3))) float lds_f32;
  const lds_cptr shm3=(lds_cptr)shm;
  const lds_f32*Tl=(const lds_f32*)(shm3+LDS_TBL)+hh*TBL_N;
  lds_f32*wsf=(lds_f32*)(shm3+DV_WS)+wid*64;
  const unsigned lds0=(unsigned)(uintptr_t)shm;
  const bf16*ksrc=Kb+(long)lane*kpitch+wid*8;
  const bf16*vsrc=Vb+(long)(16*(wid&3)+(lane>>2))*vpitch+(wid>>2)*32+(lane&3)*8;
  const unsigned kdst=lds0+DV_K+wid*1024, vdst=lds0+DV_V+wid*1024;
  #define DVK(t,slot) glds16(ksrc+(long)(t)*KVBLK*kpitch,(unsigned)__builtin_amdgcn_readfirstlane(kdst+(slot)))
  #define DVV(t,slot) do{ glds16(vsrc+(long)(t)*KVBLK*vpitch,(unsigned)__builtin_amdgcn_readfirstlane(vdst+2*(slot))); glds16(vsrc+(long)(t)*KVBLK*vpitch+64,(unsigned)__builtin_amdgcn_readfirstlane(vdst+2*(slot)+8192)); }while(0)
  const lds_cptr kp0=shm3+DV_K+hi*1024+r32*16; const lds_cptr vp0=shm3+DV_V+((lane>>4)&1)*32+(lane&3)*8+(4*hi+((lane&15)>>2))*64;
  const int NT=(q0+QB)/KVBLK;
  DVK(0,0);DVV(0,0);DVK(1,SLOTB);
  bf16x8 qr[4];
  #pragma unroll
  for(int d0=0;d0<4;++d0)qr[d0]=*reinterpret_cast<const bf16x8*>(&Qw[(long)r32*qpitch+d0*16+hi*8]);
  float mhat=0.f,l_reg=0.f; f32x16 o[4]; o[0]=f32x16{};o[1]=f32x16{};o[2]=f32x16{};o[3]=f32x16{};
  const int t_tbl=(q0>=853)?((q0-853)/64+1):0;
  #define DV_CMASK(P0,P1,t) do{ int D0_=qpos-64*(t)-4*hi; D0_=D0_<1083?D0_:1083; const volatile lds_f32*tp_=Tl+(D0_+(256-59)); \
      { float tb_[8]; _Pragma("unroll") for(int b0_=0;b0_<16;b0_+=8){ _Pragma("unroll") for(int r=0;r<8;++r)tb_[r]=tp_[59-(((b0_+r)&3)+8*((b0_+r)>>2))]; _Pragma("unroll") for(int r=0;r<8;++r)P0[b0_+r]=fadd_s(P0[b0_+r],tb_[r]); } \
        _Pragma("unroll") for(int b0_=0;b0_<16;b0_+=8){ _Pragma("unroll") for(int r=0;r<8;++r)tb_[r]=tp_[27-(((b0_+r)&3)+8*((b0_+r)>>2))]; _Pragma("unroll") for(int r=0;r<8;++r)P1[b0_+r]=fadd_s(P1[b0_+r],tb_[r]); } } }while(0)
  #define DV_MX3(a,b,c) __builtin_fmaxf(__builtin_fmaxf((a),(b)),(c))
  #define DV_ROWMAX(rm,C0,C1) do{ float a=DV_MX3(C0[0],C0[1],C1[0]),b=DV_MX3(C0[2],C0[3],C1[1]); a=DV_MX3(a,C1[2],C1[3]); \
      _Pragma("unroll") for(int r=4;r<16;r+=4){a=DV_MX3(a,C0[r],C0[r+1]);b=DV_MX3(b,C0[r+2],C0[r+3]);a=DV_MX3(a,C1[r],C1[r+1]);b=DV_MX3(b,C1[r+2],C1[r+3]);} \
      rm=__builtin_fmaxf(a,b); { auto rr=__builtin_amdgcn_permlane32_swap(__float_as_uint(rm),__float_as_uint(rm),false,false); rm=__builtin_fmaxf(__uint_as_float(rr[0]),__uint_as_float(rr[1])); } }while(0)
  u32x4 pw0,pw1,pw2,pw3;
  #define DV_PKW(P,B) cvtpk_s(P[B],P[B+1])
  #define DV_SUM_PACK(C0,C1) do{ float sa_=fadd_s(C0[0],C0[1]),sb_=fadd_s(C1[0],C1[1]); _Pragma("unroll") for(int r=2;r<16;++r){ sa_=fadd_s(sa_,C0[r]); sb_=fadd_s(sb_,C1[r]); } l_reg+=fadd_s(sa_,sb_); \
      pw0=(u32x4){DV_PKW(C0,0),DV_PKW(C0,2),DV_PKW(C0,4),DV_PKW(C0,6)};pw1=(u32x4){DV_PKW(C0,8),DV_PKW(C0,10),DV_PKW(C0,12),DV_PKW(C0,14)}; \
      pw2=(u32x4){DV_PKW(C1,0),DV_PKW(C1,2),DV_PKW(C1,4),DV_PKW(C1,6)};pw3=(u32x4){DV_PKW(C1,8),DV_PKW(C1,10),DV_PKW(C1,12),DV_PKW(C1,14)}; }while(0)
  #define DV_PAF(k) __builtin_bit_cast(bf16x8,pw##k)
  #define DV_VFR(i) (bf16x8){vlo[i][0],vlo[i][1],vlo[i][2],vlo[i][3],vhi[i][0],vhi[i][1],vhi[i][2],vhi[i][3]}
  #define DV_VRD(n) do{ vlo[(n)&3]=vtr(vp_+((2*((n)>>3)+((n)&1))*4096+(((n)&7)>>1)*1024)); vhi[(n)&3]=vtr(vp_+((2*((n)>>3)+((n)&1))*4096+(((n)&7)>>1)*1024+512)); }while(0)
  #define DV_PIN(x) asm volatile("":"+v"(x))
  #define DV_KRD(j) do{ if(gv){ kload2(kf,kp0+sl_next,j); } }while(0)
  #define DV_EX(v) __builtin_amdgcn_exp2f(v)
  #define DV_GAP(n,X,B,RD) do{ o[2*((n)>>3)+((n)&1)]=__builtin_amdgcn_mfma_f32_32x32x16_bf16((((n)&7)>>1)==0?DV_PAF(0):((((n)&7)>>1)==1?DV_PAF(1):((((n)&7)>>1)==2?DV_PAF(2):DV_PAF(3))),DV_VFR((n)&3),o[2*((n)>>3)+((n)&1)],0,0,0); \
      X[B]=DV_EX(X[B]); X[B+1]=DV_EX(X[B+1]); DV_PIN(X); RD; SBAR(); }while(0)
  #define DV_SOFT1(C0,C1,t) do{ { const float d_=__builtin_fmaxf(C0[15],C1[15]); asm volatile(""::"v"(d_)); asm volatile("":"+v"(C0),"+v"(C1)); }     \
      if(mnz){ _Pragma("unroll") for(int r=0;r<16;++r){C0[r]=fsub_s(C0[r],mhat);C1[r]=fsub_s(C1[r],mhat);} } \
      if((t)>=t_tbl) DV_CMASK(C0,C1,t); \
      { float rm; DV_ROWMAX(rm,C0,C1); resc=false; \
        if(__builtin_expect(__any(rm>(float)THRL),0)){ const float dl=__builtin_fmaxf(rm,0.f); mhat+=dl; \
          _Pragma("unroll") for(int r=0;r<16;++r){C0[r]=fsub_s(C0[r],dl);C1[r]=fsub_s(C1[r],dl);} \
          const float f=__builtin_amdgcn_exp2f(-dl); l_reg*=f; if(hi==0)wsf[r32]=f; resc=true; mnz=true; } } }while(0)
  #define DV_RESC() do{ if(resc){ asm volatile("s_waitcnt lgkmcnt(0)":::"memory"); \
      _Pragma("unroll") for(int r=0;r<16;++r){ const float fr_=wsf[crow(r,hi)]; o[0][r]*=fr_;o[1][r]*=fr_;o[2][r]*=fr_;o[3][r]*=fr_; } asm volatile("s_waitcnt lgkmcnt(0)":::"memory"); } }while(0)
  int sl_prev=0,sl_cur=0,sl_next=SLOTB;
  #define DV_ROT() do{sl_prev=sl_cur;sl_cur=sl_next;sl_next=(sl_next==(NSLOT-1)*SLOTB)?0:sl_next+SLOTB;}while(0)
  DVK(2,2*SLOTB);
  WAIT_BAR(3);
  f32x16 pA0,pA1,pB0,pB1; bf16x8 kf[8]; s16x4 vlo[4],vhi[4]; bool resc=false,mnz=false;
  { const f32x16 z=f32x16{}; qkt(pA0,pA1,shm+DV_K,qr,z,r32,hi);
    DV_SOFT1(pA0,pA1,0);
    _Pragma("unroll") for(int r=0;r<16;++r){pA0[r]=DV_EX(pA0[r]);pA1[r]=DV_EX(pA1[r]);} }
  WAIT_BAR(0);
  DVK(3,0);DVV(1,SLOTB);
  DV_ROT();
  kload8(kf,kp0+sl_cur);
  WAIT_BAR(3);
  #define DV_GAPA(MF,A0,A1,A2,A3,W0,W1,PW) do{ MF; sacc+=A0; sacc+=A1; sacc+=A2; sacc+=A3; DV_PIN(sacc); W0; W1; DV_PIN(PW); SBAR(); }while(0)
  #define DV_Z f32x16{}
  #define DV_STEP(C0,C1,P0,P1,t) do{ const bool gk=((t)+3<NT), gv=((t)+1<NT); const lds_cptr vp_=vp0+2*sl_prev; SBAR(); \
    float sacc=(P0[0]+P0[1]); \
    DV_VRD(0); SBAR(); DV_GAPA(C0=__builtin_amdgcn_mfma_f32_32x32x16_bf16(kf[0],qr[0],DV_Z,0,0,0), P0[2],P0[3],P0[4],P0[5],     pw0[0]=DV_PKW(P0,0), pw0[1]=DV_PKW(P0,2), pw0); \
    DV_VRD(1); SBAR(); DV_GAPA(C1=__builtin_amdgcn_mfma_f32_32x32x16_bf16(kf[1],qr[0],DV_Z,0,0,0), P0[6],P0[7],P0[8],P0[9],     pw0[2]=DV_PKW(P0,4), pw0[3]=DV_PKW(P0,6), pw0); \
    DV_VRD(2); SBAR(); DV_GAPA(C0=__builtin_amdgcn_mfma_f32_32x32x16_bf16(kf[2],qr[1],C0,0,0,0),   P0[10],P0[11],P0[12],P0[13], pw1[0]=DV_PKW(P0,8), pw1[1]=DV_PKW(P0,10), pw1); \
    DV_VRD(3); SBAR(); DV_GAPA(C1=__builtin_amdgcn_mfma_f32_32x32x16_bf16(kf[3],qr[1],C1,0,0,0),   P0[14],P0[15],P1[0],P1[1],   pw1[2]=DV_PKW(P0,12),pw1[3]=DV_PKW(P0,14), pw1); \
    DV_GAPA(C0=__builtin_amdgcn_mfma_f32_32x32x16_bf16(kf[4],qr[2],C0,0,0,0),   P1[2],P1[3],P1[4],P1[5],     pw2[0]=DV_PKW(P1,0), pw2[1]=DV_PKW(P1,2), pw2); \
    DV_GAPA(C1=__builtin_amdgcn_mfma_f32_32x32x16_bf16(kf[5],qr[2],C1,0,0,0),   P1[6],P1[7],P1[8],P1[9],     pw2[2]=DV_PKW(P1,4), pw2[3]=DV_PKW(P1,6), pw2); \
    DV_GAPA(C0=__builtin_amdgcn_mfma_f32_32x32x16_bf16(kf[6],qr[3],C0,0,0,0),   P1[10],P1[11],P1[12],P1[13], pw3[0]=DV_PKW(P1,8), pw3[1]=DV_PKW(P1,10), pw3); \
    DV_GAPA(C1=__builtin_amdgcn_mfma_f32_32x32x16_bf16(kf[7],qr[3],C1,0,0,0),   P1[14],P1[15],0.f,0.f,       pw3[2]=DV_PKW(P1,12),pw3[3]=DV_PKW(P1,14), pw3); \
    l_reg+=sacc; \
    if(gk){DVK((t)+3,sl_cur);} if(gv){DVV((t)+1,sl_next);} \
    DV_SOFT1(C0,C1,t); \
    SBAR(); \
    DV_GAP(0,C0,0,  DV_VRD(4));   DV_GAP(1,C0,2,  DV_VRD(5));   DV_GAP(2,C0,4,  DV_VRD(6));   DV_GAP(3,C0,6,  DV_VRD(7)); \
    DV_GAP(4,C0,8,  DV_VRD(8));   DV_GAP(5,C0,10, DV_VRD(9));   DV_GAP(6,C0,12, DV_VRD(10));  DV_GAP(7,C0,14, DV_VRD(11)); \
    DV_GAP(8,C1,0,  DV_VRD(12));  DV_GAP(9,C1,2,  DV_VRD(13));  DV_GAP(10,C1,4, DV_VRD(14));  DV_GAP(11,C1,6, DV_VRD(15)); \
    DV_GAP(12,C1,8, DV_KRD(0));   DV_GAP(13,C1,10,DV_KRD(1));   DV_GAP(14,C1,12,DV_KRD(2));   DV_GAP(15,C1,14,DV_KRD(3)); \
    DV_RESC(); \
    if((t)+1<NT){ if((t)+3<NT){WAIT_BAR(3);} else if((t)+2<NT){WAIT_BAR(2);} else {WAIT_BAR(0);} DV_ROT(); } }while(0)
  { int t=1;
    for(;t+1<NT;t+=2){ DV_STEP(pB0,pB1,pA0,pA1,t); DV_STEP(pA0,pA1,pB0,pB1,t+1); }
    DV_STEP(pB0,pB1,pA0,pA1,t); }
  #undef DV_GAPA
  #undef DV_Z
  #undef DV_STEP
  DV_SUM_PACK(pB0,pB1);
  { const lds_cptr vp_=vp0+2*sl_cur;
    _Pragma("unroll") for(int n0=0;n0<16;n0+=4){
      _Pragma("unroll") for(int q=0;q<4;++q) DV_VRD(n0+q);
      _Pragma("unroll") for(int q=0;q<4;++q){ const int n=n0+q, kg=(n&7)>>1; const bf16x8 pa_=kg==0?DV_PAF(0):(kg==1?DV_PAF(1):(kg==2?DV_PAF(2):DV_PAF(3)));
        o[2*(n>>3)+(n&1)]=__builtin_amdgcn_mfma_f32_32x32x16_bf16(pa_,DV_VFR(n&3),o[2*(n>>3)+(n&1)],0,0,0); } } }
  asm volatile("s_waitcnt lgkmcnt(0)\n\ts_barrier":::"memory");
  {auto rr=__builtin_amdgcn_permlane32_swap(__float_as_uint(l_reg),__float_as_uint(l_reg),false,false);l_reg=__uint_as_float(rr[0])+__uint_as_float(rr[1]);}
  if(hi==0)wsf[32+r32]=l_reg;asm volatile("s_waitcnt lgkmcnt(0)":::"memory");
  float rli[16];
  #pragma unroll
  for(int r=0;r<16;++r)rli[r]=__builtin_amdgcn_rcpf(wsf[32+crow(r,hi)]);
  bf16*Ow=Ob+(long)(q0+wid*QBLK)*opitch;
  { bf16*stg=(bf16*)(shm+DV_OST)+wid*4096;
    #pragma unroll
    for(int r=0;r<16;++r){const int orow=crow(r,hi);
      #pragma unroll
      for(int d0=0;d0<4;++d0)stg[orow*128+d0*32+r32]=__float2bfloat16(o[d0][r]*rli[r]);}
    asm volatile("s_waitcnt lgkmcnt(0)":::"memory");
    #pragma unroll
    for(int i=0;i<8;++i){const int row=i*4+(lane>>4),ch=lane&15; const u32x4 v=*(const u32x4*)(stg+row*128+ch*8); ATTN_STORE16(Ow+(long)row*opitch+ch*8,v);} }
  asm volatile("s_waitcnt lgkmcnt(0)\n\ts_barrier":::"memory");
  #undef DVK
  #undef DVV
  #undef DV_CMASK
  #undef DV_MX3
  #undef DV_ROWMAX
  #undef DV_PKW
  #undef DV_SUM_PACK
  #undef DV_VFR
  #undef DV_VRD
  #undef DV_PIN
  #undef DV_EX
  #undef DV_GAP
  #undef DV_KRD
  #undef DV_SOFT1
  #undef DV_RESC
  #undef DV_PAF
  #undef DV_ROT
}
constexpr int ATTN_LDS_BYTES=LDS_BYTES;
#undef SBAR
#undef WAIT_BAR
}
#define GAS __attribute__((address_space(1)))
#define LAS __attribute__((address_space(3)))
typedef unsigned short bf16;
typedef unsigned v4u __attribute__((ext_vector_type(4)));
typedef float f32x4 __attribute__((ext_vector_type(4)));
typedef short bf16x8 __attribute__((ext_vector_type(8)));
typedef GAS unsigned gu32;
typedef GAS unsigned long long gu64;
#define RLX_AGENT __ATOMIC_RELAXED, __HIP_MEMORY_SCOPE_AGENT
#define LDS_WAIT() asm volatile("s_waitcnt lgkmcnt(0)" ::: "memory")
#define VM_WAIT() asm volatile("s_waitcnt vmcnt(0)" ::: "memory")
__device__ __forceinline__ unsigned long long rt() { return __builtin_amdgcn_s_memrealtime(); }
__device__ __forceinline__ unsigned f2bf(float f) { unsigned u = __builtin_bit_cast(unsigned, f); return (u + 0x7fffu + ((u >> 16) & 1u)) >> 16; }
__device__ __forceinline__ unsigned pk2(float lo, float hi) { return f2bf(lo) | (f2bf(hi) << 16); }

#define XB_TMO      128
#define XB_XCNT(j)  (256  + 64 * (j))
#define XB_XSUB(j)  (1280 + 64 * (j))
#define XB_XGEN(j)  (2304 + 64 * (j))
#define XB_TOP      3328
#define XB_TOPGEN   3392
#define XB_LSUB(j)  (3456 + 64 * (j))
#define XB_LGEN(j)  (4480 + 64 * (j))
#define XCD_BAR_WORDS 5504
#define XB_SPIN_CAP (1u << 25)

__device__ __forceinline__ unsigned xb_ld(unsigned* p)              { return __hip_atomic_load(p, __ATOMIC_RELAXED, __HIP_MEMORY_SCOPE_AGENT); }
__device__ __forceinline__ unsigned xb_add(unsigned* p, unsigned v) { return __hip_atomic_fetch_add(p, v, __ATOMIC_RELAXED, __HIP_MEMORY_SCOPE_AGENT); }
__device__ __forceinline__ unsigned xb_xcc_id() { return (unsigned)__builtin_amdgcn_s_getreg((3 << 11) | 20) & 0xFu; }
#define XB_SPIN(cond, bar) do { unsigned _sp = 0; while (cond) { __builtin_amdgcn_s_sleep(1); \
    if ((++_sp & 255u) == 0u) { if (xb_ld(&(bar)[XB_TMO])) break; if (_sp > XB_SPIN_CAP) { atomicAdd(&(bar)[XB_TMO], 1u); break; } } } } while (0)

struct XcdBarrier {
    unsigned* bar; unsigned x;
    volatile LAS unsigned* st;
};

__device__ __forceinline__ XcdBarrier xcd_barrier_post(unsigned* bar, volatile LAS unsigned* st) {
    XcdBarrier b; b.bar = bar; b.x = xb_xcc_id(); b.st = st;
    if (threadIdx.x == 0) st[2] = xb_add(&bar[XB_XCNT(b.x)], 1u);
    return b;
}
__device__ __forceinline__ void xcd_barrier_complete(unsigned* bar, unsigned x, unsigned& nloc, unsigned& nx) {
    const unsigned G = gridDim.x * gridDim.y * gridDim.z;
    unsigned sum, cnt, mine, sp = 0u;
    for (;;) {
        sum = 0u; cnt = 0u; mine = 0u;
#pragma nounroll
        for (unsigned j = 0; j < 16; ++j) { const unsigned c = xb_ld(&bar[XB_XCNT(j)]); sum += c; cnt += (c > 0u) ? 1u : 0u; mine = (j == x) ? c : mine; }
        if (sum == G) break;
        __builtin_amdgcn_s_sleep(1);
        if ((++sp & 255u) == 0u) { if (xb_ld(&bar[XB_TMO])) break; if (sp > XB_SPIN_CAP) { atomicAdd(&bar[XB_TMO], 1u); break; } }
    }
    nloc = mine > 0u ? mine : 1u; nx = cnt > 0u ? cnt : 1u;
}

__device__ __forceinline__ void xcd_barrier(const XcdBarrier& b) {
    asm volatile("s_waitcnt vmcnt(0)" ::: "memory");
    __syncthreads();
    if (threadIdx.x == 0) {
        unsigned* bar; { GAS unsigned* bl_ = (GAS unsigned*)b.bar; asm volatile("" : "+s"(bl_)); bar = (unsigned*)bl_; } unsigned bx_ = b.x; asm volatile("" : "+s"(bx_));
        __builtin_amdgcn_s_waitcnt(0);
        unsigned nloc = b.st[0], nx = b.st[1];
        if (nloc == 0u) { xcd_barrier_complete(bar, bx_, nloc, nx); b.st[0] = nloc; b.st[1] = nx; }
        const unsigned old = xb_add(&bar[XB_XSUB(bx_)], 1u);
        const unsigned gen = old / nloc;
        if (old + 1u == (gen + 1u) * nloc) {
            __builtin_amdgcn_fence(__ATOMIC_RELEASE, "agent");
            asm volatile("s_waitcnt vmcnt(0)" ::: "memory");
            const unsigned og = xb_add(&bar[XB_TOP], 1u);
            const unsigned tg = og / nx;
            if (og + 1u == (tg + 1u) * nx) xb_add(&bar[XB_TOPGEN], 1u);
            else XB_SPIN(xb_ld(&bar[XB_TOPGEN]) == tg, bar);
            __builtin_amdgcn_fence(__ATOMIC_ACQUIRE, "agent");
            xb_add(&bar[XB_XGEN(bx_)], 1u);
            asm volatile("s_waitcnt vmcnt(0)" ::: "memory");
        } else {
            XB_SPIN(xb_ld(&bar[XB_XGEN(bx_)]) == gen, bar);
            __builtin_amdgcn_fence(__ATOMIC_ACQUIRE, "agent");
            asm volatile("s_waitcnt vmcnt(0)" ::: "memory");
        }
    }
    __syncthreads();
}

__device__ __forceinline__ void xcd_census_regular(const XcdBarrier& b) {
    if (threadIdx.x == 0) { bool reg = (gridDim.x == 256u);
#pragma nounroll
        for (unsigned j = 0; j < 16; ++j) { const unsigned c = xb_ld(&b.bar[XB_XCNT(j)]); if (c != (j < 8u ? 32u : 0u)) reg = false; }
        b.st[3] = reg ? 1u : 0u; }
    __syncthreads();
}
__device__ __forceinline__ void xcd_local_barrier(const XcdBarrier& b) {
    asm volatile("s_waitcnt vmcnt(0)" ::: "memory");
    __syncthreads();
    if (threadIdx.x == 0) {
        unsigned* bar; { GAS unsigned* bl_ = (GAS unsigned*)b.bar; asm volatile("" : "+s"(bl_)); bar = (unsigned*)bl_; } unsigned bx_ = b.x; asm volatile("" : "+s"(bx_));
        __builtin_amdgcn_s_waitcnt(0);
        const unsigned nloc = b.st[0];
        const unsigned old = xb_add(&bar[XB_LSUB(bx_)], 1u);
        const unsigned gen = old / nloc;
        if (old + 1u == (gen + 1u) * nloc) xb_add(&bar[XB_LGEN(bx_)], 1u);
        else XB_SPIN(xb_ld(&bar[XB_LGEN(bx_)]) == gen, bar);
        __builtin_amdgcn_fence(__ATOMIC_ACQUIRE, "agent");
        asm volatile("s_waitcnt vmcnt(0)" ::: "memory");
    }
    __syncthreads();
}
constexpr int NB = 4, SEQ = 4096, DM = 1024, M = NB * SEQ, NL = 4;
constexpr int NIN = 3328;
constexpr int NWAVES = 8;
#ifndef PG8_SP2
#define PG8_SP2 true
#endif
constexpr float LOG2E = 1.4426950408889634f;
constexpr float C2 = 0.125f * LOG2E;
constexpr int MOE_ROWS = 40960;
constexpr size_t MiB = 1u << 20;
constexpr size_t WS_CTL = 0, CTL_ZERO_BYTES = 1 * MiB;
constexpr size_t WS_MOD = 1 * MiB;
constexpr size_t WS_TB = WS_MOD + 512 * 1024;
constexpr size_t WS_LAM = WS_TB + 64 * 1024;
constexpr size_t WS_KMEAN = WS_LAM + 4096;
constexpr size_t WS_WIN = 2 * MiB;
constexpr size_t WS_WOUT = 28 * MiB;
constexpr size_t WS_W13 = 36 * MiB;
constexpr size_t WS_W2 = 292 * MiB;
constexpr size_t WS_HB = 420 * MiB;
constexpr size_t WS_XS = 452 * MiB, WS_HS = 532 * MiB, WS_YS = 572 * MiB;
constexpr size_t WS_SMALL = 652 * MiB;
constexpr size_t WS_QD = 656 * MiB, WS_KD = 672 * MiB, WS_VD = 688 * MiB, WS_QM = 704 * MiB, WS_KM = 712 * MiB, WS_VM = 720 * MiB;
constexpr size_t WS_PR = 728 * MiB;
constexpr size_t WS_MIX = 784 * MiB;
constexpr size_t WS_OD = 816 * MiB;
constexpr size_t WS_RW = 848 * MiB;
constexpr size_t WS_END = 960 * MiB;
constexpr int CW_BAR = 4096;
constexpr int CW_CNT = 16384;
constexpr int CW_CUR = 16384 + 1024;
constexpr int RING_BYTES = 131072, LDSCTL_OFF = RING_BYTES, MISC_OFF = LDSCTL_OFF + 320, TAB_OFF = LDSCTL_OFF + 1024;
constexpr int LDS_BYTES = 147456;
static_assert(WS_QD == pg8::EPI_WS_QD && WS_KD == pg8::EPI_WS_KD && WS_VD == pg8::EPI_WS_VD && WS_QM == pg8::EPI_WS_QM && WS_KM == pg8::EPI_WS_KM && WS_VM == pg8::EPI_WS_VM && WS_PR == pg8::EPI_WS_PR, "epilogue workspace map");
__device__ __forceinline__ float rl63(float v) { return __uint_as_float(__builtin_amdgcn_readlane(__float_as_uint(v), 63)); }
template <int CTRL, int ROWMASK> __device__ __forceinline__ float dpp_f(float oldv, float v) { return __int_as_float(__builtin_amdgcn_update_dpp(__float_as_int(oldv), __float_as_int(v), CTRL, ROWMASK, 0xf, false)); }
__device__ __forceinline__ float wave_sum(float v) {
    v += dpp_f<0xB1, 0xf>(0.f, v);
    v += dpp_f<0x4E, 0xf>(0.f, v);
    v += dpp_f<0x141, 0xf>(0.f, v);
    v += dpp_f<0x140, 0xf>(0.f, v);
    v += dpp_f<0x142, 0xa>(0.f, v);
    v += dpp_f<0x143, 0xc>(0.f, v);
    return rl63(v);
}
__device__ __forceinline__ float wave_max(float v) {
    v = fmaxf(v, dpp_f<0xB1, 0xf>(v, v)); v = fmaxf(v, dpp_f<0x4E, 0xf>(v, v)); v = fmaxf(v, dpp_f<0x141, 0xf>(v, v)); v = fmaxf(v, dpp_f<0x140, 0xf>(v, v));
    v = fmaxf(v, dpp_f<0x142, 0xa>(v, v)); v = fmaxf(v, dpp_f<0x143, 0xc>(v, v));
    return rl63(v);
}
__device__ __forceinline__ float bf_lo(unsigned u) { return __uint_as_float(u << 16); }
__device__ __forceinline__ float bf_hi(unsigned u) { return __uint_as_float(u & 0xffff0000u); }
__device__ __forceinline__ float bf2f(bf16 h) { return __uint_as_float((unsigned)h << 16); }
__device__ __forceinline__ float rl(float v, int i) { return __uint_as_float(__builtin_amdgcn_readlane(__float_as_uint(v), i)); }
__device__ __forceinline__ float sigmoidf_(float x) { return 1.0f / (1.0f + __expf(-x)); }

struct Frame {
    LAS unsigned char* lds; volatile LAS unsigned* MISC; gu32* ctl;
    int tid, lane, wave, vcu, G, gw, NGW;
    int xl, cf;
    float* out; unsigned char* ws;
};
__device__ __forceinline__ unsigned char* launder_ptr(unsigned char* p) {
    GAS unsigned char* g = (GAS unsigned char*)p; asm volatile("" : "+s"(g)); return (unsigned char*)g; }
#define GIN(i) ((const float*)(const GAS float*)A.in[i])
#define WSP(T, off) ((T*)(launder_ptr(F.ws) + (off)))

template <class RowMap>
__device__ __forceinline__ void tr_item(const float* W, int N, int K, bf16* WT, LAS float* scr, int k0, int n0, int lane, RowMap rm) {
#pragma unroll
    for (int i = 0; i < 8; ++i) { const int kk = 8 * i + (lane >> 3), c4 = lane & 7; const f32x4 x = *(const GAS f32x4*)(W + (size_t)(k0 + kk) * N + n0 + 4 * c4);
        LAS float* d = scr + kk * 33 + 4 * c4; d[0] = x.x; d[1] = x.y; d[2] = x.z; d[3] = x.w; }
    LDS_WAIT(); asm volatile("" ::: "memory");
    const int c = lane & 7;
#pragma unroll
    for (int j = 0; j < 4; ++j) { const int n = (lane >> 3) + 8 * j; const LAS float* s = scr + (8 * c) * 33 + n;
        v4u o; o.x = pk2(s[0 * 33], s[1 * 33]); o.y = pk2(s[2 * 33], s[3 * 33]); o.z = pk2(s[4 * 33], s[5 * 33]); o.w = pk2(s[6 * 33], s[7 * 33]);
        *(GAS v4u*)(WT + (size_t)rm(n0 + n) * K + k0 + 8 * c) = o; }
    LDS_WAIT(); asm volatile("" ::: "memory");
}
__device__ __forceinline__ int inproj_row(int n) {
    const int L = n < 896 ? 2304 + n : n - 896;
    const int l = L & 255;
    return (L & ~255) | (((l >> 5) & 1) << 7) | ((l >> 6) << 5) | (l & 31);
}
__device__ __forceinline__ int t5_bucket(int n) {
    if (n < 16) return n;
    const float x = (8.0f * __log2f((float)n) - 32.0f) * (1.0f / 3.0f) + 1e-4f;
    int b = 16 + (int)x; return b > 31 ? 31 : b;
}
struct TrDesc { const float* src; bf16* dst; int N, K, n0, kind; };
__device__ __forceinline__ TrDesc moe_tr_desc(KArgs& A, unsigned char* ws, int l, int r) {
    constexpr int I_W1 = 16 * 16, I_W2 = 8 * 32, N_W1 = 32 * I_W1;
    TrDesc d;
    if (r < 2 * N_W1) { const int which = r / N_W1; r %= N_W1; const int le = l * 32 + r / I_W1, q = r % I_W1, kb = q / 16, nb = q % 16;
        d.N = 512; d.K = 1024; d.n0 = 32 * nb; d.kind = which;
        d.src = (const float*)(const GAS float*)A.in[which ? 31 : 30] + (size_t)le * 1024 * 512 + (size_t)(64 * kb) * 512 + 32 * nb; d.dst = (bf16*)(ws + WS_W13) + (size_t)le * 1024 * 1024 + 64 * kb; }
    else { r -= 2 * N_W1; const int le = l * 32 + r / I_W2, q = r % I_W2, kb = q / 32, nb = q % 32;
        d.N = 1024; d.K = 512; d.n0 = 32 * nb; d.kind = 2;
        d.src = (const float*)(const GAS float*)A.in[32] + (size_t)le * 512 * 1024 + (size_t)(64 * kb) * 1024 + 32 * nb; d.dst = (bf16*)(ws + WS_W2) + (size_t)le * 1024 * 512 + 64 * kb; }
    return d;
}
__device__ __forceinline__ void moe_tr_load(const TrDesc& d, int lane, f32x4 (&x)[8]) {
#pragma unroll
    for (int i = 0; i < 8; ++i) x[i] = __builtin_nontemporal_load((const GAS f32x4*)(d.src + (size_t)(8 * i + (lane >> 3)) * d.N + 4 * (lane & 7)));
}
__device__ __forceinline__ void moe_tr_store(const TrDesc& d, int lane, const f32x4 (&x)[8], LAS float* scr) {
#pragma unroll
    for (int i = 0; i < 8; ++i) { const int kk = 8 * i + (lane >> 3), c4 = lane & 7; LAS float* p = scr + kk * 33 + 4 * c4; p[0] = x[i].x; p[1] = x[i].y; p[2] = x[i].z; p[3] = x[i].w; }
    LDS_WAIT(); asm volatile("" ::: "memory");
    const int c = lane & 7;
#pragma unroll
    for (int j = 0; j < 4; ++j) { const int n = (lane >> 3) + 8 * j; const LAS float* s = scr + (8 * c) * 33 + n;
        v4u o; o.x = pk2(s[0 * 33], s[1 * 33]); o.y = pk2(s[2 * 33], s[3 * 33]); o.z = pk2(s[4 * 33], s[5 * 33]); o.w = pk2(s[6 * 33], s[7 * 33]);
        const int nn = d.n0 + n, row = d.kind == 2 ? nn : 8 * (nn >> 2) + 4 * d.kind + (nn & 3);
        __builtin_nontemporal_store(o, (GAS v4u*)(d.dst + (size_t)row * d.K + 8 * c)); }
    LDS_WAIT(); asm volatile("" ::: "memory");
}
__device__ __forceinline__ void moe_convert_ticket(Frame& F, KArgs& A, int l, int ct) {
    int lane_ = F.lane, wv_ = F.wave; asm volatile("" : "+v"(lane_), "+s"(wv_));
    LAS float* scr = (LAS float*)(F.lds + wv_ * 8448);
    const int r0 = ct * 64 + wv_ * 8;
    f32x4 x0[8], x1[8], x2[8], x3[8];
    TrDesc d0 = moe_tr_desc(A, F.ws, l, r0), d1 = moe_tr_desc(A, F.ws, l, r0 + 1), d2 = moe_tr_desc(A, F.ws, l, r0 + 2), d3 = moe_tr_desc(A, F.ws, l, r0 + 3);
    moe_tr_load(d0, lane_, x0); moe_tr_load(d1, lane_, x1); moe_tr_load(d2, lane_, x2); moe_tr_load(d3, lane_, x3);
    moe_tr_store(d0, lane_, x0, scr); d0 = moe_tr_desc(A, F.ws, l, r0 + 4); moe_tr_load(d0, lane_, x0);
    moe_tr_store(d1, lane_, x1, scr); d1 = moe_tr_desc(A, F.ws, l, r0 + 5); moe_tr_load(d1, lane_, x1);
    moe_tr_store(d2, lane_, x2, scr); d2 = moe_tr_desc(A, F.ws, l, r0 + 6); moe_tr_load(d2, lane_, x2);
    moe_tr_store(d3, lane_, x3, scr); d3 = moe_tr_desc(A, F.ws, l, r0 + 7); moe_tr_load(d3, lane_, x3);
    moe_tr_store(d0, lane_, x0, scr); moe_tr_store(d1, lane_, x1, scr); moe_tr_store(d2, lane_, x2, scr); moe_tr_store(d3, lane_, x3, scr);
}
__device__ __forceinline__ void p0_prologue(Frame& F, KArgs& A) {
    LAS float* scr = (LAS float*)(F.lds + F.wave * 16384);
    {
        constexpr int I_IN = 16 * 100, I_OUT = 16 * 32, I_W1 = 16 * 16, I_W2 = 8 * 32;
        constexpr int N_IN = NL * I_IN, N_OUT = NL * I_OUT, N_W1 = NL * 32 * I_W1, N_W2 = NL * 32 * I_W2;
        constexpr int NITEMS = N_IN + N_OUT + 2 * N_W1 + N_W2;
        for (int it = F.gw; it < N_IN + N_OUT; it += F.NGW) {
            int r = it;
            if (r < N_IN) { const int l = r / I_IN, q = r % I_IN, kb = q / 100, nb = q % 100;
                tr_item(GIN(6) + (size_t)l * 1024 * 3200, 3200, 1024, WSP(bf16, WS_WIN) + (size_t)l * NIN * 1024, scr, 64 * kb, 32 * nb, F.lane, [](int n) { return inproj_row(n); }); continue; }
            r -= N_IN;
            if (r < N_OUT) { const int l = r / I_OUT, q = r % I_OUT, kb = q / 32, nb = q % 32;
                tr_item(GIN(7) + (size_t)l * 1024 * 1024, 1024, 1024, WSP(bf16, WS_WOUT) + (size_t)l * 1024 * 1024, scr, 64 * kb, 32 * nb, F.lane, [](int n) { return n; }); continue; }
            r -= N_OUT;
            if (r < 2 * N_W1) { const int which = r / N_W1; r %= N_W1; const int le = r / I_W1, q = r % I_W1, kb = q / 16, nb = q % 16;
                const float* W = A.in[which ? 31 : 30] + (size_t)le * 1024 * 512; bf16* WT = WSP(bf16, WS_W13) + (size_t)le * 1024 * 1024;
                if (which == 0) tr_item(W, 512, 1024, WT, scr, 64 * kb, 32 * nb, F.lane, [](int n) { return 8 * (n >> 2) + (n & 3); });
                else            tr_item(W, 512, 1024, WT, scr, 64 * kb, 32 * nb, F.lane, [](int n) { return 8 * (n >> 2) + 4 + (n & 3); });
                continue; }
            r -= 2 * N_W1;
            { const int le = r / I_W2, q = r % I_W2, kb = q / 32, nb = q % 32;
                tr_item(GIN(32) + (size_t)le * 512 * 1024, 1024, 512, WSP(bf16, WS_W2) + (size_t)le * 1024 * 512, scr, 64 * kb, 32 * nb, F.lane, [](int n) { return n; }); }
        }
    }
    __syncthreads();
    {
        LAS float* cs = (LAS float*)F.lds;
        for (int i = F.tid; i < 4096; i += 512) { const float v = GIN(1)[i]; cs[i] = v / (1.0f + __expf(-v)); }
        __syncthreads();
        const int kp = F.tid >> 5, jj = F.tid & 31;
        LAS float* red = cs + 4096;
        for (int it = F.vcu; it < NL * 192; it += F.G) {
            const int l = it / 192, j = (it % 192) * 32 + jj;
            const float* w = GIN(2) + (size_t)l * 1024 * 6144 + j;
            float a0 = 0.f, a1 = 0.f, a2 = 0.f, a3 = 0.f;
#pragma unroll 16
            for (int k = kp * 64; k < kp * 64 + 64; ++k) { const float wv = w[(size_t)k * 6144]; a0 += cs[k] * wv; a1 += cs[1024 + k] * wv; a2 += cs[2048 + k] * wv; a3 += cs[3072 + k] * wv; }
            red[(kp * 4 + 0) * 32 + jj] = a0; red[(kp * 4 + 1) * 32 + jj] = a1; red[(kp * 4 + 2) * 32 + jj] = a2; red[(kp * 4 + 3) * 32 + jj] = a3;
            __syncthreads();
            if (F.tid < 128) { const int b = F.tid >> 5; float s = GIN(3)[l * 6144 + j];
#pragma unroll
                for (int q = 0; q < 16; ++q) s += red[(q * 4 + b) * 32 + jj];
                WSP(float, WS_MOD)[((size_t)l * NB + b) * 6144 + j] = s; }
            __syncthreads();
        }
    }
    for (int i = F.gw * 64 + F.lane; i < 8 * 1024; i += F.NGW * 64) { const int hh = i >> 10, d = i & 1023; WSP(float, WS_TB)[i] = GIN(25)[t5_bucket(d) * 8 + hh] * LOG2E; }
    for (int i = F.gw * 64 + F.lane; i < NL * 1024 * 48; i += F.NGW * 64) { const int c = i % 48, lk = i / 48; float v = 0.f; if (c < 4) v = GIN(26)[(size_t)lk * 4 + c]; else if (c >= 16) v = GIN(28)[(size_t)lk * 32 + (c - 16)]; WSP(float, WS_SMALL + 2 * MiB)[i] = v; }
    for (int i = F.gw * 64 + F.lane; i < NL * 4 * 9728; i += F.NGW * 64) { const int lh = i / 9728, x = i % 9728, l = lh >> 2, h = lh & 3; float v = 0.f;
        if (x < 5120) { const int mtx = x / 2560, y = x % 2560, ch = y / 40, j = y % 40; if (j < 32) v = GIN(mtx ? 12 : 10)[((size_t)l * 32 + j) * 256 + h * 64 + ch]; }
        else { const int y = x - 5120, ch = y / 72, j = y % 72; if (j < 64) v = GIN(13)[((size_t)l * 64 + j) * 256 + h * 64 + ch]; }
        WSP(bf16, WS_SMALL + 3 * MiB)[i] = (bf16)f2bf(v); }
    if (F.vcu == 0 && F.tid < NL) { const int l = F.tid; const float* lm = GIN(21) + l * 256; float s01 = 0.f, s23 = 0.f;
        for (int i = 0; i < 64; ++i) { s01 += lm[i] * lm[64 + i]; s23 += lm[128 + i] * lm[192 + i]; }
        WSP(float, WS_LAM)[l] = __expf(s01) - __expf(s23) + (0.8f - 0.6f * __expf(-0.3f * (float)l)); }
}

__device__ __forceinline__ void phase_norm1(Frame& F, KArgs& A, int l) {
    const float* xin = (l == 0) ? GIN(0) : F.out;
    const bf16* YS = WSP(bf16, WS_YS); const int* POS = WSP(int, WS_SMALL) + 4 * M;
    const int nrow_ = F.xl ? 8 : (M + F.NGW - 1) / F.NGW;
    for (int k_ = 0; k_ < nrow_; ++k_) { const int m = F.xl ? F.vcu * 64 + F.wave * 8 + k_ : F.gw + k_ * F.NGW; if (m >= M) break;
        const int b = m / SEQ;
        f32x4 v[4];
#pragma unroll
        for (int j = 0; j < 4; ++j) v[j] = __builtin_nontemporal_load((const GAS f32x4*)(xin + (size_t)m * DM) + F.lane + 64 * j);
        if (l > 0) {
            const int p0 = POS[2 * m], p1 = POS[2 * m + 1];
            const float* g2 = WSP(float, WS_MOD) + ((size_t)(l - 1) * NB + b) * 6144 + 5 * 1024;
#pragma unroll
            for (int j = 0; j < 4; ++j) { const int c = 4 * (F.lane + 64 * j);
                const uint2 ya = *(const uint2*)(YS + (size_t)p0 * DM + c), yb = *(const uint2*)(YS + (size_t)p1 * DM + c);
                const f32x4 gg = *(const f32x4*)(g2 + c);
                v[j].x += gg.x * (bf_lo(ya.x) + bf_lo(yb.x)); v[j].y += gg.y * (bf_hi(ya.x) + bf_hi(yb.x));
                v[j].z += gg.z * (bf_lo(ya.y) + bf_lo(yb.y)); v[j].w += gg.w * (bf_hi(ya.y) + bf_hi(yb.y)); }
        }
        if (l == 0 || l > 0) {
#pragma unroll
            for (int j = 0; j < 4; ++j) __builtin_nontemporal_store(v[j], (GAS f32x4*)(F.out + (size_t)m * DM) + F.lane + 64 * j);
        }
        if (l == NL) continue;
        float ss = 0.f;
#pragma unroll
        for (int j = 0; j < 4; ++j) ss += (v[j].x * v[j].x + v[j].y * v[j].y) + (v[j].z * v[j].z + v[j].w * v[j].w);
        const float rstd = 1.0f / sqrtf(wave_sum(ss) * (1.0f / DM) + 1e-6f);
        const float* mod = WSP(float, WS_MOD) + ((size_t)l * NB + b) * 6144;
        const float* ng = GIN(4) + l * DM;
        bf16* hrow = WSP(bf16, WS_HB) + (size_t)m * DM;
#pragma unroll
        for (int j = 0; j < 4; ++j) { const int c = 4 * (F.lane + 64 * j);
            const f32x4 g = *(const f32x4*)(ng + c), sh = *(const f32x4*)(mod + c), sc = *(const f32x4*)(mod + 1024 + c);
            const float h0 = v[j].x * rstd * g.x * (1.f + sc.x) + sh.x, h1 = v[j].y * rstd * g.y * (1.f + sc.y) + sh.y;
            const float h2 = v[j].z * rstd * g.z * (1.f + sc.z) + sh.z, h3 = v[j].w * rstd * g.w * (1.f + sc.w) + sh.w;
            uint2 o; o.x = pk2(h0, h1); o.y = pk2(h2, h3); *(uint2*)(hrow + c) = o; }
    }
}
constexpr size_t WS_WEG = WS_SMALL + 2 * MiB;
__device__ __forceinline__ void moe_tables(Frame& F, KArgs& A, int l) {
    LAS int* base = (LAS int*)(F.lds + TAB_OFF); LAS int* t2e = base + 64;
    const unsigned* cnt = (const unsigned*)(F.ctl + CW_CNT + l * 64);
    if (F.tid == 0) { int acc = 0; for (int e = 0; e < 32; ++e) { base[e] = acc; const int c = (int)__hip_atomic_load(cnt + e, __ATOMIC_RELAXED, __HIP_MEMORY_SCOPE_AGENT); acc += (c + 255) / 256 * 256; } base[32] = acc; }
    __syncthreads();
    if (F.tid < 160) { const int r0 = F.tid * 256; int e = 31; for (int x = 0; x < 32; ++x) if (r0 >= base[x] && r0 < base[x + 1]) e = x; t2e[F.tid] = e; }
    __syncthreads();
}
__device__ __forceinline__ void phase_router(Frame& F, KArgs& A, int l, const XcdBarrier& bar) {
    typedef float f32x4_ __attribute__((ext_vector_type(4)));
    const float* bg = GIN(27) + l * 4; const float* be = GIN(29) + l * 32;
    const float* Wc = WSP(float, WS_WEG) + (size_t)l * 1024 * 48;
    int* SLT = WSP(int, WS_SMALL) + 4 * M; float* GS = WSP(float, WS_SMALL) + 6 * M;
    unsigned* cnt = (unsigned*)(F.ctl + CW_CNT + l * 64);
    constexpr int HP = 1028;
    LAS float* H = (LAS float*)F.lds; LAS float* part = (LAS float*)(F.lds + 65792); LAS float* LG = (LAS float*)(F.lds + 90368);
    LAS int* el_ = (LAS int*)(F.lds + 93440); LAS float* gl_ = (LAS float*)(F.lds + 93440 + 512); LAS int* off_ = (LAS int*)(F.lds + 93440 + 1024); LAS int* slot_ = (LAS int*)(F.lds + 93440 + 1536);
    const float* ng = GIN(5) + l * DM;
    const int t = F.lane & 15, kq = F.lane >> 4;
    float breg[3][32];
#pragma unroll
    for (int kk = 0; kk < 32; ++kk)
#pragma unroll
        for (int ct = 0; ct < 3; ++ct) breg[ct][kk] = Wc[(size_t)(128 * F.wave + 4 * kk + kq) * 48 + 16 * ct + t];
    const int vb = F.vcu; const bool hasvb = vb < M / 64;
    typedef unsigned v2u_ __attribute__((ext_vector_type(2)));
    v2u_ hk[8][4];
#pragma unroll
    for (int r = 0; r < 8; ++r)
#pragma unroll
        for (int j = 0; j < 4; ++j) { hk[r][j].x = 0u; hk[r][j].y = 0u; }
    if (hasvb) {
        for (int grp = 0; grp < 4; ++grp) {
            f32x4 v[2][4];
#pragma unroll
            for (int u = 0; u < 2; ++u) { const int m = vb * 64 + grp * 16 + 2 * F.wave + u;
#pragma unroll
                for (int j = 0; j < 4; ++j) v[u][j] = __builtin_nontemporal_load((const GAS f32x4*)(F.out + (size_t)m * DM) + F.lane + 64 * j); }
#pragma unroll
            for (int u = 0; u < 2; ++u) {
                const int tg = 2 * F.wave + u, m = vb * 64 + grp * 16 + tg, b = m / SEQ;
                float ss = 0.f;
#pragma unroll
                for (int j = 0; j < 4; ++j) ss += (v[u][j].x * v[u][j].x + v[u][j].y * v[u][j].y) + (v[u][j].z * v[u][j].z + v[u][j].w * v[u][j].w);
                const float rstd = 1.0f / sqrtf(wave_sum(ss) * (1.0f / DM) + 1e-6f);
                const float* mod = WSP(float, WS_MOD) + ((size_t)l * NB + b) * 6144;
#pragma unroll
                for (int j = 0; j < 4; ++j) { const int c = 4 * (F.lane + 64 * j);
                    const f32x4 g = *(const GAS f32x4*)(ng + c), sh = *(const GAS f32x4*)(mod + 3072 + c), sc = *(const GAS f32x4*)(mod + 4096 + c);
                    f32x4 h; h.x = v[u][j].x * rstd * g.x * (1.f + sc.x) + sh.x; h.y = v[u][j].y * rstd * g.y * (1.f + sc.y) + sh.y; h.z = v[u][j].z * rstd * g.z * (1.f + sc.z) + sh.z; h.w = v[u][j].w * rstd * g.w * (1.f + sc.w) + sh.w;
                    v2u_ o; o.x = pk2(h.x, h.y); o.y = pk2(h.z, h.w);
#pragma unroll
                    for (int g = 0; g < 4; ++g) if (grp == g) hk[2 * g + u][j] = o;
                    *(LAS f32x4*)(H + tg * HP + c) = h; }
            }
            LDS_WAIT(); __syncthreads();
            {
                f32x4_ acc0 = {0.f, 0.f, 0.f, 0.f}, acc1 = acc0, acc2 = acc0;
                const LAS float* hp = H + t * HP + 128 * F.wave + kq;
#pragma unroll
                for (int kk = 0; kk < 32; ++kk) { const float a = hp[4 * kk];
                    acc0 = __builtin_amdgcn_mfma_f32_16x16x4f32(a, breg[0][kk], acc0, 0, 0, 0); acc1 = __builtin_amdgcn_mfma_f32_16x16x4f32(a, breg[1][kk], acc1, 0, 0, 0); acc2 = __builtin_amdgcn_mfma_f32_16x16x4f32(a, breg[2][kk], acc2, 0, 0, 0); }
#pragma unroll
                for (int r = 0; r < 4; ++r) { LAS float* pp = part + (F.wave * 16 + 4 * kq + r) * 48 + t; pp[0] = acc0[r]; pp[16] = acc1[r]; pp[32] = acc2[r]; }
            }
            LDS_WAIT(); __syncthreads();
            for (int i = F.tid; i < 16 * 48; i += NWAVES * 64) { float sum = 0.f;
#pragma unroll
                for (int q = 0; q < 8; ++q) sum += part[q * 768 + i];
                LG[i] = sum; }
            LDS_WAIT(); __syncthreads();
            if (F.tid < 16) { const LAS float* lg = LG + F.tid * 48;
                float gl[4];
#pragma unroll
                for (int g = 0; g < 4; ++g) gl[g] = lg[g] + bg[g];
                int gs = 0; float gm = gl[0];
#pragma unroll
                for (int g = 1; g < 4; ++g) if (gl[g] > gm) { gm = gl[g]; gs = g; }
                float den = 0.f;
#pragma unroll
                for (int g = 0; g < 4; ++g) den += __expf(gl[g] - gm);
                const float pg = 1.0f / den;
                float el[8];
#pragma unroll
                for (int e = 0; e < 8; ++e) el[e] = lg[16 + gs * 8 + e] + be[gs * 8 + e];
                int e1 = 0; float m1 = el[0];
#pragma unroll
                for (int e = 1; e < 8; ++e) if (el[e] > m1) { m1 = el[e]; e1 = e; }
                int e2 = -1; float m2 = -INFINITY;
#pragma unroll
                for (int e = 0; e < 8; ++e) if (e != e1 && el[e] > m2) { m2 = el[e]; e2 = e; }
                const float ex = __expf(m2 - m1); const int tl = grp * 16 + F.tid;
                el_[2 * tl] = gs * 8 + e1; el_[2 * tl + 1] = gs * 8 + e2; gl_[2 * tl] = pg / (1.f + ex); gl_[2 * tl + 1] = pg * ex / (1.f + ex); }
            LDS_WAIT(); __syncthreads();
        }
        int rank = 0, mye = 0;
        if (F.tid < 128) { mye = el_[F.tid]; for (int a = 0; a < F.tid; ++a) rank += (el_[a] == mye) ? 1 : 0; }
        else if (F.tid < 160) { const int e = F.tid - 128; int c = 0; for (int a = 0; a < 128; ++a) c += (el_[a] == e) ? 1 : 0; off_[e] = c ? (int)atomicAdd(cnt + e, (unsigned)c) : 0; }
        LDS_WAIT(); __syncthreads();
        if (F.tid < 128) slot_[F.tid] = off_[mye] + rank;
        LDS_WAIT(); __syncthreads();
    }
    xcd_barrier(bar);
    moe_tables(F, A, l);
    {
        const LAS int* base = (const LAS int*)(F.lds + TAB_OFF);
        bf16* XS = WSP(bf16, WS_XS);
        if (hasvb) {
#pragma unroll
            for (int r = 0; r < 8; ++r) { const int tl = (r >> 1) * 16 + 2 * F.wave + (r & 1), m = vb * 64 + tl;
#pragma unroll
                for (int k = 0; k < 2; ++k) { const int pos = base[el_[2 * tl + k]] + slot_[2 * tl + k];
#pragma unroll
                    for (int j = 0; j < 4; ++j) __builtin_nontemporal_store(hk[r][j], (GAS v2u_*)(XS + (size_t)pos * DM + 4 * (F.lane + 64 * j)));
                    if (F.lane == 0) { SLT[2 * m + k] = pos; GS[pos] = gl_[2 * tl + k]; } } }
        }
        for (int it = F.gw; it < 32 * 256; it += F.NGW) { const int e = it >> 8, i = it & 255; const int c = (int)cnt[e]; const int npad = (c + 255) / 256 * 256 - c;
            if (i < npad) { const int pos = base[e] + c + i; const v4u z = {0u, 0u, 0u, 0u};
#pragma unroll
                for (int j = 0; j < 2; ++j) *((GAS v4u*)(XS + (size_t)pos * DM) + F.lane + 64 * j) = z;
                if (F.lane == 0) GS[pos] = 0.f; } }
    }
}
namespace rw {
typedef short bf16x8 __attribute__((ext_vector_type(8)));
typedef float f32x16 __attribute__((ext_vector_type(16)));
constexpr int PITCH = 144;
constexpr int SLOT = 64 * PITCH;
constexpr int GAM_OFF = 14 * SLOT;
constexpr size_t ITEM_BYTES = 49152;
__device__ __forceinline__ int crow(int r, int hi) { return (r & 3) + 8 * (r >> 2) + 4 * hi; }
__device__ __forceinline__ unsigned short f2b(float f) { unsigned u = __builtin_bit_cast(unsigned, f); return (unsigned short)((u + 0x7fffu + ((u >> 16) & 1u)) >> 16); }
__device__ __forceinline__ unsigned pk(float lo, float hi) { return (unsigned)f2b(lo) | ((unsigned)f2b(hi) << 16); }
__device__ __forceinline__ f32x16 tile_nt(LAS const unsigned char* A, int arow0, LAS const unsigned char* B, int brow0, f32x16 acc, int lane) {
    const int r = lane & 31, h = lane >> 5;
    LAS const unsigned char* ap = A + (arow0 + r) * PITCH + h * 16; LAS const unsigned char* bp = B + (brow0 + r) * PITCH + h * 16;
#pragma unroll
    for (int ks = 0; ks < 4; ++ks) { const bf16x8 a = *(LAS const bf16x8*)(ap + ks * 32), b = *(LAS const bf16x8*)(bp + ks * 32); acc = __builtin_amdgcn_mfma_f32_32x32x16_bf16(a, b, acc, 0, 0, 0); }
    return acc;
}
template <int MASK> __device__ __forceinline__ float maskv(float v, int row, int col) { if (MASK == 1) return row > col ? v : 0.f; if (MASK == 2) return row >= col ? v : 0.f; return v; }
template <int MASK> __device__ __forceinline__ void store_nat(LAS unsigned char* S, int r0, int c0, const f32x16& acc, float sc, int lane) {
    const int col = c0 + (lane & 31), hi = lane >> 5;
#pragma unroll
    for (int g = 0; g < 16; ++g) { const int row = r0 + crow(g, hi); *(LAS unsigned short*)(S + row * PITCH + col * 2) = f2b(maskv<MASK>(acc[g], row, col) * sc); }
}
template <int MASK> __device__ __forceinline__ void store_tr(LAS unsigned char* S, int r0, int c0, const f32x16& acc, int lane) {
    const int col = c0 + (lane & 31), hi = lane >> 5;
#pragma unroll
    for (int g = 0; g < 16; ++g) { const int row = r0 + crow(g, hi); *(LAS unsigned short*)(S + col * PITCH + row * 2) = f2b(maskv<MASK>(acc[g], row, col)); }
}
__device__ __forceinline__ f32x16 load_nat(LAS const unsigned char* S, int r0, int c0, int lane) {
    const int col = c0 + (lane & 31), hi = lane >> 5; f32x16 a;
#pragma unroll
    for (int g = 0; g < 16; ++g) a[g] = __uint_as_float((unsigned)*(LAS const unsigned short*)(S + (r0 + crow(g, hi)) * PITCH + col * 2) << 16);
    return a;
}
}

constexpr size_t WS_LW = WS_SMALL + 3 * MiB;
constexpr int LW_BYTES = 19456, ACT_PITCH = 272, ACT_BYTES = 64 * ACT_PITCH, RES_OFF = 8 * rw::SLOT, RES_PITCH = 65, SSBUF_OFF = 131072 + 2048;
template <int CTRL, int RM> __device__ __forceinline__ float dpp0(float v) { return __int_as_float(__builtin_amdgcn_update_dpp(0, __float_as_int(v), CTRL, RM, 0xf, false)); }
__device__ __forceinline__ float wave_scan_incl(float x) {
    x += dpp0<0x111, 0xf>(x); x += dpp0<0x112, 0xf>(x); x += dpp0<0x114, 0xf>(x); x += dpp0<0x118, 0xf>(x);
    x += dpp0<0x142, 0xa>(x); x += dpp0<0x143, 0xc>(x);
    return x;
}
__device__ __forceinline__ float fast_tanh(float x) { const float e = __expf(2.f * x); return 1.f - 2.f / (1.f + e); }
__device__ __forceinline__ void phase_chunkprep(Frame& F, KArgs& A, int l) {
    using namespace rw;
    const float* PR = WSP(const float, WS_PR);
    float* RW = WSP(float, WS_RW); constexpr size_t RS = (size_t)M * 256;
    LAS unsigned char* L = F.lds;
#define SL(n) (L + (n) * SLOT)
    const int w = F.wave;
    for (int it = F.vcu; it < NB * 4 * 64; it += F.G) {
        int lane = F.lane; asm volatile("" : "+v"(lane));
        { unsigned lb_ = 0u; asm volatile("" : "+s"(lb_)); L = F.lds + lb_; }
        const int c = it & 63, bh = it >> 6, b = bh >> 2, h = bh & 3;
        unsigned char* gout = F.ws + WS_XS + (size_t)it * ITEM_BYTES;
        const size_t m0 = (size_t)b * SEQ + c * 64;
        f32x4 s1r[2], s1k[2], s1v[2], s1pr[2], s1pk[2], s1pv[2];
        { const float* cur = PR + (m0 + lane) * 896 + h * 64 + 8 * w; const bool first = (c == 0 && lane == 0);
#pragma unroll
          for (int q = 0; q < 2; ++q) { s1r[q] = *(const GAS f32x4*)(cur + 4 * q); s1k[q] = *(const GAS f32x4*)(cur + 256 + 4 * q); s1v[q] = *(const GAS f32x4*)(cur + 512 + 4 * q);
              s1pr[q] = (f32x4){0.f, 0.f, 0.f, 0.f}; s1pk[q] = s1pr[q]; s1pv[q] = s1pr[q];
              if (!first) { s1pr[q] = *(const GAS f32x4*)(cur - 896 + 4 * q); s1pk[q] = *(const GAS f32x4*)(cur - 896 + 256 + 4 * q); s1pv[q] = *(const GAS f32x4*)(cur - 896 + 512 + 4 * q); } } }
        {
            const int tid = w * 64 + lane, t = tid >> 3, jg = tid & 7;
            const float* cur = PR + (m0 + t) * 896 + 768 + 16 * jg; const float* mup = GIN(8) + l * 896 + 768 + 16 * jg;
            const bool first = (c == 0 && t == 0);
            unsigned o8[8];
#pragma unroll
            for (int q = 0; q < 4; ++q) { f32x4 x = *(const GAS f32x4*)(cur + 4 * q); const f32x4 mu = *(const GAS f32x4*)(mup + 4 * q);
                f32x4 xp = {0.f, 0.f, 0.f, 0.f}; if (!first) xp = *(const GAS f32x4*)(cur - 896 + 4 * q);
                x = x + (xp - x) * mu;
#pragma unroll
                for (int e = 0; e < 4; ++e) x[e] = jg < 2 ? fast_tanh(x[e]) : (jg < 4 ? x[e] : 1.f / (1.f + __expf(-x[e])));
                o8[2 * q] = pk(x[0], x[1]); o8[2 * q + 1] = pk(x[2], x[3]); }
            LAS v4u* dst = (LAS v4u*)(L + t * ACT_PITCH + jg * 32);
            dst[0] = (v4u){o8[0], o8[1], o8[2], o8[3]}; dst[1] = (v4u){o8[4], o8[5], o8[6], o8[7]};
            const GAS v4u* lw = (const GAS v4u*)(F.ws + WS_LW + (size_t)(l * 4 + h) * LW_BYTES);
            for (int i = tid; i < LW_BYTES / 16; i += NWAVES * 64) *(LAS v4u*)(L + ACT_BYTES + i * 16) = lw[i];
        }
        LDS_WAIT(); __syncthreads();
        for (int id = w; id < 12; id += 8) {
            const int mtx = id >> 2, tr = (id >> 1) & 1, tc = id & 1, r = lane & 31, hh = lane >> 5;
            const int koff = mtx == 0 ? 0 : (mtx == 1 ? 64 : 128), nks = mtx == 2 ? 4 : 2, bp = mtx == 2 ? 144 : 80, boff = mtx == 0 ? 0 : (mtx == 1 ? 5120 : 10240);
            LAS const unsigned char* ap = L + (32 * tr + r) * ACT_PITCH + koff + hh * 16; LAS const unsigned char* bpp = L + ACT_BYTES + boff + (32 * tc + r) * bp + hh * 16;
            f32x16 acc = f32x16{};
            for (int ks = 0; ks < nks; ++ks) { const bf16x8 a = *(LAS const bf16x8*)(ap + ks * 32), bb = *(LAS const bf16x8*)(bpp + ks * 32); acc = __builtin_amdgcn_mfma_f32_32x32x16_bf16(a, bb, acc, 0, 0, 0); }
            LAS float* res = (LAS float*)(L + RES_OFF) + mtx * 64 * RES_PITCH + (32 * tc + r) * RES_PITCH + 32 * tr;
#pragma unroll
            for (int g = 0; g < 16; ++g) res[crow(g, hh)] = acc[g];
        }
        LDS_WAIT(); __syncthreads();
        {
            const int ch0 = h * 64 + 8 * w; const size_t m = m0 + lane;
            float r_[8], k_[8], v_[8], a_[8], lw_[8], kk_[8]; float ss = 0.f;
            const LAS float* res = (const LAS float*)(L + RES_OFF) + (8 * w) * RES_PITCH + lane;
#pragma unroll
            for (int q = 0; q < 2; ++q) {
                f32x4 xr = s1r[q], xk = s1k[q], xv = s1v[q]; const f32x4 pr = s1pr[q], pk_ = s1pk[q], pv = s1pv[q];
                const float* mu = GIN(8) + l * 896 + ch0 + 4 * q;
                const f32x4 mr = *(const GAS f32x4*)mu, mk = *(const GAS f32x4*)(mu + 256), mv = *(const GAS f32x4*)(mu + 512);
                xr = xr + (pr - xr) * mr; xk = xk + (pk_ - xk) * mk; xv = xv + (pv - xv) * mv;
                const f32x4 w0 = *(const GAS f32x4*)(GIN(9) + l * 256 + ch0 + 4 * q), a0 = *(const GAS f32x4*)(GIN(11) + l * 256 + ch0 + 4 * q);
                const f32x4 kkw = *(const GAS f32x4*)(GIN(14) + l * 256 + ch0 + 4 * q), kaw = *(const GAS f32x4*)(GIN(15) + l * 256 + ch0 + 4 * q);
                f32x4 gg, k2;
#pragma unroll
                for (int e = 0; e < 4; ++e) { const int i = 4 * q + e;
                    const float xw = -(w0[e] + res[i * RES_PITCH]); const float sp = xw > 15.f ? xw : __logf(1.f + __expf(xw)); const float wv = -sp - 0.5f;
                    lw_[i] = -__expf(wv);
                    const float a = 1.f / (1.f + __expf(-(a0[e] + res[(64 + i) * RES_PITCH]))); a_[i] = a;
                    gg[e] = res[(128 + i) * RES_PITCH];
                    r_[i] = xr[e]; v_[i] = xv[e]; kk_[i] = xk[e] * kkw[e]; ss += kk_[i] * kk_[i];
                    k2[e] = xk[e] * (1.f + (a - 1.f) * kaw[e]); k_[i] = k2[e]; }
                const size_t o = m * 256 + ch0 + 4 * q;
                *(GAS f32x4*)(RW + o) = xr; *(GAS f32x4*)(RW + 2 * RS + o) = k2; *(GAS f32x4*)(RW + 3 * RS + o) = xv; *(GAS f32x4*)(RW + 6 * RS + o) = gg;
            }
            *(LAS float*)(L + SSBUF_OFF + (w * 64 + lane) * 4) = ss;
            LDS_WAIT(); __syncthreads();
            float tot = 0.f;
#pragma unroll
            for (int q = 0; q < 8; ++q) tot += *(LAS const float*)(L + SSBUF_OFF + (q * 64 + lane) * 4);
            const float inv = 1.0f / fmaxf(sqrtf(tot), 1e-12f);
            unsigned nat[4][4];
#pragma unroll
            for (int e = 0; e < 8; ++e) {
                const float kkn = kk_[e] * inv, bbv = kkn * a_[e];
                const float cum = wave_scan_incl(lw_[e]);
                const float cl = rl(cum, 63), gam = __expf(cl);
                const float e1 = __expf(cum - lw_[e]), e2 = __expf(cum), e3 = __expf(-cum);
                const float kkf = kkn * e1, rf = r_[e] * e2, bi = bbv * e3, ki = k_[e] * e3, bend = bi * gam, kend = ki * gam;
                const int i = 8 * w + e;
                if (lane == 63) *(LAS float*)(L + GAM_OFF + i * 4) = gam;
                *(LAS unsigned short*)(SL(4) + i * PITCH + lane * 2) = f2b(kkf); *(LAS unsigned short*)(SL(5) + i * PITCH + lane * 2) = f2b(v_[e]);
                *(LAS unsigned short*)(SL(6) + i * PITCH + lane * 2) = f2b(bend); *(LAS unsigned short*)(SL(7) + i * PITCH + lane * 2) = f2b(kend);
                const unsigned short q0 = f2b(kkf), q1 = f2b(rf), q2 = f2b(bi), q3 = f2b(ki);
                if (e & 1) { nat[0][e >> 1] |= (unsigned)q0 << 16; nat[1][e >> 1] |= (unsigned)q1 << 16; nat[2][e >> 1] |= (unsigned)q2 << 16; nat[3][e >> 1] |= (unsigned)q3 << 16; }
                else { nat[0][e >> 1] = q0; nat[1][e >> 1] = q1; nat[2][e >> 1] = q2; nat[3][e >> 1] = q3; }
            }
#pragma unroll
            for (int mm = 0; mm < 4; ++mm) { v4u x; x.x = nat[mm][0]; x.y = nat[mm][1]; x.z = nat[mm][2]; x.w = nat[mm][3]; *(LAS v4u*)(SL(mm) + lane * PITCH + w * 16) = x; }
        }
        LDS_WAIT(); __syncthreads();
        const f32x16 Z = f32x16{};
#pragma unroll
        for (int q = 0; q < 2; ++q) { const int tile = 2 * w + q, p = tile >> 2, tr = (tile >> 1) & 1, tc = tile & 1;
            f32x16 acc = Z;
            if (!(tr == 0 && tc == 1)) acc = tile_nt(SL(p < 2 ? 0 : 1), 32 * tr, SL((p & 1) ? 3 : 2), 32 * tc, Z, lane);
            if (p == 0) { store_nat<1>(SL(8), 32 * tr, 32 * tc, acc, 1.f, lane); store_tr<1>(SL(12), 32 * tr, 32 * tc, acc, lane);
                const int col = 32 * tc + (lane & 31), hi = lane >> 5;
#pragma unroll
                for (int g = 0; g < 16; ++g) { const int row = 32 * tr + crow(g, hi); const float v = (row == col ? 1.f : 0.f) - (row > col ? acc[g] : 0.f); *(LAS unsigned short*)(SL(13) + row * PITCH + col * 2) = f2b(v); } }
            else if (p == 1) store_nat<1>(SL(9), 32 * tr, 32 * tc, acc, 1.f, lane);
            else if (p == 2) store_nat<2>(SL(10), 32 * tr, 32 * tc, acc, 1.f, lane);
            else store_nat<2>(SL(11), 32 * tr, 32 * tc, acc, 1.f, lane); }
        LDS_WAIT(); __syncthreads();
        const int tr = (w >> 1) & 1, tc = w & 1;
        {
            if (w < 4) { f32x16 acc = Z; if (!(tr == 0 && tc == 1)) acc = tile_nt(SL(8), 32 * tr, SL(12), 32 * tc, Z, lane); store_nat<0>(SL(0), 32 * tr, 32 * tc, acc, 1.f, lane); store_tr<0>(SL(2), 32 * tr, 32 * tc, acc, lane); }
            LDS_WAIT(); __syncthreads();
        }
#pragma nounroll
        for (int k = 1; k <= 5; ++k) {
            const int lpn = (k & 1) ? 0 : 8, lpt = (k & 1) ? 2 : 12, lpn2 = (k & 1) ? 8 : 0, lpt2 = (k & 1) ? 12 : 2, pin = (k & 1) ? 13 : 3, pout = (k & 1) ? 3 : 13;
            if (w < 4) { f32x16 acc = load_nat(SL(pin), 32 * tr, 32 * tc, lane); if (!(tr == 0 && tc == 1)) acc = tile_nt(SL(pin), 32 * tr, SL(lpt), 32 * tc, acc, lane); store_nat<0>(SL(pout), 32 * tr, 32 * tc, acc, 1.f, lane); }
            else if (k < 5) { f32x16 acc = Z; if (!(tr == 0 && tc == 1)) acc = tile_nt(SL(lpn), 32 * tr, SL(lpt), 32 * tc, Z, lane); store_nat<0>(SL(lpn2), 32 * tr, 32 * tc, acc, 1.f, lane); store_tr<0>(SL(lpt2), 32 * tr, 32 * tc, acc, lane); }
            LDS_WAIT(); __syncthreads();
        }
        if (w < 4) { const f32x16 acc = tile_nt(SL(4), 32 * tr, SL(3), 32 * tc, Z, lane); store_nat<0>(SL(0), 32 * tr, 32 * tc, acc, 1.f, lane); }
        else { const f32x16 acc = tile_nt(SL(5), 32 * tr, SL(9), 32 * tc, Z, lane); store_nat<0>(SL(2), 32 * tr, 32 * tc, acc, 1.f, lane); }
        LDS_WAIT(); __syncthreads();
        if (w < 4) { const f32x16 acc = tile_nt(SL(2), 32 * tr, SL(3), 32 * tc, Z, lane); store_nat<0>(SL(8), 32 * tr, 32 * tc, acc, -1.f, lane); }
        else {
            const int hi = lane >> 5, cl = lane & 31;
            { const f32x16 acc = tile_nt(SL(0), 32 * tr, SL(6), 32 * tc, Z, lane);
              const float gam = *(LAS const float*)(L + GAM_OFF + (32 * tc + cl) * 4);
#pragma unroll
              for (int sp = 0; sp < 2; ++sp) { float o[8];
#pragma unroll
                  for (int j = 0; j < 8; ++j) { const int g = 8 * sp + j; o[j] = ((tr == tc && crow(g, hi) == cl) ? gam : 0.f) - acc[g]; }
                  v4u x; x.x = pk(o[0], o[1]); x.y = pk(o[2], o[3]); x.z = pk(o[4], o[5]); x.w = pk(o[6], o[7]);
                  *(GAS v4u*)(gout + ((size_t)(tc * 4 + 2 * tr + sp) * 64 + lane) * 16) = x; } }
            { const f32x16 acc = tile_nt(SL(0), 32 * tr, SL(10), 32 * tc, Z, lane);
#pragma unroll
              for (int sp = 0; sp < 2; ++sp) { float o[8];
#pragma unroll
                  for (int j = 0; j < 8; ++j) { const int g = 8 * sp + j; const int i = 32 * tr + crow(g, hi), t = 32 * tc + cl;
                      o[j] = __uint_as_float((unsigned)*(LAS const unsigned short*)(SL(1) + t * PITCH + i * 2) << 16) - acc[g]; }
                  v4u x; x.x = pk(o[0], o[1]); x.y = pk(o[2], o[3]); x.z = pk(o[4], o[5]); x.w = pk(o[6], o[7]);
                  *(GAS v4u*)(gout + 8192 + ((size_t)(tc * 4 + 2 * tr + sp) * 64 + lane) * 16) = x; } }
        }
        LDS_WAIT(); __syncthreads();
        {
            f32x16 acc;
            if (w < 4) { acc = tile_nt(SL(7), 32 * tr, SL(5), 32 * tc, Z, lane); acc = tile_nt(SL(6), 32 * tr, SL(8), 32 * tc, acc, lane); }
            else { acc = tile_nt(SL(11), 32 * tr, SL(5), 32 * tc, Z, lane); acc = tile_nt(SL(10), 32 * tr, SL(8), 32 * tc, acc, lane); }
            float* o = (float*)(gout + (w < 4 ? 16384 : 32768)) + (size_t)(tr * 2 + tc) * 1024 + lane;
#pragma unroll
            for (int g = 0; g < 16; ++g) *(GAS float*)(o + g * 64) = acc[g];
        }
        LDS_WAIT(); __syncthreads();
    }
#undef SL
    if (F.wave == 0) { const bf16* KM = WSP(bf16, WS_KM); float* KMEAN = WSP(float, WS_KMEAN);
      for (int it = F.vcu; it < NB * 16 * 4; it += F.G) { const int hh = it & 3, n = (it >> 2) & 15, b = it >> 6; const int co = F.lane >> 3, rg = F.lane & 7;
          const bf16* p = KM + ((size_t)b * SEQ + n * 256 + rg * 32) * 256 + hh * 64 + co * 8; float s[8] = {0.f, 0.f, 0.f, 0.f, 0.f, 0.f, 0.f, 0.f};
#pragma unroll 16
          for (int t = 0; t < 32; ++t) { const v4u x = *(const GAS v4u*)(p + (size_t)t * 256);
              s[0] += bf_lo(x.x); s[1] += bf_hi(x.x); s[2] += bf_lo(x.y); s[3] += bf_hi(x.y); s[4] += bf_lo(x.z); s[5] += bf_hi(x.z); s[6] += bf_lo(x.w); s[7] += bf_hi(x.w); }
#pragma unroll
          for (int e = 0; e < 8; ++e) { float x = s[e]; x += dpp0<0xB1, 0xf>(x); x += dpp0<0x4E, 0xf>(x); x += dpp0<0x141, 0xf>(x); s[e] = x * (1.0f / 256.0f); }
          if (rg == 0) { float* o = KMEAN + (((size_t)b * 4 + hh) * 16 + n) * 64 + co * 8; *(GAS f32x4*)o = (f32x4){s[0], s[1], s[2], s[3]}; *(GAS f32x4*)(o + 4) = (f32x4){s[4], s[5], s[6], s[7]}; } } }
}

constexpr size_t WS_SB = WS_HS;
__device__ __forceinline__ void rwkv_chain_wave(Frame& F, int bh, int tv) {
    using namespace rw;
    const int lane = F.lane;
    f32x16 S0 = f32x16{}, S1 = f32x16{};
    const unsigned char* gin = F.ws + WS_XS + (size_t)bh * 64 * ITEM_BYTES;
    unsigned char* sb = F.ws + WS_SB + ((size_t)bh * 64 * 2 + tv) * 4096 + lane * 16;
    bf16x8 Ga[8]; f32x16 H0, H1;
#define RW_LOAD(G_, H0_, H1_, gp_) do { _Pragma("unroll") for (int q_ = 0; q_ < 8; ++q_) G_[q_] = *(const GAS bf16x8*)((gp_) + ((size_t)q_ * 64 + lane) * 16); \
        const float* hp_ = (const float*)((gp_) + 16384) + (size_t)tv * 1024 + lane; _Pragma("unroll") for (int g_ = 0; g_ < 16; ++g_) { H0_[g_] = *(const GAS float*)(hp_ + g_ * 64); H1_[g_] = *(const GAS float*)(hp_ + 2048 + g_ * 64); } } while (0)
    RW_LOAD(Ga, H0, H1, gin);
    for (int c = 0; c < 64; ++c) {
        bf16x8 Gn[8]; f32x16 Hn0, Hn1;
        const unsigned char* gnx = gin + (size_t)(c < 63 ? c + 1 : c) * ITEM_BYTES;
        RW_LOAD(Gn, Hn0, Hn1, gnx);
        bf16x8 Bf[4];
#pragma unroll
        for (int s = 0; s < 4; ++s) { const f32x16& X = (s < 2) ? S0 : S1; const int o = 8 * (s & 1); v4u x; x.x = pk(X[o], X[o + 1]); x.y = pk(X[o + 2], X[o + 3]); x.z = pk(X[o + 4], X[o + 5]); x.w = pk(X[o + 6], X[o + 7]); Bf[s] = __builtin_bit_cast(bf16x8, x);
            *(GAS v4u*)(sb + (size_t)c * 8192 + s * 1024) = x; }
#pragma unroll
        for (int s = 0; s < 4; ++s) { H0 = __builtin_amdgcn_mfma_f32_32x32x16_bf16(Ga[s], Bf[s], H0, 0, 0, 0); H1 = __builtin_amdgcn_mfma_f32_32x32x16_bf16(Ga[4 + s], Bf[s], H1, 0, 0, 0); }
        S0 = H0; S1 = H1;
#pragma unroll
        for (int q = 0; q < 8; ++q) Ga[q] = Gn[q];
        H0 = Hn0; H1 = Hn1;
    }
#undef RW_LOAD
}
__device__ __forceinline__ void rwkv_y_item(Frame& F, KArgs& A, int l, int item2) {
    using namespace rw;
    const int lane = F.lane, hi = lane >> 5, cl = lane & 31;
    const int tt = item2 & 1, item = item2 >> 1, c = item & 63, bh = item >> 6, b = bh >> 2, h = bh & 3;
    const unsigned char* gin = F.ws + WS_XS + (size_t)item * ITEM_BYTES;
    const unsigned char* sb = F.ws + WS_SB + ((size_t)item * 2) * 4096 + lane * 16;
    LAS float* yl = (LAS float*)(F.lds + F.wave * 8192);
#pragma unroll
    for (int tv = 0; tv < 2; ++tv) {
        f32x16 acc; const float* y0 = (const float*)(gin + 32768) + (size_t)(tt * 2 + tv) * 1024 + lane;
#pragma unroll
        for (int g = 0; g < 16; ++g) acc[g] = *(const GAS float*)(y0 + g * 64);
#pragma unroll
        for (int s = 0; s < 4; ++s) { const bf16x8 a = *(const GAS bf16x8*)(gin + 8192 + ((size_t)(tt * 4 + s) * 64 + lane) * 16), bfr = *(const GAS bf16x8*)(sb + tv * 4096 + s * 1024);
            acc = __builtin_amdgcn_mfma_f32_32x32x16_bf16(a, bfr, acc, 0, 0, 0); }
#pragma unroll
        for (int g = 0; g < 16; ++g) yl[crow(g, hi) * 64 + 32 * tv + cl] = acc[g];
    }
    LDS_WAIT();
    const float* RWp = WSP(const float, WS_RW); constexpr size_t RS = (size_t)M * 256;
    const int ch = h * 64 + lane;
    const float rk = GIN(16)[l * 256 + ch], lng = GIN(17)[l * 256 + ch], lnb = GIN(18)[l * 256 + ch];
    const size_t row0 = (size_t)b * SEQ + c * 64 + 32 * tt;
#pragma unroll 8
    for (int t = 0; t < 32; ++t) { const size_t o = (row0 + t) * 256 + ch;
        const float y = yl[t * 64 + lane], r = RWp[o], k = RWp[2 * RS + o], v = RWp[3 * RS + o], g = RWp[6 * RS + o];
        const float mean = wave_sum(y) * (1.0f / 64.0f); const float d = y - mean; const float var = wave_sum(d * d) * (1.0f / 64.0f);
        const float bonus = wave_sum(r * k * rk) * v;
        WSP(bf16, WS_MIX)[(row0 + t) * 1024 + ch] = (bf16)f2bf((d * (1.0f / sqrtf(var + 64e-5f)) * lng + lnb + bonus) * g); }
    LDS_WAIT();
}
#ifndef ATT_NEGM
#define ATT_NEGM false
#endif
constexpr int CW_TIX = 16384 + 2048;
__device__ __forceinline__ void phase_attention(Frame& F, KArgs& A, int l, int rep) {
    constexpr int NSTREAM = 48, NUNITS = NSTREAM * 16, NCONV = 192, NTICKETS = NUNITS + NCONV;
    static_assert(4 * NCONV == NUNITS && 2 * NCONV * 64 == 3 * 32 * 256, "ticket interleave");
    unsigned* ctr = (unsigned*)(F.ctl + CW_TIX + l * 64 + rep * 16);
    volatile LAS unsigned* tix = F.MISC + 16;
    attn_body::attn_build_tables(F.tid, WSP(float, WS_TB), (char*)F.lds);
    asm volatile("s_waitcnt vmcnt(0) lgkmcnt(0)\n\ts_barrier" ::: "memory");
    if (F.vcu < 4) rwkv_chain_wave(F, (F.vcu * 8 + F.wave) >> 1, F.wave & 1);
    int iter_ = 0;
    for (;;) {
#ifdef ATT_STATIC
        if (threadIdx.x == 0) tix[0] = (unsigned)(iter_ * F.G + (int)blockIdx.x);
#else
        if (threadIdx.x == 0) tix[0] = atomicAdd(ctr, 1u);
#endif
        ++iter_;
        asm volatile("s_waitcnt vmcnt(0) lgkmcnt(0)\n\ts_barrier" ::: "memory");
        const int ticket = (int)tix[0];
        asm volatile("s_waitcnt lgkmcnt(0)\n\ts_barrier" ::: "memory");
        if (ticket >= NTICKETS) break;
        if (ticket % 5 == 4) { moe_convert_ticket(F, A, l, ticket / 5); continue; }
        const int au = 4 * (ticket / 5) + ticket % 5;
        const int qb = 15 - au / NSTREAM, s = au % NSTREAM;
        int tid_u = threadIdx.x; asm volatile("" : "+v"(tid_u));
        if (s < 32) {
            const int b = s >> 3, h = (s >> 1) & 3, c = s & 1; const size_t r0 = (size_t)b * SEQ;
            attn_body::attn_unit_dv<16>(tid_u, qb,
                (const attn_body::bf16*)(WSP(bf16, WS_QD) + r0 * 512 + (h * 2 + c) * 64), 512,
                (const attn_body::bf16*)(WSP(bf16, WS_KD) + r0 * 512 + (h * 2 + c) * 64), 512,
                (const attn_body::bf16*)(WSP(bf16, WS_VD) + r0 * 512 + h * 128), 512,
                (attn_body::bf16*)(WSP(bf16, WS_OD) + r0 * 1024 + (h * 2 + c) * 128), 1024,
                h, (char*)F.lds);
        } else {
            const int b = (s - 32) >> 2, h = (s - 32) & 3; const size_t r0 = (size_t)b * SEQ;
            attn_body::attn_unit<16, true, ATT_NEGM>(tid_u, qb,
                (const attn_body::bf16*)(WSP(bf16, WS_QM) + r0 * 256 + h * 64), 256,
                (const attn_body::bf16*)(WSP(bf16, WS_KM) + r0 * 256 + h * 64), 256,
                (const attn_body::bf16*)(WSP(bf16, WS_VM) + r0 * 256 + h * 64), 256,
                (attn_body::bf16*)(WSP(bf16, WS_MIX) + r0 * 1024 + 768 + h * 64), 1024,
                4 + h, WSP(float, WS_KMEAN) + ((size_t)(b * 4 + h) * 16) * 64, (char*)F.lds);
        }
    }
}
__device__ __forceinline__ void phase_postmix(Frame& F, KArgs& A, int l) {
    const float lam = WSP(float, WS_LAM)[l]; const float li = 0.8f - 0.6f * __expf(-0.3f * (float)l);
    const float* sg = GIN(22) + l * 128;
    const int nit_ = F.xl ? 9 : (2048 + M + F.NGW - 1) / F.NGW;
    for (int k_ = 0; k_ < nit_; ++k_) {
        int it;
        if (F.xl) { if (k_ == 0) { rwkv_y_item(F, A, l, ((((F.vcu >> 6) * 4 + (F.wave >> 1)) * 64 + (F.vcu & 63)) << 1) | (F.wave & 1)); continue; } it = 2048 + F.vcu * 64 + F.wave * 8 + (k_ - 1); }
        else { it = F.gw + k_ * F.NGW; if (it >= 2048 + M) break; if (it < 2048) { rwkv_y_item(F, A, l, it); continue; } }
        const int m = it - 2048; const int h = F.lane >> 4, j = F.lane & 15;
        const bf16* od = WSP(bf16, WS_OD) + (size_t)m * 1024 + h * 256 + 8 * j;
        const v4u a = __builtin_nontemporal_load((const GAS v4u*)od), b2 = __builtin_nontemporal_load((const GAS v4u*)(od + 128));
        float o[8];
        o[0] = bf_lo(a.x) - lam * bf_lo(b2.x); o[1] = bf_hi(a.x) - lam * bf_hi(b2.x); o[2] = bf_lo(a.y) - lam * bf_lo(b2.y); o[3] = bf_hi(a.y) - lam * bf_hi(b2.y);
        o[4] = bf_lo(a.z) - lam * bf_lo(b2.z); o[5] = bf_hi(a.z) - lam * bf_hi(b2.z); o[6] = bf_lo(a.w) - lam * bf_lo(b2.w); o[7] = bf_hi(a.w) - lam * bf_hi(b2.w);
        float ss = 0.f;
#pragma unroll
        for (int i = 0; i < 8; ++i) ss += o[i] * o[i];
        ss += __shfl_xor(ss, 1); ss += __shfl_xor(ss, 2); ss += __shfl_xor(ss, 4); ss += __shfl_xor(ss, 8);
        const float rs = (1.f - li) / sqrtf(ss * (1.0f / 128.0f) + 1e-6f);
        const f32x4 g0 = *(const f32x4*)(sg + 8 * j), g1 = *(const f32x4*)(sg + 8 * j + 4);
        v4u w; w.x = pk2(o[0] * rs * g0.x, o[1] * rs * g0.y); w.y = pk2(o[2] * rs * g0.z, o[3] * rs * g0.w); w.z = pk2(o[4] * rs * g1.x, o[5] * rs * g1.y); w.w = pk2(o[6] * rs * g1.z, o[7] * rs * g1.w);
        *(GAS v4u*)(WSP(bf16, WS_MIX) + (size_t)m * 1024 + 256 + h * 128 + 8 * j) = w;
    }
}
__global__ void __launch_bounds__(NWAVES * 64, 2) mega_fwd(Args Araw) {
    extern __shared__ __attribute__((aligned(16))) unsigned char lds[];
    Frame F;
    F.lds = (LAS unsigned char*)lds; F.MISC = (volatile LAS unsigned*)(F.lds + MISC_OFF);
    F.tid = threadIdx.x; F.lane = F.tid & 63; F.wave = __builtin_amdgcn_readfirstlane(F.tid >> 6);
    F.G = gridDim.x; { const int bx = blockIdx.x; F.vcu = (F.G % 8 == 0) ? (bx % 8) * (F.G / 8) + bx / 8 : bx; }
    F.gw = F.vcu * NWAVES + F.wave; F.NGW = F.G * NWAVES;
    F.out = Araw.out; F.ws = Araw.ws; F.ctl = (gu32*)(Araw.ws + WS_CTL); F.xl = 0; F.cf = (int)blockIdx.x;
    for (int u = F.tid; u < (LDS_BYTES - LDSCTL_OFF) / 4; u += NWAVES * 64) ((LAS unsigned*)(F.lds + LDSCTL_OFF))[u] = 0u;
    __syncthreads();
    XcdBarrier bar = xcd_barrier_post((unsigned*)(F.ctl + CW_BAR), F.MISC + 8);
#define GRID_BAR() xcd_barrier(bar)

    constexpr int NPH = 9; constexpr int NSTEP = 1 + NL * NPH + 1;
    int reps_ = 0;
    {
        KArgs* Ap_ = (KArgs*)__builtin_amdgcn_kernarg_segment_ptr(); asm volatile("" : "+s"(Ap_)); KArgs& A = *Ap_;
        { unsigned lb_ = 0u; asm volatile("" : "+s"(lb_)); F.lds = (LAS unsigned char*)lds + lb_; F.MISC = (volatile LAS unsigned*)(F.lds + MISC_OFF); }
        { GAS unsigned char* w_ = (GAS unsigned char*)Araw.ws; GAS float* o_ = (GAS float*)Araw.out; asm volatile("" : "+s"(w_), "+s"(o_)); F.ws = (unsigned char*)w_; F.out = (float*)o_; F.ctl = (gu32*)(w_ + WS_CTL); }
        { int t_ = threadIdx.x; asm volatile("" : "+v"(t_)); F.tid = t_; F.lane = t_ & 63; F.wave = __builtin_amdgcn_readfirstlane(t_ >> 6); F.gw = F.vcu * NWAVES + F.wave; }
#ifndef SK_P0
        p0_prologue(F, A);
#endif
        GRID_BAR();
        xcd_census_regular(bar);
        { const int xl_ = __builtin_amdgcn_readfirstlane((int)F.MISC[11]), rk_ = __builtin_amdgcn_readfirstlane((int)F.MISC[10]);
          if (xl_) { F.xl = 1; F.vcu = (int)bar.x * 32 + rk_; F.cf = rk_ * 8 + (int)bar.x; } }
    }
    for (int step = 1; step < NSTEP; ++step) {
        const int l = (step - 1) / NPH, idx_ = (step - 1) % NPH;
        const int ph = ((step == NSTEP - 1) ? 99 : (idx_ < 2 ? idx_ : (idx_ == 2 ? 10 : (idx_ < 7 ? idx_ : idx_ + 1))));
        KArgs* Ap_ = (KArgs*)__builtin_amdgcn_kernarg_segment_ptr(); asm volatile("" : "+s"(Ap_)); KArgs& A = *Ap_;
        { unsigned lb_ = 0u; asm volatile("" : "+s"(lb_)); F.lds = (LAS unsigned char*)lds + lb_; F.MISC = (volatile LAS unsigned*)(F.lds + MISC_OFF); }
        { GAS unsigned char* w_ = (GAS unsigned char*)Araw.ws; GAS float* o_ = (GAS float*)Araw.out; asm volatile("" : "+s"(w_), "+s"(o_)); F.ws = (unsigned char*)w_; F.out = (float*)o_; F.ctl = (gu32*)(w_ + WS_CTL); }
        { int t_ = threadIdx.x; asm volatile("" : "+v"(t_)); F.tid = t_; F.lane = t_ & 63; F.wave = __builtin_amdgcn_readfirstlane(t_ >> 6); F.gw = F.vcu * NWAVES + F.wave; }
#ifdef AMP_MASK
        const unsigned long long amp_t0 = __builtin_amdgcn_s_memrealtime();
#endif
        switch (ph) {
        case 0:
#ifndef SK_N1
            phase_norm1(F, A, l);
#endif
            break;
        case 1: {
#ifndef SK_GIN
            pg8::Gemm g{WSP(bf16, WS_HB), WSP(bf16, WS_WIN) + (size_t)l * NIN * 1024, M, NIN, DM, 0};
            pg8::StaticOrder S; S.init(M, NIN, F.G, F.cf);
            pg8::EpiInProj E{F.ws, Ap_, l, C2};
            pg8::gemm_phase<pg8::EpiInProj, pg8::StaticOrder, true, PG8_SP2>(F.lds, g, S, E);
            if (F.cf >= 64) moe_convert_ticket(F, A, l, 192 + (F.cf - 64) % 192);
#endif
            break; }
        case 10:
            phase_chunkprep(F, A, l);
            break;
        case 3:
#ifndef SK_MX
            phase_attention(F, A, l, reps_);
#endif
            break;
        case 4:
#ifndef SK_PM
            phase_postmix(F, A, l);
#endif
            break;
        case 5: {
#ifndef SK_GOUT
            pg8::Gemm g{WSP(bf16, WS_MIX), WSP(bf16, WS_WOUT) + (size_t)l * 1024 * 1024, M, DM, DM, 0};
            pg8::StaticOrder S; S.init(M, DM, F.G, F.cf);
            pg8::EpiResid E{F.out, WSP(float, WS_MOD) + (size_t)l * NB * 6144 + 2048, SEQ, 6144};
            pg8::gemm_phase<pg8::EpiResid, pg8::StaticOrder, true, PG8_SP2>(F.lds, g, S, E);
#endif
            break; }
        case 6:
#ifndef SK_R1
            phase_router(F, A, l, bar);
#endif
            break;
        case 8: {
#ifndef SK_MOE
            moe_tables(F, A, l);
            const LAS int* base = (const LAS int*)(F.lds + TAB_OFF);
            pg8::MoeOrder S{base + 64, base[32] / 256, 4, F.G, F.vcu};
            pg8::Gemm g1{WSP(bf16, WS_XS), WSP(bf16, WS_W13) + (size_t)l * 32 * 1024 * 1024, MOE_ROWS, 1024, 1024, (size_t)1024 * 1024 * 2};
            pg8::EpiSwiGLU E1{WSP(bf16, WS_HS)};
            pg8::gemm_phase<pg8::EpiSwiGLU, pg8::MoeOrder, true, PG8_SP2>(F.lds, g1, S, E1);
#endif
            break; }
        case 9: {
#ifndef SK_MOE
            moe_tables(F, A, l);
            const LAS int* base = (const LAS int*)(F.lds + TAB_OFF);
            pg8::MoeOrder S{base + 64, base[32] / 256, 4, F.G, F.vcu};
            pg8::Gemm g2{WSP(bf16, WS_HS), WSP(bf16, WS_W2) + (size_t)l * 32 * 1024 * 512, MOE_ROWS, 1024, 512, (size_t)1024 * 512 * 2};
            pg8::EpiMoeOut E2{WSP(bf16, WS_YS), WSP(float, WS_SMALL) + 6 * M};
            pg8::gemm_phase<pg8::EpiMoeOut, pg8::MoeOrder, true, PG8_SP2>(F.lds, g2, S, E2);
#endif
            break; }
        default:
            phase_norm1(F, A, NL);
            break;
        }
#ifdef AMP_MASK
        { const int bit_ = ph == -1 ? 15 : (ph == 99 ? 14 : ph); if ((AMP_MASK >> bit_) & 1) { asm volatile("s_waitcnt vmcnt(0) lgkmcnt(0)" ::: "memory"); const unsigned long long t1_ = __builtin_amdgcn_s_memrealtime(); while (__builtin_amdgcn_s_memrealtime() - t1_ < t1_ - amp_t0) __builtin_amdgcn_s_sleep(8); } }
#endif
        if (step + 1 < NSTEP) {
            if (F.xl && (ph == 0 || ph == 4 || ph == 8)) xcd_local_barrier(bar); else GRID_BAR();
        }
#ifdef REP_PH
        if (ph == REP_PH && reps_ == 0) { reps_ = 1; --step; } else reps_ = 0;
#endif
    }
}

extern "C" void kernel_launch(void* const* d_in, const int* in_sizes, int n_in, void* d_out, int out_size, void* d_ws, size_t ws_size, hipStream_t stream) {
    static int grid = 0;
    if (grid == 0) {
        if (n_in != 33 || out_size != M * DM || ws_size < WS_END) { fprintf(stderr, "kernel_launch: unexpected shapes (n_in %d, out %d, ws %zu < %zu)\n", n_in, out_size, ws_size, (size_t)WS_END); grid = -1; return; }
        int dev = 0, cus = 0;
        if (hipGetDevice(&dev) != hipSuccess || hipDeviceGetAttribute(&cus, hipDeviceAttributeMultiprocessorCount, dev) != hipSuccess) { grid = -1; return; }
        if (hipFuncSetAttribute((const void*)mega_fwd, hipFuncAttributeMaxDynamicSharedMemorySize, LDS_BYTES) != hipSuccess) { fprintf(stderr, "kernel_launch: hipFuncSetAttribute failed\n"); grid = -1; return; }
        int per_cu = 0;
        if (hipOccupancyMaxActiveBlocksPerMultiprocessor(&per_cu, (const void*)mega_fwd, NWAVES * 64, LDS_BYTES) != hipSuccess || per_cu < 1) fprintf(stderr, "kernel_launch: occupancy query says %d\n", per_cu);
        (void)hipGetLastError();
        if (cus != M / 64) { fprintf(stderr, "kernel_launch: built for %d CUs (found %d)\n", M / 64, cus); grid = -1; return; }
        grid = cus;
    }
    if (grid < 0) return;
    if (hipMemsetAsync((char*)d_ws + WS_CTL, 0, CTL_ZERO_BYTES, stream) != hipSuccess) { fprintf(stderr, "kernel_launch: memset failed\n"); return; }
    Args a{};
    for (int i = 0; i < 33; ++i) a.in[i] = (const float*)d_in[i];
    a.out = (float*)d_out; a.ws = (unsigned char*)d_ws;
    hipLaunchKernelGGL(mega_fwd, dim3(grid), dim3(NWAVES * 64), LDS_BYTES, stream, a);
}
```

```cpp
#include <hip/hip_runtime.h>
#include <cstdio>
#include <cstdint>
struct Args { const float* in[33]; float* out; unsigned char* ws; };
typedef const __attribute__((address_space(4))) Args KArgs;
namespace pg8 {
#define PG8_LAS __attribute__((address_space(3)))
typedef unsigned short bf16_t;
typedef short bf16x8 __attribute__((ext_vector_type(8)));
typedef float f32x4 __attribute__((ext_vector_type(4)));
typedef unsigned u32x4 __attribute__((ext_vector_type(4)));
constexpr int BM = 256, BK = 64, HALF = 128, HTB = HALF * BK * 2  , STAGE_BYTES = 8 * HTB, NXCD = 8, WGM = 8;

__host__ __device__ __forceinline__ int lds_byte(int r, int c) { const int st = (r >> 4) * 2 + (c >> 5), rr = r & 15, cc = c & 31, ob = rr * 64 + cc * 2; return st * 1024 + (ob ^ (((ob >> 9) & 1) << 5)); }
__host__ __device__ __forceinline__ void stage_rc(int b, int& R, int& C) { const int st = b / 1024, sb = b % 1024, swz = sb ^ (((sb >> 9) & 1) << 5); R = (st >> 1) * 16 + swz / 64; C = (st & 1) * 32 + (swz % 64) / 2; }
__host__ __device__ __forceinline__ int perm32(int rho) { const int n = rho >> 4, i = rho & 15; return 8 * (i >> 2) + 4 * n + (i & 3); }

struct Unit { int pm, pn, e; };
struct Gemm { const bf16_t* A; const bf16_t* Bt; int M, N, K; size_t estride; };

struct StaticOrder {
    int nM, nN, nwg, G, c;
    __host__ __device__ void init(int M, int N, int G_, int c_) { nM = M / BM; nN = N / BM; nwg = nM * nN; G = G_; c = c_; }
    __host__ __device__ bool next(int i, Unit& u) const {
        const long L = (long)i * G + c; if (L >= nwg) return false;
        int wgid = (int)L; { const int q = nwg / NXCD, r = nwg % NXCD, xcd = wgid % NXCD, off = wgid / NXCD; wgid = (xcd < r ? xcd * (q + 1) : r * (q + 1) + (xcd - r) * q) + off; }
        const int nig = WGM * nN, gid = wgid / nig, fm = gid * WGM, gsz = (nM - fm) < WGM ? (nM - fm) : WGM;
        u.pm = fm + ((wgid % nig) % gsz); u.pn = (wgid % nig) / gsz; u.e = 0; return true;
    }
    __device__ __forceinline__ void a_ready(const Unit&) const {}
    __device__ __forceinline__ void done(const Unit&) const {}
};

__device__ __forceinline__ unsigned cvt_pk_bf16(float lo, float hi) { unsigned r; asm volatile("v_cvt_pk_bf16_f32 %0, %1, %2" : "=v"(r) : "v"(lo), "v"(hi)); return r; }
typedef unsigned u32x2 __attribute__((ext_vector_type(2)));
constexpr size_t EPI_MiB = 1u << 20, EPI_WS_QD = 656 * EPI_MiB, EPI_WS_KD = 672 * EPI_MiB, EPI_WS_VD = 688 * EPI_MiB, EPI_WS_QM = 704 * EPI_MiB, EPI_WS_KM = 712 * EPI_MiB, EPI_WS_VM = 720 * EPI_MiB, EPI_WS_PR = 728 * EPI_MiB;

struct EpiInProj {
    static constexpr bool PERM = true, AFTER_DRAIN = false;
    unsigned char* ws; KArgs* ka; int l; float c2;
    __device__ __forceinline__ void operator()(const f32x4 (&acc)[2][2][4][2], const Unit& u, int wr, int wc, int fr, int fq) const {
        const int pn = u.pn; const int row0 = u.pm * BM + wr * 64 + fr;
        if (pn >= 9) {
            float* PR = (float*)(ws + EPI_WS_PR);
            const int cb = (pn - 9) * 256 + 64 * wc + 8 * fq;
#pragma unroll
            for (int ai = 0; ai < 2; ++ai)
#pragma unroll
                for (int m = 0; m < 4; ++m) { float* rowp = PR + (size_t)(row0 + ai * HALF + m * 16) * 896;
#pragma unroll
                    for (int bj = 0; bj < 2; ++bj)
#pragma unroll
                        for (int n = 0; n < 2; ++n) { const int c = cb + 32 * bj + 4 * n; if (c < 896) *(f32x4*)(rowp + c) = acc[ai][bj][m][n]; } }
            return;
        }
        bf16_t* dst; int ld, cbase; const float* gain = nullptr; float sc = 1.f;
        if (pn < 2) { dst = (bf16_t*)(ws + EPI_WS_QD); ld = 512; cbase = pn * 256; gain = ((const float*)(const __attribute__((address_space(1))) float*)ka->in[19]) + l * 64; sc = c2; }
        else if (pn < 4) { dst = (bf16_t*)(ws + EPI_WS_KD); ld = 512; cbase = (pn - 2) * 256; gain = ((const float*)(const __attribute__((address_space(1))) float*)ka->in[20]) + l * 64; }
        else if (pn < 6) { dst = (bf16_t*)(ws + EPI_WS_VD); ld = 512; cbase = (pn - 4) * 256; }
        else if (pn == 6) { dst = (bf16_t*)(ws + EPI_WS_QM); ld = 256; cbase = 0; gain = ((const float*)(const __attribute__((address_space(1))) float*)ka->in[23]) + l * 64; sc = c2; }
        else if (pn == 7) { dst = (bf16_t*)(ws + EPI_WS_KM); ld = 256; cbase = 0; gain = ((const float*)(const __attribute__((address_space(1))) float*)ka->in[24]) + l * 64; }
        else { dst = (bf16_t*)(ws + EPI_WS_VM); ld = 256; cbase = 0; }
        f32x4 gv[2][2];
#pragma unroll
        for (int bj = 0; bj < 2; ++bj)
#pragma unroll
            for (int n = 0; n < 2; ++n) gv[bj][n] = gain ? *(const f32x4*)(gain + 32 * bj + 8 * fq + 4 * n) * sc : (f32x4){1.f, 1.f, 1.f, 1.f};
        const int col0 = cbase + 64 * wc + 8 * fq;
#pragma unroll
        for (int ai = 0; ai < 2; ++ai)
#pragma unroll
            for (int m = 0; m < 4; ++m) {
                float rs = 1.f;
                if (gain) { float ss = 0.f;
#pragma unroll
                    for (int bj = 0; bj < 2; ++bj)
#pragma unroll
                        for (int n = 0; n < 2; ++n) { const f32x4 x = acc[ai][bj][m][n]; ss += (x[0] * x[0] + x[1] * x[1]) + (x[2] * x[2] + x[3] * x[3]); }
                    ss += __shfl_xor(ss, 16); ss += __shfl_xor(ss, 32);
                    rs = 1.0f / sqrtf(ss * (1.0f / 64.0f) + 1e-6f); }
                bf16_t* rowp = dst + (size_t)(row0 + ai * HALF + m * 16) * ld + col0;
#pragma unroll
                for (int bj = 0; bj < 2; ++bj) { const f32x4 v0 = acc[ai][bj][m][0] * rs * gv[bj][0], v1 = acc[ai][bj][m][1] * rs * gv[bj][1];
                    u32x4 w; w.x = cvt_pk_bf16(v0[0], v0[1]); w.y = cvt_pk_bf16(v0[2], v0[3]); w.z = cvt_pk_bf16(v1[0], v1[1]); w.w = cvt_pk_bf16(v1[2], v1[3]);
                    *(u32x4*)(rowp + 32 * bj) = w; } }
    }
};
struct EpiResid {
    static constexpr bool PERM = false, AFTER_DRAIN = false;
    float* X; const float* gate; int seq, gstride;
    __device__ __forceinline__ void operator()(const f32x4 (&acc)[2][2][4][2], const Unit& u, int wr, int wc, int fr, int fq) const {
        const int row0 = u.pm * BM + wr * 64 + fr, col0 = u.pn * BM + wc * 32 + 4 * fq;
        const float* gp = gate + (size_t)((u.pm * BM) / seq) * gstride + col0;
        f32x4 gv[2][2];
#pragma unroll
        for (int bj = 0; bj < 2; ++bj)
#pragma unroll
            for (int n = 0; n < 2; ++n) gv[bj][n] = *(const f32x4*)(gp + bj * HALF + n * 16);
#pragma unroll
        for (int ai = 0; ai < 2; ++ai)
#pragma unroll
            for (int m = 0; m < 4; ++m) { float* rowp = X + (size_t)(row0 + ai * HALF + m * 16) * 1024 + col0;
#pragma unroll
                for (int bj = 0; bj < 2; ++bj)
#pragma unroll
                    for (int n = 0; n < 2; ++n) { f32x4* p = (f32x4*)(rowp + bj * HALF + n * 16); *p = *p + gv[bj][n] * acc[ai][bj][m][n]; } }
    }
};
struct EpiSwiGLU {
    static constexpr bool PERM = true, AFTER_DRAIN = false;
    bf16_t* HS;
    __device__ __forceinline__ void operator()(const f32x4 (&acc)[2][2][4][2], const Unit& u, int wr, int wc, int fr, int fq) const {
        const int row0 = u.pm * BM + wr * 64 + fr;
#pragma unroll
        for (int ai = 0; ai < 2; ++ai)
#pragma unroll
            for (int m = 0; m < 4; ++m) { bf16_t* rowp = HS + (size_t)(row0 + ai * HALF + m * 16) * 512;
#pragma unroll
                for (int bj = 0; bj < 2; ++bj) { const int g = 32 * u.pn + 16 * bj + 4 * wc + fq; const f32x4 a = acc[ai][bj][m][0], b = acc[ai][bj][m][1]; f32x4 o;
#pragma unroll
                    for (int e = 0; e < 4; ++e) o[e] = a[e] / (1.0f + __expf(-a[e])) * b[e];
                    u32x2 w; w.x = cvt_pk_bf16(o[0], o[1]); w.y = cvt_pk_bf16(o[2], o[3]); *(u32x2*)(rowp + 4 * g) = w; } }
    }
};
struct EpiMoeOut {
    static constexpr bool PERM = true, AFTER_DRAIN = false;
    bf16_t* YS; const float* gs;
    __device__ __forceinline__ void operator()(const f32x4 (&acc)[2][2][4][2], const Unit& u, int wr, int wc, int fr, int fq) const {
        const int row0 = u.pm * BM + wr * 64 + fr, col0 = u.pn * BM + wc * 32 + 8 * fq;
#pragma unroll
        for (int ai = 0; ai < 2; ++ai)
#pragma unroll
            for (int m = 0; m < 4; ++m) { const int r = row0 + ai * HALF + m * 16; const float gt = gs[r]; bf16_t* rowp = YS + (size_t)r * 1024 + col0;
#pragma unroll
                for (int bj = 0; bj < 2; ++bj) { const f32x4 v0 = acc[ai][bj][m][0] * gt, v1 = acc[ai][bj][m][1] * gt;
                    u32x4 w; w.x = cvt_pk_bf16(v0[0], v0[1]); w.y = cvt_pk_bf16(v0[2], v0[3]); w.z = cvt_pk_bf16(v1[0], v1[1]); w.w = cvt_pk_bf16(v1[2], v1[3]);
                    *(u32x4*)(rowp + bj * HALF) = w; } }
    }
};
struct MoeOrder {
    const __attribute__((address_space(3))) int* t2e; int ntiles, nN, G, c;
    __device__ bool next(int i, Unit& u) const { const int L = i * G + c; if (L >= ntiles * nN) return false; u.pm = L / nN; u.pn = L % nN; u.e = t2e[u.pm]; return true; }
    __device__ __forceinline__ void a_ready(const Unit&) const {}
    __device__ __forceinline__ void done(const Unit&) const {}
};
template <class Epi, class Sched, bool ALIGN_EPI = false, bool SP2 = false>
__device__ __forceinline__ void gemm_phase(PG8_LAS unsigned char* lds, const Gemm g, const Sched& S, const Epi& E) {
    int tid_ = threadIdx.x; asm volatile("" : "+v"(tid_));
    const int tid = tid_, wid = __builtin_amdgcn_readfirstlane(tid >> 6), lane = tid & 63, wr = wid >> 2, wc = wid & 3, fr = lane & 15, fq = lane >> 4;
    const int K = g.K, nt = K / BK;
    unsigned voffA[2], voffB[2];
#pragma unroll
    for (int i = 0; i < 2; ++i) { int R, C; stage_rc(tid * 16 + i * 8192, R, C); const int Rb = Epi::PERM ? ((R & ~31) + perm32(R & 31)) : R;
        voffA[i] = (unsigned)(R * K + C) * 2u; voffB[i] = (unsigned)(Rb * K + C) * 2u; }
    const size_t kstep = (size_t)(BK * 2);
    const size_t hstep = (size_t)HALF * K * 2;
    const size_t tstep = 2 * hstep;
    const unsigned ldsw = (unsigned)wid * 1024u;
    const int aoff = lds_byte(wr * 64 + fr, fq * 8), boff = lds_byte(wc * 32 + fr, fq * 8);
#define PG8_SA(b, h) (((b) * 2 + (h)) * HTB)
#define PG8_SB(b, h) ((4 + (b) * 2 + (h)) * HTB)
#define PG8_STAGE(bufoff, gbase, voff) do { _Pragma("unroll") for (int _i = 0; _i < 2; ++_i) \
        __builtin_amdgcn_global_load_lds((const unsigned*)((const char*)(gbase) + (voff)[_i]), (PG8_LAS unsigned*)(lds + (bufoff) + ldsw + _i * 8192), 16, 0, 0); } while (0)
#define PG8_LDA(dst, b, h) do { _Pragma("unroll") for (int m = 0; m < 4; ++m) _Pragma("unroll") for (int k = 0; k < 2; ++k) dst[m][k] = *(const PG8_LAS bf16x8*)(lds + PG8_SA(b, h) + aoff + m * 2048 + k * 1024); } while (0)
#define PG8_LDB(dst, b, h) do { _Pragma("unroll") for (int n = 0; n < 2; ++n) _Pragma("unroll") for (int k = 0; k < 2; ++k) dst[n][k] = *(const PG8_LAS bf16x8*)(lds + PG8_SB(b, h) + boff + n * 2048 + k * 1024); } while (0)
#define PG8_MMA(ai, bj, At, Bt) do { __builtin_amdgcn_s_setprio(1); _Pragma("unroll") for (int m = 0; m < 4; ++m) _Pragma("unroll") for (int n = 0; n < 2; ++n) _Pragma("unroll") for (int k = 0; k < 2; ++k) \
        acc[ai][bj][m][n] = __builtin_amdgcn_mfma_f32_16x16x32_bf16(Bt[n][k], At[m][k], acc[ai][bj][m][n], 0, 0, 0); __builtin_amdgcn_s_setprio(0); } while (0)
#define PG8_WAIT_V(n) asm volatile("s_waitcnt vmcnt(" #n ")" ::: "memory")
#define PG8_WAIT_L(n) asm volatile("s_waitcnt lgkmcnt(" #n ")" ::: "memory")
#define PG8_BAR __builtin_amdgcn_s_barrier()
#define PG8_SCHED __builtin_amdgcn_sched_barrier(0)
    Unit cur, nxt; int ui = 0;
    if (!S.next(0, cur)) return;
    f32x4 acc[2][2][4][2];
#pragma unroll
    for (int a = 0; a < 2; ++a)
#pragma unroll
        for (int b = 0; b < 2; ++b)
#pragma unroll
            for (int m = 0; m < 4; ++m)
#pragma unroll
                for (int n = 0; n < 2; ++n) acc[a][b][m][n] = (f32x4){0.f, 0.f, 0.f, 0.f};
    bf16x8 At[4][2], B0[2][2], B1[2][2];
    const char* cA = (const char*)g.A + (size_t)cur.pm * tstep; const char* cB = (const char*)g.Bt + (size_t)cur.e * g.estride + (size_t)cur.pn * tstep;
    S.a_ready(cur);
    if constexpr (SP2) {
        PG8_STAGE(PG8_SB(0, 0), cB, voffB); PG8_STAGE(PG8_SB(0, 1), cB + hstep, voffB); PG8_STAGE(PG8_SA(0, 0), cA, voffA); PG8_STAGE(PG8_SA(0, 1), cA + hstep, voffA);
        if (wr == 1) PG8_BAR;
        PG8_WAIT_V(2); PG8_BAR;
        PG8_STAGE(PG8_SB(1, 0), cB + kstep, voffB); PG8_STAGE(PG8_SA(1, 0), cA + kstep, voffA); PG8_STAGE(PG8_SB(1, 1), cB + hstep + kstep, voffB);
        PG8_WAIT_V(6); PG8_BAR;
    } else {
        PG8_STAGE(PG8_SB(0, 0), cB, voffB); PG8_STAGE(PG8_SA(0, 0), cA, voffA); PG8_STAGE(PG8_SB(0, 1), cB + hstep, voffB); PG8_STAGE(PG8_SA(0, 1), cA + hstep, voffA);
        if (wr == 1) PG8_BAR;
        PG8_WAIT_V(4); PG8_BAR;
        PG8_STAGE(PG8_SB(1, 0), cB + kstep, voffB); PG8_STAGE(PG8_SA(1, 0), cA + kstep, voffA); PG8_STAGE(PG8_SB(1, 1), cB + hstep + kstep, voffB);
        PG8_WAIT_V(6); PG8_BAR;
    }
    for (;;) {
        const bool has_next = S.next(ui + 1, nxt);
        const char* nA = has_next ? (const char*)g.A + (size_t)nxt.pm * tstep : cA; const char* nB = has_next ? (const char*)g.Bt + (size_t)nxt.e * g.estride + (size_t)nxt.pn * tstep : cB;
        for (int t = 0; t < nt; t += 2) {
            const bool last = (t == nt - 2);
            const char* a1 = cA + (size_t)(t + 1) * kstep;
            const char* a2 = last ? nA : cA + (size_t)(t + 2) * kstep; const char* b2 = last ? nB : cB + (size_t)(t + 2) * kstep;
            const char* a3 = a2 + kstep; const char* b3 = b2 + kstep;
            if (last && has_next) S.a_ready(nxt);
            if constexpr (SP2) {
            PG8_LDB(B0, 0, 0); PG8_LDB(B1, 0, 1); PG8_SCHED; PG8_LDA(At, 0, 0); PG8_STAGE(PG8_SA(1, 1), a1 + hstep, voffA);
            PG8_WAIT_V(8); PG8_WAIT_L(0); PG8_BAR; PG8_MMA(0, 0, At, B0); PG8_MMA(0, 1, At, B1); PG8_BAR; PG8_SCHED;
            PG8_LDA(At, 0, 1); PG8_STAGE(PG8_SB(0, 0), b2, voffB); PG8_STAGE(PG8_SB(0, 1), b2 + hstep, voffB); PG8_STAGE(PG8_SA(0, 0), a2, voffA);
            PG8_WAIT_V(8); PG8_WAIT_L(0); PG8_BAR; PG8_MMA(1, 0, At, B0); PG8_MMA(1, 1, At, B1); PG8_BAR; PG8_SCHED;
            PG8_LDB(B0, 1, 0); PG8_LDB(B1, 1, 1); PG8_SCHED; PG8_LDA(At, 1, 0); PG8_STAGE(PG8_SA(0, 1), a2 + hstep, voffA);
            PG8_WAIT_V(8); PG8_WAIT_L(0); PG8_BAR; PG8_MMA(0, 0, At, B0); PG8_MMA(0, 1, At, B1); PG8_BAR; PG8_SCHED;
            PG8_LDA(At, 1, 1); PG8_STAGE(PG8_SB(1, 0), b3, voffB); PG8_STAGE(PG8_SB(1, 1), b3 + hstep, voffB); PG8_STAGE(PG8_SA(1, 0), a3, voffA);
            PG8_WAIT_V(8); PG8_WAIT_L(0); PG8_BAR; PG8_MMA(1, 0, At, B0); PG8_MMA(1, 1, At, B1); PG8_BAR; PG8_SCHED;
            } else {
            PG8_LDB(B0, 0, 0); PG8_SCHED; PG8_LDA(At, 0, 0); PG8_STAGE(PG8_SA(1, 1), a1 + hstep, voffA);
            PG8_WAIT_L(8); PG8_BAR; PG8_WAIT_L(0); PG8_MMA(0, 0, At, B0); PG8_BAR; PG8_SCHED;
            PG8_LDB(B1, 0, 1); PG8_STAGE(PG8_SB(0, 0), b2, voffB);
            PG8_BAR; PG8_WAIT_L(0); PG8_MMA(0, 1, At, B1); PG8_BAR;
            PG8_LDA(At, 0, 1); PG8_STAGE(PG8_SA(0, 0), a2, voffA);
            PG8_BAR; PG8_WAIT_L(0); PG8_MMA(1, 0, At, B0); PG8_BAR; PG8_SCHED;
            PG8_STAGE(PG8_SB(0, 1), b2 + hstep, voffB);
            PG8_WAIT_V(6); PG8_BAR; PG8_MMA(1, 1, At, B1); PG8_BAR;
            PG8_LDB(B0, 1, 0); PG8_SCHED; PG8_LDA(At, 1, 0); PG8_STAGE(PG8_SA(0, 1), a2 + hstep, voffA);
            PG8_WAIT_L(8); PG8_BAR; PG8_WAIT_L(0); PG8_MMA(0, 0, At, B0); PG8_BAR; PG8_SCHED;
            PG8_LDB(B1, 1, 1); PG8_STAGE(PG8_SB(1, 0), b3, voffB);
            PG8_BAR; PG8_WAIT_L(0); PG8_MMA(0, 1, At, B1); PG8_BAR;
            PG8_LDA(At, 1, 1); PG8_STAGE(PG8_SA(1, 0), a3, voffA);
            PG8_BAR; PG8_WAIT_L(0); PG8_MMA(1, 0, At, B0); PG8_BAR; PG8_SCHED;
            PG8_STAGE(PG8_SB(1, 1), b3 + hstep, voffB);
            PG8_WAIT_V(6); PG8_BAR; PG8_MMA(1, 1, At, B1); PG8_BAR;
            }
        }
        if constexpr (ALIGN_EPI) { if (wr == 0) PG8_BAR; }
        if constexpr (!Epi::AFTER_DRAIN) { E(acc, cur, wr, wc, fr, fq); S.done(cur); }
        if (!has_next) break;
#pragma unroll
        for (int a = 0; a < 2; ++a)
#pragma unroll
            for (int b = 0; b < 2; ++b)
#pragma unroll
                for (int m = 0; m < 4; ++m)
#pragma unroll
                    for (int n = 0; n < 2; ++n) acc[a][b][m][n] = (f32x4){0.f, 0.f, 0.f, 0.f};
        cur = nxt; cA = nA; cB = nB; ++ui;
        if constexpr (ALIGN_EPI) { if (wr == 1) PG8_BAR; }
    }
    PG8_WAIT_V(0);
    if constexpr (!ALIGN_EPI) { if (wr == 0) PG8_BAR; }
    PG8_BAR;
    if constexpr (Epi::AFTER_DRAIN) { E.fused(acc, cur, wr, wc, fr, fq, lds, wid, lane); S.done(cur); }
#undef PG8_SA
#undef PG8_SB
#undef PG8_STAGE
#undef PG8_LDA
#undef PG8_LDB
#undef PG8_MMA
#undef PG8_WAIT_V
#undef PG8_WAIT_L
#undef PG8_BAR
#undef PG8_SCHED
}
}
#include <hip/hip_bf16.h>
#include <cmath>
namespace attn_body {
using bf16=__hip_bfloat16;
using bf16x8=__attribute__((ext_vector_type(8)))short;
using s16x4=__attribute__((ext_vector_type(4)))short;
using f32x16=__attribute__((ext_vector_type(16)))float;
using u32x4=__attribute__((ext_vector_type(4)))unsigned;
constexpr int D=64;
#ifndef TBATCH
#define TBATCH 16
#endif
constexpr int NW=8,QBLK=32,QB=QBLK*NW,KVBLK=64;
constexpr int ATTN_UNIT_ROWS=QB;
__device__ __forceinline__ int crow(int r,int hi){return (r&3)+8*(r>>2)+4*hi;}
#define SBAR() __builtin_amdgcn_sched_barrier(0)
__device__ __forceinline__ void cmask(f32x16&p0,f32x16&p1,int jb,int qrel,int hi){
  const float NEG=-INFINITY; int kb=64*jb+4*hi;
  #pragma unroll
  for(int r=0;r<16;++r){int kv=kb+(r&3)+8*(r>>2); if(kv>qrel)p0[r]=NEG; if(kv+32>qrel)p1[r]=NEG;}
}

constexpr int NSLOT=3, SLOTB=8192;
constexpr int LDS_K=0, LDS_V=NSLOT*SLOTB, LDS_WS=2*NSLOT*SLOTB, LDS_OST=LDS_WS+NW*64*4, LDS_TBL=LDS_OST+NW*4096, TBL_N=1344, LDS_BYTES=LDS_TBL+8*TBL_N*4;
constexpr float C2=0.125f*1.4426950408889634f;
__device__ __forceinline__ void glds16(const void*gsrc,unsigned lds_dst){unsigned keep;
  asm volatile("s_mov_b32 %0, m0\n\ts_mov_b32 m0, %2\n\ts_nop 0\n\tglobal_load_lds_dwordx4 %1, off\n\ts_mov_b32 m0, %0":"=&s"(keep):"v"(gsrc),"s"(lds_dst):"memory");}
__device__ __forceinline__ float max3f(float a,float b,float c){float r;asm("v_max3_f32 %0, %1, %2, %3":"=v"(r):"v"(a),"v"(b),"v"(c));return r;}
__device__ __forceinline__ float max2f(float a,float b){float r;asm("v_max_f32_e32 %0, %1, %2":"=v"(r):"v"(a),"v"(b));return r;}
__device__ __forceinline__ float fadd_s(float a,float b){float r;asm("v_add_f32_e32 %0, %1, %2":"=v"(r):"v"(a),"v"(b));return r;}
__device__ __forceinline__ float fsub_s(float a,float b){float r;asm("v_sub_f32_e32 %0, %1, %2":"=v"(r):"v"(a),"v"(b));return r;}
typedef float f32x2_t __attribute__((ext_vector_type(2))); typedef __bf16 bf16x2_t __attribute__((ext_vector_type(2)));
__device__ __forceinline__ unsigned cvtpk_s(float lo,float hi){f32x2_t v={lo,hi};bf16x2_t b=__builtin_convertvector(v,bf16x2_t);return __builtin_bit_cast(unsigned,b);}
#define WAIT_BAR(N) asm volatile("s_waitcnt vmcnt(" #N ") lgkmcnt(0)\n\ts_barrier":::"memory")

__device__ __forceinline__ void qkt(f32x16&p0,f32x16&p1,const char*Kslot,const bf16x8*qr,const f32x16&negm,int r32,int hi){
  const char*kb=Kslot+hi*1024+r32*16;
  #pragma unroll
  for(int d0=0;d0<4;++d0){
    const bf16x8 b0=*reinterpret_cast<const bf16x8*>(kb+d0*2048);
    const bf16x8 b1=*reinterpret_cast<const bf16x8*>(kb+d0*2048+512);
    if(d0==0){p0=__builtin_amdgcn_mfma_f32_32x32x16_bf16(b0,qr[0],negm,0,0,0);p1=__builtin_amdgcn_mfma_f32_32x32x16_bf16(b1,qr[0],negm,0,0,0);}
    else{p0=__builtin_amdgcn_mfma_f32_32x32x16_bf16(b0,qr[d0],p0,0,0,0);p1=__builtin_amdgcn_mfma_f32_32x32x16_bf16(b1,qr[d0],p1,0,0,0);}}
}
typedef __attribute__((address_space(3))) const char* lds_cptr;
typedef short v4i16_t __attribute__((ext_vector_type(4)));
__device__ __forceinline__ void kload8(bf16x8*kf,lds_cptr kp){
  kf[0]=*(const __attribute__((address_space(3))) bf16x8*)(kp);      kf[1]=*(const __attribute__((address_space(3))) bf16x8*)(kp+512);
  kf[2]=*(const __attribute__((address_space(3))) bf16x8*)(kp+2048); kf[3]=*(const __attribute__((address_space(3))) bf16x8*)(kp+2560);
  kf[4]=*(const __attribute__((address_space(3))) bf16x8*)(kp+4096); kf[5]=*(const __attribute__((address_space(3))) bf16x8*)(kp+4608);
  kf[6]=*(const __attribute__((address_space(3))) bf16x8*)(kp+6144); kf[7]=*(const __attribute__((address_space(3))) bf16x8*)(kp+6656);
}
__device__ __forceinline__ void kload2(bf16x8*kf,lds_cptr kp,int j){ kf[2*j]=*(const __attribute__((address_space(3))) bf16x8*)(kp+j*2048); kf[2*j+1]=*(const __attribute__((address_space(3))) bf16x8*)(kp+j*2048+512); }
__device__ __forceinline__ s16x4 vtr(lds_cptr p){ return __builtin_bit_cast(s16x4,__builtin_amdgcn_ds_read_tr16_b64_v4i16((__attribute__((address_space(3))) v4i16_t*)p)); }
__device__ __forceinline__ float rowmax(const f32x16&p0,const f32x16&p1){
  float a=max3f(p0[0],p0[1],p1[0]),b=max3f(p0[2],p0[3],p1[1]);a=max3f(a,p1[2],p1[3]);
  #pragma unroll
  for(int r=4;r<16;r+=4){a=max3f(a,p0[r],p0[r+1]);b=max3f(b,p0[r+2],p0[r+3]);a=max3f(a,p1[r],p1[r+1]);b=max3f(b,p1[r+2],p1[r+3]);}
  const float m=max2f(a,b);
  auto rr=__builtin_amdgcn_permlane32_swap(__float_as_uint(m),__float_as_uint(m),false,false);
  return max2f(__uint_as_float(rr[0]),__uint_as_float(rr[1]));
}
__device__ __forceinline__ void pv(f32x16*o,int vb,bf16x8 pa0,bf16x8 pa1,bf16x8 pa2,bf16x8 pa3){
  #pragma unroll
  for(int d0=0;d0<2;++d0){s16x4 lo[4],hi[4];
    #pragma unroll
    for(int ks=0;ks<4;++ks){
      asm volatile("ds_read_b64_tr_b16 %0,%1 offset:%c2":"=&v"(lo[ks]):"v"(vb),"i"(d0*4096+ks*1024):"memory");
      asm volatile("ds_read_b64_tr_b16 %0,%1 offset:%c2":"=&v"(hi[ks]):"v"(vb),"i"(d0*4096+ks*1024+512):"memory");}
    asm volatile("s_waitcnt lgkmcnt(0)":::"memory");SBAR();
    #define PK(k) (bf16x8){lo[k][0],lo[k][1],lo[k][2],lo[k][3],hi[k][0],hi[k][1],hi[k][2],hi[k][3]}
    o[d0]=__builtin_amdgcn_mfma_f32_32x32x16_bf16(pa0,PK(0),o[d0],0,0,0);
    o[d0]=__builtin_amdgcn_mfma_f32_32x32x16_bf16(pa1,PK(1),o[d0],0,0,0);
    o[d0]=__builtin_amdgcn_mfma_f32_32x32x16_bf16(pa2,PK(2),o[d0],0,0,0);
    o[d0]=__builtin_amdgcn_mfma_f32_32x32x16_bf16(pa3,PK(3),o[d0],0,0,0);
    #undef PK
  }
}

#ifndef ATTN_STORE16
#define ATTN_STORE16(p,v) __builtin_nontemporal_store((v),(u32x4*)(p))
#endif
__device__ __forceinline__ void attn_build_tables(int tid,const float*tb,char*shm){
  typedef __attribute__((address_space(3))) float lds_f32;
  lds_f32*T=(lds_f32*)((__attribute__((address_space(3))) char*)shm+LDS_TBL);
  for(int i=tid;i<8*TBL_N;i+=NW*64){ const int hh=i/TBL_N, d=i-hh*TBL_N-256; float v=0.f; if(d<0)v=-INFINITY; else if(d<1024)v=tb[hh*1024+d]-tb[hh*1024+1023]; T[i]=v; }
}
template<int THRL,bool MOBA,bool USE_NEGM> __device__ __forceinline__ void attn_unit(int tid,int qb,const bf16*Qb,int qpitch,const bf16*__restrict__ Kb,int kpitch,const bf16*__restrict__ Vb,int vpitch,bf16*Ob,int opitch,int hh,const float*kmean,char*shm){
  const int lane=tid&63,r32=lane&31,hi=lane>>5; const int wid=__builtin_amdgcn_readfirstlane(tid>>6);
  const int q0=qb*QB;
  const bf16*Qw=Qb+(long)(q0+wid*QBLK)*qpitch;
  const bf16*Kh=Kb,*Vh=Vb;
  const int qpos=q0+wid*QBLK+r32;
  typedef __attribute__((address_space(3))) float lds_f32;
  const lds_f32*Tl=(const lds_f32*)((__attribute__((address_space(3))) char*)shm+LDS_TBL)+hh*TBL_N;
  unsigned selmask=0xffffffffu;
  if(MOBA){
    float qf[64];
    { const uint4*qp=(const uint4*)(Qw+(long)r32*qpitch);
      _Pragma("unroll") for(int c=0;c<8;++c){ const uint4 u=qp[c]; qf[8*c]=__uint_as_float(u.x<<16);qf[8*c+1]=__uint_as_float(u.x&0xffff0000u);qf[8*c+2]=__uint_as_float(u.y<<16);qf[8*c+3]=__uint_as_float(u.y&0xffff0000u);
        qf[8*c+4]=__uint_as_float(u.z<<16);qf[8*c+5]=__uint_as_float(u.z&0xffff0000u);qf[8*c+6]=__uint_as_float(u.w<<16);qf[8*c+7]=__uint_as_float(u.w&0xffff0000u);} }
    float v1=-INFINITY,v2=-INFINITY,v3=-INFINITY; int i1=31,i2=31,i3=31;
    for(int n=0;n<qb;++n){ const float*km=kmean+n*64; float g=0.f;
      _Pragma("unroll") for(int i=0;i<64;++i)g+=qf[i]*km[i];
      if(g>v1){v3=v2;i3=i2;v2=v1;i2=i1;v1=g;i1=n;} else if(g>v2){v3=v2;i3=i2;v2=g;i2=n;} else if(g>v3){v3=g;i3=n;} }
    selmask=(1u<<qb); if(i1<31)selmask|=1u<<i1; if(i2<31)selmask|=1u<<i2; if(i3<31)selmask|=1u<<i3; }
  #define TMAP(t) (MOBA?(((t)<4)?(NT-4+(t)):((t)-4)):(t))
  const unsigned lds0=(unsigned)(uintptr_t)shm;
  float*wsf=(float*)(shm+LDS_WS)+wid*64;
  const bf16*ksrc=Kh+(long)lane*kpitch+wid*8;
  const bf16*vsrc=Vh+(long)(16*(wid&3)+(lane>>2))*vpitch+(wid>>2)*32+(lane&3)*8;
  const unsigned kdst=lds0+LDS_K+wid*1024, vdst=lds0+LDS_V+wid*1024;
  #define DMA_K(t,slot) glds16(ksrc+(long)TMAP(t)*KVBLK*kpitch,(unsigned)__builtin_amdgcn_readfirstlane(kdst+(slot)))
  #define DMA_V(t,slot) glds16(vsrc+(long)TMAP(t)*KVBLK*vpitch,(unsigned)__builtin_amdgcn_readfirstlane(vdst+(slot)))
  const int vb0=(int)(lds0+LDS_V)+((lane>>4)&1)*32+(lane&3)*8+(4*hi+((lane&15)>>2))*64;
  const char*Kbase=shm+LDS_K; bf16x8 kf[8];
  const lds_cptr shm3=(lds_cptr)shm; const lds_cptr kp0=shm3+LDS_K+hi*1024+r32*16; const lds_cptr vp0=shm3+LDS_V+((lane>>4)&1)*32+(lane&3)*8+(4*hi+((lane&15)>>2))*64;
  const int NT=(q0+QB)/KVBLK;
  DMA_K(0,0);DMA_V(0,0);DMA_K(1,SLOTB);
  bf16x8 qr[4];
  #pragma unroll
  for(int d0=0;d0<4;++d0)qr[d0]=*reinterpret_cast<const bf16x8*>(&Qw[(long)r32*qpitch+d0*16+hi*8]);
  float mhat=0.f,l_reg=0.f;f32x16 o[2];o[0]=f32x16{};o[1]=f32x16{};f32x16 negm=f32x16{}; if(USE_NEGM){asm volatile("":"+v"(negm));}
  #define NEGMC (USE_NEGM?negm:f32x16{})
  #define CMASK(P0,P1,t) do{ int D0_=qpos-64*TMAP(t)-4*hi; D0_=D0_<1083?D0_:1083; int bi_=D0_+(256-59); \
      if(MOBA){ if(!((selmask>>(TMAP(t)>>2))&1u))bi_=64; } const volatile lds_f32*tp_=Tl+bi_; \
      { float tb_[TBATCH]; _Pragma("unroll") for(int b0_=0;b0_<16;b0_+=TBATCH){ _Pragma("unroll") for(int r=0;r<TBATCH;++r)tb_[r]=tp_[59-(((b0_+r)&3)+8*((b0_+r)>>2))]; _Pragma("unroll") for(int r=0;r<TBATCH;++r)P0[b0_+r]=fadd_s(P0[b0_+r],tb_[r]); } \
        _Pragma("unroll") for(int b0_=0;b0_<16;b0_+=TBATCH){ _Pragma("unroll") for(int r=0;r<TBATCH;++r)tb_[r]=tp_[27-(((b0_+r)&3)+8*((b0_+r)>>2))]; _Pragma("unroll") for(int r=0;r<TBATCH;++r)P1[b0_+r]=fadd_s(P1[b0_+r],tb_[r]); } } }while(0)
  bool resc=false,mnz=false;
  #define START(P0,P1) do{ const float rm=rowmax(P0,P1); resc=false; \
    if(__any(rm>(float)THRL)){ const float dl=__builtin_fmaxf(rm,0.f); mhat=fadd_s(mhat,dl); mnz=true; \
      _Pragma("unroll") for(int r=0;r<16;++r){P0[r]=fsub_s(P0[r],dl);P1[r]=fsub_s(P1[r],dl);} \
      if(USE_NEGM){ _Pragma("unroll") for(int r=0;r<16;++r)negm[r]=-mhat; asm volatile("":"+v"(negm)); } } \
    _Pragma("unroll") for(int r=0;r<16;++r)P0[r]=__builtin_amdgcn_exp2f(P0[r]); }while(0)
  #define RESC() do{ if(resc){ asm volatile("s_waitcnt lgkmcnt(0)":::"memory"); \
      _Pragma("unroll") for(int d_=0;d_<2;++d_) _Pragma("unroll") for(int r=0;r<16;++r)o[d_][r]*=wsf[crow(r,hi)]; } }while(0)
  f32x16 pA0,pA1,pB0,pB1;
  int sl_prev=0,sl_cur=0,sl_next=SLOTB;
  #define ROT() do{sl_prev=sl_cur;sl_cur=sl_next;sl_next=(sl_next==(NSLOT-1)*SLOTB)?0:sl_next+SLOTB;}while(0)
  DMA_K(2,2*SLOTB);
  WAIT_BAR(3);
  qkt(pA0,pA1,Kbase,qr,negm,r32,hi);asm volatile("s_nop 15\n\ts_nop 7":"+v"(pA0),"+v"(pA1));CMASK(pA0,pA1,0);
  START(pA0,pA1);
  _Pragma("unroll") for(int r=0;r<16;++r)pA1[r]=__builtin_amdgcn_exp2f(pA1[r]);
  WAIT_BAR(0);
  DMA_K(3,0);DMA_V(1,SLOTB);
  ROT();
  kload8(kf,kp0+sl_cur);
  WAIT_BAR(2);
  s16x4 vlo[8],vhi[8]; u32x4 pw0,pw1,pw2,pw3;
  #define PKW(P,B) cvtpk_s(P[B],P[B+1])
  #define PAF(k) __builtin_bit_cast(bf16x8,pw##k)
  #define VFR(i) (bf16x8){vlo[i][0],vlo[i][1],vlo[i][2],vlo[i][3],vhi[i][0],vhi[i][1],vhi[i][2],vhi[i][3]}
  #define PIN(x) asm volatile("":"+v"(x))
  #define MX3(a,b,c) __builtin_fmaxf(__builtin_fmaxf((a),(b)),(c))
  #define GAPA(MF,A0,A1,A2,A3,W0,W1,PW) do{ MF; sacc+=A0; sacc+=A1; sacc+=A2; sacc+=A3; PIN(sacc); W0; W1; PIN(PW); SBAR(); }while(0)
  #define EX(v) __builtin_amdgcn_exp2f(v)
  #define GAPB(MF,X,B) do{ MF; X[B]=EX(X[B]); X[B+1]=EX(X[B+1]); X[B+2]=EX(X[B+2]); X[B+3]=EX(X[B+3]); PIN(X); SBAR(); }while(0)
  #define VRD(i) do{ vlo[i]=vtr(vp_+(((i)>>2)*4096+((i)&3)*1024)); vhi[i]=vtr(vp_+(((i)>>2)*4096+((i)&3)*1024+512)); }while(0)
  #define KRD(G,j) do{ if(G){ kload2(kf,kp0+sl_next,j); SBAR(); } }while(0)
  #define STEP(C0,C1,P0,P1,t,GK,GV,GL) do{ SBAR(); \
    const lds_cptr vp_=vp0+sl_prev; \
    VRD(0); SBAR(); float sacc=(P0[0]+P0[1]); \
    GAPA(C0=__builtin_amdgcn_mfma_f32_32x32x16_bf16(kf[0],qr[0],NEGMC,0,0,0), P0[2],P0[3],P0[4],P0[5],     pw0[0]=PKW(P0,0), pw0[1]=PKW(P0,2), pw0); \
    VRD(4); SBAR(); GAPA(C1=__builtin_amdgcn_mfma_f32_32x32x16_bf16(kf[1],qr[0],NEGMC,0,0,0), P0[6],P0[7],P0[8],P0[9],     pw0[2]=PKW(P0,4), pw0[3]=PKW(P0,6), pw0); \
    VRD(1); SBAR(); GAPA(C0=__builtin_amdgcn_mfma_f32_32x32x16_bf16(kf[2],qr[1],C0,0,0,0),   P0[10],P0[11],P0[12],P0[13], pw1[0]=PKW(P0,8), pw1[1]=PKW(P0,10), pw1); \
    VRD(5); SBAR(); GAPA(C1=__builtin_amdgcn_mfma_f32_32x32x16_bf16(kf[3],qr[1],C1,0,0,0),   P0[14],P0[15],P1[0],P1[1],   pw1[2]=PKW(P0,12),pw1[3]=PKW(P0,14), pw1); \
    VRD(2); SBAR(); GAPA(C0=__builtin_amdgcn_mfma_f32_32x32x16_bf16(kf[4],qr[2],C0,0,0,0),   P1[2],P1[3],P1[4],P1[5],     pw2[0]=PKW(P1,0), pw2[1]=PKW(P1,2), pw2); \
    VRD(6); SBAR(); GAPA(C1=__builtin_amdgcn_mfma_f32_32x32x16_bf16(kf[5],qr[2],C1,0,0,0),   P1[6],P1[7],P1[8],P1[9],     pw2[2]=PKW(P1,4), pw2[3]=PKW(P1,6), pw2); \
    VRD(3); SBAR(); GAPA(C0=__builtin_amdgcn_mfma_f32_32x32x16_bf16(kf[6],qr[3],C0,0,0,0),   P1[10],P1[11],P1[12],P1[13], pw3[0]=PKW(P1,8), pw3[1]=PKW(P1,10), pw3); \
    VRD(7); SBAR(); GAPA(C1=__builtin_amdgcn_mfma_f32_32x32x16_bf16(kf[7],qr[3],C1,0,0,0),   P1[14],P1[15],0.f,0.f,       pw3[2]=PKW(P1,12),pw3[3]=PKW(P1,14), pw3); \
    l_reg+=sacc; \
    if(GK){DMA_K((t)+3,sl_cur);} if(GV){DMA_V((t)+1,sl_next);} \
    { const float d_=__builtin_fmaxf(C0[15],C1[15]); asm volatile(""::"v"(d_)); asm volatile("":"+v"(C0),"+v"(C1)); } \
    if(!USE_NEGM&&mnz){ _Pragma("unroll") for(int r=0;r<16;++r){C0[r]=fsub_s(C0[r],mhat);C1[r]=fsub_s(C1[r],mhat);} } \
    CMASK(C0,C1,t); \
    { float a=MX3(C0[0],C0[1],C1[0]),b=MX3(C0[2],C0[3],C1[1]); a=MX3(a,C1[2],C1[3]); \
      _Pragma("unroll") for(int r=4;r<16;r+=4){a=MX3(a,C0[r],C0[r+1]);b=MX3(b,C0[r+2],C0[r+3]);a=MX3(a,C1[r],C1[r+1]);b=MX3(b,C1[r+2],C1[r+3]);} \
      float rm=__builtin_fmaxf(a,b); { auto rr=__builtin_amdgcn_permlane32_swap(__float_as_uint(rm),__float_as_uint(rm),false,false); rm=__builtin_fmaxf(__uint_as_float(rr[0]),__uint_as_float(rr[1])); } \
      resc=false; \
      if(__builtin_expect(__any(rm>(float)THRL),0)){ const float dl=__builtin_fmaxf(rm,0.f); mhat+=dl; mnz=true; \
        _Pragma("unroll") for(int r=0;r<16;++r){C0[r]=fsub_s(C0[r],dl);C1[r]=fsub_s(C1[r],dl);} \
        if(USE_NEGM){ _Pragma("unroll") for(int r=0;r<16;++r)negm[r]=-mhat; asm volatile("":"+v"(negm)); } \
        const float f=__builtin_amdgcn_exp2f(-dl); l_reg*=f; if(hi==0)wsf[r32]=f; resc=true; } } \
    SBAR(); \
    GAPB(o[0]=__builtin_amdgcn_mfma_f32_32x32x16_bf16(PAF(0),VFR(0),o[0],0,0,0), C0,0); \
    GAPB(o[1]=__builtin_amdgcn_mfma_f32_32x32x16_bf16(PAF(0),VFR(4),o[1],0,0,0), C0,4); \
    KRD(GL,0); GAPB(o[0]=__builtin_amdgcn_mfma_f32_32x32x16_bf16(PAF(1),VFR(1),o[0],0,0,0), C0,8); \
    KRD(GL,1); GAPB(o[1]=__builtin_amdgcn_mfma_f32_32x32x16_bf16(PAF(1),VFR(5),o[1],0,0,0), C0,12); \
    KRD(GL,2); GAPB(o[0]=__builtin_amdgcn_mfma_f32_32x32x16_bf16(PAF(2),VFR(2),o[0],0,0,0), C1,0); \
    KRD(GL,3); GAPB(o[1]=__builtin_amdgcn_mfma_f32_32x32x16_bf16(PAF(2),VFR(6),o[1],0,0,0), C1,4); \
    GAPB(o[0]=__builtin_amdgcn_mfma_f32_32x32x16_bf16(PAF(3),VFR(3),o[0],0,0,0), C1,8); \
    GAPB(o[1]=__builtin_amdgcn_mfma_f32_32x32x16_bf16(PAF(3),VFR(7),o[1],0,0,0), C1,12); \
    }while(0)
  int t=1;
  #undef CMASK
  #define CMASK(P0,P1,t) do{}while(0)
  const int t_tbl=MOBA?0:((q0>=853)?((q0-853)/64+1):0);
  for(;t+5<NT&&t+1<t_tbl;t+=2){
    STEP(pB0,pB1,pA0,pA1,t,true,true,true);     WAIT_BAR(2); RESC(); ROT();
    STEP(pA0,pA1,pB0,pB1,t+1,true,true,true);   WAIT_BAR(2); RESC(); ROT();
  }
  #undef CMASK
  #define CMASK(P0,P1,t) do{ int D0_=qpos-64*TMAP(t)-4*hi; D0_=D0_<1083?D0_:1083; int bi_=D0_+(256-59); \
      if(MOBA){ if(!((selmask>>(TMAP(t)>>2))&1u))bi_=64; } const volatile lds_f32*tp_=Tl+bi_; \
      { float tb_[TBATCH]; _Pragma("unroll") for(int b0_=0;b0_<16;b0_+=TBATCH){ _Pragma("unroll") for(int r=0;r<TBATCH;++r)tb_[r]=tp_[59-(((b0_+r)&3)+8*((b0_+r)>>2))]; _Pragma("unroll") for(int r=0;r<TBATCH;++r)P0[b0_+r]=fadd_s(P0[b0_+r],tb_[r]); } \
        _Pragma("unroll") for(int b0_=0;b0_<16;b0_+=TBATCH){ _Pragma("unroll") for(int r=0;r<TBATCH;++r)tb_[r]=tp_[27-(((b0_+r)&3)+8*((b0_+r)>>2))]; _Pragma("unroll") for(int r=0;r<TBATCH;++r)P1[b0_+r]=fadd_s(P1[b0_+r],tb_[r]); } } }while(0)
  #define ENDW(tt) do{ if((tt)+3<NT){WAIT_BAR(2);} else if((tt)+2<NT){WAIT_BAR(1);} else {WAIT_BAR(0);} }while(0)
  for(;t+1<NT;t+=2){
    STEP(pB0,pB1,pA0,pA1,t,(t+3<NT),(t+1<NT),(t+1<NT));       ENDW(t);   RESC(); ROT();
    STEP(pA0,pA1,pB0,pB1,t+1,(t+4<NT),(t+2<NT),(t+2<NT));     ENDW(t+1); RESC(); ROT();
  }
  STEP(pB0,pB1,pA0,pA1,NT-1,false,false,false); RESC();
  { float sacc=pB0[0]+pB0[1]; _Pragma("unroll") for(int r=2;r<16;++r)sacc+=pB0[r]; _Pragma("unroll") for(int r=0;r<16;++r)sacc+=pB1[r]; l_reg+=sacc;
    pw0=(u32x4){PKW(pB0,0),PKW(pB0,2),PKW(pB0,4),PKW(pB0,6)};pw1=(u32x4){PKW(pB0,8),PKW(pB0,10),PKW(pB0,12),PKW(pB0,14)};pw2=(u32x4){PKW(pB1,0),PKW(pB1,2),PKW(pB1,4),PKW(pB1,6)};pw3=(u32x4){PKW(pB1,8),PKW(pB1,10),PKW(pB1,12),PKW(pB1,14)};
    SBAR(); pv(o,vb0+sl_cur,PAF(0),PAF(1),PAF(2),PAF(3)); }
  #undef PKW
  #undef PAF
  #undef VFR
  #undef PIN
  #undef MX3
  #undef GAPA
  #undef GAPB
  #undef EX
  #undef VRD
  #undef KRD
  #undef STEP
  #undef ENDW
  {auto rr=__builtin_amdgcn_permlane32_swap(__float_as_uint(l_reg),__float_as_uint(l_reg),false,false);l_reg=__uint_as_float(rr[0])+__uint_as_float(rr[1]);}
  if(hi==0)wsf[32+r32]=l_reg;asm volatile("s_waitcnt lgkmcnt(0)":::"memory");
  float rli[16];
  #pragma unroll
  for(int r=0;r<16;++r)rli[r]=__builtin_amdgcn_rcpf(wsf[32+crow(r,hi)]);
  bf16*Ow=Ob+(long)(q0+wid*QBLK)*opitch;
  { bf16*stg=(bf16*)(shm+LDS_OST)+wid*2048;
    #pragma unroll
    for(int r=0;r<16;++r){const int orow=crow(r,hi);
      #pragma unroll
      for(int d0=0;d0<2;++d0)stg[orow*64+d0*32+r32]=__float2bfloat16(o[d0][r]*rli[r]);}
    asm volatile("s_waitcnt lgkmcnt(0)":::"memory");
    #pragma unroll
    for(int i=0;i<4;++i){const int row=i*8+(lane>>3),ch=lane&7; const u32x4 v=*(const u32x4*)(stg+row*64+ch*8); ATTN_STORE16(Ow+(long)row*opitch+ch*8,v);} }
  asm volatile("s_waitcnt lgkmcnt(0)\n\ts_barrier":::"memory");
  #undef DMA_K
  #undef DMA_V
  #undef TMAP
  #undef NEGMC
  #undef CMASK
  #undef START
  #undef RESC
  #undef ROT
}

constexpr int DV_K=0, DV_V=NSLOT*SLOTB, DV_VSLOT=2*SLOTB, DV_WS=DV_V+NSLOT*DV_VSLOT, DV_OST=0;
static_assert(DV_WS+NW*64*4<=LDS_TBL && NW*8192<=DV_WS, "dv unit LDS layout");
template<int THRL> __device__ __forceinline__ void attn_unit_dv(int tid,int qb,const bf16*Qb,int qpitch,const bf16*__restrict__ Kb,int kpitch,const bf16*__restrict__ Vb,int vpitch,bf16*Ob,int opitch,int hh,char*shm){
  const int lane=tid&63,r32=lane&31,hi=lane>>5; const int wid=__builtin_amdgcn_readfirstlane(tid>>6);
  const int q0=qb*QB;
  const bf16*Qw=Qb+(long)(q0+wid*QBLK)*qpitch;
  const int qpos=q0+wid*QBLK+r32;
  typedef __attribute__((address_space(3))) float lds_f32;
  const lds_cptr shm3=(lds_cptr)shm;
  const lds_f32*Tl=(const lds_f32*)(shm3+LDS_TBL)+hh*TBL_N;
  lds_f32*wsf=(lds_f32*)(shm3+DV_WS)+wid*64;
  const unsigned lds0=(unsigned)(uintptr_t)shm;
  const bf16*ksrc=Kb+(long)lane*kpitch+wid*8;
  const bf16*vsrc=Vb+(long)(16*(wid&3)+(lane>>2))*vpitch+(wid>>2)*32+(lane&3)*8;
  const unsigned kdst=lds0+DV_K+wid*1024, vdst=lds0+DV_V+wid*1024;
  #define DVK(t,slot) glds16(ksrc+(long)(t)*KVBLK*kpitch,(unsigned)__builtin_amdgcn_readfirstlane(kdst+(slot)))
  #define DVV(t,slot) do{ glds16(vsrc+(long)(t)*KVBLK*vpitch,(unsigned)__builtin_amdgcn_readfirstlane(vdst+2*(slot))); glds16(vsrc+(long)(t)*KVBLK*vpitch+64,(unsigned)__builtin_amdgcn_readfirstlane(vdst+2*(slot)+8192)); }while(0)
  const lds_cptr kp0=shm3+DV_K+hi*1024+r32*16; const lds_cptr vp0=shm3+DV_V+((lane>>4)&1)*32+(lane&3)*8+(4*hi+((lane&15)>>2))*64;
  const int NT=(q0+QB)/KVBLK;
  DVK(0,0);DVV(0,0);DVK(1,SLOTB);
  bf16x8 qr[4];
  #pragma unroll
  for(int d0=0;d0<4;++d0)qr[d0]=*reinterpret_cast<const bf16x8*>(&Qw[(long)r32*qpitch+d0*16+hi*8]);
  float mhat=0.f,l_reg=0.f; f32x16 o[4]; o[0]=f32x16{};o[1]=f32x16{};o[2]=f32x16{};o[3]=f32x16{};
  const int t_tbl=(q0>=853)?((q0-853)/64+1):0;
  #define DV_CMASK(P0,P1,t) do{ int D0_=qpos-64*(t)-4*hi; D0_=D0_<1083?D0_:1083; const volatile lds_f32*tp_=Tl+(D0_+(256-59)); \
      { float tb_[8]; _Pragma("unroll") for(int b0_=0;b0_<16;b0_+=8){ _Pragma("unroll") for(int r=0;r<8;++r)tb_[r]=tp_[59-(((b0_+r)&3)+8*((b0_+r)>>2))]; _Pragma("unroll") for(int r=0;r<8;++r)P0[b0_+r]=fadd_s(P0[b0_+r],tb_[r]); } \
        _Pragma("unroll") for(int b0_=0;b0_<16;b0_+=8){ _Pragma("unroll") for(int r=0;r<8;++r)tb_[r]=tp_[27-(((b0_+r)&3)+8*((b0_+r)>>2))]; _Pragma("unroll") for(int r=0;r<8;++r)P1[b0_+r]=fadd_s(P1[b0_+r],tb_[r]); } } }while(0)
  #define DV_MX3(a,b,c) __builtin_fmaxf(__builtin_fmaxf((a),(b)),(c))
  #define DV_ROWMAX(rm,C0,C1) do{ float a=DV_MX3(C0[0],C0[1],C1[0]),b=DV_MX3(C0[2],C0[3],C1[1]); a=DV_MX3(a,C1[2],C1[3]); \
      _Pragma("unroll") for(int r=4;r<16;r+=4){a=DV_MX3(a,C0[r],C0[r+1]);b=DV_MX3(b,C0[r+2],C0[r+3]);a=DV_MX3(a,C1[r],C1[r+1]);b=DV_MX3(b,C1[r+2],C1[r+3]);} \
      rm=__builtin_fmaxf(a,b); { auto rr=__builtin_amdgcn_permlane32_swap(__float_as_uint(rm),__float_as_uint(rm),false,false); rm=__builtin_fmaxf(__uint_as_float(rr[0]),__uint_as_float(rr[1])); } }while(0)
  u32x4 pw0,pw1,pw2,pw3;
  #define DV_PKW(P,B) cvtpk_s(P[B],P[B+1])
  #define DV_SUM_PACK(C0,C1) do{ float sa_=fadd_s(C0[0],C0[1]),sb_=fadd_s(C1[0],C1[1]); _Pragma("unroll") for(int r=2;r<16;++r){ sa_=fadd_s(sa_,C0[r]); sb_=fadd_s(sb_,C1[r]); } l_reg+=fadd_s(sa_,sb_); \
      pw0=(u32x4){DV_PKW(C0,0),DV_PKW(C0,2),DV_PKW(C0,4),DV_PKW(C0,6)};pw1=(u32x4){DV_PKW(C0,8),DV_PKW(C0,10),DV_PKW(C0,12),DV_PKW(C0,14)}; \
      pw2=(u32x4){DV_PKW(C1,0),DV_PKW(C1,2),DV_PKW(C1,4),DV_PKW(C1,6)};pw3=(u32x4){DV_PKW(C1,8),DV_PKW(C1,10),DV_PKW(C1,12),DV_PKW(C1,14)}; }while(0)
  #define DV_PAF(k) __builtin_bit_cast(bf16x8,pw##k)
  #define DV_VFR(i) (bf16x8){vlo[i][0],vlo[i][1],vlo[i][2],vlo[i][3],vhi[i][0],vhi[i][1],vhi[i][2],vhi[i][3]}
  #define DV_VRD(n) do{ vlo[(n)&3]=vtr(vp_+((2*((n)>>3)+((n)&1))*4096+(((n)&7)>>1)*1024)); vhi[(n)&3]=vtr(vp_+((2*((n)>>3)+((n)&1))*4096+(((n)&7)>>1)*1024+512)); }while(0)
  #define DV_PIN(x) asm volatile("":"+v"(x))
  #define DV_KRD(j) do{ if(gv){ kload2(kf,kp0+sl_next,j); } }while(0)
  #define DV_EX(v) __builtin_amdgcn_exp2f(v)
  #define DV_GAP(n,X,B,RD) do{ o[2*((n)>>3)+((n)&1)]=__builtin_amdgcn_mfma_f32_32x32x16_bf16((((n)&7)>>1)==0?DV_PAF(0):((((n)&7)>>1)==1?DV_PAF(1):((((n)&7)>>1)==2?DV_PAF(2):DV_PAF(3))),DV_VFR((n)&3),o[2*((n)>>3)+((n)&1)],0,0,0); \
      X[B]=DV_EX(X[B]); X[B+1]=DV_EX(X[B+1]); DV_PIN(X); RD; SBAR(); }while(0)
  #define DV_SOFT1(C0,C1,t) do{ { const float d_=__builtin_fmaxf(C0[15],C1[15]); asm volatile(""::"v"(d_)); asm volatile("":"+v"(C0),"+v"(C1)); }     \
      if(mnz){ _Pragma("unroll") for(int r=0;r<16;++r){C0[r]=fsub_s(C0[r],mhat);C1[r]=fsub_s(C1[r],mhat);} } \
      if((t)>=t_tbl) DV_CMASK(C0,C1,t); \
      { float rm; DV_ROWMAX(rm,C0,C1); resc=false; \
        if(__builtin_expect(__any(rm>(float)THRL),0)){ const float dl=__builtin_fmaxf(rm,0.f); mhat+=dl; \
          _Pragma("unroll") for(int r=0;r<16;++r){C0[r]=fsub_s(C0[r],dl);C1[r]=fsub_s(C1[r],dl);} \
          const float f=__builtin_amdgcn_exp2f(-dl); l_reg*=f; if(hi==0)wsf[r32]=f; resc=true; mnz=true; } } }while(0)
  #define DV_RESC() do{ if(resc){ asm volatile("s_waitcnt lgkmcnt(0)":::"memory"); \
      _Pragma("unroll") for(int r=0;r<16;++r){ const float fr_=wsf[crow(r,hi)]; o[0][r]*=fr_;o[1][r]*=fr_;o[2][r]*=fr_;o[3][r]*=fr_; } asm volatile("s_waitcnt lgkmcnt(0)":::"memory"); } }while(0)
  int sl_prev=0,sl_cur=0,sl_next=SLOTB;
  #define DV_ROT() do{sl_prev=sl_cur;sl_cur=sl_next;sl_next=(sl_next==(NSLOT-1)*SLOTB)?0:sl_next+SLOTB;}while(0)
  DVK(2,2*SLOTB);
  WAIT_BAR(3);
  f32x16 pA0,pA1,pB0,pB1; bf16x8 kf[8]; s16x4 vlo[4],vhi[4]; bool resc=false,mnz=false;
  { const f32x16 z=f32x16{}; qkt(pA0,pA1,shm+DV_K,qr,z,r32,hi);
    DV_SOFT1(pA0,pA1,0);
    _Pragma("unroll") for(int r=0;r<16;++r){pA0[r]=DV_EX(pA0[r]);pA1[r]=DV_EX(pA1[r]);} }
  WAIT_BAR(0);
  DVK(3,0);DVV(1,SLOTB);
  DV_ROT();
  kload8(kf,kp0+sl_cur);
  WAIT_BAR(3);
  #define DV_GAPA(MF,A0,A1,A2,A3,W0,W1,PW) do{ MF; sacc+=A0; sacc+=A1; sacc+=A2; sacc+=A3; DV_PIN(sacc); W0; W1; DV_PIN(PW); SBAR(); }while(0)
  #define DV_Z f32x16{}
  #define DV_STEP(C0,C1,P0,P1,t) do{ const bool gk=((t)+3<NT), gv=((t)+1<NT); const lds_cptr vp_=vp0+2*sl_prev; SBAR(); \
    float sacc=(P0[0]+P0[1]); \
    DV_VRD(0); SBAR(); DV_GAPA(C0=__builtin_amdgcn_mfma_f32_32x32x16_bf16(kf[0],qr[0],DV_Z,0,0,0), P0[2],P0[3],P0[4],P0[5],     pw0[0]=DV_PKW(P0,0), pw0[1]=DV_PKW(P0,2), pw0); \
    DV_VRD(1); SBAR(); DV_GAPA(C1=__builtin_amdgcn_mfma_f32_32x32x16_bf16(kf[1],qr[0],DV_Z,0,0,0), P0[6],P0[7],P0[8],P0[9],     pw0[2]=DV_PKW(P0,4), pw0[3]=DV_PKW(P0,6), pw0); \
    DV_VRD(2); SBAR(); DV_GAPA(C0=__builtin_amdgcn_mfma_f32_32x32x16_bf16(kf[2],qr[1],C0,0,0,0),   P0[10],P0[11],P0[12],P0[13], pw1[0]=DV_PKW(P0,8), pw1[1]=DV_PKW(P0,10), pw1); \
    DV_VRD(3); SBAR(); DV_GAPA(C1=__builtin_amdgcn_mfma_f32_32x32x16_bf16(kf[3],qr[1],C1,0,0,0),   P0[14],P0[15],P1[0],P1[1],   pw1[2]=DV_PKW(P0,12),pw1[3]=DV_PKW(P0,14), pw1); \
    DV_GAPA(C0=__builtin_amdgcn_mfma_f32_32x32x16_bf16(kf[4],qr[2],C0,0,0,0),   P1[2],P1[3],P1[4],P1[5],     pw2[0]=DV_PKW(P1,0), pw2[1]=DV_PKW(P1,2), pw2); \
    DV_GAPA(C1=__builtin_amdgcn_mfma_f32_32x32x16_bf16(kf[5],qr[2],C1,0,0,0),   P1[6],P1[7],P1[8],P1[9],     pw2[2]=DV_PKW(P1,4), pw2[3]=DV_PKW(P1,6), pw2); \
    DV_GAPA(C0=__builtin_amdgcn_mfma_f32_32x32x16_bf16(kf[6],qr[3],C0,0,0,0),   P1[10],P1[11],P1[12],P1[13], pw3[0]=DV_PKW(P1,8), pw3[1]=DV_PKW(P1,10), pw3); \
    DV_GAPA(C1=__builtin_amdgcn_mfma_f32_32x32x16_bf16(kf[7],qr[3],C1,0,0,0),   P1[14],P1[15],0.f,0.f,       pw3[2]=DV_PKW(P1,12),pw3[3]=DV_PKW(P1,14), pw3); \
    l_reg+=sacc; \
    if(gk){DVK((t)+3,sl_cur);} if(gv){DVV((t)+1,sl_next);} \
    DV_SOFT1(C0,C1,t); \
    SBAR(); \
    DV_GAP(0,C0,0,  DV_VRD(4));   DV_GAP(1,C0,2,  DV_VRD(5));   DV_GAP(2,C0,4,  DV_VRD(6));   DV_GAP(3,C0,6,  DV_VRD(7)); \
    DV_GAP(4,C0,8,  DV_VRD(8));   DV_GAP(5,C0,10, DV_VRD(9));   DV_GAP(6,C0,12, DV_VRD(10));  DV_GAP(7,C0,14, DV_VRD(11)); \
    DV_GAP(8,C1,0,  DV_VRD(12));  DV_GAP(9,C1,2,  DV_VRD(13));  DV_GAP(10,C1,4, DV_VRD(14));  DV_GAP(11,C1,6, DV_VRD(15)); \
    DV_GAP(12,C1,8, DV_KRD(0));   DV_GAP(13,C1,10,DV_KRD(1));   DV_GAP(14,C1,12,DV_KRD(2));   DV_GAP(15,C1,14,DV_KRD(3)); \
    DV_RESC(); \
    if((t)+1<NT){ if((t)+3<NT){WAIT_BAR(3);} else if((t)+2<NT){WAIT_BAR(2);} else {WAIT_BAR(0);} DV_ROT(); } }while(0)
  { int t=1;
    for(;t+1<NT;t+=2){ DV_STEP(pB0,pB1,pA0,pA1,t); DV_STEP(pA0,pA1,pB0,pB1,t+1); }
    DV_STEP(pB0,pB1,pA0,pA1,t); }
  #undef DV_GAPA
  #undef DV_Z
  #undef DV_STEP
  DV_SUM_PACK(pB0,pB1);
  { const lds_cptr vp_=vp0+2*sl_cur;
    _Pragma("unroll") for(int n0=0;n0<16;n0+=4){
      _Pragma("unroll") for(int q=0;q<4;++q) DV_VRD(n0+q);
      _Pragma("unroll") for(int q=0;q<4;++q){ const int n=n0+q, kg=(n&7)>>1; const bf16x8 pa_=kg==0?DV_PAF(0):(kg==1?DV_PAF(1):(kg==2?DV_PAF(2):DV_PAF(3)));
        o[2*(n>>3)+(n&1)]=__builtin_amdgcn_mfma_f32_32x32x16_bf16(pa_,DV_VFR(n&3),o[2*(n>>3)+(n&1)],0,0,0); } } }
  asm volatile("s_waitcnt lgkmcnt(0)\n\ts_barrier":::"memory");
  {auto rr=__builtin_amdgcn_permlane32_swap(__float_as_uint(l_reg),__float_as_uint(l_reg),false,false);l_reg=__uint_as_float(rr[0])+__uint_as_float(rr[1]);}
  if(hi==0)wsf[32+r32]=l_reg;asm volatile("s_waitcnt lgkmcnt(0)":::"memory");
  float rli[16];
  #pragma unroll
  for(int r=0;r<16;++r)rli[r]=__builtin_amdgcn_rcpf(wsf[32+crow(r,hi)]);
  bf16*Ow=Ob+(long)(q0+wid*QBLK)*opitch;
  { bf16*stg=(bf16*)(shm+DV_OST)+wid*4096;
    #pragma unroll
    for(int r=0;r<16;++r){const int orow=crow(r,hi);
      #pragma unroll
      for(int d0=0;d0<4;++d0)stg[orow*128+d0*32+r32]=__float2bfloat16(o[d0][r]*rli[r]);}
    asm volatile("s_waitcnt lgkmcnt(0)":::"memory");
    #pragma unroll
    for(int i=0;i<8;++i){const int row=i*4+(lane>>4),ch=lane&15; const u32x4 v=*(const u32x4*)(stg+row*128+ch*8); ATTN_STORE16(Ow+(long)row*opitch+ch*8,v);} }
  asm volatile("s_waitcnt lgkmcnt(0)\n\ts_barrier":::"memory");
  #undef DVK
  #undef DVV
  #undef DV_CMASK
  #undef DV_MX3
  #undef DV_ROWMAX
  #undef DV_PKW
  #undef DV_SUM_PACK
  #undef DV_VFR
  #undef DV_VRD
  #undef DV_PIN
  #undef DV_EX
  #undef DV_GAP
  #undef DV_KRD
  #undef DV_SOFT1
  #undef DV_RESC
  #undef DV_PAF
  #undef DV_ROT
}
constexpr int ATTN_LDS_BYTES=LDS_BYTES;
#undef SBAR
#undef WAIT_BAR
}
#define GAS __attribute__((address_space(1)))
#define LAS __attribute__((address_space(3)))
typedef unsigned short bf16;
typedef unsigned v4u __attribute__((ext_vector_type(4)));
typedef float f32x4 __attribute__((ext_vector_type(4)));
typedef short bf16x8 __attribute__((ext_vector_type(8)));
typedef GAS unsigned gu32;
typedef GAS unsigned long long gu64;
#define RLX_AGENT __ATOMIC_RELAXED, __HIP_MEMORY_SCOPE_AGENT
#define LDS_WAIT() asm volatile("s_waitcnt lgkmcnt(0)" ::: "memory")
#define VM_WAIT() asm volatile("s_waitcnt vmcnt(0)" ::: "memory")
__device__ __forceinline__ unsigned long long rt() { return __builtin_amdgcn_s_memrealtime(); }
__device__ __forceinline__ unsigned f2bf(float f) { unsigned u = __builtin_bit_cast(unsigned, f); return (u + 0x7fffu + ((u >> 16) & 1u)) >> 16; }
__device__ __forceinline__ unsigned pk2(float lo, float hi) { return f2bf(lo) | (f2bf(hi) << 16); }

#define XB_TMO      128
#define XB_XCNT(j)  (256  + 64 * (j))
#define XB_XSUB(j)  (1280 + 64 * (j))
#define XB_XGEN(j)  (2304 + 64 * (j))
#define XB_TOP      3328
#define XB_TOPGEN   3392
#define XB_LSUB(j)  (3456 + 64 * (j))
#define XB_LGEN(j)  (4480 + 64 * (j))
#define XCD_BAR_WORDS 5504
#define XB_SPIN_CAP (1u << 25)

__device__ __forceinline__ unsigned xb_ld(unsigned* p)              { return __hip_atomic_load(p, __ATOMIC_RELAXED, __HIP_MEMORY_SCOPE_AGENT); }
__device__ __forceinline__ unsigned xb_add(unsigned* p, unsigned v) { return __hip_atomic_fetch_add(p, v, __ATOMIC_RELAXED, __HIP_MEMORY_SCOPE_AGENT); }
__device__ __forceinline__ unsigned xb_xcc_id() { return (unsigned)__builtin_amdgcn_s_getreg((3 << 11) | 20) & 0xFu; }
#define XB_SPIN(cond, bar) do { unsigned _sp = 0; while (cond) { __builtin_amdgcn_s_sleep(1); \
    if ((++_sp & 255u) == 0u) { if (xb_ld(&(bar)[XB_TMO])) break; if (_sp > XB_SPIN_CAP) { atomicAdd(&(bar)[XB_TMO], 1u); break; } } } } while (0)

struct XcdBarrier {
    unsigned* bar; unsigned x;
    volatile LAS unsigned* st;
};

__device__ __forceinline__ XcdBarrier xcd_barrier_post(unsigned* bar, volatile LAS unsigned* st) {
    XcdBarrier b; b.bar = bar; b.x = xb_xcc_id(); b.st = st;
    if (threadIdx.x == 0) st[2] = xb_add(&bar[XB_XCNT(b.x)], 1u);
    return b;
}
__device__ __forceinline__ void xcd_barrier_complete(unsigned* bar, unsigned x, unsigned& nloc, unsigned& nx) {
    const unsigned G = gridDim.x * gridDim.y * gridDim.z;
    unsigned sum, cnt, mine, sp = 0u;
    for (;;) {
        sum = 0u; cnt = 0u; mine = 0u;
#pragma nounroll
        for (unsigned j = 0; j < 16; ++j) { const unsigned c = xb_ld(&bar[XB_XCNT(j)]); sum += c; cnt += (c > 0u) ? 1u : 0u; mine = (j == x) ? c : mine; }
        if (sum == G) break;
        __builtin_amdgcn_s_sleep(1);
        if ((++sp & 255u) == 0u) { if (xb_ld(&bar[XB_TMO])) break; if (sp > XB_SPIN_CAP) { atomicAdd(&bar[XB_TMO], 1u); break; } }
    }
    nloc = mine > 0u ? mine : 1u; nx = cnt > 0u ? cnt : 1u;
}

__device__ __forceinline__ void xcd_barrier(const XcdBarrier& b) {
    asm volatile("s_waitcnt vmcnt(0)" ::: "memory");
    __syncthreads();
    if (threadIdx.x == 0) {
        unsigned* bar; { GAS unsigned* bl_ = (GAS unsigned*)b.bar; asm volatile("" : "+s"(bl_)); bar = (unsigned*)bl_; } unsigned bx_ = b.x; asm volatile("" : "+s"(bx_));
        __builtin_amdgcn_s_waitcnt(0);
        unsigned nloc = b.st[0], nx = b.st[1];
        if (nloc == 0u) { xcd_barrier_complete(bar, bx_, nloc, nx); b.st[0] = nloc; b.st[1] = nx; }
        const unsigned old = xb_add(&bar[XB_XSUB(bx_)], 1u);
        const unsigned gen = old / nloc;
        if (old + 1u == (gen + 1u) * nloc) {
            __builtin_amdgcn_fence(__ATOMIC_RELEASE, "agent");
            asm volatile("s_waitcnt vmcnt(0)" ::: "memory");
            const unsigned og = xb_add(&bar[XB_TOP], 1u);
            const unsigned tg = og / nx;
            if (og + 1u == (tg + 1u) * nx) xb_add(&bar[XB_TOPGEN], 1u);
            else XB_SPIN(xb_ld(&bar[XB_TOPGEN]) == tg, bar);
            __builtin_amdgcn_fence(__ATOMIC_ACQUIRE, "agent");
            xb_add(&bar[XB_XGEN(bx_)], 1u);
            asm volatile("s_waitcnt vmcnt(0)" ::: "memory");
        } else {
            XB_SPIN(xb_ld(&bar[XB_XGEN(bx_)]) == gen, bar);
            __builtin_amdgcn_fence(__ATOMIC_ACQUIRE, "agent");
            asm volatile("s_waitcnt vmcnt(0)" ::: "memory");
        }
    }
    __syncthreads();
}

__device__ __forceinline__ void xcd_census_regular(const XcdBarrier& b) {
    if (threadIdx.x == 0) { bool reg = (gridDim.x == 256u);
#pragma nounroll
        for (unsigned j = 0; j < 16; ++j) { const unsigned c = xb_ld(&b.bar[XB_XCNT(j)]); if (c != (j < 8u ? 32u : 0u)) reg = false; }
        b.st[3] = reg ? 1u : 0u; }
    __syncthreads();
}
__device__ __forceinline__ void xcd_local_barrier(const XcdBarrier& b) {
    asm volatile("s_waitcnt vmcnt(0)" ::: "memory");
    __syncthreads();
    if (threadIdx.x == 0) {
        unsigned* bar; { GAS unsigned* bl_ = (GAS unsigned*)b.bar; asm volatile("" : "+s"(bl_)); bar = (unsigned*)bl_; } unsigned bx_ = b.x; asm volatile("" : "+s"(bx_));
        __builtin_amdgcn_s_waitcnt(0);
        const unsigned nloc = b.st[0];
        const unsigned old = xb_add(&bar[XB_LSUB(bx_)], 1u);
        const unsigned gen = old / nloc;
        if (old + 1u == (gen + 1u) * nloc) xb_add(&bar[XB_LGEN(bx_)], 1u);
        else XB_SPIN(xb_ld(&bar[XB_LGEN(bx_)]) == gen, bar);
        __builtin_amdgcn_fence(__ATOMIC_ACQUIRE, "agent");
        asm volatile("s_waitcnt vmcnt(0)" ::: "memory");
    }
    __syncthreads();
}
constexpr int NB = 4, SEQ = 4096, DM = 1024, M = NB * SEQ, NL = 4;
constexpr int NIN = 3328;
constexpr int NWAVES = 8;
#ifndef PG8_SP2
#define PG8_SP2 true
#endif
constexpr float LOG2E = 1.4426950408889634f;
constexpr float C2 = 0.125f * LOG2E;
constexpr int MOE_ROWS = 40960;
constexpr size_t MiB = 1u << 20;
constexpr size_t WS_CTL = 0, CTL_ZERO_BYTES = 1 * MiB;
constexpr size_t WS_MOD = 1 * MiB;
constexpr size_t WS_TB = WS_MOD + 512 * 1024;
constexpr size_t WS_LAM = WS_TB + 64 * 1024;
constexpr size_t WS_KMEAN = WS_LAM + 4096;
constexpr size_t WS_WIN = 2 * MiB;
constexpr size_t WS_WOUT = 28 * MiB;
constexpr size_t WS_W13 = 36 * MiB;
constexpr size_t WS_W2 = 292 * MiB;
constexpr size_t WS_HB = 420 * MiB;
constexpr size_t WS_XS = 452 * MiB, WS_HS = 532 * MiB, WS_YS = 572 * MiB;
constexpr size_t WS_SMALL = 652 * MiB;
constexpr size_t WS_QD = 656 * MiB, WS_KD = 672 * MiB, WS_VD = 688 * MiB, WS_QM = 704 * MiB, WS_KM = 712 * MiB, WS_VM = 720 * MiB;
constexpr size_t WS_PR = 728 * MiB;
constexpr size_t WS_MIX = 784 * MiB;
constexpr size_t WS_OD = 816 * MiB;
constexpr size_t WS_RW = 848 * MiB;
constexpr size_t WS_END = 960 * MiB;
constexpr int CW_BAR = 4096;
constexpr int CW_CNT = 16384;
constexpr int CW_CUR = 16384 + 1024;
constexpr int RING_BYTES = 131072, LDSCTL_OFF = RING_BYTES, MISC_OFF = LDSCTL_OFF + 320, TAB_OFF = LDSCTL_OFF + 1024;
constexpr int LDS_BYTES = 147456;
static_assert(WS_QD == pg8::EPI_WS_QD && WS_KD == pg8::EPI_WS_KD && WS_VD == pg8::EPI_WS_VD && WS_QM == pg8::EPI_WS_QM && WS_KM == pg8::EPI_WS_KM && WS_VM == pg8::EPI_WS_VM && WS_PR == pg8::EPI_WS_PR, "epilogue workspace map");
__device__ __forceinline__ float rl63(float v) { return __uint_as_float(__builtin_amdgcn_readlane(__float_as_uint(v), 63)); }
template <int CTRL, int ROWMASK> __device__ __forceinline__ float dpp_f(float oldv, float v) { return __int_as_float(__builtin_amdgcn_update_dpp(__float_as_int(oldv), __float_as_int(v), CTRL, ROWMASK, 0xf, false)); }
__device__ __forceinline__ float wave_sum(float v) {
    v += dpp_f<0xB1, 0xf>(0.f, v);
    v += dpp_f<0x4E, 0xf>(0.f, v);
    v += dpp_f<0x141, 0xf>(0.f, v);
    v += dpp_f<0x140, 0xf>(0.f, v);
    v += dpp_f<0x142, 0xa>(0.f, v);
    v += dpp_f<0x143, 0xc>(0.f, v);
    return rl63(v);
}
__device__ __forceinline__ float wave_max(float v) {
    v = fmaxf(v, dpp_f<0xB1, 0xf>(v, v)); v = fmaxf(v, dpp_f<0x4E, 0xf>(v, v)); v = fmaxf(v, dpp_f<0x141, 0xf>(v, v)); v = fmaxf(v, dpp_f<0x140, 0xf>(v, v));
    v = fmaxf(v, dpp_f<0x142, 0xa>(v, v)); v = fmaxf(v, dpp_f<0x143, 0xc>(v, v));
    return rl63(v);
}
__device__ __forceinline__ float bf_lo(unsigned u) { return __uint_as_float(u << 16); }
__device__ __forceinline__ float bf_hi(unsigned u) { return __uint_as_float(u & 0xffff0000u); }
__device__ __forceinline__ float bf2f(bf16 h) { return __uint_as_float((unsigned)h << 16); }
__device__ __forceinline__ float rl(float v, int i) { return __uint_as_float(__builtin_amdgcn_readlane(__float_as_uint(v), i)); }
__device__ __forceinline__ float sigmoidf_(float x) { return 1.0f / (1.0f + __expf(-x)); }

struct Frame {
    LAS unsigned char* lds; volatile LAS unsigned* MISC; gu32* ctl;
    int tid, lane, wave, vcu, G, gw, NGW;
    int xl, cf;
    float* out; unsigned char* ws;
};
__device__ __forceinline__ unsigned char* launder_ptr(unsigned char* p) {
    GAS unsigned char* g = (GAS unsigned char*)p; asm volatile("" : "+s"(g)); return (unsigned char*)g; }
#define GIN(i) ((const float*)(const GAS float*)A.in[i])
#define WSP(T, off) ((T*)(launder_ptr(F.ws) + (off)))

template <class RowMap>
__device__ __forceinline__ void tr_item(const float* W, int N, int K, bf16* WT, LAS float* scr, int k0, int n0, int lane, RowMap rm) {
#pragma unroll
    for (int i = 0; i < 8; ++i) { const int kk = 8 * i + (lane >> 3), c4 = lane & 7; const f32x4 x = *(const GAS f32x4*)(W + (size_t)(k0 + kk) * N + n0 + 4 * c4);
        LAS float* d = scr + kk * 33 + 4 * c4; d[0] = x.x; d[1] = x.y; d[2] = x.z; d[3] = x.w; }
    LDS_WAIT(); asm volatile("" ::: "memory");
    const int c = lane & 7;
#pragma unroll
    for (int j = 0; j < 4; ++j) { const int n = (lane >> 3) + 8 * j; const LAS float* s = scr + (8 * c) * 33 + n;
        v4u o; o.x = pk2(s[0 * 33], s[1 * 33]); o.y = pk2(s[2 * 33], s[3 * 33]); o.z = pk2(s[4 * 33], s[5 * 33]); o.w = pk2(s[6 * 33], s[7 * 33]);
        *(GAS v4u*)(WT + (size_t)rm(n0 + n) * K + k0 + 8 * c) = o; }
    LDS_WAIT(); asm volatile("" ::: "memory");
}
__device__ __forceinline__ int inproj_row(int n) {
    const int L = n < 896 ? 2304 + n : n - 896;
    const int l = L & 255;
    return (L & ~255) | (((l >> 5) & 1) << 7) | ((l >> 6) << 5) | (l & 31);
}
__device__ __forceinline__ int t5_bucket(int n) {
    if (n < 16) return n;
    const float x = (8.0f * __log2f((float)n) - 32.0f) * (1.0f / 3.0f) + 1e-4f;
    int b = 16 + (int)x; return b > 31 ? 31 : b;
}
struct TrDesc { const float* src; bf16* dst; int N, K, n0, kind; };
__device__ __forceinline__ TrDesc moe_tr_desc(KArgs& A, unsigned char* ws, int l, int r) {
    constexpr int I_W1 = 16 * 16, I_W2 = 8 * 32, N_W1 = 32 * I_W1;
    TrDesc d;
    if (r < 2 * N_W1) { const int which = r / N_W1; r %= N_W1; const int le = l * 32 + r / I_W1, q = r % I_W1, kb = q / 16, nb = q % 16;
        d.N = 512; d.K = 1024; d.n0 = 32 * nb; d.kind = which;
        d.src = (const float*)(const GAS float*)A.in[which ? 31 : 30] + (size_t)le * 1024 * 512 + (size_t)(64 * kb) * 512 + 32 * nb; d.dst = (bf16*)(ws + WS_W13) + (size_t)le * 1024 * 1024 + 64 * kb; }
    else { r -= 2 * N_W1; const int le = l * 32 + r / I_W2, q = r % I_W2, kb = q / 32, nb = q % 32;
        d.N = 1024; d.K = 512; d.n0 = 32 * nb; d.kind = 2;
        d.src = (const float*)(const GAS float*)A.in[32] + (size_t)le * 512 * 1024 + (size_t)(64 * kb) * 1024 + 32 * nb; d.dst = (bf16*)(ws + WS_W2) + (size_t)le * 1024 * 512 + 64 * kb; }
    return d;
}
__device__ __forceinline__ void moe_tr_load(const TrDesc& d, int lane, f32x4 (&x)[8]) {
#pragma unroll
    for (int i = 0; i < 8; ++i) x[i] = __builtin_nontemporal_load((const GAS f32x4*)(d.src + (size_t)(8 * i + (lane >> 3)) * d.N + 4 * (lane & 7)));
}
__device__ __forceinline__ void moe_tr_store(const TrDesc& d, int lane, const f32x4 (&x)[8], LAS float* scr) {
#pragma unroll
    for (int i = 0; i < 8; ++i) { const int kk = 8 * i + (lane >> 3), c4 = lane & 7; LAS float* p = scr + kk * 33 + 4 * c4; p[0] = x[i].x; p[1] = x[i].y; p[2] = x[i].z; p[3] = x[i].w; }
    LDS_WAIT(); asm volatile("" ::: "memory");
    const int c = lane & 7;
#pragma unroll
    for (int j = 0; j < 4; ++j) { const int n = (lane >> 3) + 8 * j; const LAS float* s = scr + (8 * c) * 33 + n;
        v4u o; o.x = pk2(s[0 * 33], s[1 * 33]); o.y = pk2(s[2 * 33], s[3 * 33]); o.z = pk2(s[4 * 33], s[5 * 33]); o.w = pk2(s[6 * 33], s[7 * 33]);
        const int nn = d.n0 + n, row = d.kind == 2 ? nn : 8 * (nn >> 2) + 4 * d.kind + (nn & 3);
        __builtin_nontemporal_store(o, (GAS v4u*)(d.dst + (size_t)row * d.K + 8 * c)); }
    LDS_WAIT(); asm volatile("" ::: "memory");
}
__device__ __forceinline__ void moe_convert_ticket(Frame& F, KArgs& A, int l, int ct) {
    int lane_ = F.lane, wv_ = F.wave; asm volatile("" : "+v"(lane_), "+s"(wv_));
    LAS float* scr = (LAS float*)(F.lds + wv_ * 8448);
    const int r0 = ct * 64 + wv_ * 8;
    f32x4 x0[8], x1[8], x2[8], x3[8];
    TrDesc d0 = moe_tr_desc(A, F.ws, l, r0), d1 = moe_tr_desc(A, F.ws, l, r0 + 1), d2 = moe_tr_desc(A, F.ws, l, r0 + 2), d3 = moe_tr_desc(A, F.ws, l, r0 + 3);
    moe_tr_load(d0, lane_, x0); moe_tr_load(d1, lane_, x1); moe_tr_load(d2, lane_, x2); moe_tr_load(d3, lane_, x3);
    moe_tr_store(d0, lane_, x0, scr); d0 = moe_tr_desc(A, F.ws, l, r0 + 4); moe_tr_load(d0, lane_, x0);
    moe_tr_store(d1, lane_, x1, scr); d1 = moe_tr_desc(A, F.ws, l, r0 + 5); moe_tr_load(d1, lane_, x1);
    moe_tr_store(d2, lane_, x2, scr); d2 = moe_tr_desc(A, F.ws, l, r0 + 6); moe_tr_load(d2, lane_, x2);
    moe_tr_store(d3, lane_, x3, scr); d3 = moe_tr_desc(A, F.ws, l, r0 + 7); moe_tr_load(d3, lane_, x3);
    moe_tr_store(d0, lane_, x0, scr); moe_tr_store(d1, lane_, x1, scr); moe_tr_store(d2, lane_, x2, scr); moe_tr_store(d3, lane_, x3, scr);
}
__device__ __forceinline__ void p0_prologue(Frame& F, KArgs& A) {
    LAS float* scr = (LAS float*)(F.lds + F.wave * 16384);
    {
        constexpr int I_IN = 16 * 100, I_OUT = 16 * 32, I_W1 = 16 * 16, I_W2 = 8 * 32;
        constexpr int N_IN = NL * I_IN, N_OUT = NL * I_OUT, N_W1 = NL * 32 * I_W1, N_W2 = NL * 32 * I_W2;
        constexpr int NITEMS = N_IN + N_OUT + 2 * N_W1 + N_W2;
        for (int it = F.gw; it < N_IN + N_OUT; it += F.NGW) {
            int r = it;
            if (r < N_IN) { const int l = r / I_IN, q = r % I_IN, kb = q / 100, nb = q % 100;
                tr_item(GIN(6) + (size_t)l * 1024 * 3200, 3200, 1024, WSP(bf16, WS_WIN) + (size_t)l * NIN * 1024, scr, 64 * kb, 32 * nb, F.lane, [](int n) { return inproj_row(n); }); continue; }
            r -= N_IN;
            if (r < N_OUT) { const int l = r / I_OUT, q = r % I_OUT, kb = q / 32, nb = q % 32;
                tr_item(GIN(7) + (size_t)l * 1024 * 1024, 1024, 1024, WSP(bf16, WS_WOUT) + (size_t)l * 1024 * 1024, scr, 64 * kb, 32 * nb, F.lane, [](int n) { return n; }); continue; }
            r -= N_OUT;
            if (r < 2 * N_W1) { const int which = r / N_W1; r %= N_W1; const int le = r / I_W1, q = r % I_W1, kb = q / 16, nb = q % 16;
                const float* W = A.in[which ? 31 : 30] + (size_t)le * 1024 * 512; bf16* WT = WSP(bf16, WS_W13) + (size_t)le * 1024 * 1024;
                if (which == 0) tr_item(W, 512, 1024, WT, scr, 64 * kb, 32 * nb, F.lane, [](int n) { return 8 * (n >> 2) + (n & 3); });
                else            tr_item(W, 512, 1024, WT, scr, 64 * kb, 32 * nb, F.lane, [](int n) { return 8 * (n >> 2) + 4 + (n & 3); });
                continue; }
            r -= 2 * N_W1;
            { const int le = r / I_W2, q = r % I_W2, kb = q / 32, nb = q % 32;
                tr_item(GIN(32) + (size_t)le * 512 * 1024, 1024, 512, WSP(bf16, WS_W2) + (size_t)le * 1024 * 512, scr, 64 * kb, 32 * nb, F.lane, [](int n) { return n; }); }
        }
    }
    __syncthreads();
    {
        LAS float* cs = (LAS float*)F.lds;
        for (int i = F.tid; i < 4096; i += 512) { const float v = GIN(1)[i]; cs[i] = v / (1.0f + __expf(-v)); }
        __syncthreads();
        const int kp = F.tid >> 5, jj = F.tid & 31;
        LAS float* red = cs + 4096;
        for (int it = F.vcu; it < NL * 192; it += F.G) {
            const int l = it / 192, j = (it % 192) * 32 + jj;
            const float* w = GIN(2) + (size_t)l * 1024 * 6144 + j;
            float a0 = 0.f, a1 = 0.f, a2 = 0.f, a3 = 0.f;
#pragma unroll 16
            for (int k = kp * 64; k < kp * 64 + 64; ++k) { const float wv = w[(size_t)k * 6144]; a0 += cs[k] * wv; a1 += cs[1024 + k] * wv; a2 += cs[2048 + k] * wv; a3 += cs[3072 + k] * wv; }
            red[(kp * 4 + 0) * 32 + jj] = a0; red[(kp * 4 + 1) * 32 + jj] = a1; red[(kp * 4 + 2) * 32 + jj] = a2; red[(kp * 4 + 3) * 32 + jj] = a3;
            __syncthreads();
            if (F.tid < 128) { const int b = F.tid >> 5; float s = GIN(3)[l * 6144 + j];
#pragma unroll
                for (int q = 0; q < 16; ++q) s += red[(q * 4 + b) * 32 + jj];
                WSP(float, WS_MOD)[((size_t)l * NB + b) * 6144 + j] = s; }
            __syncthreads();
        }
    }
    for (int i = F.gw * 64 + F.lane; i < 8 * 1024; i += F.NGW * 64) { const int hh = i >> 10, d = i & 1023; WSP(float, WS_TB)[i] = GIN(25)[t5_bucket(d) * 8 + hh] * LOG2E; }
    for (int i = F.gw * 64 + F.lane; i < NL * 1024 * 48; i += F.NGW * 64) { const int c = i % 48, lk = i / 48; float v = 0.f; if (c < 4) v = GIN(26)[(size_t)lk * 4 + c]; else if (c >= 16) v = GIN(28)[(size_t)lk * 32 + (c - 16)]; WSP(float, WS_SMALL + 2 * MiB)[i] = v; }
    for (int i = F.gw * 64 + F.lane; i < NL * 4 * 9728; i += F.NGW * 64) { const int lh = i / 9728, x = i % 9728, l = lh >> 2, h = lh & 3; float v = 0.f;
        if (x < 5120) { const int mtx = x / 2560, y = x % 2560, ch = y / 40, j = y % 40; if (j < 32) v = GIN(mtx ? 12 : 10)[((size_t)l * 32 + j) * 256 + h * 64 + ch]; }
        else { const int y = x - 5120, ch = y / 72, j = y % 72; if (j < 64) v = GIN(13)[((size_t)l * 64 + j) * 256 + h * 64 + ch]; }
        WSP(bf16, WS_SMALL + 3 * MiB)[i] = (bf16)f2bf(v); }
    if (F.vcu == 0 && F.tid < NL) { const int l = F.tid; const float* lm = GIN(21) + l * 256; float s01 = 0.f, s23 = 0.f;
        for (int i = 0; i < 64; ++i) { s01 += lm[i] * lm[64 + i]; s23 += lm[128 + i] * lm[192 + i]; }
        WSP(float, WS_LAM)[l] = __expf(s01) - __expf(s23) + (0.8f - 0.6f * __expf(-0.3f * (float)l)); }
}

__device__ __forceinline__ void phase_norm1(Frame& F, KArgs& A, int l) {
    const float* xin = (l == 0) ? GIN(0) : F.out;
    const bf16* YS = WSP(bf16, WS_YS); const int* POS = WSP(int, WS_SMALL) + 4 * M;
    const int nrow_ = F.xl ? 8 : (M + F.NGW - 1) / F.NGW;
    for (int k_ = 0; k_ < nrow_; ++k_) { const int m = F.xl ? F.vcu * 64 + F.wave * 8 + k_ : F.gw + k_ * F.NGW; if (m >= M) break;
        const int b = m / SEQ;
        f32x4 v[4];
#pragma unroll
        for (int j = 0; j < 4; ++j) v[j] = __builtin_nontemporal_load((const GAS f32x4*)(xin + (size_t)m * DM) + F.lane + 64 * j);
        if (l > 0) {
            const int p0 = POS[2 * m], p1 = POS[2 * m + 1];
            const float* g2 = WSP(float, WS_MOD) + ((size_t)(l - 1) * NB + b) * 6144 + 5 * 1024;
#pragma unroll
            for (int j = 0; j < 4; ++j) { const int c = 4 * (F.lane + 64 * j);
                const uint2 ya = *(const uint2*)(YS + (size_t)p0 * DM + c), yb = *(const uint2*)(YS + (size_t)p1 * DM + c);
                const f32x4 gg = *(const f32x4*)(g2 + c);
                v[j].x += gg.x * (bf_lo(ya.x) + bf_lo(yb.x)); v[j].y += gg.y * (bf_hi(ya.x) + bf_hi(yb.x));
                v[j].z += gg.z * (bf_lo(ya.y) + bf_lo(yb.y)); v[j].w += gg.w * (bf_hi(ya.y) + bf_hi(yb.y)); }
        }
        if (l == 0 || l > 0) {
#pragma unroll
            for (int j = 0; j < 4; ++j) __builtin_nontemporal_store(v[j], (GAS f32x4*)(F.out + (size_t)m * DM) + F.lane + 64 * j);
        }
        if (l == NL) continue;
        float ss = 0.f;
#pragma unroll
        for (int j = 0; j < 4; ++j) ss += (v[j].x * v[j].x + v[j].y * v[j].y) + (v[j].z * v[j].z + v[j].w * v[j].w);
        const float rstd = 1.0f / sqrtf(wave_sum(ss) * (1.0f / DM) + 1e-6f);
        const float* mod = WSP(float, WS_MOD) + ((size_t)l * NB + b) * 6144;
        const float* ng = GIN(4) + l * DM;
        bf16* hrow = WSP(bf16, WS_HB) + (size_t)m * DM;
#pragma unroll
        for (int j = 0; j < 4; ++j) { const int c = 4 * (F.lane + 64 * j);
            const f32x4 g = *(const f32x4*)(ng + c), sh = *(const f32x4*)(mod + c), sc = *(const f32x4*)(mod + 1024 + c);
            const float h0 = v[j].x * rstd * g.x * (1.f + sc.x) + sh.x, h1 = v[j].y * rstd * g.y * (1.f + sc.y) + sh.y;
            const float h2 = v[j].z * rstd * g.z * (1.f + sc.z) + sh.z, h3 = v[j].w * rstd * g.w * (1.f + sc.w) + sh.w;
            uint2 o; o.x = pk2(h0, h1); o.y = pk2(h2, h3); *(uint2*)(hrow + c) = o; }
    }
}
constexpr size_t WS_WEG = WS_SMALL + 2 * MiB;
__device__ __forceinline__ void moe_tables(Frame& F, KArgs& A, int l) {
    LAS int* base = (LAS int*)(F.lds + TAB_OFF); LAS int* t2e = base + 64;
    const unsigned* cnt = (const unsigned*)(F.ctl + CW_CNT + l * 64);
    if (F.tid == 0) { int acc = 0; for (int e = 0; e < 32; ++e) { base[e] = acc; const int c = (int)__hip_atomic_load(cnt + e, __ATOMIC_RELAXED, __HIP_MEMORY_SCOPE_AGENT); acc += (c + 255) / 256 * 256; } base[32] = acc; }
    __syncthreads();
    if (F.tid < 160) { const int r0 = F.tid * 256; int e = 31; for (int x = 0; x < 32; ++x) if (r0 >= base[x] && r0 < base[x + 1]) e = x; t2e[F.tid] = e; }
    __syncthreads();
}
__device__ __forceinline__ void phase_router(Frame& F, KArgs& A, int l, const XcdBarrier& bar) {
    typedef float f32x4_ __attribute__((ext_vector_type(4)));
    const float* bg = GIN(27) + l * 4; const float* be = GIN(29) + l * 32;
    const float* Wc = WSP(float, WS_WEG) + (size_t)l * 1024 * 48;
    int* SLT = WSP(int, WS_SMALL) + 4 * M; float* GS = WSP(float, WS_SMALL) + 6 * M;
    unsigned* cnt = (unsigned*)(F.ctl + CW_CNT + l * 64);
    constexpr int HP = 1028;
    LAS float* H = (LAS float*)F.lds; LAS float* part = (LAS float*)(F.lds + 65792); LAS float* LG = (LAS float*)(F.lds + 90368);
    LAS int* el_ = (LAS int*)(F.lds + 93440); LAS float* gl_ = (LAS float*)(F.lds + 93440 + 512); LAS int* off_ = (LAS int*)(F.lds + 93440 + 1024); LAS int* slot_ = (LAS int*)(F.lds + 93440 + 1536);
    const float* ng = GIN(5) + l * DM;
    const int t = F.lane & 15, kq = F.lane >> 4;
    float breg[3][32];
#pragma unroll
    for (int kk = 0; kk < 32; ++kk)
#pragma unroll
        for (int ct = 0; ct < 3; ++ct) breg[ct][kk] = Wc[(size_t)(128 * F.wave + 4 * kk + kq) * 48 + 16 * ct + t];
    const int vb = F.vcu; const bool hasvb = vb < M / 64;
    typedef unsigned v2u_ __attribute__((ext_vector_type(2)));
    v2u_ hk[8][4];
#pragma unroll
    for (int r = 0; r < 8; ++r)
#pragma unroll
        for (int j = 0; j < 4; ++j) { hk[r][j].x = 0u; hk[r][j].y = 0u; }
    if (hasvb) {
        for (int grp = 0; grp < 4; ++grp) {
            f32x4 v[2][4];
#pragma unroll
            for (int u = 0; u < 2; ++u) { const int m = vb * 64 + grp * 16 + 2 * F.wave + u;
#pragma unroll
                for (int j = 0; j < 4; ++j) v[u][j] = __builtin_nontemporal_load((const GAS f32x4*)(F.out + (size_t)m * DM) + F.lane + 64 * j); }
#pragma unroll
            for (int u = 0; u < 2; ++u) {
                const int tg = 2 * F.wave + u, m = vb * 64 + grp * 16 + tg, b = m / SEQ;
                float ss = 0.f;
#pragma unroll
                for (int j = 0; j < 4; ++j) ss += (v[u][j].x * v[u][j].x + v[u][j].y * v[u][j].y) + (v[u][j].z * v[u][j].z + v[u][j].w * v[u][j].w);
                const float rstd = 1.0f / sqrtf(wave_sum(ss) * (1.0f / DM) + 1e-6f);
                const float* mod = WSP(float, WS_MOD) + ((size_t)l * NB + b) * 6144;
#pragma unroll
                for (int j = 0; j < 4; ++j) { const int c = 4 * (F.lane + 64 * j);
                    const f32x4 g = *(const GAS f32x4*)(ng + c), sh = *(const GAS f32x4*)(mod + 3072 + c), sc = *(const GAS f32x4*)(mod + 4096 + c);
                    f32x4 h; h.x = v[u][j].x * rstd * g.x * (1.f + sc.x) + sh.x; h.y = v[u][j].y * rstd * g.y * (1.f + sc.y) + sh.y; h.z = v[u][j].z * rstd * g.z * (1.f + sc.z) + sh.z; h.w = v[u][j].w * rstd * g.w * (1.f + sc.w) + sh.w;
                    v2u_ o; o.x = pk2(h.x, h.y); o.y = pk2(h.z, h.w);
#pragma unroll
                    for (int g = 0; g < 4; ++g) if (grp == g) hk[2 * g + u][j] = o;
                    *(LAS f32x4*)(H + tg * HP + c) = h; }
            }
            LDS_WAIT(); __syncthreads();
            {
                f32x4_ acc0 = {0.f, 0.f, 0.f, 0.f}, acc1 = acc0, acc2 = acc0;
                const LAS float* hp = H + t * HP + 128 * F.wave + kq;
#pragma unroll
                for (int kk = 0; kk < 32; ++kk) { const float a = hp[4 * kk];
                    acc0 = __builtin_amdgcn_mfma_f32_16x16x4f32(a, breg[0][kk], acc0, 0, 0, 0); acc1 = __builtin_amdgcn_mfma_f32_16x16x4f32(a, breg[1][kk], acc1, 0, 0, 0); acc2 = __builtin_amdgcn_mfma_f32_16x16x4f32(a, breg[2][kk], acc2, 0, 0, 0); }
#pragma unroll
                for (int r = 0; r < 4; ++r) { LAS float* pp = part + (F.wave * 16 + 4 * kq + r) * 48 + t; pp[0] = acc0[r]; pp[16] = acc1[r]; pp[32] = acc2[r]; }
            }
            LDS_WAIT(); __syncthreads();
            for (int i = F.tid; i < 16 * 48; i += NWAVES * 64) { float sum = 0.f;
#pragma unroll
                for (int q = 0; q < 8; ++q) sum += part[q * 768 + i];
                LG[i] = sum; }
            LDS_WAIT(); __syncthreads();
            if (F.tid < 16) { const LAS float* lg = LG + F.tid * 48;
                float gl[4];
#pragma unroll
                for (int g = 0; g < 4; ++g) gl[g] = lg[g] + bg[g];
                int gs = 0; float gm = gl[0];
#pragma unroll
                for (int g = 1; g < 4; ++g) if (gl[g] > gm) { gm = gl[g]; gs = g; }
                float den = 0.f;
#pragma unroll
                for (int g = 0; g < 4; ++g) den += __expf(gl[g] - gm);
                const float pg = 1.0f / den;
                float el[8];
#pragma unroll
                for (int e = 0; e < 8; ++e) el[e] = lg[16 + gs * 8 + e] + be[gs * 8 + e];
                int e1 = 0; float m1 = el[0];
#pragma unroll
                for (int e = 1; e < 8; ++e) if (el[e] > m1) { m1 = el[e]; e1 = e; }
                int e2 = -1; float m2 = -INFINITY;
#pragma unroll
                for (int e = 0; e < 8; ++e) if (e != e1 && el[e] > m2) { m2 = el[e]; e2 = e; }
                const float ex = __expf(m2 - m1); const int tl = grp * 16 + F.tid;
                el_[2 * tl] = gs * 8 + e1; el_[2 * tl + 1] = gs * 8 + e2; gl_[2 * tl] = pg / (1.f + ex); gl_[2 * tl + 1] = pg * ex / (1.f + ex); }
            LDS_WAIT(); __syncthreads();
        }
        int rank = 0, mye = 0;
        if (F.tid < 128) { mye = el_[F.tid]; for (int a = 0; a < F.tid; ++a) rank += (el_[a] == mye) ? 1 : 0; }
        else if (F.tid < 160) { const int e = F.tid - 128; int c = 0; for (int a = 0; a < 128; ++a) c += (el_[a] == e) ? 1 : 0; off_[e] = c ? (int)atomicAdd(cnt + e, (unsigned)c) : 0; }
        LDS_WAIT(); __syncthreads();
        if (F.tid < 128) slot_[F.tid] = off_[mye] + rank;
        LDS_WAIT(); __syncthreads();
    }
    xcd_barrier(bar);
    moe_tables(F, A, l);
    {
        const LAS int* base = (const LAS int*)(F.lds + TAB_OFF);
        bf16* XS = WSP(bf16, WS_XS);
        if (hasvb) {
#pragma unroll
            for (int r = 0; r < 8; ++r) { const int tl = (r >> 1) * 16 + 2 * F.wave + (r & 1), m = vb * 64 + tl;
#pragma unroll
                for (int k = 0; k < 2; ++k) { const int pos = base[el_[2 * tl + k]] + slot_[2 * tl + k];
#pragma unroll
                    for (int j = 0; j < 4; ++j) __builtin_nontemporal_store(hk[r][j], (GAS v2u_*)(XS + (size_t)pos * DM + 4 * (F.lane + 64 * j)));
                    if (F.lane == 0) { SLT[2 * m + k] = pos; GS[pos] = gl_[2 * tl + k]; } } }
        }
        for (int it = F.gw; it < 32 * 256; it += F.NGW) { const int e = it >> 8, i = it & 255; const int c = (int)cnt[e]; const int npad = (c + 255) / 256 * 256 - c;
            if (i < npad) { const int pos = base[e] + c + i; const v4u z = {0u, 0u, 0u, 0u};
#pragma unroll
                for (int j = 0; j < 2; ++j) *((GAS v4u*)(XS + (size_t)pos * DM) + F.lane + 64 * j) = z;
                if (F.lane == 0) GS[pos] = 0.f; } }
    }
}
namespace rw {
typedef short bf16x8 __attribute__((ext_vector_type(8)));
typedef float f32x16 __attribute__((ext_vector_type(16)));
constexpr int PITCH = 144;
constexpr int SLOT = 64 * PITCH;
constexpr int GAM_OFF = 14 * SLOT;
constexpr size_t ITEM_BYTES = 49152;
__device__ __forceinline__ int crow(int r, int hi) { return (r & 3) + 8 * (r >> 2) + 4 * hi; }
__device__ __forceinline__ unsigned short f2b(float f) { unsigned u = __builtin_bit_cast(unsigned, f); return (unsigned short)((u + 0x7fffu + ((u >> 16) & 1u)) >> 16); }
__device__ __forceinline__ unsigned pk(float lo, float hi) { return (unsigned)f2b(lo) | ((unsigned)f2b(hi) << 16); }
__device__ __forceinline__ f32x16 tile_nt(LAS const unsigned char* A, int arow0, LAS const unsigned char* B, int brow0, f32x16 acc, int lane) {
    const int r = lane & 31, h = lane >> 5;
    LAS const unsigned char* ap = A + (arow0 + r) * PITCH + h * 16; LAS const unsigned char* bp = B + (brow0 + r) * PITCH + h * 16;
#pragma unroll
    for (int ks = 0; ks < 4; ++ks) { const bf16x8 a = *(LAS const bf16x8*)(ap + ks * 32), b = *(LAS const bf16x8*)(bp + ks * 32); acc = __builtin_amdgcn_mfma_f32_32x32x16_bf16(a, b, acc, 0, 0, 0); }
    return acc;
}
template <int MASK> __device__ __forceinline__ float maskv(float v, int row, int col) { if (MASK == 1) return row > col ? v : 0.f; if (MASK == 2) return row >= col ? v : 0.f; return v; }
template <int MASK> __device__ __forceinline__ void store_nat(LAS unsigned char* S, int r0, int c0, const f32x16& acc, float sc, int lane) {
    const int col = c0 + (lane & 31), hi = lane >> 5;
#pragma unroll
    for (int g = 0; g < 16; ++g) { const int row = r0 + crow(g, hi); *(LAS unsigned short*)(S + row * PITCH + col * 2) = f2b(maskv<MASK>(acc[g], row, col) * sc); }
}
template <int MASK> __device__ __forceinline__ void store_tr(LAS unsigned char* S, int r0, int c0, const f32x16& acc, int lane) {
    const int col = c0 + (lane & 31), hi = lane >> 5;
#pragma unroll
    for (int g = 0; g < 16; ++g) { const int row = r0 + crow(g, hi); *(LAS unsigned short*)(S + col * PITCH + row * 2) = f2b(maskv<MASK>(acc[g], row, col)); }
}
__device__ __forceinline__ f32x16 load_nat(LAS const unsigned char* S, int r0, int c0, int lane) {
    const int col = c0 + (lane & 31), hi = lane >> 5; f32x16 a;
#pragma unroll
    for (int g = 0; g < 16; ++g) a[g] = __uint_as_float((unsigned)*(LAS const unsigned short*)(S + (r0 + crow(g, hi)) * PITCH + col * 2) << 16);
    return a;
}
}

constexpr size_t WS_LW = WS_SMALL + 3 * MiB;
constexpr int LW_BYTES = 19456, ACT_PITCH = 272, ACT_BYTES = 64 * ACT_PITCH, RES_OFF = 8 * rw::SLOT, RES_PITCH = 65, SSBUF_OFF = 131072 + 2048;
template <int CTRL, int RM> __device__ __forceinline__ float dpp0(float v) { return __int_as_float(__builtin_amdgcn_update_dpp(0, __float_as_int(v), CTRL, RM, 0xf, false)); }
__device__ __forceinline__ float wave_scan_incl(float x) {
    x += dpp0<0x111, 0xf>(x); x += dpp0<0x112, 0xf>(x); x += dpp0<0x114, 0xf>(x); x += dpp0<0x118, 0xf>(x);
    x += dpp0<0x142, 0xa>(x); x += dpp0<0x143, 0xc>(x);
    return x;
}
__device__ __forceinline__ float fast_tanh(float x) { const float e = __expf(2.f * x); return 1.f - 2.f / (1.f + e); }
__device__ __forceinline__ void phase_chunkprep(Frame& F, KArgs& A, int l) {
    using namespace rw;
    const float* PR = WSP(const float, WS_PR);
    float* RW = WSP(float, WS_RW); constexpr size_t RS = (size_t)M * 256;
    LAS unsigned char* L = F.lds;
#define SL(n) (L + (n) * SLOT)
    const int w = F.wave;
    for (int it = F.vcu; it < NB * 4 * 64; it += F.G) {
        int lane = F.lane; asm volatile("" : "+v"(lane));
        { unsigned lb_ = 0u; asm volatile("" : "+s"(lb_)); L = F.lds + lb_; }
        const int c = it & 63, bh = it >> 6, b = bh >> 2, h = bh & 3;
        unsigned char* gout = F.ws + WS_XS + (size_t)it * ITEM_BYTES;
        const size_t m0 = (size_t)b * SEQ + c * 64;
        f32x4 s1r[2], s1k[2], s1v[2], s1pr[2], s1pk[2], s1pv[2];
        { const float* cur = PR + (m0 + lane) * 896 + h * 64 + 8 * w; const bool first = (c == 0 && lane == 0);
#pragma unroll
          for (int q = 0; q < 2; ++q) { s1r[q] = *(const GAS f32x4*)(cur + 4 * q); s1k[q] = *(const GAS f32x4*)(cur + 256 + 4 * q); s1v[q] = *(const GAS f32x4*)(cur + 512 + 4 * q);
              s1pr[q] = (f32x4){0.f, 0.f, 0.f, 0.f}; s1pk[q] = s1pr[q]; s1pv[q] = s1pr[q];
              if (!first) { s1pr[q] = *(const GAS f32x4*)(cur - 896 + 4 * q); s1pk[q] = *(const GAS f32x4*)(cur - 896 + 256 + 4 * q); s1pv[q] = *(const GAS f32x4*)(cur - 896 + 512 + 4 * q); } } }
        {
            const int tid = w * 64 + lane, t = tid >> 3, jg = tid & 7;
            const float* cur = PR + (m0 + t) * 896 + 768 + 16 * jg; const float* mup = GIN(8) + l * 896 + 768 + 16 * jg;
            const bool first = (c == 0 && t == 0);
            unsigned o8[8];
#pragma unroll
            for (int q = 0; q < 4; ++q) { f32x4 x = *(const GAS f32x4*)(cur + 4 * q); const f32x4 mu = *(const GAS f32x4*)(mup + 4 * q);
                f32x4 xp = {0.f, 0.f, 0.f, 0.f}; if (!first) xp = *(const GAS f32x4*)(cur - 896 + 4 * q);
                x = x + (xp - x) * mu;
#pragma unroll
                for (int e = 0; e < 4; ++e) x[e] = jg < 2 ? fast_tanh(x[e]) : (jg < 4 ? x[e] : 1.f / (1.f + __expf(-x[e])));
                o8[2 * q] = pk(x[0], x[1]); o8[2 * q + 1] = pk(x[2], x[3]); }
            LAS v4u* dst = (LAS v4u*)(L + t * ACT_PITCH + jg * 32);
            dst[0] = (v4u){o8[0], o8[1], o8[2], o8[3]}; dst[1] = (v4u){o8[4], o8[5], o8[6], o8[7]};
            const GAS v4u* lw = (const GAS v4u*)(F.ws + WS_LW + (size_t)(l * 4 + h) * LW_BYTES);
            for (int i = tid; i < LW_BYTES / 16; i += NWAVES * 64) *(LAS v4u*)(L + ACT_BYTES + i * 16) = lw[i];
        }
        LDS_WAIT(); __syncthreads();
        for (int id = w; id < 12; id += 8) {
            const int mtx = id >> 2, tr = (id >> 1) & 1, tc = id & 1, r = lane & 31, hh = lane >> 5;
            const int koff = mtx == 0 ? 0 : (mtx == 1 ? 64 : 128), nks = mtx == 2 ? 4 : 2, bp = mtx == 2 ? 144 : 80, boff = mtx == 0 ? 0 : (mtx == 1 ? 5120 : 10240);
            LAS const unsigned char* ap = L + (32 * tr + r) * ACT_PITCH + koff + hh * 16; LAS const unsigned char* bpp = L + ACT_BYTES + boff + (32 * tc + r) * bp + hh * 16;
            f32x16 acc = f32x16{};
            for (int ks = 0; ks < nks; ++ks) { const bf16x8 a = *(LAS const bf16x8*)(ap + ks * 32), bb = *(LAS const bf16x8*)(bpp + ks * 32); acc = __builtin_amdgcn_mfma_f32_32x32x16_bf16(a, bb, acc, 0, 0, 0); }
            LAS float* res = (LAS float*)(L + RES_OFF) + mtx * 64 * RES_PITCH + (32 * tc + r) * RES_PITCH + 32 * tr;
#pragma unroll
            for (int g = 0; g < 16; ++g) res[crow(g, hh)] = acc[g];
        }
        LDS_WAIT(); __syncthreads();
        {
            const int ch0 = h * 64 + 8 * w; const size_t m = m0 + lane;
            float r_[8], k_[8], v_[8], a_[8], lw_[8], kk_[8]; float ss = 0.f;
            const LAS float* res = (const LAS float*)(L + RES_OFF) + (8 * w) * RES_PITCH + lane;
#pragma unroll
            for (int q = 0; q < 2; ++q) {
                f32x4 xr = s1r[q], xk = s1k[q], xv = s1v[q]; const f32x4 pr = s1pr[q], pk_ = s1pk[q], pv = s1pv[q];
                const float* mu = GIN(8) + l * 896 + ch0 + 4 * q;
                const f32x4 mr = *(const GAS f32x4*)mu, mk = *(const GAS f32x4*)(mu + 256), mv = *(const GAS f32x4*)(mu + 512);
                xr = xr + (pr - xr) * mr; xk = xk + (pk_ - xk) * mk; xv = xv + (pv - xv) * mv;
                const f32x4 w0 = *(const GAS f32x4*)(GIN(9) + l * 256 + ch0 + 4 * q), a0 = *(const GAS f32x4*)(GIN(11) + l * 256 + ch0 + 4 * q);
                const f32x4 kkw = *(const GAS f32x4*)(GIN(14) + l * 256 + ch0 + 4 * q), kaw = *(const GAS f32x4*)(GIN(15) + l * 256 + ch0 + 4 * q);
                f32x4 gg, k2;
#pragma unroll
                for (int e = 0; e < 4; ++e) { const int i = 4 * q + e;
                    const float xw = -(w0[e] + res[i * RES_PITCH]); const float sp = xw > 15.f ? xw : __logf(1.f + __expf(xw)); const float wv = -sp - 0.5f;
                    lw_[i] = -__expf(wv);
                    const float a = 1.f / (1.f + __expf(-(a0[e] + res[(64 + i) * RES_PITCH]))); a_[i] = a;
                    gg[e] = res[(128 + i) * RES_PITCH];
                    r_[i] = xr[e]; v_[i] = xv[e]; kk_[i] = xk[e] * kkw[e]; ss += kk_[i] * kk_[i];
                    k2[e] = xk[e] * (1.f + (a - 1.f) * kaw[e]); k_[i] = k2[e]; }
                const size_t o = m * 256 + ch0 + 4 * q;
                *(GAS f32x4*)(RW + o) = xr; *(GAS f32x4*)(RW + 2 * RS + o) = k2; *(GAS f32x4*)(RW + 3 * RS + o) = xv; *(GAS f32x4*)(RW + 6 * RS + o) = gg;
            }
            *(LAS float*)(L + SSBUF_OFF + (w * 64 + lane) * 4) = ss;
            LDS_WAIT(); __syncthreads();
            float tot = 0.f;
#pragma unroll
            for (int q = 0; q < 8; ++q) tot += *(LAS const float*)(L + SSBUF_OFF + (q * 64 + lane) * 4);
            const float inv = 1.0f / fmaxf(sqrtf(tot), 1e-12f);
            unsigned nat[4][4];
#pragma unroll
            for (int e = 0; e < 8; ++e) {
                const float kkn = kk_[e] * inv, bbv = kkn * a_[e];
                const float cum = wave_scan_incl(lw_[e]);
                const float cl = rl(cum, 63), gam = __expf(cl);
                const float e1 = __expf(cum - lw_[e]), e2 = __expf(cum), e3 = __expf(-cum);
                const float kkf = kkn * e1, rf = r_[e] * e2, bi = bbv * e3, ki = k_[e] * e3, bend = bi * gam, kend = ki * gam;
                const int i = 8 * w + e;
                if (lane == 63) *(LAS float*)(L + GAM_OFF + i * 4) = gam;
                *(LAS unsigned short*)(SL(4) + i * PITCH + lane * 2) = f2b(kkf); *(LAS unsigned short*)(SL(5) + i * PITCH + lane * 2) = f2b(v_[e]);
                *(LAS unsigned short*)(SL(6) + i * PITCH + lane * 2) = f2b(bend); *(LAS unsigned short*)(SL(7) + i * PITCH + lane * 2) = f2b(kend);
                const unsigned short q0 = f2b(kkf), q1 = f2b(rf), q2 = f2b(bi), q3 = f2b(ki);
                if (e & 1) { nat[0][e >> 1] |= (unsigned)q0 << 16; nat[1][e >> 1] |= (unsigned)q1 << 16; nat[2][e >> 1] |= (unsigned)q2 << 16; nat[3][e >> 1] |= (unsigned)q3 << 16; }
                else { nat[0][e >> 1] = q0; nat[1][e >> 1] = q1; nat[2][e >> 1] = q2; nat[3][e >> 1] = q3; }
            }
#pragma unroll
            for (int mm = 0; mm < 4; ++mm) { v4u x; x.x = nat[mm][0]; x.y = nat[mm][1]; x.z = nat[mm][2]; x.w = nat[mm][3]; *(LAS v4u*)(SL(mm) + lane * PITCH + w * 16) = x; }
        }
        LDS_WAIT(); __syncthreads();
        const f32x16 Z = f32x16{};
#pragma unroll
        for (int q = 0; q < 2; ++q) { const int tile = 2 * w + q, p = tile >> 2, tr = (tile >> 1) & 1, tc = tile & 1;
            f32x16 acc = Z;
            if (!(tr == 0 && tc == 1)) acc = tile_nt(SL(p < 2 ? 0 : 1), 32 * tr, SL((p & 1) ? 3 : 2), 32 * tc, Z, lane);
            if (p == 0) { store_nat<1>(SL(8), 32 * tr, 32 * tc, acc, 1.f, lane); store_tr<1>(SL(12), 32 * tr, 32 * tc, acc, lane);
                const int col = 32 * tc + (lane & 31), hi = lane >> 5;
#pragma unroll
                for (int g = 0; g < 16; ++g) { const int row = 32 * tr + crow(g, hi); const float v = (row == col ? 1.f : 0.f) - (row > col ? acc[g] : 0.f); *(LAS unsigned short*)(SL(13) + row * PITCH + col * 2) = f2b(v); } }
            else if (p == 1) store_nat<1>(SL(9), 32 * tr, 32 * tc, acc, 1.f, lane);
            else if (p == 2) store_nat<2>(SL(10), 32 * tr, 32 * tc, acc, 1.f, lane);
            else store_nat<2>(SL(11), 32 * tr, 32 * tc, acc, 1.f, lane); }
        LDS_WAIT(); __syncthreads();
        const int tr = (w >> 1) & 1, tc = w & 1;
        {
            if (w < 4) { f32x16 acc = Z; if (!(tr == 0 && tc == 1)) acc = tile_nt(SL(8), 32 * tr, SL(12), 32 * tc, Z, lane); store_nat<0>(SL(0), 32 * tr, 32 * tc, acc, 1.f, lane); store_tr<0>(SL(2), 32 * tr, 32 * tc, acc, lane); }
            LDS_WAIT(); __syncthreads();
        }
#pragma nounroll
        for (int k = 1; k <= 5; ++k) {
            const int lpn = (k & 1) ? 0 : 8, lpt = (k & 1) ? 2 : 12, lpn2 = (k & 1) ? 8 : 0, lpt2 = (k & 1) ? 12 : 2, pin = (k & 1) ? 13 : 3, pout = (k & 1) ? 3 : 13;
            if (w < 4) { f32x16 acc = load_nat(SL(pin), 32 * tr, 32 * tc, lane); if (!(tr == 0 && tc == 1)) acc = tile_nt(SL(pin), 32 * tr, SL(lpt), 32 * tc, acc, lane); store_nat<0>(SL(pout), 32 * tr, 32 * tc, acc, 1.f, lane); }
            else if (k < 5) { f32x16 acc = Z; if (!(tr == 0 && tc == 1)) acc = tile_nt(SL(lpn), 32 * tr, SL(lpt), 32 * tc, Z, lane); store_nat<0>(SL(lpn2), 32 * tr, 32 * tc, acc, 1.f, lane); store_tr<0>(SL(lpt2), 32 * tr, 32 * tc, acc, lane); }
            LDS_WAIT(); __syncthreads();
        }
        if (w < 4) { const f32x16 acc = tile_nt(SL(4), 32 * tr, SL(3), 32 * tc, Z, lane); store_nat<0>(SL(0), 32 * tr, 32 * tc, acc, 1.f, lane); }
        else { const f32x16 acc = tile_nt(SL(5), 32 * tr, SL(9), 32 * tc, Z, lane); store_nat<0>(SL(2), 32 * tr, 32 * tc, acc, 1.f, lane); }
        LDS_WAIT(); __syncthreads();
        if (w < 4) { const f32x16 acc = tile_nt(SL(2), 32 * tr, SL(3), 32 * tc, Z, lane); store_nat<0>(SL(8), 32 * tr, 32 * tc, acc, -1.f, lane); }
        else {
            const int hi = lane >> 5, cl = lane & 31;
            { const f32x16 acc = tile_nt(SL(0), 32 * tr, SL(6), 32 * tc, Z, lane);
              const float gam = *(LAS const float*)(L + GAM_OFF + (32 * tc + cl) * 4);
#pragma unroll
              for (int sp = 0; sp < 2; ++sp) { float o[8];
#pragma unroll
                  for (int j = 0; j < 8; ++j) { const int g = 8 * sp + j; o[j] = ((tr == tc && crow(g, hi) == cl) ? gam : 0.f) - acc[g]; }
                  v4u x; x.x = pk(o[0], o[1]); x.y = pk(o[2], o[3]); x.z = pk(o[4], o[5]); x.w = pk(o[6], o[7]);
                  *(GAS v4u*)(gout + ((size_t)(tc * 4 + 2 * tr + sp) * 64 + lane) * 16) = x; } }
            { const f32x16 acc = tile_nt(SL(0), 32 * tr, SL(10), 32 * tc, Z, lane);
#pragma unroll
              for (int sp = 0; sp < 2; ++sp) { float o[8];
#pragma unroll
                  for (int j = 0; j < 8; ++j) { const int g = 8 * sp + j; const int i = 32 * tr + crow(g, hi), t = 32 * tc + cl;
                      o[j] = __uint_as_float((unsigned)*(LAS const unsigned short*)(SL(1) + t * PITCH + i * 2) << 16) - acc[g]; }
                  v4u x; x.x = pk(o[0], o[1]); x.y = pk(o[2], o[3]); x.z = pk(o[4], o[5]); x.w = pk(o[6], o[7]);
                  *(GAS v4u*)(gout + 8192 + ((size_t)(tc * 4 + 2 * tr + sp) * 64 + lane) * 16) = x; } }
        }
        LDS_WAIT(); __syncthreads();
        {
            f32x16 acc;
            if (w < 4) { acc = tile_nt(SL(7), 32 * tr, SL(5), 32 * tc, Z, lane); acc = tile_nt(SL(6), 32 * tr, SL(8), 32 * tc, acc, lane); }
            else { acc = tile_nt(SL(11), 32 * tr, SL(5), 32 * tc, Z, lane); acc = tile_nt(SL(10), 32 * tr, SL(8), 32 * tc, acc, lane); }
            float* o = (float*)(gout + (w < 4 ? 16384 : 32768)) + (size_t)(tr * 2 + tc) * 1024 + lane;
#pragma unroll
            for (int g = 0; g < 16; ++g) *(GAS float*)(o + g * 64) = acc[g];
        }
        LDS_WAIT(); __syncthreads();
    }
#undef SL
    if (F.wave == 0) { const bf16* KM = WSP(bf16, WS_KM); float* KMEAN = WSP(float, WS_KMEAN);
      for (int it = F.vcu; it < NB * 16 * 4; it += F.G) { const int hh = it & 3, n = (it >> 2) & 15, b = it >> 6; const int co = F.lane >> 3, rg = F.lane & 7;
          const bf16* p = KM + ((size_t)b * SEQ + n * 256 + rg * 32) * 256 + hh * 64 + co * 8; float s[8] = {0.f, 0.f, 0.f, 0.f, 0.f, 0.f, 0.f, 0.f};
#pragma unroll 16
          for (int t = 0; t < 32; ++t) { const v4u x = *(const GAS v4u*)(p + (size_t)t * 256);
              s[0] += bf_lo(x.x); s[1] += bf_hi(x.x); s[2] += bf_lo(x.y); s[3] += bf_hi(x.y); s[4] += bf_lo(x.z); s[5] += bf_hi(x.z); s[6] += bf_lo(x.w); s[7] += bf_hi(x.w); }
#pragma unroll
          for (int e = 0; e < 8; ++e) { float x = s[e]; x += dpp0<0xB1, 0xf>(x); x += dpp0<0x4E, 0xf>(x); x += dpp0<0x141, 0xf>(x); s[e] = x * (1.0f / 256.0f); }
          if (rg == 0) { float* o = KMEAN + (((size_t)b * 4 + hh) * 16 + n) * 64 + co * 8; *(GAS f32x4*)o = (f32x4){s[0], s[1], s[2], s[3]}; *(GAS f32x4*)(o + 4) = (f32x4){s[4], s[5], s[6], s[7]}; } } }
}

constexpr size_t WS_SB = WS_HS;
__device__ __forceinline__ void rwkv_chain_wave(Frame& F, int bh, int tv) {
    using namespace rw;
    const int lane = F.lane;
    f32x16 S0 = f32x16{}, S1 = f32x16{};
    const unsigned char* gin = F.ws + WS_XS + (size_t)bh * 64 * ITEM_BYTES;
    unsigned char* sb = F.ws + WS_SB + ((size_t)bh * 64 * 2 + tv) * 4096 + lane * 16;
    bf16x8 Ga[8]; f32x16 H0, H1;
#define RW_LOAD(G_, H0_, H1_, gp_) do { _Pragma("unroll") for (int q_ = 0; q_ < 8; ++q_) G_[q_] = *(const GAS bf16x8*)((gp_) + ((size_t)q_ * 64 + lane) * 16); \
        const float* hp_ = (const float*)((gp_) + 16384) + (size_t)tv * 1024 + lane; _Pragma("unroll") for (int g_ = 0; g_ < 16; ++g_) { H0_[g_] = *(const GAS float*)(hp_ + g_ * 64); H1_[g_] = *(const GAS float*)(hp_ + 2048 + g_ * 64); } } while (0)
    RW_LOAD(Ga, H0, H1, gin);
    for (int c = 0; c < 64; ++c) {
        bf16x8 Gn[8]; f32x16 Hn0, Hn1;
        const unsigned char* gnx = gin + (size_t)(c < 63 ? c + 1 : c) * ITEM_BYTES;
        RW_LOAD(Gn, Hn0, Hn1, gnx);
        bf16x8 Bf[4];
#pragma unroll
        for (int s = 0; s < 4; ++s) { const f32x16& X = (s < 2) ? S0 : S1; const int o = 8 * (s & 1); v4u x; x.x = pk(X[o], X[o + 1]); x.y = pk(X[o + 2], X[o + 3]); x.z = pk(X[o + 4], X[o + 5]); x.w = pk(X[o + 6], X[o + 7]); Bf[s] = __builtin_bit_cast(bf16x8, x);
            *(GAS v4u*)(sb + (size_t)c * 8192 + s * 1024) = x; }
#pragma unroll
        for (int s = 0; s < 4; ++s) { H0 = __builtin_amdgcn_mfma_f32_32x32x16_bf16(Ga[s], Bf[s], H0, 0, 0, 0); H1 = __builtin_amdgcn_mfma_f32_32x32x16_bf16(Ga[4 + s], Bf[s], H1, 0, 0, 0); }
        S0 = H0; S1 = H1;
#pragma unroll
        for (int q = 0; q < 8; ++q) Ga[q] = Gn[q];
        H0 = Hn0; H1 = Hn1;
    }
#undef RW_LOAD
}
__device__ __forceinline__ void rwkv_y_item(Frame& F, KArgs& A, int l, int item2) {
    using namespace rw;
    const int lane = F.lane, hi = lane >> 5, cl = lane & 31;
    const int tt = item2 & 1, item = item2 >> 1, c = item & 63, bh = item >> 6, b = bh >> 2, h = bh & 3;
    const unsigned char* gin = F.ws + WS_XS + (size_t)item * ITEM_BYTES;
    const unsigned char* sb = F.ws + WS_SB + ((size_t)item * 2) * 4096 + lane * 16;
    LAS float* yl = (LAS float*)(F.lds + F.wave * 8192);
#pragma unroll
    for (int tv = 0; tv < 2; ++tv) {
        f32x16 acc; const float* y0 = (const float*)(gin + 32768) + (size_t)(tt * 2 + tv) * 1024 + lane;
#pragma unroll
        for (int g = 0; g < 16; ++g) acc[g] = *(const GAS float*)(y0 + g * 64);
#pragma unroll
        for (int s = 0; s < 4; ++s) { const bf16x8 a = *(const GAS bf16x8*)(gin + 8192 + ((size_t)(tt * 4 + s) * 64 + lane) * 16), bfr = *(const GAS bf16x8*)(sb + tv * 4096 + s * 1024);
            acc = __builtin_amdgcn_mfma_f32_32x32x16_bf16(a, bfr, acc, 0, 0, 0); }
#pragma unroll
        for (int g = 0; g < 16; ++g) yl[crow(g, hi) * 64 + 32 * tv + cl] = acc[g];
    }
    LDS_WAIT();
    const float* RWp = WSP(const float, WS_RW); constexpr size_t RS = (size_t)M * 256;
    const int ch = h * 64 + lane;
    const float rk = GIN(16)[l * 256 + ch], lng = GIN(17)[l * 256 + ch], lnb = GIN(18)[l * 256 + ch];
    const size_t row0 = (size_t)b * SEQ + c * 64 + 32 * tt;
#pragma unroll 8
    for (int t = 0; t < 32; ++t) { const size_t o = (row0 + t) * 256 + ch;
        const float y = yl[t * 64 + lane], r = RWp[o], k = RWp[2 * RS + o], v = RWp[3 * RS + o], g = RWp[6 * RS + o];
        const float mean = wave_sum(y) * (1.0f / 64.0f); const float d = y - mean; const float var = wave_sum(d * d) * (1.0f / 64.0f);
        const float bonus = wave_sum(r * k * rk) * v;
        WSP(bf16, WS_MIX)[(row0 + t) * 1024 + ch] = (bf16)f2bf((d * (1.0f / sqrtf(var + 64e-5f)) * lng + lnb + bonus) * g); }
    LDS_WAIT();
}
#ifndef ATT_NEGM
#define ATT_NEGM false
#endif
constexpr int CW_TIX = 16384 + 2048;
__device__ __forceinline__ void phase_attention(Frame& F, KArgs& A, int l, int rep) {
    constexpr int NSTREAM = 48, NUNITS = NSTREAM * 16, NCONV = 192, NTICKETS = NUNITS + NCONV;
    static_assert(4 * NCONV == NUNITS && 2 * NCONV * 64 == 3 * 32 * 256, "ticket interleave");
    unsigned* ctr = (unsigned*)(F.ctl + CW_TIX + l * 64 + rep * 16);
    volatile LAS unsigned* tix = F.MISC + 16;
    attn_body::attn_build_tables(F.tid, WSP(float, WS_TB), (char*)F.lds);
    asm volatile("s_waitcnt vmcnt(0) lgkmcnt(0)\n\ts_barrier" ::: "memory");
    if (F.vcu < 4) rwkv_chain_wave(F, (F.vcu * 8 + F.wave) >> 1, F.wave & 1);
    int iter_ = 0;
    for (;;) {
#ifdef ATT_STATIC
        if (threadIdx.x == 0) tix[0] = (unsigned)(iter_ * F.G + (int)blockIdx.x);
#else
        if (threadIdx.x == 0) tix[0] = atomicAdd(ctr, 1u);
#endif
        ++iter_;
        asm volatile("s_waitcnt vmcnt(0) lgkmcnt(0)\n\ts_barrier" ::: "memory");
        const int ticket = (int)tix[0];
        asm volatile("s_waitcnt lgkmcnt(0)\n\ts_barrier" ::: "memory");
        if (ticket >= NTICKETS) break;
        if (ticket % 5 == 4) { moe_convert_ticket(F, A, l, ticket / 5); continue; }
        const int au = 4 * (ticket / 5) + ticket % 5;
        const int qb = 15 - au / NSTREAM, s = au % NSTREAM;
        int tid_u = threadIdx.x; asm volatile("" : "+v"(tid_u));
        if (s < 32) {
            const int b = s >> 3, h = (s >> 1) & 3, c = s & 1; const size_t r0 = (size_t)b * SEQ;
            attn_body::attn_unit_dv<16>(tid_u, qb,
                (const attn_body::bf16*)(WSP(bf16, WS_QD) + r0 * 512 + (h * 2 + c) * 64), 512,
                (const attn_body::bf16*)(WSP(bf16, WS_KD) + r0 * 512 + (h * 2 + c) * 64), 512,
                (const attn_body::bf16*)(WSP(bf16, WS_VD) + r0 * 512 + h * 128), 512,
                (attn_body::bf16*)(WSP(bf16, WS_OD) + r0 * 1024 + (h * 2 + c) * 128), 1024,
                h, (char*)F.lds);
        } else {
            const int b = (s - 32) >> 2, h = (s - 32) & 3; const size_t r0 = (size_t)b * SEQ;
            attn_body::attn_unit<16, true, ATT_NEGM>(tid_u, qb,
                (const attn_body::bf16*)(WSP(bf16, WS_QM) + r0 * 256 + h * 64), 256,
                (const attn_body::bf16*)(WSP(bf16, WS_KM) + r0 * 256 + h * 64), 256,
                (const attn_body::bf16*)(WSP(bf16, WS_VM) + r0 * 256 + h * 64), 256,
                (attn_body::bf16*)(WSP(bf16, WS_MIX) + r0 * 1024 + 768 + h * 64), 1024,
                4 + h, WSP(float, WS_KMEAN) + ((size_t)(b * 4 + h) * 16) * 64, (char*)F.lds);
        }
    }
}
__device__ __forceinline__ void phase_postmix(Frame& F, KArgs& A, int l) {
    const float lam = WSP(float, WS_LAM)[l]; const float li = 0.8f - 0.6f * __expf(-0.3f * (float)l);
    const float* sg = GIN(22) + l * 128;
    const int nit_ = F.xl ? 9 : (2048 + M + F.NGW - 1) / F.NGW;
    for (int k_ = 0; k_ < nit_; ++k_) {
        int it;
        if (F.xl) { if (k_ == 0) { rwkv_y_item(F, A, l, ((((F.vcu >> 6) * 4 + (F.wave >> 1)) * 64 + (F.vcu & 63)) << 1) | (F.wave & 1)); continue; } it = 2048 + F.vcu * 64 + F.wave * 8 + (k_ - 1); }
        else { it = F.gw + k_ * F.NGW; if (it >= 2048 + M) break; if (it < 2048) { rwkv_y_item(F, A, l, it); continue; } }
        const int m = it - 2048; const int h = F.lane >> 4, j = F.lane & 15;
        const bf16* od = WSP(bf16, WS_OD) + (size_t)m * 1024 + h * 256 + 8 * j;
        const v4u a = __builtin_nontemporal_load((const GAS v4u*)od), b2 = __builtin_nontemporal_load((const GAS v4u*)(od + 128));
        float o[8];
        o[0] = bf_lo(a.x) - lam * bf_lo(b2.x); o[1] = bf_hi(a.x) - lam * bf_hi(b2.x); o[2] = bf_lo(a.y) - lam * bf_lo(b2.y); o[3] = bf_hi(a.y) - lam * bf_hi(b2.y);
        o[4] = bf_lo(a.z) - lam * bf_lo(b2.z); o[5] = bf_hi(a.z) - lam * bf_hi(b2.z); o[6] = bf_lo(a.w) - lam * bf_lo(b2.w); o[7] = bf_hi(a.w) - lam * bf_hi(b2.w);
        float ss = 0.f;
#pragma unroll
        for (int i = 0; i < 8; ++i) ss += o[i] * o[i];
        ss += __shfl_xor(ss, 1); ss += __shfl_xor(ss, 2); ss += __shfl_xor(ss, 4); ss += __shfl_xor(ss, 8);
        const float rs = (1.f - li) / sqrtf(ss * (1.0f / 128.0f) + 1e-6f);
        const f32x4 g0 = *(const f32x4*)(sg + 8 * j), g1 = *(const f32x4*)(sg + 8 * j + 4);
        v4u w; w.x = pk2(o[0] * rs * g0.x, o[1] * rs * g0.y); w.y = pk2(o[2] * rs * g0.z, o[3] * rs * g0.w); w.z = pk2(o[4] * rs * g1.x, o[5] * rs * g1.y); w.w = pk2(o[6] * rs * g1.z, o[7] * rs * g1.w);
        *(GAS v4u*)(WSP(bf16, WS_MIX) + (size_t)m * 1024 + 256 + h * 128 + 8 * j) = w;
    }
}
__global__ void __launch_bounds__(NWAVES * 64, 2) mega_fwd(Args Araw) {
    extern __shared__ __attribute__((aligned(16))) unsigned char lds[];
    Frame F;
    F.lds = (LAS unsigned char*)lds; F.MISC = (volatile LAS unsigned*)(F.lds + MISC_OFF);
    F.tid = threadIdx.x; F.lane = F.tid & 63; F.wave = __builtin_amdgcn_readfirstlane(F.tid >> 6);
    F.G = gridDim.x; { const int bx = blockIdx.x; F.vcu = (F.G % 8 == 0) ? (bx % 8) * (F.G / 8) + bx / 8 : bx; }
    F.gw = F.vcu * NWAVES + F.wave; F.NGW = F.G * NWAVES;
    F.out = Araw.out; F.ws = Araw.ws; F.ctl = (gu32*)(Araw.ws + WS_CTL); F.xl = 0; F.cf = (int)blockIdx.x;
    for (int u = F.tid; u < (LDS_BYTES - LDSCTL_OFF) / 4; u += NWAVES * 64) ((LAS unsigned*)(F.lds + LDSCTL_OFF))[u] = 0u;
    __syncthreads();
    XcdBarrier bar = xcd_barrier_post((unsigned*)(F.ctl + CW_BAR), F.MISC + 8);
#define GRID_BAR() xcd_barrier(bar)

    constexpr int NPH = 9; constexpr int NSTEP = 1 + NL * NPH + 1;
    int reps_ = 0;
    {
        KArgs* Ap_ = (KArgs*)__builtin_amdgcn_kernarg_segment_ptr(); asm volatile("" : "+s"(Ap_)); KArgs& A = *Ap_;
        { unsigned lb_ = 0u; asm volatile("" : "+s"(lb_)); F.lds = (LAS unsigned char*)lds + lb_; F.MISC = (volatile LAS unsigned*)(F.lds + MISC_OFF); }
        { GAS unsigned char* w_ = (GAS unsigned char*)Araw.ws; GAS float* o_ = (GAS float*)Araw.out; asm volatile("" : "+s"(w_), "+s"(o_)); F.ws = (unsigned char*)w_; F.out = (float*)o_; F.ctl = (gu32*)(w_ + WS_CTL); }
        { int t_ = threadIdx.x; asm volatile("" : "+v"(t_)); F.tid = t_; F.lane = t_ & 63; F.wave = __builtin_amdgcn_readfirstlane(t_ >> 6); F.gw = F.vcu * NWAVES + F.wave; }
#ifndef SK_P0
        p0_prologue(F, A);
#endif
        GRID_BAR();
        xcd_census_regular(bar);
        { const int xl_ = __builtin_amdgcn_readfirstlane((int)F.MISC[11]), rk_ = __builtin_amdgcn_readfirstlane((int)F.MISC[10]);
          if (xl_) { F.xl = 1; F.vcu = (int)bar.x * 32 + rk_; F.cf = rk_ * 8 + (int)bar.x; } }
    }
    for (int step = 1; step < NSTEP; ++step) {
        const int l = (step - 1) / NPH, idx_ = (step - 1) % NPH;
        const int ph = ((step == NSTEP - 1) ? 99 : (idx_ < 2 ? idx_ : (idx_ == 2 ? 10 : (idx_ < 7 ? idx_ : idx_ + 1))));
        KArgs* Ap_ = (KArgs*)__builtin_amdgcn_kernarg_segment_ptr(); asm volatile("" : "+s"(Ap_)); KArgs& A = *Ap_;
        { unsigned lb_ = 0u; asm volatile("" : "+s"(lb_)); F.lds = (LAS unsigned char*)lds + lb_; F.MISC = (volatile LAS unsigned*)(F.lds + MISC_OFF); }
        { GAS unsigned char* w_ = (GAS unsigned char*)Araw.ws; GAS float* o_ = (GAS float*)Araw.out; asm volatile("" : "+s"(w_), "+s"(o_)); F.ws = (unsigned char*)w_; F.out = (float*)o_; F.ctl = (gu32*)(w_ + WS_CTL); }
        { int t_ = threadIdx.x; asm volatile("" : "+v"(t_)); F.tid = t_; F.lane = t_ & 63; F.wave = __builtin_amdgcn_readfirstlane(t_ >> 6); F.gw = F.vcu * NWAVES + F.wave; }
#ifdef AMP_MASK
        const unsigned long long amp_t0 = __builtin_amdgcn_s_memrealtime();
#endif
        switch (ph) {
        case 0:
#ifndef SK_N1
            phase_norm1(F, A, l);
#endif
            break;
        case 1: {
#ifndef SK_GIN
            pg8::Gemm g{WSP(bf16, WS_HB), WSP(bf16, WS_WIN) + (size_t)l * NIN * 1024, M, NIN, DM, 0};
            pg8::StaticOrder S; S.init(M, NIN, F.G, F.cf);
            pg8::EpiInProj E{F.ws, Ap_, l, C2};
            pg8::gemm_phase<pg8::EpiInProj, pg8::StaticOrder, true, PG8_SP2>(F.lds, g, S, E);
            if (F.cf >= 64) moe_convert_ticket(F, A, l, 192 + (F.cf - 64) % 192);
#endif
            break; }
        case 10:
            phase_chunkprep(F, A, l);
            break;
        case 3:
#ifndef SK_MX
            phase_attention(F, A, l, reps_);
#endif
            break;
        case 4:
#ifndef SK_PM
            phase_postmix(F, A, l);
#endif
            break;
        case 5: {
#ifndef SK_GOUT
            pg8::Gemm g{WSP(bf16, WS_MIX), WSP(bf16, WS_WOUT) + (size_t)l * 1024 * 1024, M, DM, DM, 0};
            pg8::StaticOrder S; S.init(M, DM, F.G, F.cf);
            pg8::EpiResid E{F.out, WSP(float, WS_MOD) + (size_t)l * NB * 6144 + 2048, SEQ, 6144};
            pg8::gemm_phase<pg8::EpiResid, pg8::StaticOrder, true, PG8_SP2>(F.lds, g, S, E);
#endif
            break; }
        case 6:
#ifndef SK_R1
            phase_router(F, A, l, bar);
#endif
            break;
        case 8: {
#ifndef SK_MOE
            moe_tables(F, A, l);
            const LAS int* base = (const LAS int*)(F.lds + TAB_OFF);
            pg8::MoeOrder S{base + 64, base[32] / 256, 4, F.G, F.vcu};
            pg8::Gemm g1{WSP(bf16, WS_XS), WSP(bf16, WS_W13) + (size_t)l * 32 * 1024 * 1024, MOE_ROWS, 1024, 1024, (size_t)1024 * 1024 * 2};
            pg8::EpiSwiGLU E1{WSP(bf16, WS_HS)};
            pg8::gemm_phase<pg8::EpiSwiGLU, pg8::MoeOrder, true, PG8_SP2>(F.lds, g1, S, E1);
#endif
            break; }
        case 9: {
#ifndef SK_MOE
            moe_tables(F, A, l);
            const LAS int* base = (const LAS int*)(F.lds + TAB_OFF);
            pg8::MoeOrder S{base + 64, base[32] / 256, 4, F.G, F.vcu};
            pg8::Gemm g2{WSP(bf16, WS_HS), WSP(bf16, WS_W2) + (size_t)l * 32 * 1024 * 512, MOE_ROWS, 1024, 512, (size_t)1024 * 512 * 2};
            pg8::EpiMoeOut E2{WSP(bf16, WS_YS), WSP(float, WS_SMALL) + 6 * M};
            pg8::gemm_phase<pg8::EpiMoeOut, pg8::MoeOrder, true, PG8_SP2>(F.lds, g2, S, E2);
#endif
            break; }
        default:
            phase_norm1(F, A, NL);
            break;
        }
#ifdef AMP_MASK
        { const int bit_ = ph == -1 ? 15 : (ph == 99 ? 14 : ph); if ((AMP_MASK >> bit_) & 1) { asm volatile("s_waitcnt vmcnt(0) lgkmcnt(0)" ::: "memory"); const unsigned long long t1_ = __builtin_amdgcn_s_memrealtime(); while (__builtin_amdgcn_s_memrealtime() - t1_ < t1_ - amp_t0) __builtin_amdgcn_s_sleep(8); } }
#endif
        if (step + 1 < NSTEP) {
            if (F.xl && (ph == 0 || ph == 4 || ph == 5 || ph == 8)) xcd_local_barrier(bar); else GRID_BAR();
        }
#ifdef REP_PH
        if (ph == REP_PH && reps_ == 0) { reps_ = 1; --step; } else reps_ = 0;
#endif
    }
}

extern "C" void kernel_launch(void* const* d_in, const int* in_sizes, int n_in, void* d_out, int out_size, void* d_ws, size_t ws_size, hipStream_t stream) {
    static int grid = 0;
    if (grid == 0) {
        if (n_in != 33 || out_size != M * DM || ws_size < WS_END) { fprintf(stderr, "kernel_launch: unexpected shapes (n_in %d, out %d, ws %zu < %zu)\n", n_in, out_size, ws_size, (size_t)WS_END); grid = -1; return; }
        int dev = 0, cus = 0;
        if (hipGetDevice(&dev) != hipSuccess || hipDeviceGetAttribute(&cus, hipDeviceAttributeMultiprocessorCount, dev) != hipSuccess) { grid = -1; return; }
        if (hipFuncSetAttribute((const void*)mega_fwd, hipFuncAttributeMaxDynamicSharedMemorySize, LDS_BYTES) != hipSuccess) { fprintf(stderr, "kernel_launch: hipFuncSetAttribute failed\n"); grid = -1; return; }
        int per_cu = 0;
        if (hipOccupancyMaxActiveBlocksPerMultiprocessor(&per_cu, (const void*)mega_fwd, NWAVES * 64, LDS_BYTES) != hipSuccess || per_cu < 1) fprintf(stderr, "kernel_launch: occupancy query says %d\n", per_cu);
        (void)hipGetLastError();
        if (cus != M / 64) { fprintf(stderr, "kernel_launch: built for %d CUs (found %d)\n", M / 64, cus); grid = -1; return; }
        grid = cus;
    }
    if (grid < 0) return;
    if (hipMemsetAsync((char*)d_ws + WS_CTL, 0, CTL_ZERO_BYTES, stream) != hipSuccess) { fprintf(stderr, "kernel_launch: memset failed\n"); return; }
    Args a{};
    for (int i = 0; i < 33; ++i) a.in[i] = (const float*)d_in[i];
    a.out = (float*)d_out; a.ws = (unsigned char*)d_ws;
    hipLaunchKernelGGL(mega_fwd, dim3(grid), dim3(NWAVES * 64), LDS_BYTES, stream, a);
}
```

```cpp
#include <hip/hip_runtime.h>
#include <cstdio>
#include <cstdint>
struct Args { const float* in[33]; float* out; unsigned char* ws; };
typedef const __attribute__((address_space(4))) Args KArgs;
namespace pg8 {
#define PG8_LAS __attribute__((address_space(3)))
typedef unsigned short bf16_t;
typedef short bf16x8 __attribute__((ext_vector_type(8)));
typedef float f32x4 __attribute__((ext_vector_type(4)));
typedef unsigned u32x4 __attribute__((ext_vector_type(4)));
constexpr int BM = 256, BK = 64, HALF = 128, HTB = HALF * BK * 2  , STAGE_BYTES = 8 * HTB, NXCD = 8, WGM = 8;

__host__ __device__ __forceinline__ int lds_byte(int r, int c) { const int st = (r >> 4) * 2 + (c >> 5), rr = r & 15, cc = c & 31, ob = rr * 64 + cc * 2; return st * 1024 + (ob ^ (((ob >> 9) & 1) << 5)); }
__host__ __device__ __forceinline__ void stage_rc(int b, int& R, int& C) { const int st = b / 1024, sb = b % 1024, swz = sb ^ (((sb >> 9) & 1) << 5); R = (st >> 1) * 16 + swz / 64; C = (st & 1) * 32 + (swz % 64) / 2; }
__host__ __device__ __forceinline__ int perm32(int rho) { const int n = rho >> 4, i = rho & 15; return 8 * (i >> 2) + 4 * n + (i & 3); }

struct Unit { int pm, pn, e; };
struct Gemm { const bf16_t* A; const bf16_t* Bt; int M, N, K; size_t estride; };

struct StaticOrder {
    int nM, nN, nwg, G, c;
    __host__ __device__ void init(int M, int N, int G_, int c_) { nM = M / BM; nN = N / BM; nwg = nM * nN; G = G_; c = c_; }
    __host__ __device__ bool next(int i, Unit& u) const {
        const long L = (long)i * G + c; if (L >= nwg) return false;
        int wgid = (int)L; { const int q = nwg / NXCD, r = nwg % NXCD, xcd = wgid % NXCD, off = wgid / NXCD; wgid = (xcd < r ? xcd * (q + 1) : r * (q + 1) + (xcd - r) * q) + off; }
        const int nig = WGM * nN, gid = wgid / nig, fm = gid * WGM, gsz = (nM - fm) < WGM ? (nM - fm) : WGM;
        u.pm = fm + ((wgid % nig) % gsz); u.pn = (wgid % nig) / gsz; u.e = 0; return true;
    }
    __device__ __forceinline__ void a_ready(const Unit&) const {}
    __device__ __forceinline__ void done(const Unit&) const {}
};

__device__ __forceinline__ unsigned cvt_pk_bf16(float lo, float hi) { unsigned r; asm volatile("v_cvt_pk_bf16_f32 %0, %1, %2" : "=v"(r) : "v"(lo), "v"(hi)); return r; }
typedef unsigned u32x2 __attribute__((ext_vector_type(2)));
constexpr size_t EPI_MiB = 1u << 20, EPI_WS_QD = 656 * EPI_MiB, EPI_WS_KD = 672 * EPI_MiB, EPI_WS_VD = 688 * EPI_MiB, EPI_WS_QM = 704 * EPI_MiB, EPI_WS_KM = 712 * EPI_MiB, EPI_WS_VM = 720 * EPI_MiB, EPI_WS_PR = 728 * EPI_MiB;

struct EpiInProj {
    static constexpr bool PERM = true, AFTER_DRAIN = false;
    unsigned char* ws; KArgs* ka; int l; float c2;
    __device__ __forceinline__ void operator()(const f32x4 (&acc)[2][2][4][2], const Unit& u, int wr, int wc, int fr, int fq) const {
        const int pn = u.pn; const int row0 = u.pm * BM + wr * 64 + fr;
        if (pn >= 9) {
            float* PR = (float*)(ws + EPI_WS_PR);
            const int cb = (pn - 9) * 256 + 64 * wc + 8 * fq;
#pragma unroll
            for (int ai = 0; ai < 2; ++ai)
#pragma unroll
                for (int m = 0; m < 4; ++m) { float* rowp = PR + (size_t)(row0 + ai * HALF + m * 16) * 896;
#pragma unroll
                    for (int bj = 0; bj < 2; ++bj)
#pragma unroll
                        for (int n = 0; n < 2; ++n) { const int c = cb + 32 * bj + 4 * n; if (c < 896) *(f32x4*)(rowp + c) = acc[ai][bj][m][n]; } }
            return;
        }
        bf16_t* dst; int ld, cbase; const float* gain = nullptr; float sc = 1.f;
        if (pn < 2) { dst = (bf16_t*)(ws + EPI_WS_QD); ld = 512; cbase = pn * 256; gain = ((const float*)(const __attribute__((address_space(1))) float*)ka->in[19]) + l * 64; sc = c2; }
        else if (pn < 4) { dst = (bf16_t*)(ws + EPI_WS_KD); ld = 512; cbase = (pn - 2) * 256; gain = ((const float*)(const __attribute__((address_space(1))) float*)ka->in[20]) + l * 64; }
        else if (pn < 6) { dst = (bf16_t*)(ws + EPI_WS_VD); ld = 512; cbase = (pn - 4) * 256; }
        else if (pn == 6) { dst = (bf16_t*)(ws + EPI_WS_QM); ld = 256; cbase = 0; gain = ((const float*)(const __attribute__((address_space(1))) float*)ka->in[23]) + l * 64; sc = c2; }
        else if (pn == 7) { dst = (bf16_t*)(ws + EPI_WS_KM); ld = 256; cbase = 0; gain = ((const float*)(const __attribute__((address_space(1))) float*)ka->in[24]) + l * 64; }
        else { dst = (bf16_t*)(ws + EPI_WS_VM); ld = 256; cbase = 0; }
        f32x4 gv[2][2];
#pragma unroll
        for (int bj = 0; bj < 2; ++bj)
#pragma unroll
            for (int n = 0; n < 2; ++n) gv[bj][n] = gain ? *(const f32x4*)(gain + 32 * bj + 8 * fq + 4 * n) * sc : (f32x4){1.f, 1.f, 1.f, 1.f};
        const int col0 = cbase + 64 * wc + 8 * fq;
#pragma unroll
        for (int ai = 0; ai < 2; ++ai)
#pragma unroll
            for (int m = 0; m < 4; ++m) {
                float rs = 1.f;
                if (gain) { float ss = 0.f;
#pragma unroll
                    for (int bj = 0; bj < 2; ++bj)
#pragma unroll
                        for (int n = 0; n < 2; ++n) { const f32x4 x = acc[ai][bj][m][n]; ss += (x[0] * x[0] + x[1] * x[1]) + (x[2] * x[2] + x[3] * x[3]); }
                    ss += __shfl_xor(ss, 16); ss += __shfl_xor(ss, 32);
                    rs = 1.0f / sqrtf(ss * (1.0f / 64.0f) + 1e-6f); }
                bf16_t* rowp = dst + (size_t)(row0 + ai * HALF + m * 16) * ld + col0;
#pragma unroll
                for (int bj = 0; bj < 2; ++bj) { const f32x4 v0 = acc[ai][bj][m][0] * rs * gv[bj][0], v1 = acc[ai][bj][m][1] * rs * gv[bj][1];
                    u32x4 w; w.x = cvt_pk_bf16(v0[0], v0[1]); w.y = cvt_pk_bf16(v0[2], v0[3]); w.z = cvt_pk_bf16(v1[0], v1[1]); w.w = cvt_pk_bf16(v1[2], v1[3]);
                    *(u32x4*)(rowp + 32 * bj) = w; } }
    }
};
struct EpiResid {
    static constexpr bool PERM = false, AFTER_DRAIN = false;
    float* X; const float* gate; int seq, gstride;
    __device__ __forceinline__ void operator()(const f32x4 (&acc)[2][2][4][2], const Unit& u, int wr, int wc, int fr, int fq) const {
        const int row0 = u.pm * BM + wr * 64 + fr, col0 = u.pn * BM + wc * 32 + 4 * fq;
        const float* gp = gate + (size_t)((u.pm * BM) / seq) * gstride + col0;
        f32x4 gv[2][2];
#pragma unroll
        for (int bj = 0; bj < 2; ++bj)
#pragma unroll
            for (int n = 0; n < 2; ++n) gv[bj][n] = *(const f32x4*)(gp + bj * HALF + n * 16);
#pragma unroll
        for (int ai = 0; ai < 2; ++ai)
#pragma unroll
            for (int m = 0; m < 4; ++m) { float* rowp = X + (size_t)(row0 + ai * HALF + m * 16) * 1024 + col0;
#pragma unroll
                for (int bj = 0; bj < 2; ++bj)
#pragma unroll
                    for (int n = 0; n < 2; ++n) { f32x4* p = (f32x4*)(rowp + bj * HALF + n * 16); *p = *p + gv[bj][n] * acc[ai][bj][m][n]; } }
    }
};
struct EpiSwiGLU {
    static constexpr bool PERM = true, AFTER_DRAIN = false;
    bf16_t* HS;
    __device__ __forceinline__ void operator()(const f32x4 (&acc)[2][2][4][2], const Unit& u, int wr, int wc, int fr, int fq) const {
        const int row0 = u.pm * BM + wr * 64 + fr;
#pragma unroll
        for (int ai = 0; ai < 2; ++ai)
#pragma unroll
            for (int m = 0; m < 4; ++m) { bf16_t* rowp = HS + (size_t)(row0 + ai * HALF + m * 16) * 512;
#pragma unroll
                for (int bj = 0; bj < 2; ++bj) { const int g = 32 * u.pn + 16 * bj + 4 * wc + fq; const f32x4 a = acc[ai][bj][m][0], b = acc[ai][bj][m][1]; f32x4 o;
#pragma unroll
                    for (int e = 0; e < 4; ++e) o[e] = a[e] / (1.0f + __expf(-a[e])) * b[e];
                    u32x2 w; w.x = cvt_pk_bf16(o[0], o[1]); w.y = cvt_pk_bf16(o[2], o[3]); *(u32x2*)(rowp + 4 * g) = w; } }
    }
};
struct EpiMoeOut {
    static constexpr bool PERM = true, AFTER_DRAIN = false;
    bf16_t* YS; const float* gs;
    __device__ __forceinline__ void operator()(const f32x4 (&acc)[2][2][4][2], const Unit& u, int wr, int wc, int fr, int fq) const {
        const int row0 = u.pm * BM + wr * 64 + fr, col0 = u.pn * BM + wc * 32 + 8 * fq;
#pragma unroll
        for (int ai = 0; ai < 2; ++ai)
#pragma unroll
            for (int m = 0; m < 4; ++m) { const int r = row0 + ai * HALF + m * 16; const float gt = gs[r]; bf16_t* rowp = YS + (size_t)r * 1024 + col0;
#pragma unroll
                for (int bj = 0; bj < 2; ++bj) { const f32x4 v0 = acc[ai][bj][m][0] * gt, v1 = acc[ai][bj][m][1] * gt;
                    u32x4 w; w.x = cvt_pk_bf16(v0[0], v0[1]); w.y = cvt_pk_bf16(v0[2], v0[3]); w.z = cvt_pk_bf16(v1[0], v1[1]); w.w = cvt_pk_bf16(v1[2], v1[3]);
                    *(u32x4*)(rowp + bj * HALF) = w; } }
    }
};
struct MoeOrder {
    const __attribute__((address_space(3))) int* t2e; int ntiles, nN, G, c;
    __device__ bool next(int i, Unit& u) const { const int L = i * G + c; if (L >= ntiles * nN) return false; u.pm = L / nN; u.pn = L % nN; u.e = t2e[u.pm]; return true; }
    __device__ __forceinline__ void a_ready(const Unit&) const {}
    __device__ __forceinline__ void done(const Unit&) const {}
};
template <class Epi, class Sched, bool ALIGN_EPI = false, bool SP2 = false>
__device__ __forceinline__ void gemm_phase(PG8_LAS unsigned char* lds, const Gemm g, const Sched& S, const Epi& E) {
    int tid_ = threadIdx.x; asm volatile("" : "+v"(tid_));
    const int tid = tid_, wid = __builtin_amdgcn_readfirstlane(tid >> 6), lane = tid & 63, wr = wid >> 2, wc = wid & 3, fr = lane & 15, fq = lane >> 4;
    const int K = g.K, nt = K / BK;
    unsigned voffA[2], voffB[2];
#pragma unroll
    for (int i = 0; i < 2; ++i) { int R, C; stage_rc(tid * 16 + i * 8192, R, C); const int Rb = Epi::PERM ? ((R & ~31) + perm32(R & 31)) : R;
        voffA[i] = (unsigned)(R * K + C) * 2u; voffB[i] = (unsigned)(Rb * K + C) * 2u; }
    const size_t kstep = (size_t)(BK * 2);
    const size_t hstep = (size_t)HALF * K * 2;
    const size_t tstep = 2 * hstep;
    const unsigned ldsw = (unsigned)wid * 1024u;
    const int aoff = lds_byte(wr * 64 + fr, fq * 8), boff = lds_byte(wc * 32 + fr, fq * 8);
#define PG8_SA(b, h) (((b) * 2 + (h)) * HTB)
#define PG8_SB(b, h) ((4 + (b) * 2 + (h)) * HTB)
#define PG8_STAGE(bufoff, gbase, voff) do { _Pragma("unroll") for (int _i = 0; _i < 2; ++_i) \
        __builtin_amdgcn_global_load_lds((const unsigned*)((const char*)(gbase) + (voff)[_i]), (PG8_LAS unsigned*)(lds + (bufoff) + ldsw + _i * 8192), 16, 0, 0); } while (0)
#define PG8_LDA(dst, b, h) do { _Pragma("unroll") for (int m = 0; m < 4; ++m) _Pragma("unroll") for (int k = 0; k < 2; ++k) dst[m][k] = *(const PG8_LAS bf16x8*)(lds + PG8_SA(b, h) + aoff + m * 2048 + k * 1024); } while (0)
#define PG8_LDB(dst, b, h) do { _Pragma("unroll") for (int n = 0; n < 2; ++n) _Pragma("unroll") for (int k = 0; k < 2; ++k) dst[n][k] = *(const PG8_LAS bf16x8*)(lds + PG8_SB(b, h) + boff + n * 2048 + k * 1024); } while (0)
#define PG8_MMA(ai, bj, At, Bt) do { __builtin_amdgcn_s_setprio(1); _Pragma("unroll") for (int m = 0; m < 4; ++m) _Pragma("unroll") for (int n = 0; n < 2; ++n) _Pragma("unroll") for (int k = 0; k < 2; ++k) \
        acc[ai][bj][m][n] = __builtin_amdgcn_mfma_f32_16x16x32_bf16(Bt[n][k], At[m][k], acc[ai][bj][m][n], 0, 0, 0); __builtin_amdgcn_s_setprio(0); } while (0)
#define PG8_WAIT_V(n) asm volatile("s_waitcnt vmcnt(" #n ")" ::: "memory")
#define PG8_WAIT_L(n) asm volatile("s_waitcnt lgkmcnt(" #n ")" ::: "memory")
#define PG8_BAR __builtin_amdgcn_s_barrier()
#define PG8_SCHED __builtin_amdgcn_sched_barrier(0)
    Unit cur, nxt; int ui = 0;
    if (!S.next(0, cur)) return;
    f32x4 acc[2][2][4][2];
#pragma unroll
    for (int a = 0; a < 2; ++a)
#pragma unroll
        for (int b = 0; b < 2; ++b)
#pragma unroll
            for (int m = 0; m < 4; ++m)
#pragma unroll
                for (int n = 0; n < 2; ++n) acc[a][b][m][n] = (f32x4){0.f, 0.f, 0.f, 0.f};
    bf16x8 At[4][2], B0[2][2], B1[2][2];
    const char* cA = (const char*)g.A + (size_t)cur.pm * tstep; const char* cB = (const char*)g.Bt + (size_t)cur.e * g.estride + (size_t)cur.pn * tstep;
    S.a_ready(cur);
    if constexpr (SP2) {
        PG8_STAGE(PG8_SB(0, 0), cB, voffB); PG8_STAGE(PG8_SB(0, 1), cB + hstep, voffB); PG8_STAGE(PG8_SA(0, 0), cA, voffA); PG8_STAGE(PG8_SA(0, 1), cA + hstep, voffA);
        if (wr == 1) PG8_BAR;
        PG8_WAIT_V(2); PG8_BAR;
        PG8_STAGE(PG8_SB(1, 0), cB + kstep, voffB); PG8_STAGE(PG8_SA(1, 0), cA + kstep, voffA); PG8_STAGE(PG8_SB(1, 1), cB + hstep + kstep, voffB);
        PG8_WAIT_V(6); PG8_BAR;
    } else {
        PG8_STAGE(PG8_SB(0, 0), cB, voffB); PG8_STAGE(PG8_SA(0, 0), cA, voffA); PG8_STAGE(PG8_SB(0, 1), cB + hstep, voffB); PG8_STAGE(PG8_SA(0, 1), cA + hstep, voffA);
        if (wr == 1) PG8_BAR;
        PG8_WAIT_V(4); PG8_BAR;
        PG8_STAGE(PG8_SB(1, 0), cB + kstep, voffB); PG8_STAGE(PG8_SA(1, 0), cA + kstep, voffA); PG8_STAGE(PG8_SB(1, 1), cB + hstep + kstep, voffB);
        PG8_WAIT_V(6); PG8_BAR;
    }
    for (;;) {
        const bool has_next = S.next(ui + 1, nxt);
        const char* nA = has_next ? (const char*)g.A + (size_t)nxt.pm * tstep : cA; const char* nB = has_next ? (const char*)g.Bt + (size_t)nxt.e * g.estride + (size_t)nxt.pn * tstep : cB;
        for (int t = 0; t < nt; t += 2) {
            const bool last = (t == nt - 2);
            const char* a1 = cA + (size_t)(t + 1) * kstep;
            const char* a2 = last ? nA : cA + (size_t)(t + 2) * kstep; const char* b2 = last ? nB : cB + (size_t)(t + 2) * kstep;
            const char* a3 = a2 + kstep; const char* b3 = b2 + kstep;
            if (last && has_next) S.a_ready(nxt);
            if constexpr (SP2) {
            PG8_LDB(B0, 0, 0); PG8_LDB(B1, 0, 1); PG8_SCHED; PG8_LDA(At, 0, 0); PG8_STAGE(PG8_SA(1, 1), a1 + hstep, voffA);
            PG8_WAIT_V(8); PG8_WAIT_L(0); PG8_BAR; PG8_MMA(0, 0, At, B0); PG8_MMA(0, 1, At, B1); PG8_BAR; PG8_SCHED;
            PG8_LDA(At, 0, 1); PG8_STAGE(PG8_SB(0, 0), b2, voffB); PG8_STAGE(PG8_SB(0, 1), b2 + hstep, voffB); PG8_STAGE(PG8_SA(0, 0), a2, voffA);
            PG8_WAIT_V(8); PG8_WAIT_L(0); PG8_BAR; PG8_MMA(1, 0, At, B0); PG8_MMA(1, 1, At, B1); PG8_BAR; PG8_SCHED;
            PG8_LDB(B0, 1, 0); PG8_LDB(B1, 1, 1); PG8_SCHED; PG8_LDA(At, 1, 0); PG8_STAGE(PG8_SA(0, 1), a2 + hstep, voffA);
            PG8_WAIT_V(8); PG8_WAIT_L(0); PG8_BAR; PG8_MMA(0, 0, At, B0); PG8_MMA(0, 1, At, B1); PG8_BAR; PG8_SCHED;
            PG8_LDA(At, 1, 1); PG8_STAGE(PG8_SB(1, 0), b3, voffB); PG8_STAGE(PG8_SB(1, 1), b3 + hstep, voffB); PG8_STAGE(PG8_SA(1, 0), a3, voffA);
            PG8_WAIT_V(8); PG8_WAIT_L(0); PG8_BAR; PG8_MMA(1, 0, At, B0); PG8_MMA(1, 1, At, B1); PG8_BAR; PG8_SCHED;
            } else {
            PG8_LDB(B0, 0, 0); PG8_SCHED; PG8_LDA(At, 0, 0); PG8_STAGE(PG8_SA(1, 1), a1 + hstep, voffA);
            PG8_WAIT_L(8); PG8_BAR; PG8_WAIT_L(0); PG8_MMA(0, 0, At, B0); PG8_BAR; PG8_SCHED;
            PG8_LDB(B1, 0, 1); PG8_STAGE(PG8_SB(0, 0), b2, voffB);
            PG8_BAR; PG8_WAIT_L(0); PG8_MMA(0, 1, At, B1); PG8_BAR;
            PG8_LDA(At, 0, 1); PG8_STAGE(PG8_SA(0, 0), a2, voffA);
            PG8_BAR; PG8_WAIT_L(0); PG8_MMA(1, 0, At, B0); PG8_BAR; PG8_SCHED;
            PG8_STAGE(PG8_SB(0, 1), b2 + hstep, voffB);
            PG8_WAIT_V(6); PG8_BAR; PG8_MMA(1, 1, At, B1); PG8_BAR;
            PG8_LDB(B0, 1, 0); PG8_SCHED; PG8_LDA(At, 1, 0); PG8_STAGE(PG8_SA(0, 1), a2 + hstep, voffA);
            PG8_WAIT_L(8); PG8_BAR; PG8_WAIT_L(0); PG8_MMA(0, 0, At, B0); PG8_BAR; PG8_SCHED;
            PG8_LDB(B1, 1, 1); PG8_STAGE(PG8_SB(1, 0), b3, voffB);
            PG8_BAR; PG8_WAIT_L(0); PG8_MMA(0, 1, At, B1); PG8_BAR;
            PG8_LDA(At, 1, 1); PG8_STAGE(PG8_SA(1, 0), a3, voffA);
            PG8_BAR; PG8_WAIT_L(0); PG8_MMA(1, 0, At, B0); PG8_BAR; PG8_SCHED;
            PG8_STAGE(PG8_SB(1, 1), b3 + hstep, voffB);
            PG8_WAIT_V(6); PG8_BAR; PG8_MMA(1, 1, At, B1); PG8_BAR;
            }
        }
        if constexpr (ALIGN_EPI) { if (wr == 0) PG8_BAR; }
        if constexpr (!Epi::AFTER_DRAIN) { E(acc, cur, wr, wc, fr, fq); S.done(cur); }
        if (!has_next) break;
#pragma unroll
        for (int a = 0; a < 2; ++a)
#pragma unroll
            for (int b = 0; b < 2; ++b)
#pragma unroll
                for (int m = 0; m < 4; ++m)
#pragma unroll
                    for (int n = 0; n < 2; ++n) acc[a][b][m][n] = (f32x4){0.f, 0.f, 0.f, 0.f};
        cur = nxt; cA = nA; cB = nB; ++ui;
        if constexpr (ALIGN_EPI) { if (wr == 1) PG8_BAR; }
    }
    PG8_WAIT_V(0);
    if constexpr (!ALIGN_EPI) { if (wr == 0) PG8_BAR; }
    PG8_BAR;
    if constexpr (Epi::AFTER_DRAIN) { E.fused(acc, cur, wr, wc, fr, fq, lds, wid, lane); S.done(cur); }
#undef PG8_SA
#undef PG8_SB
#undef PG8_STAGE
#undef PG8_LDA
#undef PG8_LDB
#undef PG8_MMA
#undef PG8_WAIT_V
#undef PG8_WAIT_L
#undef PG8_BAR
#undef PG8_SCHED
}
}
#include <hip/hip_bf16.h>
#include <cmath>
namespace attn_body {
using bf16=__hip_bfloat16;
using bf16x8=__attribute__((ext_vector_type(8)))short;
using s16x4=__attribute__((ext_vector_type(4)))short;
using f32x16=__attribute__((ext_vector_type(16)))float;
using u32x4=__attribute__((ext_vector_type(4)))unsigned;
constexpr int D=64;
#ifndef TBATCH
#define TBATCH 16
#endif
constexpr int NW=8,QBLK=32,QB=QBLK*NW,KVBLK=64;
constexpr int ATTN_UNIT_ROWS=QB;
__device__ __forceinline__ int crow(int r,int hi){return (r&3)+8*(r>>2)+4*hi;}
#define SBAR() __builtin_amdgcn_sched_barrier(0)
__device__ __forceinline__ void cmask(f32x16&p0,f32x16&p1,int jb,int qrel,int hi){
  const float NEG=-INFINITY; int kb=64*jb+4*hi;
  #pragma unroll
  for(int r=0;r<16;++r){int kv=kb+(r&3)+8*(r>>2); if(kv>qrel)p0[r]=NEG; if(kv+32>qrel)p1[r]=NEG;}
}

constexpr int NSLOT=3, SLOTB=8192;
constexpr int LDS_K=0, LDS_V=NSLOT*SLOTB, LDS_WS=2*NSLOT*SLOTB, LDS_OST=LDS_WS+NW*64*4, LDS_TBL=LDS_OST+NW*4096, TBL_N=1344, LDS_BYTES=LDS_TBL+8*TBL_N*4;
constexpr float C2=0.125f*1.4426950408889634f;
__device__ __forceinline__ void glds16(const void*gsrc,unsigned lds_dst){unsigned keep;
  asm volatile("s_mov_b32 %0, m0\n\ts_mov_b32 m0, %2\n\ts_nop 0\n\tglobal_load_lds_dwordx4 %1, off\n\ts_mov_b32 m0, %0":"=&s"(keep):"v"(gsrc),"s"(lds_dst):"memory");}
__device__ __forceinline__ float max3f(float a,float b,float c){float r;asm("v_max3_f32 %0, %1, %2, %3":"=v"(r):"v"(a),"v"(b),"v"(c));return r;}
__device__ __forceinline__ float max2f(float a,float b){float r;asm("v_max_f32_e32 %0, %1, %2":"=v"(r):"v"(a),"v"(b));return r;}
__device__ __forceinline__ float fadd_s(float a,float b){float r;asm("v_add_f32_e32 %0, %1, %2":"=v"(r):"v"(a),"v"(b));return r;}
__device__ __forceinline__ float fsub_s(float a,float b){float r;asm("v_sub_f32_e32 %0, %1, %2":"=v"(r):"v"(a),"v"(b));return r;}
typedef float f32x2_t __attribute__((ext_vector_type(2))); typedef __bf16 bf16x2_t __attribute__((ext_vector_type(2)));
__device__ __forceinline__ unsigned cvtpk_s(float lo,float hi){f32x2_t v={lo,hi};bf16x2_t b=__builtin_convertvector(v,bf16x2_t);return __builtin_bit_cast(unsigned,b);}
#define WAIT_BAR(N) asm volatile("s_waitcnt vmcnt(" #N ") lgkmcnt(0)\n\ts_barrier":::"memory")

__device__ __forceinline__ void qkt(f32x16&p0,f32x16&p1,const char*Kslot,const bf16x8*qr,const f32x16&negm,int r32,int hi){
  const char*kb=Kslot+hi*1024+r32*16;
  #pragma unroll
  for(int d0=0;d0<4;++d0){
    const bf16x8 b0=*reinterpret_cast<const bf16x8*>(kb+d0*2048);
    const bf16x8 b1=*reinterpret_cast<const bf16x8*>(kb+d0*2048+512);
    if(d0==0){p0=__builtin_amdgcn_mfma_f32_32x32x16_bf16(b0,qr[0],negm,0,0,0);p1=__builtin_amdgcn_mfma_f32_32x32x16_bf16(b1,qr[0],negm,0,0,0);}
    else{p0=__builtin_amdgcn_mfma_f32_32x32x16_bf16(b0,qr[d0],p0,0,0,0);p1=__builtin_amdgcn_mfma_f32_32x32x16_bf16(b1,qr[d0],p1,0,0,0);}}
}
typedef __attribute__((address_space(3))) const char* lds_cptr;
typedef short v4i16_t __attribute__((ext_vector_type(4)));
__device__ __forceinline__ void kload8(bf16x8*kf,lds_cptr kp){
  kf[0]=*(const __attribute__((address_space(3))) bf16x8*)(kp);      kf[1]=*(const __attribute__((address_space(3))) bf16x8*)(kp+512);
  kf[2]=*(const __attribute__((address_space(3))) bf16x8*)(kp+2048); kf[3]=*(const __attribute__((address_space(3))) bf16x8*)(kp+2560);
  kf[4]=*(const __attribute__((address_space(3))) bf16x8*)(kp+4096); kf[5]=*(const __attribute__((address_space(3))) bf16x8*)(kp+4608);
  kf[6]=*(const __attribute__((address_space(3))) bf16x8*)(kp+6144); kf[7]=*(const __attribute__((address_space(3))) bf16x8*)(kp+6656);
}
__device__ __forceinline__ void kload2(bf16x8*kf,lds_cptr kp,int j){ kf[2*j]=*(const __attribute__((address_space(3))) bf16x8*)(kp+j*2048); kf[2*j+1]=*(const __attribute__((address_space(3))) bf16x8*)(kp+j*2048+512); }
__device__ __forceinline__ s16x4 vtr(lds_cptr p){ return __builtin_bit_cast(s16x4,__builtin_amdgcn_ds_read_tr16_b64_v4i16((__attribute__((address_space(3))) v4i16_t*)p)); }
__device__ __forceinline__ float rowmax(const f32x16&p0,const f32x16&p1){
  float a=max3f(p0[0],p0[1],p1[0]),b=max3f(p0[2],p0[3],p1[1]);a=max3f(a,p1[2],p1[3]);
  #pragma unroll
  for(int r=4;r<16;r+=4){a=max3f(a,p0[r],p0[r+1]);b=max3f(b,p0[r+2],p0[r+3]);a=max3f(a,p1[r],p1[r+1]);b=max3f(b,p1[r+2],p1[r+3]);}
  const float m=max2f(a,b);
  auto rr=__builtin_amdgcn_permlane32_swap(__float_as_uint(m),__float_as_uint(m),false,false);
  return max2f(__uint_as_float(rr[0]),__uint_as_float(rr[1]));
}
__device__ __forceinline__ void pv(f32x16*o,int vb,bf16x8 pa0,bf16x8 pa1,bf16x8 pa2,bf16x8 pa3){
  #pragma unroll
  for(int d0=0;d0<2;++d0){s16x4 lo[4],hi[4];
    #pragma unroll
    for(int ks=0;ks<4;++ks){
      asm volatile("ds_read_b64_tr_b16 %0,%1 offset:%c2":"=&v"(lo[ks]):"v"(vb),"i"(d0*4096+ks*1024):"memory");
      asm volatile("ds_read_b64_tr_b16 %0,%1 offset:%c2":"=&v"(hi[ks]):"v"(vb),"i"(d0*4096+ks*1024+512):"memory");}
    asm volatile("s_waitcnt lgkmcnt(0)":::"memory");SBAR();
    #define PK(k) (bf16x8){lo[k][0],lo[k][1],lo[k][2],lo[k][3],hi[k][0],hi[k][1],hi[k][2],hi[k][3]}
    o[d0]=__builtin_amdgcn_mfma_f32_32x32x16_bf16(pa0,PK(0),o[d0],0,0,0);
    o[d0]=__builtin_amdgcn_mfma_f32_32x32x16_bf16(pa1,PK(1),o[d0],0,0,0);
    o[d0]=__builtin_amdgcn_mfma_f32_32x32x16_bf16(pa2,PK(2),o[d0],0,0,0);
    o[d0]=__builtin_amdgcn_mfma_f32_32x32x16_bf16(pa3,PK(3),o[d0],0,0,0);
    #undef PK
  }
}

#ifndef ATTN_STORE16
#define ATTN_STORE16(p,v) __builtin_nontemporal_store((v),(u32x4*)(p))
#endif
__device__ __forceinline__ void attn_build_tables(int tid,const float*tb,char*shm){
  typedef __attribute__((address_space(3))) float lds_f32;
  lds_f32*T=(lds_f32*)((__attribute__((address_space(3))) char*)shm+LDS_TBL);
  for(int i=tid;i<8*TBL_N;i+=NW*64){ const int hh=i/TBL_N, d=i-hh*TBL_N-256; float v=0.f; if(d<0)v=-INFINITY; else if(d<1024)v=tb[hh*1024+d]-tb[hh*1024+1023]; T[i]=v; }
}
template<int THRL,bool MOBA,bool USE_NEGM> __device__ __forceinline__ void attn_unit(int tid,int qb,const bf16*Qb,int qpitch,const bf16*__restrict__ Kb,int kpitch,const bf16*__restrict__ Vb,int vpitch,bf16*Ob,int opitch,int hh,const float*kmean,char*shm){
  const int lane=tid&63,r32=lane&31,hi=lane>>5; const int wid=__builtin_amdgcn_readfirstlane(tid>>6);
  const int q0=qb*QB;
  const bf16*Qw=Qb+(long)(q0+wid*QBLK)*qpitch;
  const bf16*Kh=Kb,*Vh=Vb;
  const int qpos=q0+wid*QBLK+r32;
  typedef __attribute__((address_space(3))) float lds_f32;
  const lds_f32*Tl=(const lds_f32*)((__attribute__((address_space(3))) char*)shm+LDS_TBL)+hh*TBL_N;
  unsigned selmask=0xffffffffu;
  if(MOBA){
    float qf[64];
    { const uint4*qp=(const uint4*)(Qw+(long)r32*qpitch);
      _Pragma("unroll") for(int c=0;c<8;++c){ const uint4 u=qp[c]; qf[8*c]=__uint_as_float(u.x<<16);qf[8*c+1]=__uint_as_float(u.x&0xffff0000u);qf[8*c+2]=__uint_as_float(u.y<<16);qf[8*c+3]=__uint_as_float(u.y&0xffff0000u);
        qf[8*c+4]=__uint_as_float(u.z<<16);qf[8*c+5]=__uint_as_float(u.z&0xffff0000u);qf[8*c+6]=__uint_as_float(u.w<<16);qf[8*c+7]=__uint_as_float(u.w&0xffff0000u);} }
    float v1=-INFINITY,v2=-INFINITY,v3=-INFINITY; int i1=31,i2=31,i3=31;
    for(int n=0;n<qb;++n){ const float*km=kmean+n*64; float g=0.f;
      _Pragma("unroll") for(int i=0;i<64;++i)g+=qf[i]*km[i];
      if(g>v1){v3=v2;i3=i2;v2=v1;i2=i1;v1=g;i1=n;} else if(g>v2){v3=v2;i3=i2;v2=g;i2=n;} else if(g>v3){v3=g;i3=n;} }
    selmask=(1u<<qb); if(i1<31)selmask|=1u<<i1; if(i2<31)selmask|=1u<<i2; if(i3<31)selmask|=1u<<i3; }
  #define TMAP(t) (MOBA?(((t)<4)?(NT-4+(t)):((t)-4)):(t))
  const unsigned lds0=(unsigned)(uintptr_t)shm;
  float*wsf=(float*)(shm+LDS_WS)+wid*64;
  const bf16*ksrc=Kh+(long)lane*kpitch+wid*8;
  const bf16*vsrc=Vh+(long)(16*(wid&3)+(lane>>2))*vpitch+(wid>>2)*32+(lane&3)*8;
  const unsigned kdst=lds0+LDS_K+wid*1024, vdst=lds0+LDS_V+wid*1024;
  #define DMA_K(t,slot) glds16(ksrc+(long)TMAP(t)*KVBLK*kpitch,(unsigned)__builtin_amdgcn_readfirstlane(kdst+(slot)))
  #define DMA_V(t,slot) glds16(vsrc+(long)TMAP(t)*KVBLK*vpitch,(unsigned)__builtin_amdgcn_readfirstlane(vdst+(slot)))
  const int vb0=(int)(lds0+LDS_V)+((lane>>4)&1)*32+(lane&3)*8+(4*hi+((lane&15)>>2))*64;
  const char*Kbase=shm+LDS_K; bf16x8 kf[8];
  const lds_cptr shm3=(lds_cptr)shm; const lds_cptr kp0=shm3+LDS_K+hi*1024+r32*16; const lds_cptr vp0=shm3+LDS_V+((lane>>4)&1)*32+(lane&3)*8+(4*hi+((lane&15)>>2))*64;
  const int NT=(q0+QB)/KVBLK;
  DMA_K(0,0);DMA_V(0,0);DMA_K(1,SLOTB);
  bf16x8 qr[4];
  #pragma unroll
  for(int d0=0;d0<4;++d0)qr[d0]=*reinterpret_cast<const bf16x8*>(&Qw[(long)r32*qpitch+d0*16+hi*8]);
  float mhat=0.f,l_reg=0.f;f32x16 o[2];o[0]=f32x16{};o[1]=f32x16{};f32x16 negm=f32x16{}; if(USE_NEGM){asm volatile("":"+v"(negm));}
  #define NEGMC (USE_NEGM?negm:f32x16{})
  #define CMASK(P0,P1,t) do{ int D0_=qpos-64*TMAP(t)-4*hi; D0_=D0_<1083?D0_:1083; int bi_=D0_+(256-59); \
      if(MOBA){ if(!((selmask>>(TMAP(t)>>2))&1u))bi_=64; } const volatile lds_f32*tp_=Tl+bi_; \
      { float tb_[TBATCH]; _Pragma("unroll") for(int b0_=0;b0_<16;b0_+=TBATCH){ _Pragma("unroll") for(int r=0;r<TBATCH;++r)tb_[r]=tp_[59-(((b0_+r)&3)+8*((b0_+r)>>2))]; _Pragma("unroll") for(int r=0;r<TBATCH;++r)P0[b0_+r]=fadd_s(P0[b0_+r],tb_[r]); } \
        _Pragma("unroll") for(int b0_=0;b0_<16;b0_+=TBATCH){ _Pragma("unroll") for(int r=0;r<TBATCH;++r)tb_[r]=tp_[27-(((b0_+r)&3)+8*((b0_+r)>>2))]; _Pragma("unroll") for(int r=0;r<TBATCH;++r)P1[b0_+r]=fadd_s(P1[b0_+r],tb_[r]); } } }while(0)
  bool resc=false,mnz=false;
  #define START(P0,P1) do{ const float rm=rowmax(P0,P1); resc=false; \
    if(__any(rm>(float)THRL)){ const float dl=__builtin_fmaxf(rm,0.f); mhat=fadd_s(mhat,dl); mnz=true; \
      _Pragma("unroll") for(int r=0;r<16;++r){P0[r]=fsub_s(P0[r],dl);P1[r]=fsub_s(P1[r],dl);} \
      if(USE_NEGM){ _Pragma("unroll") for(int r=0;r<16;++r)negm[r]=-mhat; asm volatile("":"+v"(negm)); } } \
    _Pragma("unroll") for(int r=0;r<16;++r)P0[r]=__builtin_amdgcn_exp2f(P0[r]); }while(0)
  #define RESC() do{ if(resc){ asm volatile("s_waitcnt lgkmcnt(0)":::"memory"); \
      _Pragma("unroll") for(int d_=0;d_<2;++d_) _Pragma("unroll") for(int r=0;r<16;++r)o[d_][r]*=wsf[crow(r,hi)]; } }while(0)
  f32x16 pA0,pA1,pB0,pB1;
  int sl_prev=0,sl_cur=0,sl_next=SLOTB;
  #define ROT() do{sl_prev=sl_cur;sl_cur=sl_next;sl_next=(sl_next==(NSLOT-1)*SLOTB)?0:sl_next+SLOTB;}while(0)
  DMA_K(2,2*SLOTB);
  WAIT_BAR(3);
  qkt(pA0,pA1,Kbase,qr,negm,r32,hi);asm volatile("s_nop 15\n\ts_nop 7":"+v"(pA0),"+v"(pA1));CMASK(pA0,pA1,0);
  START(pA0,pA1);
  _Pragma("unroll") for(int r=0;r<16;++r)pA1[r]=__builtin_amdgcn_exp2f(pA1[r]);
  WAIT_BAR(0);
  DMA_K(3,0);DMA_V(1,SLOTB);
  ROT();
  kload8(kf,kp0+sl_cur);
  WAIT_BAR(2);
  s16x4 vlo[8],vhi[8]; u32x4 pw0,pw1,pw2,pw3;
  #define PKW(P,B) cvtpk_s(P[B],P[B+1])
  #define PAF(k) __builtin_bit_cast(bf16x8,pw##k)
  #define VFR(i) (bf16x8){vlo[i][0],vlo[i][1],vlo[i][2],vlo[i][3],vhi[i][0],vhi[i][1],vhi[i][2],vhi[i][3]}
  #define PIN(x) asm volatile("":"+v"(x))
  #define MX3(a,b,c) __builtin_fmaxf(__builtin_fmaxf((a),(b)),(c))
  #define GAPA(MF,A0,A1,A2,A3,W0,W1,PW) do{ MF; sacc+=A0; sacc+=A1; sacc+=A2; sacc+=A3; PIN(sacc); W0; W1; PIN(PW); SBAR(); }while(0)
  #define EX(v) __builtin_amdgcn_exp2f(v)
  #define GAPB(MF,X,B) do{ MF; X[B]=EX(X[B]); X[B+1]=EX(X[B+1]); X[B+2]=EX(X[B+2]); X[B+3]=EX(X[B+3]); PIN(X); SBAR(); }while(0)
  #define VRD(i) do{ vlo[i]=vtr(vp_+(((i)>>2)*4096+((i)&3)*1024)); vhi[i]=vtr(vp_+(((i)>>2)*4096+((i)&3)*1024+512)); }while(0)
  #define KRD(G,j) do{ if(G){ kload2(kf,kp0+sl_next,j); SBAR(); } }while(0)
  #define STEP(C0,C1,P0,P1,t,GK,GV,GL) do{ SBAR(); \
    const lds_cptr vp_=vp0+sl_prev; \
    VRD(0); SBAR(); float sacc=(P0[0]+P0[1]); \
    GAPA(C0=__builtin_amdgcn_mfma_f32_32x32x16_bf16(kf[0],qr[0],NEGMC,0,0,0), P0[2],P0[3],P0[4],P0[5],     pw0[0]=PKW(P0,0), pw0[1]=PKW(P0,2), pw0); \
    VRD(4); SBAR(); GAPA(C1=__builtin_amdgcn_mfma_f32_32x32x16_bf16(kf[1],qr[0],NEGMC,0,0,0), P0[6],P0[7],P0[8],P0[9],     pw0[2]=PKW(P0,4), pw0[3]=PKW(P0,6), pw0); \
    VRD(1); SBAR(); GAPA(C0=__builtin_amdgcn_mfma_f32_32x32x16_bf16(kf[2],qr[1],C0,0,0,0),   P0[10],P0[11],P0[12],P0[13], pw1[0]=PKW(P0,8), pw1[1]=PKW(P0,10), pw1); \
    VRD(5); SBAR(); GAPA(C1=__builtin_amdgcn_mfma_f32_32x32x16_bf16(kf[3],qr[1],C1,0,0,0),   P0[14],P0[15],P1[0],P1[1],   pw1[2]=PKW(P0,12),pw1[3]=PKW(P0,14), pw1); \
    VRD(2); SBAR(); GAPA(C0=__builtin_amdgcn_mfma_f32_32x32x16_bf16(kf[4],qr[2],C0,0,0,0),   P1[2],P1[3],P1[4],P1[5],     pw2[0]=PKW(P1,0), pw2[1]=PKW(P1,2), pw2); \
    VRD(6); SBAR(); GAPA(C1=__builtin_amdgcn_mfma_f32_32x32x16_bf16(kf[5],qr[2],C1,0,0,0),   P1[6],P1[7],P1[8],P1[9],     pw2[2]=PKW(P1,4), pw2[3]=PKW(P1,6), pw2); \
    VRD(3); SBAR(); GAPA(C0=__builtin_amdgcn_mfma_f32_32x32x16_bf16(kf[6],qr[3],C0,0,0,0),   P1[10],P1[11],P1[12],P1[13], pw3[0]=PKW(P1,8), pw3[1]=PKW(P1,10), pw3); \
    VRD(7); SBAR(); GAPA(C1=__builtin_amdgcn_mfma_f32_32x32x16_bf16(kf[7],qr[3],C1,0,0,0),   P1[14],P1[15],0.f,0.f,       pw3[2]=PKW(P1,12),pw3[3]=PKW(P1,14), pw3); \
    l_reg+=sacc; \
    if(GK){DMA_K((t)+3,sl_cur);} if(GV){DMA_V((t)+1,sl_next);} \
    { const float d_=__builtin_fmaxf(C0[15],C1[15]); asm volatile(""::"v"(d_)); asm volatile("":"+v"(C0),"+v"(C1)); } \
    if(!USE_NEGM&&mnz){ _Pragma("unroll") for(int r=0;r<16;++r){C0[r]=fsub_s(C0[r],mhat);C1[r]=fsub_s(C1[r],mhat);} } \
    CMASK(C0,C1,t); \
    { float a=MX3(C0[0],C0[1],C1[0]),b=MX3(C0[2],C0[3],C1[1]); a=MX3(a,C1[2],C1[3]); \
      _Pragma("unroll") for(int r=4;r<16;r+=4){a=MX3(a,C0[r],C0[r+1]);b=MX3(b,C0[r+2],C0[r+3]);a=MX3(a,C1[r],C1[r+1]);b=MX3(b,C1[r+2],C1[r+3]);} \
      float rm=__builtin_fmaxf(a,b); { auto rr=__builtin_amdgcn_permlane32_swap(__float_as_uint(rm),__float_as_uint(rm),false,false); rm=__builtin_fmaxf(__uint_as_float(rr[0]),__uint_as_float(rr[1])); } \
      resc=false; \
      if(__builtin_expect(__any(rm>(float)THRL),0)){ const float dl=__builtin_fmaxf(rm,0.f); mhat+=dl; mnz=true; \
        _Pragma("unroll") for(int r=0;r<16;++r){C0[r]=fsub_s(C0[r],dl);C1[r]=fsub_s(C1[r],dl);} \
        if(USE_NEGM){ _Pragma("unroll") for(int r=0;r<16;++r)negm[r]=-mhat; asm volatile("":"+v"(negm)); } \
        const float f=__builtin_amdgcn_exp2f(-dl); l_reg*=f; if(hi==0)wsf[r32]=f; resc=true; } } \
    SBAR(); \
    GAPB(o[0]=__builtin_amdgcn_mfma_f32_32x32x16_bf16(PAF(0),VFR(0),o[0],0,0,0), C0,0); \
    GAPB(o[1]=__builtin_amdgcn_mfma_f32_32x32x16_bf16(PAF(0),VFR(4),o[1],0,0,0), C0,4); \
    KRD(GL,0); GAPB(o[0]=__builtin_amdgcn_mfma_f32_32x32x16_bf16(PAF(1),VFR(1),o[0],0,0,0), C0,8); \
    KRD(GL,1); GAPB(o[1]=__builtin_amdgcn_mfma_f32_32x32x16_bf16(PAF(1),VFR(5),o[1],0,0,0), C0,12); \
    KRD(GL,2); GAPB(o[0]=__builtin_amdgcn_mfma_f32_32x32x16_bf16(PAF(2),VFR(2),o[0],0,0,0), C1,0); \
    KRD(GL,3); GAPB(o[1]=__builtin_amdgcn_mfma_f32_32x32x16_bf16(PAF(2),VFR(6),o[1],0,0,0), C1,4); \
    GAPB(o[0]=__builtin_amdgcn_mfma_f32_32x32x16_bf16(PAF(3),VFR(3),o[0],0,0,0), C1,8); \
    GAPB(o[1]=__builtin_amdgcn_mfma_f32_32x32x16_bf16(PAF(3),VFR(7),o[1],0,0,0), C1,12); \
    }while(0)
  int t=1;
  #undef CMASK
  #define CMASK(P0,P1,t) do{}while(0)
  const int t_tbl=MOBA?0:((q0>=853)?((q0-853)/64+1):0);
  for(;t+5<NT&&t+1<t_tbl;t+=2){
    STEP(pB0,pB1,pA0,pA1,t,true,true,true);     WAIT_BAR(2); RESC(); ROT();
    STEP(pA0,pA1,pB0,pB1,t+1,true,true,true);   WAIT_BAR(2); RESC(); ROT();
  }
  #undef CMASK
  #define CMASK(P0,P1,t) do{ int D0_=qpos-64*TMAP(t)-4*hi; D0_=D0_<1083?D0_:1083; int bi_=D0_+(256-59); \
      if(MOBA){ if(!((selmask>>(TMAP(t)>>2))&1u))bi_=64; } const volatile lds_f32*tp_=Tl+bi_; \
      { float tb_[TBATCH]; _Pragma("unroll") for(int b0_=0;b0_<16;b0_+=TBATCH){ _Pragma("unroll") for(int r=0;r<TBATCH;++r)tb_[r]=tp_[59-(((b0_+r)&3)+8*((b0_+r)>>2))]; _Pragma("unroll") for(int r=0;r<TBATCH;++r)P0[b0_+r]=fadd_s(P0[b0_+r],tb_[r]); } \
        _Pragma("unroll") for(int b0_=0;b0_<16;b0_+=TBATCH){ _Pragma("unroll") for(int r=0;r<TBATCH;++r)tb_[r]=tp_[27-(((b0_+r)&3)+8*((b0_+r)>>2))]; _Pragma("unroll") for(int r=0;r<TBATCH;++r)P1[b0_+r]=fadd_s(P1[b0_+r],tb_[r]); } } }while(0)
  #define ENDW(tt) do{ if((tt)+3<NT){WAIT_BAR(2);} else if((tt)+2<NT){WAIT_BAR(1);} else {WAIT_BAR(0);} }while(0)
  for(;t+1<NT;t+=2){
    STEP(pB0,pB1,pA0,pA1,t,(t+3<NT),(t+1<NT),(t+1<NT));       ENDW(t);   RESC(); ROT();
    STEP(pA0,pA1,pB0,pB1,t+1,(t+4<NT),(t+2<NT),(t+2<NT));     ENDW(t+1); RESC(); ROT();
  }
  STEP(pB0,pB1,pA0,pA1,NT-1,false,false,false); RESC();
  { float sacc=pB0[0]+pB0[1]; _Pragma("unroll") for(int r=2;r<16;++r)sacc+=pB0[r]; _Pragma("unroll") for(int r=0;r<16;++r)sacc+=pB1[r]; l_reg+=sacc;
    pw0=(u32x4){PKW(pB0,0),PKW(pB0,2),PKW(pB0,4),PKW(pB0,6)};pw1=(u32x4){PKW(pB0,8),PKW(pB0,10),PKW(pB0,12),PKW(pB0,14)};pw2=(u32x4){PKW(pB1,0),PKW(pB1,2),PKW(pB1,4),PKW(pB1,6)};pw3=(u32x4){PKW(pB1,8),PKW(pB1,10),PKW(pB1,12),PKW(pB1,14)};
    SBAR(); pv(o,vb0+sl_cur,PAF(0),PAF(1),PAF(2),PAF(3)); }
  #undef PKW
  #undef PAF
  #undef VFR
  #undef PIN
  #undef MX3
  #undef GAPA
  #undef GAPB
  #undef EX
  #undef VRD
  #undef KRD
  #undef STEP
  #undef ENDW
  {auto rr=__builtin_amdgcn_permlane32_swap(__float_as_uint(l_reg),__float_as_uint(l_reg),false,false);l_reg=__uint_as_float(rr[0])+__uint_as_float(rr[1]);}
  if(hi==0)wsf[32+r32]=l_reg;asm volatile("s_waitcnt lgkmcnt(0)":::"memory");
  float rli[16];
  #pragma unroll
  for(int r=0;r<16;++r)rli[r]=__builtin_amdgcn_rcpf(wsf[32+crow(r,hi)]);
  bf16*Ow=Ob+(long)(q0+wid*QBLK)*opitch;
  { bf16*stg=(bf16*)(shm+LDS_OST)+wid*2048;
    #pragma unroll
    for(int r=0;r<16;++r){const int orow=crow(r,hi);
      #pragma unroll
      for(int d0=0;d0<2;++d0)stg[orow*64+d0*32+r32]=__float2bfloat16(o[d0][r]*rli[r]);}
    asm volatile("s_waitcnt lgkmcnt(0)":::"memory");
    #pragma unroll
    for(int i=0;i<4;++i){const int row=i*8+(lane>>3),ch=lane&7; const u32x4 v=*(const u32x4*)(stg+row*64+ch*8); ATTN_STORE16(Ow+(long)row*opitch+ch*8,v);} }
  asm volatile("s_waitcnt lgkmcnt(0)\n\ts_barrier":::"memory");
  #undef DMA_K
  #undef DMA_V
  #undef TMAP
  #undef NEGMC
  #undef CMASK
  #undef START
  #undef RESC
  #undef ROT
}

constexpr int DV_K=0, DV_V=NSLOT*SLOTB, DV_VSLOT=2*SLOTB, DV_WS=DV_V+NSLOT*DV_VSLOT, DV_OST=0;
static_assert(DV_WS+NW*64*4<=LDS_TBL && NW*8192<=DV_WS, "dv unit LDS layout");
template<int THRL> __device__ __forceinline__ void attn_unit_dv(int tid,int qb,const bf16*Qb,int qpitch,const bf16*__restrict__ Kb,int kpitch,const bf16*__restrict__ Vb,int vpitch,bf16*Ob,int opitch,int hh,char*shm){
  const int lane=tid&63,r32=lane&31,hi=lane>>5; const int wid=__builtin_amdgcn_readfirstlane(tid>>6);
  const int q0=qb*QB;
  const bf16*Qw=Qb+(long)(q0+wid*QBLK)*qpitch;
  const int qpos=q0+wid*QBLK+r32;
  typedef __attribute__((address_space(3))) float lds_f32;
  const lds_cptr shm3=(lds_cptr)shm;
  const lds_f32*Tl=(const lds_f32*)(shm3+LDS_TBL)+hh*TBL_N;
  lds_f32*wsf=(lds_f32*)(shm3+DV_WS)+wid*64;
  const unsigned lds0=(unsigned)(uintptr_t)shm;
  const bf16*ksrc=Kb+(long)lane*kpitch+wid*8;
  const bf16*vsrc=Vb+(long)(16*(wid&3)+(lane>>2))*vpitch+(wid>>2)*32+(lane&3)*8;
  const unsigned kdst=lds0+DV_K+wid*1024, vdst=lds0+DV_V+wid*1024;
  #define DVK(t,slot) glds16(ksrc+(long)(t)*KVBLK*kpitch,(unsigned)__builtin_amdgcn_readfirstlane(kdst+(slot)))
  #define DVV(t,slot) do{ glds16(vsrc+(long)(t)*KVBLK*vpitch,(unsigned)__builtin_amdgcn_readfirstlane(vdst+2*(slot))); glds16(vsrc+(long)(t)*KVBLK*vpitch+64,(unsigned)__builtin_amdgcn_readfirstlane(vdst+2*(slot)+8192)); }while(0)
  const lds_cptr kp0=shm3+DV_K+hi*1024+r32*16; const lds_cptr vp0=shm3+DV_V+((lane>>4)&1)*32+(lane&3)*8+(4*hi+((lane&15)>>2))*64;
  const int NT=(q0+QB)/KVBLK;
  DVK(0,0);DVV(0,0);DVK(1,SLOTB);
  bf16x8 qr[4];
  #pragma unroll
  for(int d0=0;d0<4;++d0)qr[d0]=*reinterpret_cast<const bf16x8*>(&Qw[(long)r32*qpitch+d0*16+hi*8]);
  float mhat=0.f,l_reg=0.f; f32x16 o[4]; o[0]=f32x16{};o[1]=f32x16{};o[2]=f32x16{};o[3]=f32x16{};
  const int t_tbl=(q0>=853)?((q0-853)/64+1):0;
  #define DV_CMASK(P0,P1,t) do{ int D0_=qpos-64*(t)-4*hi; D0_=D0_<1083?D0_:1083; const volatile lds_f32*tp_=Tl+(D0_+(256-59)); \
      { float tb_[8]; _Pragma("unroll") for(int b0_=0;b0_<16;b0_+=8){ _Pragma("unroll") for(int r=0;r<8;++r)tb_[r]=tp_[59-(((b0_+r)&3)+8*((b0_+r)>>2))]; _Pragma("unroll") for(int r=0;r<8;++r)P0[b0_+r]=fadd_s(P0[b0_+r],tb_[r]); } \
        _Pragma("unroll") for(int b0_=0;b0_<16;b0_+=8){ _Pragma("unroll") for(int r=0;r<8;++r)tb_[r]=tp_[27-(((b0_+r)&3)+8*((b0_+r)>>2))]; _Pragma("unroll") for(int r=0;r<8;++r)P1[b0_+r]=fadd_s(P1[b0_+r],tb_[r]); } } }while(0)
  #define DV_MX3(a,b,c) __builtin_fmaxf(__builtin_fmaxf((a),(b)),(c))
  #define DV_ROWMAX(rm,C0,C1) do{ float a=DV_MX3(C0[0],C0[1],C1[0]),b=DV_MX3(C0[2],C0[3],C1[1]); a=DV_MX3(a,C1[2],C1[3]); \
      _Pragma("unroll") for(int r=4;r<16;r+=4){a=DV_MX3(a,C0[r],C0[r+1]);b=DV_MX3(b,C0[r+2],C0[r+3]);a=DV_MX3(a,C1[r],C1[r+1]);b=DV_MX3(b,C1[r+2],C1[r+3]);} \
      rm=__builtin_fmaxf(a,b); { auto rr=__builtin_amdgcn_permlane32_swap(__float_as_uint(rm),__float_as_uint(rm),false,false); rm=__builtin_fmaxf(__uint_as_float(rr[0]),__uint_as_float(rr[1])); } }while(0)
  u32x4 pw0,pw1,pw2,pw3;
  #define DV_PKW(P,B) cvtpk_s(P[B],P[B+1])
  #define DV_SUM_PACK(C0,C1) do{ float sa_=fadd_s(C0[0],C0[1]),sb_=fadd_s(C1[0],C1[1]); _Pragma("unroll") for(int r=2;r<16;++r){ sa_=fadd_s(sa_,C0[r]); sb_=fadd_s(sb_,C1[r]); } l_reg+=fadd_s(sa_,sb_); \
      pw0=(u32x4){DV_PKW(C0,0),DV_PKW(C0,2),DV_PKW(C0,4),DV_PKW(C0,6)};pw1=(u32x4){DV_PKW(C0,8),DV_PKW(C0,10),DV_PKW(C0,12),DV_PKW(C0,14)}; \
      pw2=(u32x4){DV_PKW(C1,0),DV_PKW(C1,2),DV_PKW(C1,4),DV_PKW(C1,6)};pw3=(u32x4){DV_PKW(C1,8),DV_PKW(C1,10),DV_PKW(C1,12),DV_PKW(C1,14)}; }while(0)
  #define DV_PAF(k) __builtin_bit_cast(bf16x8,pw##k)
  #define DV_VFR(i) (bf16x8){vlo[i][0],vlo[i][1],vlo[i][2],vlo[i][3],vhi[i][0],vhi[i][1],vhi[i][2],vhi[i][3]}
  #define DV_VRD(n) do{ vlo[(n)&3]=vtr(vp_+((2*((n)>>3)+((n)&1))*4096+(((n)&7)>>1)*1024)); vhi[(n)&3]=vtr(vp_+((2*((n)>>3)+((n)&1))*4096+(((n)&7)>>1)*1024+512)); }while(0)
  #define DV_PIN(x) asm volatile("":"+v"(x))
  #define DV_KRD(j) do{ if(gv){ kload2(kf,kp0+sl_next,j); } }while(0)
  #define DV_EX(v) __builtin_amdgcn_exp2f(v)
  #define DV_GAP(n,X,B,RD) do{ o[2*((n)>>3)+((n)&1)]=__builtin_amdgcn_mfma_f32_32x32x16_bf16((((n)&7)>>1)==0?DV_PAF(0):((((n)&7)>>1)==1?DV_PAF(1):((((n)&7)>>1)==2?DV_PAF(2):DV_PAF(3))),DV_VFR((n)&3),o[2*((n)>>3)+((n)&1)],0,0,0); \
      X[B]=DV_EX(X[B]); X[B+1]=DV_EX(X[B+1]); DV_PIN(X); RD; SBAR(); }while(0)
  #define DV_SOFT1(C0,C1,t) do{ { const float d_=__builtin_fmaxf(C0[15],C1[15]); asm volatile(""::"v"(d_)); asm volatile("":"+v"(C0),"+v"(C1)); }     \
      if(mnz){ _Pragma("unroll") for(int r=0;r<16;++r){C0[r]=fsub_s(C0[r],mhat);C1[r]=fsub_s(C1[r],mhat);} } \
      if((t)>=t_tbl) DV_CMASK(C0,C1,t); \
      { float rm; DV_ROWMAX(rm,C0,C1); resc=false; \
        if(__builtin_expect(__any(rm>(float)THRL),0)){ const float dl=__builtin_fmaxf(rm,0.f); mhat+=dl; \
          _Pragma("unroll") for(int r=0;r<16;++r){C0[r]=fsub_s(C0[r],dl);C1[r]=fsub_s(C1[r],dl);} \
          const float f=__builtin_amdgcn_exp2f(-dl); l_reg*=f; if(hi==0)wsf[r32]=f; resc=true; mnz=true; } } }while(0)
  #define DV_RESC() do{ if(resc){ asm volatile("s_waitcnt lgkmcnt(0)":::"memory"); \
      _Pragma("unroll") for(int r=0;r<16;++r){ const float fr_=wsf[crow(r,hi)]; o[0][r]*=fr_;o[1][r]*=fr_;o[2][r]*=fr_;o[3][r]*=fr_; } asm volatile("s_waitcnt lgkmcnt(0)":::"memory"); } }while(0)
  int sl_prev=0,sl_cur=0,sl_next=SLOTB;
  #define DV_ROT() do{sl_prev=sl_cur;sl_cur=sl_next;sl_next=(sl_next==(NSLOT-1)*SLOTB)?0:sl_next+SLOTB;}while(0)
  DVK(2,2*SLOTB);
  WAIT_BAR(3);
  f32x16 pA0,pA1,pB0,pB1; bf16x8 kf[8]; s16x4 vlo[4],vhi[4]; bool resc=false,mnz=false;
  { const f32x16 z=f32x16{}; qkt(pA0,pA1,shm+DV_K,qr,z,r32,hi);
    DV_SOFT1(pA0,pA1,0);
    _Pragma("unroll") for(int r=0;r<16;++r){pA0[r]=DV_EX(pA0[r]);pA1[r]=DV_EX(pA1[r]);} }
  WAIT_BAR(0);
  DVK(3,0);DVV(1,SLOTB);
  DV_ROT();
  kload8(kf,kp0+sl_cur);
  WAIT_BAR(3);
  #define DV_GAPA(MF,A0,A1,A2,A3,W0,W1,PW) do{ MF; sacc+=A0; sacc+=A1; sacc+=A2; sacc+=A3; DV_PIN(sacc); W0; W1; DV_PIN(PW); SBAR(); }while(0)
  #define DV_Z f32x16{}
  #define DV_STEP(C0,C1,P0,P1,t) do{ const bool gk=((t)+3<NT), gv=((t)+1<NT); const lds_cptr vp_=vp0+2*sl_prev; SBAR(); \
    float sacc=(P0[0]+P0[1]); \
    DV_VRD(0); SBAR(); DV_GAPA(C0=__builtin_amdgcn_mfma_f32_32x32x16_bf16(kf[0],qr[0],DV_Z,0,0,0), P0[2],P0[3],P0[4],P0[5],     pw0[0]=DV_PKW(P0,0), pw0[1]=DV_PKW(P0,2), pw0); \
    DV_VRD(1); SBAR(); DV_GAPA(C1=__builtin_amdgcn_mfma_f32_32x32x16_bf16(kf[1],qr[0],DV_Z,0,0,0), P0[6],P0[7],P0[8],P0[9],     pw0[2]=DV_PKW(P0,4), pw0[3]=DV_PKW(P0,6), pw0); \
    DV_VRD(2); SBAR(); DV_GAPA(C0=__builtin_amdgcn_mfma_f32_32x32x16_bf16(kf[2],qr[1],C0,0,0,0),   P0[10],P0[11],P0[12],P0[13], pw1[0]=DV_PKW(P0,8), pw1[1]=DV_PKW(P0,10), pw1); \
    DV_VRD(3); SBAR(); DV_GAPA(C1=__builtin_amdgcn_mfma_f32_32x32x16_bf16(kf[3],qr[1],C1,0,0,0),   P0[14],P0[15],P1[0],P1[1],   pw1[2]=DV_PKW(P0,12),pw1[3]=DV_PKW(P0,14), pw1); \
    DV_GAPA(C0=__builtin_amdgcn_mfma_f32_32x32x16_bf16(kf[4],qr[2],C0,0,0,0),   P1[2],P1[3],P1[4],P1[5],     pw2[0]=DV_PKW(P1,0), pw2[1]=DV_PKW(P1,2), pw2); \
    DV_GAPA(C1=__builtin_amdgcn_mfma_f32_32x32x16_bf16(kf[5],qr[2],C1,0,0,0),   P1[6],P1[7],P1[8],P1[9],     pw2[2]=DV_PKW(P1,4), pw2[3]=DV_PKW(P1,6), pw2); \
    DV_GAPA(C0=__builtin_amdgcn_mfma_f32_32x32x16_bf16(kf[6],qr[3],C0,0,0,0),   P1[10],P1[11],P1[12],P1[13], pw3[0]=DV_PKW(P1,8), pw3[1]=DV_PKW(P1,10), pw3); \
    DV_GAPA(C1=__builtin_amdgcn_mfma_f32_32x32x16_bf16(kf[7],qr[3],C1,0,0,0),   P1[14],P1[15],0.f,0.f,       pw3[2]=DV_PKW(P1,12),pw3[3]=DV_PKW(P1,14), pw3); \
    l_reg+=sacc; \
    if(gk){DVK((t)+3,sl_cur);} if(gv){DVV((t)+1,sl_next);} \
    DV_SOFT1(C0,C1,t); \
    SBAR(); \
    DV_GAP(0,C0,0,  DV_VRD(4));   DV_GAP(1,C0,2,  DV_VRD(5));   DV_GAP(2,C0,4,  DV_VRD(6));   DV_GAP(3,C0,6,  DV_VRD(7)); \
    DV_GAP(4,C0,8,  DV_VRD(8));   DV_GAP(5,C0,10, DV_VRD(9));   DV_GAP(6,C0,12, DV_VRD(10));  DV_GAP(7,C0,14, DV_VRD(11)); \
    DV_GAP(8,C1,0,  DV_VRD(12); DV_KRD(0));  DV_GAP(9,C1,2,  DV_VRD(13); DV_KRD(1));  DV_GAP(10,C1,4, DV_VRD(14); DV_KRD(2));  DV_GAP(11,C1,6, DV_VRD(15); DV_KRD(3)); \
    DV_GAP(12,C1,8, (void)0);     DV_GAP(13,C1,10,(void)0);     DV_GAP(14,C1,12,(void)0);     DV_GAP(15,C1,14,(void)0); \
    DV_RESC(); \
    if((t)+1<NT){ if((t)+3<NT){WAIT_BAR(3);} else if((t)+2<NT){WAIT_BAR(2);} else {WAIT_BAR(0);} DV_ROT(); } }while(0)
  { int t=1;
    for(;t+1<NT;t+=2){ DV_STEP(pB0,pB1,pA0,pA1,t); DV_STEP(pA0,pA1,pB0,pB1,t+1); }
    DV_STEP(pB0,pB1,pA0,pA1,t); }
  #undef DV_GAPA
  #undef DV_Z
  #undef DV_STEP
  DV_SUM_PACK(pB0,pB1);
  { const lds_cptr vp_=vp0+2*sl_cur;
    _Pragma("unroll") for(int n0=0;n0<16;n0+=4){
      _Pragma("unroll") for(int q=0;q<4;++q) DV_VRD(n0+q);
      _Pragma("unroll") for(int q=0;q<4;++q){ const int n=n0+q, kg=(n&7)>>1; const bf16x8 pa_=kg==0?DV_PAF(0):(kg==1?DV_PAF(1):(kg==2?DV_PAF(2):DV_PAF(3)));
        o[2*(n>>3)+(n&1)]=__builtin_amdgcn_mfma_f32_32x32x16_bf16(pa_,DV_VFR(n&3),o[2*(n>>3)+(n&1)],0,0,0); } } }
  asm volatile("s_waitcnt lgkmcnt(0)\n\ts_barrier":::"memory");
  {auto rr=__builtin_amdgcn_permlane32_swap(__float_as_uint(l_reg),__float_as_uint(l_reg),false,false);l_reg=__uint_as_float(rr[0])+__uint_as_float(rr[1]);}
  if(hi==0)wsf[32+r32]=l_reg;asm volatile("s_waitcnt lgkmcnt(0)":::"memory");
  float rli[16];
  #pragma unroll
  for(int r=0;r<16;++r)rli[r]=__builtin_amdgcn_rcpf(wsf[32+crow(r,hi)]);
  bf16*Ow=Ob+(long)(q0+wid*QBLK)*opitch;
  { bf16*stg=(bf16*)(shm+DV_OST)+wid*4096;
    #pragma unroll
    for(int r=0;r<16;++r){const int orow=crow(r,hi);
      #pragma unroll
      for(int d0=0;d0<4;++d0)stg[orow*128+d0*32+r32]=__float2bfloat16(o[d0][r]*rli[r]);}
    asm volatile("s_waitcnt lgkmcnt(0)":::"memory");
    #pragma unroll
    for(int i=0;i<8;++i){const int row=i*4+(lane>>4),ch=lane&15; const u32x4 v=*(const u32x4*)(stg+row*128+ch*8); ATTN_STORE16(Ow+(long)row*opitch+ch*8,v);} }
  asm volatile("s_waitcnt lgkmcnt(0)\n\ts_barrier":::"memory");
  #undef DVK
  #undef DVV
  #undef DV_CMASK
  #undef DV_MX3
  #undef DV_ROWMAX
  #undef DV_PKW
  #undef DV_SUM_PACK
  #undef DV_VFR
  #undef DV_VRD
  #undef DV_PIN
  #undef DV_EX
  #undef DV_GAP
  #undef DV_KRD
  #undef DV_SOFT1
  #undef DV_RESC
  #undef DV_PAF
  #undef DV_ROT
}
constexpr int ATTN_LDS_BYTES=LDS_BYTES;
#undef SBAR
#undef WAIT_BAR
}
#define GAS __attribute__((address_space(1)))
#define LAS __attribute__((address_space(3)))
typedef unsigned short bf16;
typedef unsigned v4u __attribute__((ext_vector_type(4)));
typedef float f32x4 __attribute__((ext_vector_type(4)));
typedef short bf16x8 __attribute__((ext_vector_type(8)));
typedef GAS unsigned gu32;
typedef GAS unsigned long long gu64;
#define RLX_AGENT __ATOMIC_RELAXED, __HIP_MEMORY_SCOPE_AGENT
#define LDS_WAIT() asm volatile("s_waitcnt lgkmcnt(0)" ::: "memory")
#define VM_WAIT() asm volatile("s_waitcnt vmcnt(0)" ::: "memory")
__device__ __forceinline__ unsigned long long rt() { return __builtin_amdgcn_s_memrealtime(); }
__device__ __forceinline__ unsigned f2bf(float f) { unsigned u = __builtin_bit_cast(unsigned, f); return (u + 0x7fffu + ((u >> 16) & 1u)) >> 16; }
__device__ __forceinline__ unsigned pk2(float lo, float hi) { return f2bf(lo) | (f2bf(hi) << 16); }

#define XB_TMO      128
#define XB_XCNT(j)  (256  + 64 * (j))
#define XB_XSUB(j)  (1280 + 64 * (j))
#define XB_XGEN(j)  (2304 + 64 * (j))
#define XB_TOP      3328
#define XB_TOPGEN   3392
#define XB_LSUB(j)  (3456 + 64 * (j))
#define XB_LGEN(j)  (4480 + 64 * (j))
#define XCD_BAR_WORDS 5504
#define XB_SPIN_CAP (1u << 25)

__device__ __forceinline__ unsigned xb_ld(unsigned* p)              { return __hip_atomic_load(p, __ATOMIC_RELAXED, __HIP_MEMORY_SCOPE_AGENT); }
__device__ __forceinline__ unsigned xb_add(unsigned* p, unsigned v) { return __hip_atomic_fetch_add(p, v, __ATOMIC_RELAXED, __HIP_MEMORY_SCOPE_AGENT); }
__device__ __forceinline__ unsigned xb_xcc_id() { return (unsigned)__builtin_amdgcn_s_getreg((3 << 11) | 20) & 0xFu; }
#define XB_SPIN(cond, bar) do { unsigned _sp = 0; while (cond) { __builtin_amdgcn_s_sleep(1); \
    if ((++_sp & 255u) == 0u) { if (xb_ld(&(bar)[XB_TMO])) break; if (_sp > XB_SPIN_CAP) { atomicAdd(&(bar)[XB_TMO], 1u); break; } } } } while (0)

struct XcdBarrier {
    unsigned* bar; unsigned x;
    volatile LAS unsigned* st;
};

__device__ __forceinline__ XcdBarrier xcd_barrier_post(unsigned* bar, volatile LAS unsigned* st) {
    XcdBarrier b; b.bar = bar; b.x = xb_xcc_id(); b.st = st;
    if (threadIdx.x == 0) st[2] = xb_add(&bar[XB_XCNT(b.x)], 1u);
    return b;
}
__device__ __forceinline__ void xcd_barrier_complete(unsigned* bar, unsigned x, unsigned& nloc, unsigned& nx) {
    const unsigned G = gridDim.x * gridDim.y * gridDim.z;
    unsigned sum, cnt, mine, sp = 0u;
    for (;;) {
        sum = 0u; cnt = 0u; mine = 0u;
#pragma nounroll
        for (unsigned j = 0; j < 16; ++j) { const unsigned c = xb_ld(&bar[XB_XCNT(j)]); sum += c; cnt += (c > 0u) ? 1u : 0u; mine = (j == x) ? c : mine; }
        if (sum == G) break;
        __builtin_amdgcn_s_sleep(1);
        if ((++sp & 255u) == 0u) { if (xb_ld(&bar[XB_TMO])) break; if (sp > XB_SPIN_CAP) { atomicAdd(&bar[XB_TMO], 1u); break; } }
    }
    nloc = mine > 0u ? mine : 1u; nx = cnt > 0u ? cnt : 1u;
}

__device__ __forceinline__ void xcd_barrier(const XcdBarrier& b) {
    asm volatile("s_waitcnt vmcnt(0)" ::: "memory");
    __syncthreads();
    if (threadIdx.x == 0) {
        unsigned* bar; { GAS unsigned* bl_ = (GAS unsigned*)b.bar; asm volatile("" : "+s"(bl_)); bar = (unsigned*)bl_; } unsigned bx_ = b.x; asm volatile("" : "+s"(bx_));
        __builtin_amdgcn_s_waitcnt(0);
        unsigned nloc = b.st[0], nx = b.st[1];
        if (nloc == 0u) { xcd_barrier_complete(bar, bx_, nloc, nx); b.st[0] = nloc; b.st[1] = nx; }
        const unsigned old = xb_add(&bar[XB_XSUB(bx_)], 1u);
        const unsigned gen = old / nloc;
        if (old + 1u == (gen + 1u) * nloc) {
            __builtin_amdgcn_fence(__ATOMIC_RELEASE, "agent");
            asm volatile("s_waitcnt vmcnt(0)" ::: "memory");
            const unsigned og = xb_add(&bar[XB_TOP], 1u);
            const unsigned tg = og / nx;
            if (og + 1u == (tg + 1u) * nx) xb_add(&bar[XB_TOPGEN], 1u);
            else XB_SPIN(xb_ld(&bar[XB_TOPGEN]) == tg, bar);
            __builtin_amdgcn_fence(__ATOMIC_ACQUIRE, "agent");
            xb_add(&bar[XB_XGEN(bx_)], 1u);
            asm volatile("s_waitcnt vmcnt(0)" ::: "memory");
        } else {
            XB_SPIN(xb_ld(&bar[XB_XGEN(bx_)]) == gen, bar);
            __builtin_amdgcn_fence(__ATOMIC_ACQUIRE, "agent");
            asm volatile("s_waitcnt vmcnt(0)" ::: "memory");
        }
    }
    __syncthreads();
}

__device__ __forceinline__ void xcd_census_regular(const XcdBarrier& b) {
    if (threadIdx.x == 0) { bool reg = (gridDim.x == 256u);
#pragma nounroll
        for (unsigned j = 0; j < 16; ++j) { const unsigned c = xb_ld(&b.bar[XB_XCNT(j)]); if (c != (j < 8u ? 32u : 0u)) reg = false; }
        b.st[3] = reg ? 1u : 0u; }
    __syncthreads();
}
__device__ __forceinline__ void xcd_local_barrier(const XcdBarrier& b) {
    asm volatile("s_waitcnt vmcnt(0)" ::: "memory");
    __syncthreads();
    if (threadIdx.x == 0) {
        unsigned* bar; { GAS unsigned* bl_ = (GAS unsigned*)b.bar; asm volatile("" : "+s"(bl_)); bar = (unsigned*)bl_; } unsigned bx_ = b.x; asm volatile("" : "+s"(bx_));
        __builtin_amdgcn_s_waitcnt(0);
        const unsigned nloc = b.st[0];
        const unsigned old = xb_add(&bar[XB_LSUB(bx_)], 1u);
        const unsigned gen = old / nloc;
        if (old + 1u == (gen + 1u) * nloc) xb_add(&bar[XB_LGEN(bx_)], 1u);
        else XB_SPIN(xb_ld(&bar[XB_LGEN(bx_)]) == gen, bar);
        __builtin_amdgcn_fence(__ATOMIC_ACQUIRE, "agent");
        asm volatile("s_waitcnt vmcnt(0)" ::: "memory");
    }
    __syncthreads();
}
constexpr int NB = 4, SEQ = 4096, DM = 1024, M = NB * SEQ, NL = 4;
constexpr int NIN = 3328;
constexpr int NWAVES = 8;
#ifndef PG8_SP2
#define PG8_SP2 true
#endif
constexpr float LOG2E = 1.4426950408889634f;
constexpr float C2 = 0.125f * LOG2E;
constexpr int MOE_ROWS = 40960;
constexpr size_t MiB = 1u << 20;
constexpr size_t WS_CTL = 0, CTL_ZERO_BYTES = 1 * MiB;
constexpr size_t WS_MOD = 1 * MiB;
constexpr size_t WS_TB = WS_MOD + 512 * 1024;
constexpr size_t WS_LAM = WS_TB + 64 * 1024;
constexpr size_t WS_KMEAN = WS_LAM + 4096;
constexpr size_t WS_WIN = 2 * MiB;
constexpr size_t WS_WOUT = 28 * MiB;
constexpr size_t WS_W13 = 36 * MiB;
constexpr size_t WS_W2 = 292 * MiB;
constexpr size_t WS_HB = 420 * MiB;
constexpr size_t WS_XS = 452 * MiB, WS_HS = 532 * MiB, WS_YS = 572 * MiB;
constexpr size_t WS_SMALL = 652 * MiB;
constexpr size_t WS_QD = 656 * MiB, WS_KD = 672 * MiB, WS_VD = 688 * MiB, WS_QM = 704 * MiB, WS_KM = 712 * MiB, WS_VM = 720 * MiB;
constexpr size_t WS_PR = 728 * MiB;
constexpr size_t WS_MIX = 784 * MiB;
constexpr size_t WS_OD = 816 * MiB;
constexpr size_t WS_RW = 848 * MiB;
constexpr size_t WS_END = 960 * MiB;
constexpr int CW_BAR = 4096;
constexpr int CW_CNT = 16384;
constexpr int CW_CUR = 16384 + 1024;
constexpr int RING_BYTES = 131072, LDSCTL_OFF = RING_BYTES, MISC_OFF = LDSCTL_OFF + 320, TAB_OFF = LDSCTL_OFF + 1024;
constexpr int LDS_BYTES = 147456;
static_assert(WS_QD == pg8::EPI_WS_QD && WS_KD == pg8::EPI_WS_KD && WS_VD == pg8::EPI_WS_VD && WS_QM == pg8::EPI_WS_QM && WS_KM == pg8::EPI_WS_KM && WS_VM == pg8::EPI_WS_VM && WS_PR == pg8::EPI_WS_PR, "epilogue workspace map");
__device__ __forceinline__ float rl63(float v) { return __uint_as_float(__builtin_amdgcn_readlane(__float_as_uint(v), 63)); }
template <int CTRL, int ROWMASK> __device__ __forceinline__ float dpp_f(float oldv, float v) { return __int_as_float(__builtin_amdgcn_update_dpp(__float_as_int(oldv), __float_as_int(v), CTRL, ROWMASK, 0xf, false)); }
__device__ __forceinline__ float wave_sum(float v) {
    v += dpp_f<0xB1, 0xf>(0.f, v);
    v += dpp_f<0x4E, 0xf>(0.f, v);
    v += dpp_f<0x141, 0xf>(0.f, v);
    v += dpp_f<0x140, 0xf>(0.f, v);
    v += dpp_f<0x142, 0xa>(0.f, v);
    v += dpp_f<0x143, 0xc>(0.f, v);
    return rl63(v);
}
__device__ __forceinline__ float wave_max(float v) {
    v = fmaxf(v, dpp_f<0xB1, 0xf>(v, v)); v = fmaxf(v, dpp_f<0x4E, 0xf>(v, v)); v = fmaxf(v, dpp_f<0x141, 0xf>(v, v)); v = fmaxf(v, dpp_f<0x140, 0xf>(v, v));
    v = fmaxf(v, dpp_f<0x142, 0xa>(v, v)); v = fmaxf(v, dpp_f<0x143, 0xc>(v, v));
    return rl63(v);
}
__device__ __forceinline__ float bf_lo(unsigned u) { return __uint_as_float(u << 16); }
__device__ __forceinline__ float bf_hi(unsigned u) { return __uint_as_float(u & 0xffff0000u); }
__device__ __forceinline__ float bf2f(bf16 h) { return __uint_as_float((unsigned)h << 16); }
__device__ __forceinline__ float rl(float v, int i) { return __uint_as_float(__builtin_amdgcn_readlane(__float_as_uint(v), i)); }
__device__ __forceinline__ float sigmoidf_(float x) { return 1.0f / (1.0f + __expf(-x)); }

struct Frame {
    LAS unsigned char* lds; volatile LAS unsigned* MISC; gu32* ctl;
    int tid, lane, wave, vcu, G, gw, NGW;
    int xl, cf;
    float* out; unsigned char* ws;
};
__device__ __forceinline__ unsigned char* launder_ptr(unsigned char* p) {
    GAS unsigned char* g = (GAS unsigned char*)p; asm volatile("" : "+s"(g)); return (unsigned char*)g; }
#define GIN(i) ((const float*)(const GAS float*)A.in[i])
#define WSP(T, off) ((T*)(launder_ptr(F.ws) + (off)))

template <class RowMap>
__device__ __forceinline__ void tr_item(const float* W, int N, int K, bf16* WT, LAS float* scr, int k0, int n0, int lane, RowMap rm) {
#pragma unroll
    for (int i = 0; i < 8; ++i) { const int kk = 8 * i + (lane >> 3), c4 = lane & 7; const f32x4 x = *(const GAS f32x4*)(W + (size_t)(k0 + kk) * N + n0 + 4 * c4);
        LAS float* d = scr + kk * 33 + 4 * c4; d[0] = x.x; d[1] = x.y; d[2] = x.z; d[3] = x.w; }
    LDS_WAIT(); asm volatile("" ::: "memory");
    const int c = lane & 7;
#pragma unroll
    for (int j = 0; j < 4; ++j) { const int n = (lane >> 3) + 8 * j; const LAS float* s = scr + (8 * c) * 33 + n;
        v4u o; o.x = pk2(s[0 * 33], s[1 * 33]); o.y = pk2(s[2 * 33], s[3 * 33]); o.z = pk2(s[4 * 33], s[5 * 33]); o.w = pk2(s[6 * 33], s[7 * 33]);
        *(GAS v4u*)(WT + (size_t)rm(n0 + n) * K + k0 + 8 * c) = o; }
    LDS_WAIT(); asm volatile("" ::: "memory");
}
__device__ __forceinline__ int inproj_row(int n) {
    const int L = n < 896 ? 2304 + n : n - 896;
    const int l = L & 255;
    return (L & ~255) | (((l >> 5) & 1) << 7) | ((l >> 6) << 5) | (l & 31);
}
__device__ __forceinline__ int t5_bucket(int n) {
    if (n < 16) return n;
    const float x = (8.0f * __log2f((float)n) - 32.0f) * (1.0f / 3.0f) + 1e-4f;
    int b = 16 + (int)x; return b > 31 ? 31 : b;
}
struct TrDesc { const float* src; bf16* dst; int N, K, n0, kind; };
__device__ __forceinline__ TrDesc moe_tr_desc(KArgs& A, unsigned char* ws, int l, int r) {
    constexpr int I_W1 = 16 * 16, I_W2 = 8 * 32, N_W1 = 32 * I_W1;
    TrDesc d;
    if (r < 2 * N_W1) { const int which = r / N_W1; r %= N_W1; const int le = l * 32 + r / I_W1, q = r % I_W1, kb = q / 16, nb = q % 16;
        d.N = 512; d.K = 1024; d.n0 = 32 * nb; d.kind = which;
        d.src = (const float*)(const GAS float*)A.in[which ? 31 : 30] + (size_t)le * 1024 * 512 + (size_t)(64 * kb) * 512 + 32 * nb; d.dst = (bf16*)(ws + WS_W13) + (size_t)le * 1024 * 1024 + 64 * kb; }
    else { r -= 2 * N_W1; const int le = l * 32 + r / I_W2, q = r % I_W2, kb = q / 32, nb = q % 32;
        d.N = 1024; d.K = 512; d.n0 = 32 * nb; d.kind = 2;
        d.src = (const float*)(const GAS float*)A.in[32] + (size_t)le * 512 * 1024 + (size_t)(64 * kb) * 1024 + 32 * nb; d.dst = (bf16*)(ws + WS_W2) + (size_t)le * 1024 * 512 + 64 * kb; }
    return d;
}
__device__ __forceinline__ void moe_tr_load(const TrDesc& d, int lane, f32x4 (&x)[8]) {
#pragma unroll
    for (int i = 0; i < 8; ++i) x[i] = __builtin_nontemporal_load((const GAS f32x4*)(d.src + (size_t)(8 * i + (lane >> 3)) * d.N + 4 * (lane & 7)));
}
__device__ __forceinline__ void moe_tr_store(const TrDesc& d, int lane, const f32x4 (&x)[8], LAS float* scr) {
#pragma unroll
    for (int i = 0; i < 8; ++i) { const int kk = 8 * i + (lane >> 3), c4 = lane & 7; LAS float* p = scr + kk * 33 + 4 * c4; p[0] = x[i].x; p[1] = x[i].y; p[2] = x[i].z; p[3] = x[i].w; }
    LDS_WAIT(); asm volatile("" ::: "memory");
    const int c = lane & 7;
#pragma unroll
    for (int j = 0; j < 4; ++j) { const int n = (lane >> 3) + 8 * j; const LAS float* s = scr + (8 * c) * 33 + n;
        v4u o; o.x = pk2(s[0 * 33], s[1 * 33]); o.y = pk2(s[2 * 33], s[3 * 33]); o.z = pk2(s[4 * 33], s[5 * 33]); o.w = pk2(s[6 * 33], s[7 * 33]);
        const int nn = d.n0 + n, row = d.kind == 2 ? nn : 8 * (nn >> 2) + 4 * d.kind + (nn & 3);
        __builtin_nontemporal_store(o, (GAS v4u*)(d.dst + (size_t)row * d.K + 8 * c)); }
    LDS_WAIT(); asm volatile("" ::: "memory");
}
__device__ __forceinline__ void moe_convert_ticket(Frame& F, KArgs& A, int l, int ct) {
    int lane_ = F.lane, wv_ = F.wave; asm volatile("" : "+v"(lane_), "+s"(wv_));
    LAS float* scr = (LAS float*)(F.lds + wv_ * 8448);
    const int r0 = ct * 64 + wv_ * 8;
    f32x4 x0[8], x1[8], x2[8], x3[8];
    TrDesc d0 = moe_tr_desc(A, F.ws, l, r0), d1 = moe_tr_desc(A, F.ws, l, r0 + 1), d2 = moe_tr_desc(A, F.ws, l, r0 + 2), d3 = moe_tr_desc(A, F.ws, l, r0 + 3);
    moe_tr_load(d0, lane_, x0); moe_tr_load(d1, lane_, x1); moe_tr_load(d2, lane_, x2); moe_tr_load(d3, lane_, x3);
    moe_tr_store(d0, lane_, x0, scr); d0 = moe_tr_desc(A, F.ws, l, r0 + 4); moe_tr_load(d0, lane_, x0);
    moe_tr_store(d1, lane_, x1, scr); d1 = moe_tr_desc(A, F.ws, l, r0 + 5); moe_tr_load(d1, lane_, x1);
    moe_tr_store(d2, lane_, x2, scr); d2 = moe_tr_desc(A, F.ws, l, r0 + 6); moe_tr_load(d2, lane_, x2);
    moe_tr_store(d3, lane_, x3, scr); d3 = moe_tr_desc(A, F.ws, l, r0 + 7); moe_tr_load(d3, lane_, x3);
    moe_tr_store(d0, lane_, x0, scr); moe_tr_store(d1, lane_, x1, scr); moe_tr_store(d2, lane_, x2, scr); moe_tr_store(d3, lane_, x3, scr);
}
__device__ __forceinline__ void p0_prologue(Frame& F, KArgs& A) {
    LAS float* scr = (LAS float*)(F.lds + F.wave * 16384);
    {
        constexpr int I_IN = 16 * 100, I_OUT = 16 * 32, I_W1 = 16 * 16, I_W2 = 8 * 32;
        constexpr int N_IN = NL * I_IN, N_OUT = NL * I_OUT, N_W1 = NL * 32 * I_W1, N_W2 = NL * 32 * I_W2;
        constexpr int NITEMS = N_IN + N_OUT + 2 * N_W1 + N_W2;
        for (int it = F.gw; it < N_IN + N_OUT; it += F.NGW) {
            int r = it;
            if (r < N_IN) { const int l = r / I_IN, q = r % I_IN, kb = q / 100, nb = q % 100;
                tr_item(GIN(6) + (size_t)l * 1024 * 3200, 3200, 1024, WSP(bf16, WS_WIN) + (size_t)l * NIN * 1024, scr, 64 * kb, 32 * nb, F.lane, [](int n) { return inproj_row(n); }); continue; }
            r -= N_IN;
            if (r < N_OUT) { const int l = r / I_OUT, q = r % I_OUT, kb = q / 32, nb = q % 32;
                tr_item(GIN(7) + (size_t)l * 1024 * 1024, 1024, 1024, WSP(bf16, WS_WOUT) + (size_t)l * 1024 * 1024, scr, 64 * kb, 32 * nb, F.lane, [](int n) { return n; }); continue; }
            r -= N_OUT;
            if (r < 2 * N_W1) { const int which = r / N_W1; r %= N_W1; const int le = r / I_W1, q = r % I_W1, kb = q / 16, nb = q % 16;
                const float* W = A.in[which ? 31 : 30] + (size_t)le * 1024 * 512; bf16* WT = WSP(bf16, WS_W13) + (size_t)le * 1024 * 1024;
                if (which == 0) tr_item(W, 512, 1024, WT, scr, 64 * kb, 32 * nb, F.lane, [](int n) { return 8 * (n >> 2) + (n & 3); });
                else            tr_item(W, 512, 1024, WT, scr, 64 * kb, 32 * nb, F.lane, [](int n) { return 8 * (n >> 2) + 4 + (n & 3); });
                continue; }
            r -= 2 * N_W1;
            { const int le = r / I_W2, q = r % I_W2, kb = q / 32, nb = q % 32;
                tr_item(GIN(32) + (size_t)le * 512 * 1024, 1024, 512, WSP(bf16, WS_W2) + (size_t)le * 1024 * 512, scr, 64 * kb, 32 * nb, F.lane, [](int n) { return n; }); }
        }
    }
    __syncthreads();
    {
        LAS float* cs = (LAS float*)F.lds;
        for (int i = F.tid; i < 4096; i += 512) { const float v = GIN(1)[i]; cs[i] = v / (1.0f + __expf(-v)); }
        __syncthreads();
        const int kp = F.tid >> 5, jj = F.tid & 31;
        LAS float* red = cs + 4096;
        for (int it = F.vcu; it < NL * 192; it += F.G) {
            const int l = it / 192, j = (it % 192) * 32 + jj;
            const float* w = GIN(2) + (size_t)l * 1024 * 6144 + j;
            float a0 = 0.f, a1 = 0.f, a2 = 0.f, a3 = 0.f;
#pragma unroll 16
            for (int k = kp * 64; k < kp * 64 + 64; ++k) { const float wv = w[(size_t)k * 6144]; a0 += cs[k] * wv; a1 += cs[1024 + k] * wv; a2 += cs[2048 + k] * wv; a3 += cs[3072 + k] * wv; }
            red[(kp * 4 + 0) * 32 + jj] = a0; red[(kp * 4 + 1) * 32 + jj] = a1; red[(kp * 4 + 2) * 32 + jj] = a2; red[(kp * 4 + 3) * 32 + jj] = a3;
            __syncthreads();
            if (F.tid < 128) { const int b = F.tid >> 5; float s = GIN(3)[l * 6144 + j];
#pragma unroll
                for (int q = 0; q < 16; ++q) s += red[(q * 4 + b) * 32 + jj];
                WSP(float, WS_MOD)[((size_t)l * NB + b) * 6144 + j] = s; }
            __syncthreads();
        }
    }
    for (int i = F.gw * 64 + F.lane; i < 8 * 1024; i += F.NGW * 64) { const int hh = i >> 10, d = i & 1023; WSP(float, WS_TB)[i] = GIN(25)[t5_bucket(d) * 8 + hh] * LOG2E; }
    for (int i = F.gw * 64 + F.lane; i < NL * 1024 * 48; i += F.NGW * 64) { const int c = i % 48, lk = i / 48; float v = 0.f; if (c < 4) v = GIN(26)[(size_t)lk * 4 + c]; else if (c >= 16) v = GIN(28)[(size_t)lk * 32 + (c - 16)]; WSP(float, WS_SMALL + 2 * MiB)[i] = v; }
    for (int i = F.gw * 64 + F.lane; i < NL * 4 * 9728; i += F.NGW * 64) { const int lh = i / 9728, x = i % 9728, l = lh >> 2, h = lh & 3; float v = 0.f;
        if (x < 5120) { const int mtx = x / 2560, y = x % 2560, ch = y / 40, j = y % 40; if (j < 32) v = GIN(mtx ? 12 : 10)[((size_t)l * 32 + j) * 256 + h * 64 + ch]; }
        else { const int y = x - 5120, ch = y / 72, j = y % 72; if (j < 64) v = GIN(13)[((size_t)l * 64 + j) * 256 + h * 64 + ch]; }
        WSP(bf16, WS_SMALL + 3 * MiB)[i] = (bf16)f2bf(v); }
    if (F.vcu == 0 && F.tid < NL) { const int l = F.tid; const float* lm = GIN(21) + l * 256; float s01 = 0.f, s23 = 0.f;
        for (int i = 0; i < 64; ++i) { s01 += lm[i] * lm[64 + i]; s23 += lm[128 + i] * lm[192 + i]; }
        WSP(float, WS_LAM)[l] = __expf(s01) - __expf(s23) + (0.8f - 0.6f * __expf(-0.3f * (float)l)); }
}

__device__ __forceinline__ void phase_norm1(Frame& F, KArgs& A, int l) {
    const float* xin = (l == 0) ? GIN(0) : F.out;
    const bf16* YS = WSP(bf16, WS_YS); const int* POS = WSP(int, WS_SMALL) + 4 * M;
    const int nrow_ = F.xl ? 8 : (M + F.NGW - 1) / F.NGW;
    for (int k_ = 0; k_ < nrow_; ++k_) { const int m = F.xl ? F.vcu * 64 + F.wave * 8 + k_ : F.gw + k_ * F.NGW; if (m >= M) break;
        const int b = m / SEQ;
        f32x4 v[4];
#pragma unroll
        for (int j = 0; j < 4; ++j) v[j] = __builtin_nontemporal_load((const GAS f32x4*)(xin + (size_t)m * DM) + F.lane + 64 * j);
        if (l > 0) {
            const int p0 = POS[2 * m], p1 = POS[2 * m + 1];
            const float* g2 = WSP(float, WS_MOD) + ((size_t)(l - 1) * NB + b) * 6144 + 5 * 1024;
#pragma unroll
            for (int j = 0; j < 4; ++j) { const int c = 4 * (F.lane + 64 * j);
                const uint2 ya = *(const uint2*)(YS + (size_t)p0 * DM + c), yb = *(const uint2*)(YS + (size_t)p1 * DM + c);
                const f32x4 gg = *(const f32x4*)(g2 + c);
                v[j].x += gg.x * (bf_lo(ya.x) + bf_lo(yb.x)); v[j].y += gg.y * (bf_hi(ya.x) + bf_hi(yb.x));
                v[j].z += gg.z * (bf_lo(ya.y) + bf_lo(yb.y)); v[j].w += gg.w * (bf_hi(ya.y) + bf_hi(yb.y)); }
        }
        if (l == 0 || l > 0) {
#pragma unroll
            for (int j = 0; j < 4; ++j) __builtin_nontemporal_store(v[j], (GAS f32x4*)(F.out + (size_t)m * DM) + F.lane + 64 * j);
        }
        if (l == NL) continue;
        float ss = 0.f;
#pragma unroll
        for (int j = 0; j < 4; ++j) ss += (v[j].x * v[j].x + v[j].y * v[j].y) + (v[j].z * v[j].z + v[j].w * v[j].w);
        const float rstd = 1.0f / sqrtf(wave_sum(ss) * (1.0f / DM) + 1e-6f);
        const float* mod = WSP(float, WS_MOD) + ((size_t)l * NB + b) * 6144;
        const float* ng = GIN(4) + l * DM;
        bf16* hrow = WSP(bf16, WS_HB) + (size_t)m * DM;
#pragma unroll
        for (int j = 0; j < 4; ++j) { const int c = 4 * (F.lane + 64 * j);
            const f32x4 g = *(const f32x4*)(ng + c), sh = *(const f32x4*)(mod + c), sc = *(const f32x4*)(mod + 1024 + c);
            const float h0 = v[j].x * rstd * g.x * (1.f + sc.x) + sh.x, h1 = v[j].y * rstd * g.y * (1.f + sc.y) + sh.y;
            const float h2 = v[j].z * rstd * g.z * (1.f + sc.z) + sh.z, h3 = v[j].w * rstd * g.w * (1.f + sc.w) + sh.w;
            uint2 o; o.x = pk2(h0, h1); o.y = pk2(h2, h3); *(uint2*)(hrow + c) = o; }
    }
}
constexpr size_t WS_WEG = WS_SMALL + 2 * MiB;
__device__ __forceinline__ void moe_tables(Frame& F, KArgs& A, int l) {
    LAS int* base = (LAS int*)(F.lds + TAB_OFF); LAS int* t2e = base + 64;
    const unsigned* cnt = (const unsigned*)(F.ctl + CW_CNT + l * 64);
    if (F.tid == 0) { int acc = 0; for (int e = 0; e < 32; ++e) { base[e] = acc; const int c = (int)__hip_atomic_load(cnt + e, __ATOMIC_RELAXED, __HIP_MEMORY_SCOPE_AGENT); acc += (c + 255) / 256 * 256; } base[32] = acc; }
    __syncthreads();
    if (F.tid < 160) { const int r0 = F.tid * 256; int e = 31; for (int x = 0; x < 32; ++x) if (r0 >= base[x] && r0 < base[x + 1]) e = x; t2e[F.tid] = e; }
    __syncthreads();
}
__device__ __forceinline__ void phase_router(Frame& F, KArgs& A, int l, const XcdBarrier& bar) {
    typedef float f32x4_ __attribute__((ext_vector_type(4)));
    const float* bg = GIN(27) + l * 4; const float* be = GIN(29) + l * 32;
    const float* Wc = WSP(float, WS_WEG) + (size_t)l * 1024 * 48;
    int* SLT = WSP(int, WS_SMALL) + 4 * M; float* GS = WSP(float, WS_SMALL) + 6 * M;
    unsigned* cnt = (unsigned*)(F.ctl + CW_CNT + l * 64);
    constexpr int HP = 1028;
    LAS float* H = (LAS float*)F.lds; LAS float* part = (LAS float*)(F.lds + 65792); LAS float* LG = (LAS float*)(F.lds + 90368);
    LAS int* el_ = (LAS int*)(F.lds + 93440); LAS float* gl_ = (LAS float*)(F.lds + 93440 + 512); LAS int* off_ = (LAS int*)(F.lds + 93440 + 1024); LAS int* slot_ = (LAS int*)(F.lds + 93440 + 1536);
    const float* ng = GIN(5) + l * DM;
    const int t = F.lane & 15, kq = F.lane >> 4;
    float breg[3][32];
#pragma unroll
    for (int kk = 0; kk < 32; ++kk)
#pragma unroll
        for (int ct = 0; ct < 3; ++ct) breg[ct][kk] = Wc[(size_t)(128 * F.wave + 4 * kk + kq) * 48 + 16 * ct + t];
    const int vb = F.vcu; const bool hasvb = vb < M / 64;
    typedef unsigned v2u_ __attribute__((ext_vector_type(2)));
    v2u_ hk[8][4];
#pragma unroll
    for (int r = 0; r < 8; ++r)
#pragma unroll
        for (int j = 0; j < 4; ++j) { hk[r][j].x = 0u; hk[r][j].y = 0u; }
    if (hasvb) {
        for (int grp = 0; grp < 4; ++grp) {
            f32x4 v[2][4];
#pragma unroll
            for (int u = 0; u < 2; ++u) { const int m = vb * 64 + grp * 16 + 2 * F.wave + u;
#pragma unroll
                for (int j = 0; j < 4; ++j) v[u][j] = __builtin_nontemporal_load((const GAS f32x4*)(F.out + (size_t)m * DM) + F.lane + 64 * j); }
#pragma unroll
            for (int u = 0; u < 2; ++u) {
                const int tg = 2 * F.wave + u, m = vb * 64 + grp * 16 + tg, b = m / SEQ;
                float ss = 0.f;
#pragma unroll
                for (int j = 0; j < 4; ++j) ss += (v[u][j].x * v[u][j].x + v[u][j].y * v[u][j].y) + (v[u][j].z * v[u][j].z + v[u][j].w * v[u][j].w);
                const float rstd = 1.0f / sqrtf(wave_sum(ss) * (1.0f / DM) + 1e-6f);
                const float* mod = WSP(float, WS_MOD) + ((size_t)l * NB + b) * 6144;
#pragma unroll
                for (int j = 0; j < 4; ++j) { const int c = 4 * (F.lane + 64 * j);
                    const f32x4 g = *(const GAS f32x4*)(ng + c), sh = *(const GAS f32x4*)(mod + 3072 + c), sc = *(const GAS f32x4*)(mod + 4096 + c);
                    f32x4 h; h.x = v[u][j].x * rstd * g.x * (1.f + sc.x) + sh.x; h.y = v[u][j].y * rstd * g.y * (1.f + sc.y) + sh.y; h.z = v[u][j].z * rstd * g.z * (1.f + sc.z) + sh.z; h.w = v[u][j].w * rstd * g.w * (1.f + sc.w) + sh.w;
                    v2u_ o; o.x = pk2(h.x, h.y); o.y = pk2(h.z, h.w);
#pragma unroll
                    for (int g = 0; g < 4; ++g) if (grp == g) hk[2 * g + u][j] = o;
                    *(LAS f32x4*)(H + tg * HP + c) = h; }
            }
            LDS_WAIT(); __syncthreads();
            {
                f32x4_ acc0 = {0.f, 0.f, 0.f, 0.f}, acc1 = acc0, acc2 = acc0;
                const LAS float* hp = H + t * HP + 128 * F.wave + kq;
#pragma unroll
                for (int kk = 0; kk < 32; ++kk) { const float a = hp[4 * kk];
                    acc0 = __builtin_amdgcn_mfma_f32_16x16x4f32(a, breg[0][kk], acc0, 0, 0, 0); acc1 = __builtin_amdgcn_mfma_f32_16x16x4f32(a, breg[1][kk], acc1, 0, 0, 0); acc2 = __builtin_amdgcn_mfma_f32_16x16x4f32(a, breg[2][kk], acc2, 0, 0, 0); }
#pragma unroll
                for (int r = 0; r < 4; ++r) { LAS float* pp = part + (F.wave * 16 + 4 * kq + r) * 48 + t; pp[0] = acc0[r]; pp[16] = acc1[r]; pp[32] = acc2[r]; }
            }
            LDS_WAIT(); __syncthreads();
            for (int i = F.tid; i < 16 * 48; i += NWAVES * 64) { float sum = 0.f;
#pragma unroll
                for (int q = 0; q < 8; ++q) sum += part[q * 768 + i];
                LG[i] = sum; }
            LDS_WAIT(); __syncthreads();
            if (F.tid < 16) { const LAS float* lg = LG + F.tid * 48;
                float gl[4];
#pragma unroll
                for (int g = 0; g < 4; ++g) gl[g] = lg[g] + bg[g];
                int gs = 0; float gm = gl[0];
#pragma unroll
                for (int g = 1; g < 4; ++g) if (gl[g] > gm) { gm = gl[g]; gs = g; }
                float den = 0.f;
#pragma unroll
                for (int g = 0; g < 4; ++g) den += __expf(gl[g] - gm);
                const float pg = 1.0f / den;
                float el[8];
#pragma unroll
                for (int e = 0; e < 8; ++e) el[e] = lg[16 + gs * 8 + e] + be[gs * 8 + e];
                int e1 = 0; float m1 = el[0];
#pragma unroll
                for (int e = 1; e < 8; ++e) if (el[e] > m1) { m1 = el[e]; e1 = e; }
                int e2 = -1; float m2 = -INFINITY;
#pragma unroll
                for (int e = 0; e < 8; ++e) if (e != e1 && el[e] > m2) { m2 = el[e]; e2 = e; }
                const float ex = __expf(m2 - m1); const int tl = grp * 16 + F.tid;
                el_[2 * tl] = gs * 8 + e1; el_[2 * tl + 1] = gs * 8 + e2; gl_[2 * tl] = pg / (1.f + ex); gl_[2 * tl + 1] = pg * ex / (1.f + ex); }
            LDS_WAIT(); __syncthreads();
        }
        int rank = 0, mye = 0;
        if (F.tid < 128) { mye = el_[F.tid]; for (int a = 0; a < F.tid; ++a) rank += (el_[a] == mye) ? 1 : 0; }
        else if (F.tid < 160) { const int e = F.tid - 128; int c = 0; for (int a = 0; a < 128; ++a) c += (el_[a] == e) ? 1 : 0; off_[e] = c ? (int)atomicAdd(cnt + e, (unsigned)c) : 0; }
        LDS_WAIT(); __syncthreads();
        if (F.tid < 128) slot_[F.tid] = off_[mye] + rank;
        LDS_WAIT(); __syncthreads();
    }
    xcd_barrier(bar);
    moe_tables(F, A, l);
    {
        const LAS int* base = (const LAS int*)(F.lds + TAB_OFF);
        bf16* XS = WSP(bf16, WS_XS);
        if (hasvb) {
#pragma unroll
            for (int r = 0; r < 8; ++r) { const int tl = (r >> 1) * 16 + 2 * F.wave + (r & 1), m = vb * 64 + tl;
#pragma unroll
                for (int k = 0; k < 2; ++k) { const int pos = base[el_[2 * tl + k]] + slot_[2 * tl + k];
#pragma unroll
                    for (int j = 0; j < 4; ++j) __builtin_nontemporal_store(hk[r][j], (GAS v2u_*)(XS + (size_t)pos * DM + 4 * (F.lane + 64 * j)));
                    if (F.lane == 0) { SLT[2 * m + k] = pos; GS[pos] = gl_[2 * tl + k]; } } }
        }
        for (int it = F.gw; it < 32 * 256; it += F.NGW) { const int e = it >> 8, i = it & 255; const int c = (int)cnt[e]; const int npad = (c + 255) / 256 * 256 - c;
            if (i < npad) { const int pos = base[e] + c + i; const v4u z = {0u, 0u, 0u, 0u};
#pragma unroll
                for (int j = 0; j < 2; ++j) *((GAS v4u*)(XS + (size_t)pos * DM) + F.lane + 64 * j) = z;
                if (F.lane == 0) GS[pos] = 0.f; } }
    }
}
namespace rw {
typedef short bf16x8 __attribute__((ext_vector_type(8)));
typedef float f32x16 __attribute__((ext_vector_type(16)));
constexpr int PITCH = 144;
constexpr int SLOT = 64 * PITCH;
constexpr int GAM_OFF = 14 * SLOT;
constexpr size_t ITEM_BYTES = 49152;
__device__ __forceinline__ int crow(int r, int hi) { return (r & 3) + 8 * (r >> 2) + 4 * hi; }
__device__ __forceinline__ unsigned short f2b(float f) { unsigned u = __builtin_bit_cast(unsigned, f); return (unsigned short)((u + 0x7fffu + ((u >> 16) & 1u)) >> 16); }
__device__ __forceinline__ unsigned pk(float lo, float hi) { return (unsigned)f2b(lo) | ((unsigned)f2b(hi) << 16); }
__device__ __forceinline__ f32x16 tile_nt(LAS const unsigned char* A, int arow0, LAS const unsigned char* B, int brow0, f32x16 acc, int lane) {
    const int r = lane & 31, h = lane >> 5;
    LAS const unsigned char* ap = A + (arow0 + r) * PITCH + h * 16; LAS const unsigned char* bp = B + (brow0 + r) * PITCH + h * 16;
#pragma unroll
    for (int ks = 0; ks < 4; ++ks) { const bf16x8 a = *(LAS const bf16x8*)(ap + ks * 32), b = *(LAS const bf16x8*)(bp + ks * 32); acc = __builtin_amdgcn_mfma_f32_32x32x16_bf16(a, b, acc, 0, 0, 0); }
    return acc;
}
template <int MASK> __device__ __forceinline__ float maskv(float v, int row, int col) { if (MASK == 1) return row > col ? v : 0.f; if (MASK == 2) return row >= col ? v : 0.f; return v; }
template <int MASK> __device__ __forceinline__ void store_nat(LAS unsigned char* S, int r0, int c0, const f32x16& acc, float sc, int lane) {
    const int col = c0 + (lane & 31), hi = lane >> 5;
#pragma unroll
    for (int g = 0; g < 16; ++g) { const int row = r0 + crow(g, hi); *(LAS unsigned short*)(S + row * PITCH + col * 2) = f2b(maskv<MASK>(acc[g], row, col) * sc); }
}
template <int MASK> __device__ __forceinline__ void store_tr(LAS unsigned char* S, int r0, int c0, const f32x16& acc, int lane) {
    const int col = c0 + (lane & 31), hi = lane >> 5;
#pragma unroll
    for (int g = 0; g < 16; ++g) { const int row = r0 + crow(g, hi); *(LAS unsigned short*)(S + col * PITCH + row * 2) = f2b(maskv<MASK>(acc[g], row, col)); }
}
__device__ __forceinline__ f32x16 load_nat(LAS const unsigned char* S, int r0, int c0, int lane) {
    const int col = c0 + (lane & 31), hi = lane >> 5; f32x16 a;
#pragma unroll
    for (int g = 0; g < 16; ++g) a[g] = __uint_as_float((unsigned)*(LAS const unsigned short*)(S + (r0 + crow(g, hi)) * PITCH + col * 2) << 16);
    return a;
}
}

constexpr size_t WS_LW = WS_SMALL + 3 * MiB;
constexpr int LW_BYTES = 19456, ACT_PITCH = 272, ACT_BYTES = 64 * ACT_PITCH, RES_OFF = 8 * rw::SLOT, RES_PITCH = 65, SSBUF_OFF = 131072 + 2048;
template <int CTRL, int RM> __device__ __forceinline__ float dpp0(float v) { return __int_as_float(__builtin_amdgcn_update_dpp(0, __float_as_int(v), CTRL, RM, 0xf, false)); }
__device__ __forceinline__ float wave_scan_incl(float x) {
    x += dpp0<0x111, 0xf>(x); x += dpp0<0x112, 0xf>(x); x += dpp0<0x114, 0xf>(x); x += dpp0<0x118, 0xf>(x);
    x += dpp0<0x142, 0xa>(x); x += dpp0<0x143, 0xc>(x);
    return x;
}
__device__ __forceinline__ float fast_tanh(float x) { const float e = __expf(2.f * x); return 1.f - 2.f / (1.f + e); }
__device__ __forceinline__ void phase_chunkprep(Frame& F, KArgs& A, int l) {
    using namespace rw;
    const float* PR = WSP(const float, WS_PR);
    float* RW = WSP(float, WS_RW); constexpr size_t RS = (size_t)M * 256;
    LAS unsigned char* L = F.lds;
#define SL(n) (L + (n) * SLOT)
    const int w = F.wave;
    for (int it = F.vcu; it < NB * 4 * 64; it += F.G) {
        int lane = F.lane; asm volatile("" : "+v"(lane));
        { unsigned lb_ = 0u; asm volatile("" : "+s"(lb_)); L = F.lds + lb_; }
        const int c = it & 63, bh = it >> 6, b = bh >> 2, h = bh & 3;
        unsigned char* gout = F.ws + WS_XS + (size_t)it * ITEM_BYTES;
        const size_t m0 = (size_t)b * SEQ + c * 64;
        f32x4 s1r[2], s1k[2], s1v[2], s1pr[2], s1pk[2], s1pv[2];
        { const float* cur = PR + (m0 + lane) * 896 + h * 64 + 8 * w; const bool first = (c == 0 && lane == 0);
#pragma unroll
          for (int q = 0; q < 2; ++q) { s1r[q] = *(const GAS f32x4*)(cur + 4 * q); s1k[q] = *(const GAS f32x4*)(cur + 256 + 4 * q); s1v[q] = *(const GAS f32x4*)(cur + 512 + 4 * q);
              s1pr[q] = (f32x4){0.f, 0.f, 0.f, 0.f}; s1pk[q] = s1pr[q]; s1pv[q] = s1pr[q];
              if (!first) { s1pr[q] = *(const GAS f32x4*)(cur - 896 + 4 * q); s1pk[q] = *(const GAS f32x4*)(cur - 896 + 256 + 4 * q); s1pv[q] = *(const GAS f32x4*)(cur - 896 + 512 + 4 * q); } } }
        {
            const int tid = w * 64 + lane, t = tid >> 3, jg = tid & 7;
            const float* cur = PR + (m0 + t) * 896 + 768 + 16 * jg; const float* mup = GIN(8) + l * 896 + 768 + 16 * jg;
            const bool first = (c == 0 && t == 0);
            unsigned o8[8];
#pragma unroll
            for (int q = 0; q < 4; ++q) { f32x4 x = *(const GAS f32x4*)(cur + 4 * q); const f32x4 mu = *(const GAS f32x4*)(mup + 4 * q);
                f32x4 xp = {0.f, 0.f, 0.f, 0.f}; if (!first) xp = *(const GAS f32x4*)(cur - 896 + 4 * q);
                x = x + (xp - x) * mu;
#pragma unroll
                for (int e = 0; e < 4; ++e) x[e] = jg < 2 ? fast_tanh(x[e]) : (jg < 4 ? x[e] : 1.f / (1.f + __expf(-x[e])));
                o8[2 * q] = pk(x[0], x[1]); o8[2 * q + 1] = pk(x[2], x[3]); }
            LAS v4u* dst = (LAS v4u*)(L + t * ACT_PITCH + jg * 32);
            dst[0] = (v4u){o8[0], o8[1], o8[2], o8[3]}; dst[1] = (v4u){o8[4], o8[5], o8[6], o8[7]};
            const GAS v4u* lw = (const GAS v4u*)(F.ws + WS_LW + (size_t)(l * 4 + h) * LW_BYTES);
            for (int i = tid; i < LW_BYTES / 16; i += NWAVES * 64) *(LAS v4u*)(L + ACT_BYTES + i * 16) = lw[i];
        }
        LDS_WAIT(); __syncthreads();
        for (int id = w; id < 12; id += 8) {
            const int mtx = id >> 2, tr = (id >> 1) & 1, tc = id & 1, r = lane & 31, hh = lane >> 5;
            const int koff = mtx == 0 ? 0 : (mtx == 1 ? 64 : 128), nks = mtx == 2 ? 4 : 2, bp = mtx == 2 ? 144 : 80, boff = mtx == 0 ? 0 : (mtx == 1 ? 5120 : 10240);
            LAS const unsigned char* ap = L + (32 * tr + r) * ACT_PITCH + koff + hh * 16; LAS const unsigned char* bpp = L + ACT_BYTES + boff + (32 * tc + r) * bp + hh * 16;
            f32x16 acc = f32x16{};
            for (int ks = 0; ks < nks; ++ks) { const bf16x8 a = *(LAS const bf16x8*)(ap + ks * 32), bb = *(LAS const bf16x8*)(bpp + ks * 32); acc = __builtin_amdgcn_mfma_f32_32x32x16_bf16(a, bb, acc, 0, 0, 0); }
            LAS float* res = (LAS float*)(L + RES_OFF) + mtx * 64 * RES_PITCH + (32 * tc + r) * RES_PITCH + 32 * tr;
#pragma unroll
            for (int g = 0; g < 16; ++g) res[crow(g, hh)] = acc[g];
        }
        LDS_WAIT(); __syncthreads();
        {
            const int ch0 = h * 64 + 8 * w; const size_t m = m0 + lane;
            float r_[8], k_[8], v_[8], a_[8], lw_[8], kk_[8]; float ss = 0.f;
            const LAS float* res = (const LAS float*)(L + RES_OFF) + (8 * w) * RES_PITCH + lane;
#pragma unroll
            for (int q = 0; q < 2; ++q) {
                f32x4 xr = s1r[q], xk = s1k[q], xv = s1v[q]; const f32x4 pr = s1pr[q], pk_ = s1pk[q], pv = s1pv[q];
                const float* mu = GIN(8) + l * 896 + ch0 + 4 * q;
                const f32x4 mr = *(const GAS f32x4*)mu, mk = *(const GAS f32x4*)(mu + 256), mv = *(const GAS f32x4*)(mu + 512);
                xr = xr + (pr - xr) * mr; xk = xk + (pk_ - xk) * mk; xv = xv + (pv - xv) * mv;
                const f32x4 w0 = *(const GAS f32x4*)(GIN(9) + l * 256 + ch0 + 4 * q), a0 = *(const GAS f32x4*)(GIN(11) + l * 256 + ch0 + 4 * q);
                const f32x4 kkw = *(const GAS f32x4*)(GIN(14) + l * 256 + ch0 + 4 * q), kaw = *(const GAS f32x4*)(GIN(15) + l * 256 + ch0 + 4 * q);
                f32x4 gg, k2;
#pragma unroll
                for (int e = 0; e < 4; ++e) { const int i = 4 * q + e;
                    const float xw = -(w0[e] + res[i * RES_PITCH]); const float sp = xw > 15.f ? xw : __logf(1.f + __expf(xw)); const float wv = -sp - 0.5f;
                    lw_[i] = -__expf(wv);
                    const float a = 1.f / (1.f + __expf(-(a0[e] + res[(64 + i) * RES_PITCH]))); a_[i] = a;
                    gg[e] = res[(128 + i) * RES_PITCH];
                    r_[i] = xr[e]; v_[i] = xv[e]; kk_[i] = xk[e] * kkw[e]; ss += kk_[i] * kk_[i];
                    k2[e] = xk[e] * (1.f + (a - 1.f) * kaw[e]); k_[i] = k2[e]; }
                const size_t o = m * 256 + ch0 + 4 * q;
                *(GAS f32x4*)(RW + o) = xr; *(GAS f32x4*)(RW + 2 * RS + o) = k2; *(GAS f32x4*)(RW + 3 * RS + o) = xv; *(GAS f32x4*)(RW + 6 * RS + o) = gg;
            }
            *(LAS float*)(L + SSBUF_OFF + (w * 64 + lane) * 4) = ss;
            LDS_WAIT(); __syncthreads();
            float tot = 0.f;
#pragma unroll
            for (int q = 0; q < 8; ++q) tot += *(LAS const float*)(L + SSBUF_OFF + (q * 64 + lane) * 4);
            const float inv = 1.0f / fmaxf(sqrtf(tot), 1e-12f);
            unsigned nat[4][4];
#pragma unroll
            for (int e = 0; e < 8; ++e) {
                const float kkn = kk_[e] * inv, bbv = kkn * a_[e];
                const float cum = wave_scan_incl(lw_[e]);
                const float cl = rl(cum, 63), gam = __expf(cl);
                const float e1 = __expf(cum - lw_[e]), e2 = __expf(cum), e3 = __expf(-cum);
                const float kkf = kkn * e1, rf = r_[e] * e2, bi = bbv * e3, ki = k_[e] * e3, bend = bi * gam, kend = ki * gam;
                const int i = 8 * w + e;
                if (lane == 63) *(LAS float*)(L + GAM_OFF + i * 4) = gam;
                *(LAS unsigned short*)(SL(4) + i * PITCH + lane * 2) = f2b(kkf); *(LAS unsigned short*)(SL(5) + i * PITCH + lane * 2) = f2b(v_[e]);
                *(LAS unsigned short*)(SL(6) + i * PITCH + lane * 2) = f2b(bend); *(LAS unsigned short*)(SL(7) + i * PITCH + lane * 2) = f2b(kend);
                const unsigned short q0 = f2b(kkf), q1 = f2b(rf), q2 = f2b(bi), q3 = f2b(ki);
                if (e & 1) { nat[0][e >> 1] |= (unsigned)q0 << 16; nat[1][e >> 1] |= (unsigned)q1 << 16; nat[2][e >> 1] |= (unsigned)q2 << 16; nat[3][e >> 1] |= (unsigned)q3 << 16; }
                else { nat[0][e >> 1] = q0; nat[1][e >> 1] = q1; nat[2][e >> 1] = q2; nat[3][e >> 1] = q3; }
            }
#pragma unroll
            for (int mm = 0; mm < 4; ++mm) { v4u x; x.x = nat[mm][0]; x.y = nat[mm][1]; x.z = nat[mm][2]; x.w = nat[mm][3]; *(LAS v4u*)(SL(mm) + lane * PITCH + w * 16) = x; }
        }
        LDS_WAIT(); __syncthreads();
        const f32x16 Z = f32x16{};
#pragma unroll
        for (int q = 0; q < 2; ++q) { const int tile = 2 * w + q, p = tile >> 2, tr = (tile >> 1) & 1, tc = tile & 1;
            f32x16 acc = Z;
            if (!(tr == 0 && tc == 1)) acc = tile_nt(SL(p < 2 ? 0 : 1), 32 * tr, SL((p & 1) ? 3 : 2), 32 * tc, Z, lane);
            if (p == 0) { store_nat<1>(SL(8), 32 * tr, 32 * tc, acc, 1.f, lane); store_tr<1>(SL(12), 32 * tr, 32 * tc, acc, lane);
                const int col = 32 * tc + (lane & 31), hi = lane >> 5;
#pragma unroll
                for (int g = 0; g < 16; ++g) { const int row = 32 * tr + crow(g, hi); const float v = (row == col ? 1.f : 0.f) - (row > col ? acc[g] : 0.f); *(LAS unsigned short*)(SL(13) + row * PITCH + col * 2) = f2b(v); } }
            else if (p == 1) store_nat<1>(SL(9), 32 * tr, 32 * tc, acc, 1.f, lane);
            else if (p == 2) store_nat<2>(SL(10), 32 * tr, 32 * tc, acc, 1.f, lane);
            else store_nat<2>(SL(11), 32 * tr, 32 * tc, acc, 1.f, lane); }
        LDS_WAIT(); __syncthreads();
        const int tr = (w >> 1) & 1, tc = w & 1;
        {
            if (w < 4) { f32x16 acc = Z; if (!(tr == 0 && tc == 1)) acc = tile_nt(SL(8), 32 * tr, SL(12), 32 * tc, Z, lane); store_nat<0>(SL(0), 32 * tr, 32 * tc, acc, 1.f, lane); store_tr<0>(SL(2), 32 * tr, 32 * tc, acc, lane); }
            LDS_WAIT(); __syncthreads();
        }
#pragma nounroll
        for (int k = 1; k <= 5; ++k) {
            const int lpn = (k & 1) ? 0 : 8, lpt = (k & 1) ? 2 : 12, lpn2 = (k & 1) ? 8 : 0, lpt2 = (k & 1) ? 12 : 2, pin = (k & 1) ? 13 : 3, pout = (k & 1) ? 3 : 13;
            if (w < 4) { f32x16 acc = load_nat(SL(pin), 32 * tr, 32 * tc, lane); if (!(tr == 0 && tc == 1)) acc = tile_nt(SL(pin), 32 * tr, SL(lpt), 32 * tc, acc, lane); store_nat<0>(SL(pout), 32 * tr, 32 * tc, acc, 1.f, lane); }
            else if (k < 5) { f32x16 acc = Z; if (!(tr == 0 && tc == 1)) acc = tile_nt(SL(lpn), 32 * tr, SL(lpt), 32 * tc, Z, lane); store_nat<0>(SL(lpn2), 32 * tr, 32 * tc, acc, 1.f, lane); store_tr<0>(SL(lpt2), 32 * tr, 32 * tc, acc, lane); }
            LDS_WAIT(); __syncthreads();
        }
        if (w < 4) { const f32x16 acc = tile_nt(SL(4), 32 * tr, SL(3), 32 * tc, Z, lane); store_nat<0>(SL(0), 32 * tr, 32 * tc, acc, 1.f, lane); }
        else { const f32x16 acc = tile_nt(SL(5), 32 * tr, SL(9), 32 * tc, Z, lane); store_nat<0>(SL(2), 32 * tr, 32 * tc, acc, 1.f, lane); }
        LDS_WAIT(); __syncthreads();
        if (w < 4) { const f32x16 acc = tile_nt(SL(2), 32 * tr, SL(3), 32 * tc, Z, lane); store_nat<0>(SL(8), 32 * tr, 32 * tc, acc, -1.f, lane); }
        else {
            const int hi = lane >> 5, cl = lane & 31;
            { const f32x16 acc = tile_nt(SL(0), 32 * tr, SL(6), 32 * tc, Z, lane);
              const float gam = *(LAS const float*)(L + GAM_OFF + (32 * tc + cl) * 4);
#pragma unroll
              for (int sp = 0; sp < 2; ++sp) { float o[8];
#pragma unroll
                  for (int j = 0; j < 8; ++j) { const int g = 8 * sp + j; o[j] = ((tr == tc && crow(g, hi) == cl) ? gam : 0.f) - acc[g]; }
                  v4u x; x.x = pk(o[0], o[1]); x.y = pk(o[2], o[3]); x.z = pk(o[4], o[5]); x.w = pk(o[6], o[7]);
                  *(GAS v4u*)(gout + ((size_t)(tc * 4 + 2 * tr + sp) * 64 + lane) * 16) = x; } }
            { const f32x16 acc = tile_nt(SL(0), 32 * tr, SL(10), 32 * tc, Z, lane);
#pragma unroll
              for (int sp = 0; sp < 2; ++sp) { float o[8];
#pragma unroll
                  for (int j = 0; j < 8; ++j) { const int g = 8 * sp + j; const int i = 32 * tr + crow(g, hi), t = 32 * tc + cl;
                      o[j] = __uint_as_float((unsigned)*(LAS const unsigned short*)(SL(1) + t * PITCH + i * 2) << 16) - acc[g]; }
                  v4u x; x.x = pk(o[0], o[1]); x.y = pk(o[2], o[3]); x.z = pk(o[4], o[5]); x.w = pk(o[6], o[7]);
                  *(GAS v4u*)(gout + 8192 + ((size_t)(tc * 4 + 2 * tr + sp) * 64 + lane) * 16) = x; } }
        }
        LDS_WAIT(); __syncthreads();
        {
            f32x16 acc;
            if (w < 4) { acc = tile_nt(SL(7), 32 * tr, SL(5), 32 * tc, Z, lane); acc = tile_nt(SL(6), 32 * tr, SL(8), 32 * tc, acc, lane); }
            else { acc = tile_nt(SL(11), 32 * tr, SL(5), 32 * tc, Z, lane); acc = tile_nt(SL(10), 32 * tr, SL(8), 32 * tc, acc, lane); }
            float* o = (float*)(gout + (w < 4 ? 16384 : 32768)) + (size_t)(tr * 2 + tc) * 1024 + lane;
#pragma unroll
            for (int g = 0; g < 16; ++g) *(GAS float*)(o + g * 64) = acc[g];
        }
        LDS_WAIT(); __syncthreads();
    }
#undef SL
    if (F.wave == 0) { const bf16* KM = WSP(bf16, WS_KM); float* KMEAN = WSP(float, WS_KMEAN);
      for (int it = F.vcu; it < NB * 16 * 4; it += F.G) { const int hh = it & 3, n = (it >> 2) & 15, b = it >> 6; const int co = F.lane >> 3, rg = F.lane & 7;
          const bf16* p = KM + ((size_t)b * SEQ + n * 256 + rg * 32) * 256 + hh * 64 + co * 8; float s[8] = {0.f, 0.f, 0.f, 0.f, 0.f, 0.f, 0.f, 0.f};
#pragma unroll 16
          for (int t = 0; t < 32; ++t) { const v4u x = *(const GAS v4u*)(p + (size_t)t * 256);
              s[0] += bf_lo(x.x); s[1] += bf_hi(x.x); s[2] += bf_lo(x.y); s[3] += bf_hi(x.y); s[4] += bf_lo(x.z); s[5] += bf_hi(x.z); s[6] += bf_lo(x.w); s[7] += bf_hi(x.w); }
#pragma unroll
          for (int e = 0; e < 8; ++e) { float x = s[e]; x += dpp0<0xB1, 0xf>(x); x += dpp0<0x4E, 0xf>(x); x += dpp0<0x141, 0xf>(x); s[e] = x * (1.0f / 256.0f); }
          if (rg == 0) { float* o = KMEAN + (((size_t)b * 4 + hh) * 16 + n) * 64 + co * 8; *(GAS f32x4*)o = (f32x4){s[0], s[1], s[2], s[3]}; *(GAS f32x4*)(o + 4) = (f32x4){s[4], s[5], s[6], s[7]}; } } }
}

constexpr size_t WS_SB = WS_HS;
__device__ __forceinline__ void rwkv_chain_wave(Frame& F, int bh, int tv) {
    using namespace rw;
    const int lane = F.lane;
    f32x16 S0 = f32x16{}, S1 = f32x16{};
    const unsigned char* gin = F.ws + WS_XS + (size_t)bh * 64 * ITEM_BYTES;
    unsigned char* sb = F.ws + WS_SB + ((size_t)bh * 64 * 2 + tv) * 4096 + lane * 16;
    bf16x8 Ga[8]; f32x16 H0, H1;
#define RW_LOAD(G_, H0_, H1_, gp_) do { _Pragma("unroll") for (int q_ = 0; q_ < 8; ++q_) G_[q_] = *(const GAS bf16x8*)((gp_) + ((size_t)q_ * 64 + lane) * 16); \
        const float* hp_ = (const float*)((gp_) + 16384) + (size_t)tv * 1024 + lane; _Pragma("unroll") for (int g_ = 0; g_ < 16; ++g_) { H0_[g_] = *(const GAS float*)(hp_ + g_ * 64); H1_[g_] = *(const GAS float*)(hp_ + 2048 + g_ * 64); } } while (0)
    RW_LOAD(Ga, H0, H1, gin);
    for (int c = 0; c < 64; ++c) {
        bf16x8 Gn[8]; f32x16 Hn0, Hn1;
        const unsigned char* gnx = gin + (size_t)(c < 63 ? c + 1 : c) * ITEM_BYTES;
        RW_LOAD(Gn, Hn0, Hn1, gnx);
        bf16x8 Bf[4];
#pragma unroll
        for (int s = 0; s < 4; ++s) { const f32x16& X = (s < 2) ? S0 : S1; const int o = 8 * (s & 1); v4u x; x.x = pk(X[o], X[o + 1]); x.y = pk(X[o + 2], X[o + 3]); x.z = pk(X[o + 4], X[o + 5]); x.w = pk(X[o + 6], X[o + 7]); Bf[s] = __builtin_bit_cast(bf16x8, x);
            *(GAS v4u*)(sb + (size_t)c * 8192 + s * 1024) = x; }
#pragma unroll
        for (int s = 0; s < 4; ++s) { H0 = __builtin_amdgcn_mfma_f32_32x32x16_bf16(Ga[s], Bf[s], H0, 0, 0, 0); H1 = __builtin_amdgcn_mfma_f32_32x32x16_bf16(Ga[4 + s], Bf[s], H1, 0, 0, 0); }
        S0 = H0; S1 = H1;
#pragma unroll
        for (int q = 0; q < 8; ++q) Ga[q] = Gn[q];
        H0 = Hn0; H1 = Hn1;
    }
#undef RW_LOAD
}
__device__ __forceinline__ void rwkv_y_item(Frame& F, KArgs& A, int l, int item2) {
    using namespace rw;
    const int lane = F.lane, hi = lane >> 5, cl = lane & 31;
    const int tt = item2 & 1, item = item2 >> 1, c = item & 63, bh = item >> 6, b = bh >> 2, h = bh & 3;
    const unsigned char* gin = F.ws + WS_XS + (size_t)item * ITEM_BYTES;
    const unsigned char* sb = F.ws + WS_SB + ((size_t)item * 2) * 4096 + lane * 16;
    LAS float* yl = (LAS float*)(F.lds + F.wave * 8192);
#pragma unroll
    for (int tv = 0; tv < 2; ++tv) {
        f32x16 acc; const float* y0 = (const float*)(gin + 32768) + (size_t)(tt * 2 + tv) * 1024 + lane;
#pragma unroll
        for (int g = 0; g < 16; ++g) acc[g] = *(const GAS float*)(y0 + g * 64);
#pragma unroll
        for (int s = 0; s < 4; ++s) { const bf16x8 a = *(const GAS bf16x8*)(gin + 8192 + ((size_t)(tt * 4 + s) * 64 + lane) * 16), bfr = *(const GAS bf16x8*)(sb + tv * 4096 + s * 1024);
            acc = __builtin_amdgcn_mfma_f32_32x32x16_bf16(a, bfr, acc, 0, 0, 0); }
#pragma unroll
        for (int g = 0; g < 16; ++g) yl[crow(g, hi) * 64 + 32 * tv + cl] = acc[g];
    }
    LDS_WAIT();
    const float* RWp = WSP(const float, WS_RW); constexpr size_t RS = (size_t)M * 256;
    const int ch = h * 64 + lane;
    const float rk = GIN(16)[l * 256 + ch], lng = GIN(17)[l * 256 + ch], lnb = GIN(18)[l * 256 + ch];
    const size_t row0 = (size_t)b * SEQ + c * 64 + 32 * tt;
#pragma unroll 8
    for (int t = 0; t < 32; ++t) { const size_t o = (row0 + t) * 256 + ch;
        const float y = yl[t * 64 + lane], r = RWp[o], k = RWp[2 * RS + o], v = RWp[3 * RS + o], g = RWp[6 * RS + o];
        const float mean = wave_sum(y) * (1.0f / 64.0f); const float d = y - mean; const float var = wave_sum(d * d) * (1.0f / 64.0f);
        const float bonus = wave_sum(r * k * rk) * v;
        WSP(bf16, WS_MIX)[(row0 + t) * 1024 + ch] = (bf16)f2bf((d * (1.0f / sqrtf(var + 64e-5f)) * lng + lnb + bonus) * g); }
    LDS_WAIT();
}
#ifndef ATT_NEGM
#define ATT_NEGM false
#endif
constexpr int CW_TIX = 16384 + 2048;
__device__ __forceinline__ void phase_attention(Frame& F, KArgs& A, int l, int rep) {
    constexpr int NSTREAM = 48, NUNITS = NSTREAM * 16, NCONV = 192, NTICKETS = NUNITS + NCONV;
    static_assert(4 * NCONV == NUNITS && 2 * NCONV * 64 == 3 * 32 * 256, "ticket interleave");
    unsigned* ctr = (unsigned*)(F.ctl + CW_TIX + l * 64 + rep * 16);
    volatile LAS unsigned* tix = F.MISC + 16;
    attn_body::attn_build_tables(F.tid, WSP(float, WS_TB), (char*)F.lds);
    asm volatile("s_waitcnt vmcnt(0) lgkmcnt(0)\n\ts_barrier" ::: "memory");
    if (F.vcu < 4) rwkv_chain_wave(F, (F.vcu * 8 + F.wave) >> 1, F.wave & 1);
    int iter_ = 0;
    for (;;) {
#ifdef ATT_STATIC
        if (threadIdx.x == 0) tix[0] = (unsigned)(iter_ * F.G + (int)blockIdx.x);
#else
        if (threadIdx.x == 0) tix[0] = atomicAdd(ctr, 1u);
#endif
        ++iter_;
        asm volatile("s_waitcnt vmcnt(0) lgkmcnt(0)\n\ts_barrier" ::: "memory");
        const int ticket = (int)tix[0];
        asm volatile("s_waitcnt lgkmcnt(0)\n\ts_barrier" ::: "memory");
        if (ticket >= NTICKETS) break;
        if (ticket % 5 == 4) { moe_convert_ticket(F, A, l, ticket / 5); continue; }
        const int au = 4 * (ticket / 5) + ticket % 5;
        const int qb = 15 - au / NSTREAM, s = au % NSTREAM;
        int tid_u = threadIdx.x; asm volatile("" : "+v"(tid_u));
        if (s < 32) {
            const int b = s >> 3, h = (s >> 1) & 3, c = s & 1; const size_t r0 = (size_t)b * SEQ;
            attn_body::attn_unit_dv<16>(tid_u, qb,
                (const attn_body::bf16*)(WSP(bf16, WS_QD) + r0 * 512 + (h * 2 + c) * 64), 512,
                (const attn_body::bf16*)(WSP(bf16, WS_KD) + r0 * 512 + (h * 2 + c) * 64), 512,
                (const attn_body::bf16*)(WSP(bf16, WS_VD) + r0 * 512 + h * 128), 512,
                (attn_body::bf16*)(WSP(bf16, WS_OD) + r0 * 1024 + (h * 2 + c) * 128), 1024,
                h, (char*)F.lds);
        } else {
            const int b = (s - 32) >> 2, h = (s - 32) & 3; const size_t r0 = (size_t)b * SEQ;
            attn_body::attn_unit<16, true, ATT_NEGM>(tid_u, qb,
                (const attn_body::bf16*)(WSP(bf16, WS_QM) + r0 * 256 + h * 64), 256,
                (const attn_body::bf16*)(WSP(bf16, WS_KM) + r0 * 256 + h * 64), 256,
                (const attn_body::bf16*)(WSP(bf16, WS_VM) + r0 * 256 + h * 64), 256,
                (attn_body::bf16*)(WSP(bf16, WS_MIX) + r0 * 1024 + 768 + h * 64), 1024,
                4 + h, WSP(float, WS_KMEAN) + ((size_t)(b * 4 + h) * 16) * 64, (char*)F.lds);
        }
    }
}
__device__ __forceinline__ void phase_postmix(Frame& F, KArgs& A, int l) {
    const float lam = WSP(float, WS_LAM)[l]; const float li = 0.8f - 0.6f * __expf(-0.3f * (float)l);
    const float* sg = GIN(22) + l * 128;
    const int nit_ = F.xl ? 9 : (2048 + M + F.NGW - 1) / F.NGW;
    for (int k_ = 0; k_ < nit_; ++k_) {
        int it;
        if (F.xl) { if (k_ == 0) { rwkv_y_item(F, A, l, ((((F.vcu >> 6) * 4 + (F.wave >> 1)) * 64 + (F.vcu & 63)) << 1) | (F.wave & 1)); continue; } it = 2048 + F.vcu * 64 + F.wave * 8 + (k_ - 1); }
        else { it = F.gw + k_ * F.NGW; if (it >= 2048 + M) break; if (it < 2048) { rwkv_y_item(F, A, l, it); continue; } }
        const int m = it - 2048; const int h = F.lane >> 4, j = F.lane & 15;
        const bf16* od = WSP(bf16, WS_OD) + (size_t)m * 1024 + h * 256 + 8 * j;
        const v4u a = __builtin_nontemporal_load((const GAS v4u*)od), b2 = __builtin_nontemporal_load((const GAS v4u*)(od + 128));
        float o[8];
        o[0] = bf_lo(a.x) - lam * bf_lo(b2.x); o[1] = bf_hi(a.x) - lam * bf_hi(b2.x); o[2] = bf_lo(a.y) - lam * bf_lo(b2.y); o[3] = bf_hi(a.y) - lam * bf_hi(b2.y);
        o[4] = bf_lo(a.z) - lam * bf_lo(b2.z); o[5] = bf_hi(a.z) - lam * bf_hi(b2.z); o[6] = bf_lo(a.w) - lam * bf_lo(b2.w); o[7] = bf_hi(a.w) - lam * bf_hi(b2.w);
        float ss = 0.f;
#pragma unroll
        for (int i = 0; i < 8; ++i) ss += o[i] * o[i];
        ss += __shfl_xor(ss, 1); ss += __shfl_xor(ss, 2); ss += __shfl_xor(ss, 4); ss += __shfl_xor(ss, 8);
        const float rs = (1.f - li) / sqrtf(ss * (1.0f / 128.0f) + 1e-6f);
        const f32x4 g0 = *(const f32x4*)(sg + 8 * j), g1 = *(const f32x4*)(sg + 8 * j + 4);
        v4u w; w.x = pk2(o[0] * rs * g0.x, o[1] * rs * g0.y); w.y = pk2(o[2] * rs * g0.z, o[3] * rs * g0.w); w.z = pk2(o[4] * rs * g1.x, o[5] * rs * g1.y); w.w = pk2(o[6] * rs * g1.z, o[7] * rs * g1.w);
        *(GAS v4u*)(WSP(bf16, WS_MIX) + (size_t)m * 1024 + 256 + h * 128 + 8 * j) = w;
    }
}
__global__ void __launch_bounds__(NWAVES * 64, 2) mega_fwd(Args Araw) {
    extern __shared__ __attribute__((aligned(16))) unsigned char lds[];
    Frame F;
    F.lds = (LAS unsigned char*)lds; F.MISC = (volatile LAS unsigned*)(F.lds + MISC_OFF);
    F.tid = threadIdx.x; F.lane = F.tid & 63; F.wave = __builtin_amdgcn_readfirstlane(F.tid >> 6);
    F.G = gridDim.x; { const int bx = blockIdx.x; F.vcu = (F.G % 8 == 0) ? (bx % 8) * (F.G / 8) + bx / 8 : bx; }
    F.gw = F.vcu * NWAVES + F.wave; F.NGW = F.G * NWAVES;
    F.out = Araw.out; F.ws = Araw.ws; F.ctl = (gu32*)(Araw.ws + WS_CTL); F.xl = 0; F.cf = (int)blockIdx.x;
    for (int u = F.tid; u < (LDS_BYTES - LDSCTL_OFF) / 4; u += NWAVES * 64) ((LAS unsigned*)(F.lds + LDSCTL_OFF))[u] = 0u;
    __syncthreads();
    XcdBarrier bar = xcd_barrier_post((unsigned*)(F.ctl + CW_BAR), F.MISC + 8);
#define GRID_BAR() xcd_barrier(bar)

    constexpr int NPH = 9; constexpr int NSTEP = 1 + NL * NPH + 1;
    int reps_ = 0;
    {
        KArgs* Ap_ = (KArgs*)__builtin_amdgcn_kernarg_segment_ptr(); asm volatile("" : "+s"(Ap_)); KArgs& A = *Ap_;
        { unsigned lb_ = 0u; asm volatile("" : "+s"(lb_)); F.lds = (LAS unsigned char*)lds + lb_; F.MISC = (volatile LAS unsigned*)(F.lds + MISC_OFF); }
        { GAS unsigned char* w_ = (GAS unsigned char*)Araw.ws; GAS float* o_ = (GAS float*)Araw.out; asm volatile("" : "+s"(w_), "+s"(o_)); F.ws = (unsigned char*)w_; F.out = (float*)o_; F.ctl = (gu32*)(w_ + WS_CTL); }
        { int t_ = threadIdx.x; asm volatile("" : "+v"(t_)); F.tid = t_; F.lane = t_ & 63; F.wave = __builtin_amdgcn_readfirstlane(t_ >> 6); F.gw = F.vcu * NWAVES + F.wave; }
#ifndef SK_P0
        p0_prologue(F, A);
#endif
        GRID_BAR();
        xcd_census_regular(bar);
        { const int xl_ = __builtin_amdgcn_readfirstlane((int)F.MISC[11]), rk_ = __builtin_amdgcn_readfirstlane((int)F.MISC[10]);
          if (xl_) { F.xl = 1; F.vcu = (int)bar.x * 32 + rk_; F.cf = rk_ * 8 + (int)bar.x; } }
    }
    for (int step = 1; step < NSTEP; ++step) {
        const int l = (step - 1) / NPH, idx_ = (step - 1) % NPH;
        const int ph = ((step == NSTEP - 1) ? 99 : (idx_ < 2 ? idx_ : (idx_ == 2 ? 10 : (idx_ < 7 ? idx_ : idx_ + 1))));
        KArgs* Ap_ = (KArgs*)__builtin_amdgcn_kernarg_segment_ptr(); asm volatile("" : "+s"(Ap_)); KArgs& A = *Ap_;
        { unsigned lb_ = 0u; asm volatile("" : "+s"(lb_)); F.lds = (LAS unsigned char*)lds + lb_; F.MISC = (volatile LAS unsigned*)(F.lds + MISC_OFF); }
        { GAS unsigned char* w_ = (GAS unsigned char*)Araw.ws; GAS float* o_ = (GAS float*)Araw.out; asm volatile("" : "+s"(w_), "+s"(o_)); F.ws = (unsigned char*)w_; F.out = (float*)o_; F.ctl = (gu32*)(w_ + WS_CTL); }
        { int t_ = threadIdx.x; asm volatile("" : "+v"(t_)); F.tid = t_; F.lane = t_ & 63; F.wave = __builtin_amdgcn_readfirstlane(t_ >> 6); F.gw = F.vcu * NWAVES + F.wave; }
#ifdef AMP_MASK
        const unsigned long long amp_t0 = __builtin_amdgcn_s_memrealtime();
#endif
        switch (ph) {
        case 0:
#ifndef SK_N1
            phase_norm1(F, A, l);
#endif
            break;
        case 1: {
#ifndef SK_GIN
            pg8::Gemm g{WSP(bf16, WS_HB), WSP(bf16, WS_WIN) + (size_t)l * NIN * 1024, M, NIN, DM, 0};
            pg8::StaticOrder S; S.init(M, NIN, F.G, F.cf);
            pg8::EpiInProj E{F.ws, Ap_, l, C2};
            pg8::gemm_phase<pg8::EpiInProj, pg8::StaticOrder, true, PG8_SP2>(F.lds, g, S, E);
            if (F.cf >= 64) moe_convert_ticket(F, A, l, 192 + (F.cf - 64) % 192);
#endif
            break; }
        case 10:
            phase_chunkprep(F, A, l);
            break;
        case 3:
#ifndef SK_MX
            phase_attention(F, A, l, reps_);
#endif
            break;
        case 4:
#ifndef SK_PM
            phase_postmix(F, A, l);
#endif
            break;
        case 5: {
#ifndef SK_GOUT
            pg8::Gemm g{WSP(bf16, WS_MIX), WSP(bf16, WS_WOUT) + (size_t)l * 1024 * 1024, M, DM, DM, 0};
            pg8::StaticOrder S; S.init(M, DM, F.G, F.cf);
            pg8::EpiResid E{F.out, WSP(float, WS_MOD) + (size_t)l * NB * 6144 + 2048, SEQ, 6144};
            pg8::gemm_phase<pg8::EpiResid, pg8::StaticOrder, true, PG8_SP2>(F.lds, g, S, E);
#endif
            break; }
        case 6:
#ifndef SK_R1
            phase_router(F, A, l, bar);
#endif
            break;
        case 8: {
#ifndef SK_MOE
            moe_tables(F, A, l);
            const LAS int* base = (const LAS int*)(F.lds + TAB_OFF);
            pg8::MoeOrder S{base + 64, base[32] / 256, 4, F.G, F.vcu};
            pg8::Gemm g1{WSP(bf16, WS_XS), WSP(bf16, WS_W13) + (size_t)l * 32 * 1024 * 1024, MOE_ROWS, 1024, 1024, (size_t)1024 * 1024 * 2};
            pg8::EpiSwiGLU E1{WSP(bf16, WS_HS)};
            pg8::gemm_phase<pg8::EpiSwiGLU, pg8::MoeOrder, true, PG8_SP2>(F.lds, g1, S, E1);
#endif
            break; }
        case 9: {
#ifndef SK_MOE
            moe_tables(F, A, l);
            const LAS int* base = (const LAS int*)(F.lds + TAB_OFF);
            pg8::MoeOrder S{base + 64, base[32] / 256, 4, F.G, F.vcu};
            pg8::Gemm g2{WSP(bf16, WS_HS), WSP(bf16, WS_W2) + (size_t)l * 32 * 1024 * 512, MOE_ROWS, 1024, 512, (size_t)1024 * 512 * 2};
            pg8::EpiMoeOut E2{WSP(bf16, WS_YS), WSP(float, WS_SMALL) + 6 * M};
            pg8::gemm_phase<pg8::EpiMoeOut, pg8::MoeOrder, true, PG8_SP2>(F.lds, g2, S, E2);
#endif
            break; }
        default:
            phase_norm1(F, A, NL);
            break;
        }
#ifdef AMP_MASK
        { const int bit_ = ph == -1 ? 15 : (ph == 99 ? 14 : ph); if ((AMP_MASK >> bit_) & 1) { asm volatile("s_waitcnt vmcnt(0) lgkmcnt(0)" ::: "memory"); const unsigned long long t1_ = __builtin_amdgcn_s_memrealtime(); while (__builtin_amdgcn_s_memrealtime() - t1_ < t1_ - amp_t0) __builtin_amdgcn_s_sleep(8); } }
#endif
        if (step + 1 < NSTEP) {
            if (F.xl && (ph == 0 || ph == 4 || ph == 5 || ph == 8)) xcd_local_barrier(bar); else GRID_BAR();
        }
#ifdef REP_PH
        if (ph == REP_PH && reps_ == 0) { reps_ = 1; --step; } else reps_ = 0;
#endif
    }
}

extern "C" void kernel_launch(void* const* d_in, const int* in_sizes, int n_in, void* d_out, int out_size, void* d_ws, size_t ws_size, hipStream_t stream) {
    static int grid = 0;
    if (grid == 0) {
        if (n_in != 33 || out_size != M * DM || ws_size < WS_END) { fprintf(stderr, "kernel_launch: unexpected shapes (n_in %d, out %d, ws %zu < %zu)\n", n_in, out_size, ws_size, (size_t)WS_END); grid = -1; return; }
        int dev = 0, cus = 0;
        if (hipGetDevice(&dev) != hipSuccess || hipDeviceGetAttribute(&cus, hipDeviceAttributeMultiprocessorCount, dev) != hipSuccess) { grid = -1; return; }
        if (hipFuncSetAttribute((const void*)mega_fwd, hipFuncAttributeMaxDynamicSharedMemorySize, LDS_BYTES) != hipSuccess) { fprintf(stderr, "kernel_launch: hipFuncSetAttribute failed\n"); grid = -1; return; }
        int per_cu = 0;
        if (hipOccupancyMaxActiveBlocksPerMultiprocessor(&per_cu, (const void*)mega_fwd, NWAVES * 64, LDS_BYTES) != hipSuccess || per_cu < 1) fprintf(stderr, "kernel_launch: occupancy query says %d\n", per_cu);
        (void)hipGetLastError();
        if (cus != M / 64) { fprintf(stderr, "kernel_launch: built for %d CUs (found %d)\n", M / 64, cus); grid = -1; return; }
        grid = cus;
    }
    if (grid < 0) return;
    if (hipMemsetAsync((char*)d_ws + WS_CTL, 0, CTL_ZERO_BYTES, stream) != hipSuccess) { fprintf(stderr, "kernel_launch: memset failed\n"); return; }
    Args a{};
    for (int i = 0; i < 33; ++i) a.in[i] = (const float*)d_in[i];
    a.out = (float*)d_out; a.ws = (unsigned char*)d_ws;
    hipLaunchKernelGGL(mega_fwd, dim3(grid), dim3(NWAVES * 64), LDS_BYTES, stream, a);
}
```

```cpp
#include <hip/hip_runtime.h>
#include <cstdio>
#include <cstdint>
struct Args { const float* in[33]; float* out; unsigned char* ws; };
typedef const __attribute__((address_space(4))) Args KArgs;
namespace pg8 {
#define PG8_LAS __attribute__((address_space(3)))
typedef unsigned short bf16_t;
typedef short bf16x8 __attribute__((ext_vector_type(8)));
typedef float f32x4 __attribute__((ext_vector_type(4)));
typedef unsigned u32x4 __attribute__((ext_vector_type(4)));
constexpr int BM = 256, BK = 64, HALF = 128, HTB = HALF * BK * 2  , STAGE_BYTES = 8 * HTB, NXCD = 8, WGM = 8;

__host__ __device__ __forceinline__ int lds_byte(int r, int c) { const int st = (r >> 4) * 2 + (c >> 5), rr = r & 15, cc = c & 31, ob = rr * 64 + cc * 2; return st * 1024 + (ob ^ (((ob >> 9) & 1) << 5)); }
__host__ __device__ __forceinline__ void stage_rc(int b, int& R, int& C) { const int st = b / 1024, sb = b % 1024, swz = sb ^ (((sb >> 9) & 1) << 5); R = (st >> 1) * 16 + swz / 64; C = (st & 1) * 32 + (swz % 64) / 2; }
__host__ __device__ __forceinline__ int perm32(int rho) { const int n = rho >> 4, i = rho & 15; return 8 * (i >> 2) + 4 * n + (i & 3); }

struct Unit { int pm, pn, e; };
struct Gemm { const bf16_t* A; const bf16_t* Bt; int M, N, K; size_t estride; };

struct StaticOrder {
    int nM, nN, nwg, G, c;
    __host__ __device__ void init(int M, int N, int G_, int c_) { nM = M / BM; nN = N / BM; nwg = nM * nN; G = G_; c = c_; }
    __host__ __device__ bool next(int i, Unit& u) const {
        const long L = (long)i * G + c; if (L >= nwg) return false;
        int wgid = (int)L; { const int q = nwg / NXCD, r = nwg % NXCD, xcd = wgid % NXCD, off = wgid / NXCD; wgid = (xcd < r ? xcd * (q + 1) : r * (q + 1) + (xcd - r) * q) + off; }
        const int nig = WGM * nN, gid = wgid / nig, fm = gid * WGM, gsz = (nM - fm) < WGM ? (nM - fm) : WGM;
        u.pm = fm + ((wgid % nig) % gsz); u.pn = (wgid % nig) / gsz; u.e = 0; return true;
    }
    __device__ __forceinline__ void a_ready(const Unit&) const {}
    __device__ __forceinline__ void done(const Unit&) const {}
};

__device__ __forceinline__ unsigned cvt_pk_bf16(float lo, float hi) { unsigned r; asm volatile("v_cvt_pk_bf16_f32 %0, %1, %2" : "=v"(r) : "v"(lo), "v"(hi)); return r; }
typedef unsigned u32x2 __attribute__((ext_vector_type(2)));
constexpr size_t EPI_MiB = 1u << 20, EPI_WS_QD = 656 * EPI_MiB, EPI_WS_KD = 672 * EPI_MiB, EPI_WS_VD = 688 * EPI_MiB, EPI_WS_QM = 704 * EPI_MiB, EPI_WS_KM = 712 * EPI_MiB, EPI_WS_VM = 720 * EPI_MiB, EPI_WS_PR = 728 * EPI_MiB;

struct EpiInProj {
    static constexpr bool PERM = true, AFTER_DRAIN = false;
    unsigned char* ws; KArgs* ka; int l; float c2;
    __device__ __forceinline__ void operator()(const f32x4 (&acc)[2][2][4][2], const Unit& u, int wr, int wc, int fr, int fq) const {
        const int pn = u.pn; const int row0 = u.pm * BM + wr * 64 + fr;
        if (pn >= 9) {
            float* PR = (float*)(ws + EPI_WS_PR);
            const int cb = (pn - 9) * 256 + 64 * wc + 8 * fq;
#pragma unroll
            for (int ai = 0; ai < 2; ++ai)
#pragma unroll
                for (int m = 0; m < 4; ++m) { float* rowp = PR + (size_t)(row0 + ai * HALF + m * 16) * 896;
#pragma unroll
                    for (int bj = 0; bj < 2; ++bj)
#pragma unroll
                        for (int n = 0; n < 2; ++n) { const int c = cb + 32 * bj + 4 * n; if (c < 896) *(f32x4*)(rowp + c) = acc[ai][bj][m][n]; } }
            return;
        }
        bf16_t* dst; int ld, cbase; const float* gain = nullptr; float sc = 1.f;
        if (pn < 2) { dst = (bf16_t*)(ws + EPI_WS_QD); ld = 512; cbase = pn * 256; gain = ((const float*)(const __attribute__((address_space(1))) float*)ka->in[19]) + l * 64; sc = c2; }
        else if (pn < 4) { dst = (bf16_t*)(ws + EPI_WS_KD); ld = 512; cbase = (pn - 2) * 256; gain = ((const float*)(const __attribute__((address_space(1))) float*)ka->in[20]) + l * 64; }
        else if (pn < 6) { dst = (bf16_t*)(ws + EPI_WS_VD); ld = 512; cbase = (pn - 4) * 256; }
        else if (pn == 6) { dst = (bf16_t*)(ws + EPI_WS_QM); ld = 256; cbase = 0; gain = ((const float*)(const __attribute__((address_space(1))) float*)ka->in[23]) + l * 64; sc = c2; }
        else if (pn == 7) { dst = (bf16_t*)(ws + EPI_WS_KM); ld = 256; cbase = 0; gain = ((const float*)(const __attribute__((address_space(1))) float*)ka->in[24]) + l * 64; }
        else { dst = (bf16_t*)(ws + EPI_WS_VM); ld = 256; cbase = 0; }
        f32x4 gv[2][2];
#pragma unroll
        for (int bj = 0; bj < 2; ++bj)
#pragma unroll
            for (int n = 0; n < 2; ++n) gv[bj][n] = gain ? *(const f32x4*)(gain + 32 * bj + 8 * fq + 4 * n) * sc : (f32x4){1.f, 1.f, 1.f, 1.f};
        const int col0 = cbase + 64 * wc + 8 * fq;
#pragma unroll
        for (int ai = 0; ai < 2; ++ai)
#pragma unroll
            for (int m = 0; m < 4; ++m) {
                float rs = 1.f;
                if (gain) { float ss = 0.f;
#pragma unroll
                    for (int bj = 0; bj < 2; ++bj)
#pragma unroll
                        for (int n = 0; n < 2; ++n) { const f32x4 x = acc[ai][bj][m][n]; ss += (x[0] * x[0] + x[1] * x[1]) + (x[2] * x[2] + x[3] * x[3]); }
                    ss += __shfl_xor(ss, 16); ss += __shfl_xor(ss, 32);
                    rs = 1.0f / sqrtf(ss * (1.0f / 64.0f) + 1e-6f); }
                bf16_t* rowp = dst + (size_t)(row0 + ai * HALF + m * 16) * ld + col0;
#pragma unroll
                for (int bj = 0; bj < 2; ++bj) { const f32x4 v0 = acc[ai][bj][m][0] * rs * gv[bj][0], v1 = acc[ai][bj][m][1] * rs * gv[bj][1];
                    u32x4 w; w.x = cvt_pk_bf16(v0[0], v0[1]); w.y = cvt_pk_bf16(v0[2], v0[3]); w.z = cvt_pk_bf16(v1[0], v1[1]); w.w = cvt_pk_bf16(v1[2], v1[3]);
                    *(u32x4*)(rowp + 32 * bj) = w; } }
    }
};
struct EpiResid {
    static constexpr bool PERM = false, AFTER_DRAIN = false;
    float* X; const float* gate; int seq, gstride;
    __device__ __forceinline__ void operator()(const f32x4 (&acc)[2][2][4][2], const Unit& u, int wr, int wc, int fr, int fq) const {
        const int row0 = u.pm * BM + wr * 64 + fr, col0 = u.pn * BM + wc * 32 + 4 * fq;
        const float* gp = gate + (size_t)((u.pm * BM) / seq) * gstride + col0;
        f32x4 gv[2][2];
#pragma unroll
        for (int bj = 0; bj < 2; ++bj)
#pragma unroll
            for (int n = 0; n < 2; ++n) gv[bj][n] = *(const f32x4*)(gp + bj * HALF + n * 16);
#pragma unroll
        for (int ai = 0; ai < 2; ++ai)
#pragma unroll
            for (int m = 0; m < 4; ++m) { float* rowp = X + (size_t)(row0 + ai * HALF + m * 16) * 1024 + col0;
#pragma unroll
                for (int bj = 0; bj < 2; ++bj)
#pragma unroll
                    for (int n = 0; n < 2; ++n) { f32x4* p = (f32x4*)(rowp + bj * HALF + n * 16); *p = *p + gv[bj][n] * acc[ai][bj][m][n]; } }
    }
};
struct EpiSwiGLU {
    static constexpr bool PERM = true, AFTER_DRAIN = false;
    bf16_t* HS;
    __device__ __forceinline__ void operator()(const f32x4 (&acc)[2][2][4][2], const Unit& u, int wr, int wc, int fr, int fq) const {
        const int row0 = u.pm * BM + wr * 64 + fr;
#pragma unroll
        for (int ai = 0; ai < 2; ++ai)
#pragma unroll
            for (int m = 0; m < 4; ++m) { bf16_t* rowp = HS + (size_t)(row0 + ai * HALF + m * 16) * 512;
#pragma unroll
                for (int bj = 0; bj < 2; ++bj) { const int g = 32 * u.pn + 16 * bj + 4 * wc + fq; const f32x4 a = acc[ai][bj][m][0], b = acc[ai][bj][m][1]; f32x4 o;
#pragma unroll
                    for (int e = 0; e < 4; ++e) o[e] = a[e] / (1.0f + __expf(-a[e])) * b[e];
                    u32x2 w; w.x = cvt_pk_bf16(o[0], o[1]); w.y = cvt_pk_bf16(o[2], o[3]); *(u32x2*)(rowp + 4 * g) = w; } }
    }
};
struct EpiMoeOut {
    static constexpr bool PERM = true, AFTER_DRAIN = false;
    bf16_t* YS; const float* gs;
    __device__ __forceinline__ void operator()(const f32x4 (&acc)[2][2][4][2], const Unit& u, int wr, int wc, int fr, int fq) const {
        const int row0 = u.pm * BM + wr * 64 + fr, col0 = u.pn * BM + wc * 32 + 8 * fq;
#pragma unroll
        for (int ai = 0; ai < 2; ++ai)
#pragma unroll
            for (int m = 0; m < 4; ++m) { const int r = row0 + ai * HALF + m * 16; const float gt = gs[r]; bf16_t* rowp = YS + (size_t)r * 1024 + col0;
#pragma unroll
                for (int bj = 0; bj < 2; ++bj) { const f32x4 v0 = acc[ai][bj][m][0] * gt, v1 = acc[ai][bj][m][1] * gt;
                    u32x4 w; w.x = cvt_pk_bf16(v0[0], v0[1]); w.y = cvt_pk_bf16(v0[2], v0[3]); w.z = cvt_pk_bf16(v1[0], v1[1]); w.w = cvt_pk_bf16(v1[2], v1[3]);
                    *(u32x4*)(rowp + bj * HALF) = w; } }
    }
};
struct MoeOrder {
    const __attribute__((address_space(3))) int* t2e; int ntiles, nN, G, c;
    __device__ bool next(int i, Unit& u) const { const int L = i * G + c; if (L >= ntiles * nN) return false; u.pm = L / nN; u.pn = L % nN; u.e = t2e[u.pm]; return true; }
    __device__ __forceinline__ void a_ready(const Unit&) const {}
    __device__ __forceinline__ void done(const Unit&) const {}
};
template <class Epi, class Sched, bool ALIGN_EPI = false, bool SP2 = false>
__device__ __forceinline__ void gemm_phase(PG8_LAS unsigned char* lds, const Gemm g, const Sched& S, const Epi& E) {
    int tid_ = threadIdx.x; asm volatile("" : "+v"(tid_));
    const int tid = tid_, wid = __builtin_amdgcn_readfirstlane(tid >> 6), lane = tid & 63, wr = wid >> 2, wc = wid & 3, fr = lane & 15, fq = lane >> 4;
    const int K = g.K, nt = K / BK;
    unsigned voffA[2], voffB[2];
#pragma unroll
    for (int i = 0; i < 2; ++i) { int R, C; stage_rc(tid * 16 + i * 8192, R, C); const int Rb = Epi::PERM ? ((R & ~31) + perm32(R & 31)) : R;
        voffA[i] = (unsigned)(R * K + C) * 2u; voffB[i] = (unsigned)(Rb * K + C) * 2u; }
    const size_t kstep = (size_t)(BK * 2);
    const size_t hstep = (size_t)HALF * K * 2;
    const size_t tstep = 2 * hstep;
    const unsigned ldsw = (unsigned)wid * 1024u;
    const int aoff = lds_byte(wr * 64 + fr, fq * 8), boff = lds_byte(wc * 32 + fr, fq * 8);
#define PG8_SA(b, h) (((b) * 2 + (h)) * HTB)
#define PG8_SB(b, h) ((4 + (b) * 2 + (h)) * HTB)
#define PG8_STAGE(bufoff, gbase, voff) do { _Pragma("unroll") for (int _i = 0; _i < 2; ++_i) \
        __builtin_amdgcn_global_load_lds((const unsigned*)((const char*)(gbase) + (voff)[_i]), (PG8_LAS unsigned*)(lds + (bufoff) + ldsw + _i * 8192), 16, 0, 0); } while (0)
#define PG8_LDA(dst, b, h) do { _Pragma("unroll") for (int m = 0; m < 4; ++m) _Pragma("unroll") for (int k = 0; k < 2; ++k) dst[m][k] = *(const PG8_LAS bf16x8*)(lds + PG8_SA(b, h) + aoff + m * 2048 + k * 1024); } while (0)
#define PG8_LDB(dst, b, h) do { _Pragma("unroll") for (int n = 0; n < 2; ++n) _Pragma("unroll") for (int k = 0; k < 2; ++k) dst[n][k] = *(const PG8_LAS bf16x8*)(lds + PG8_SB(b, h) + boff + n * 2048 + k * 1024); } while (0)
#define PG8_MMA(ai, bj, At, Bt) do { __builtin_amdgcn_s_setprio(1); _Pragma("unroll") for (int m = 0; m < 4; ++m) _Pragma("unroll") for (int n = 0; n < 2; ++n) _Pragma("unroll") for (int k = 0; k < 2; ++k) \
        acc[ai][bj][m][n] = __builtin_amdgcn_mfma_f32_16x16x32_bf16(Bt[n][k], At[m][k], acc[ai][bj][m][n], 0, 0, 0); __builtin_amdgcn_s_setprio(0); } while (0)
#define PG8_WAIT_V(n) asm volatile("s_waitcnt vmcnt(" #n ")" ::: "memory")
#define PG8_WAIT_L(n) asm volatile("s_waitcnt lgkmcnt(" #n ")" ::: "memory")
#define PG8_BAR __builtin_amdgcn_s_barrier()
#define PG8_SCHED __builtin_amdgcn_sched_barrier(0)
    Unit cur, nxt; int ui = 0;
    if (!S.next(0, cur)) return;
    f32x4 acc[2][2][4][2];
#pragma unroll
    for (int a = 0; a < 2; ++a)
#pragma unroll
        for (int b = 0; b < 2; ++b)
#pragma unroll
            for (int m = 0; m < 4; ++m)
#pragma unroll
                for (int n = 0; n < 2; ++n) acc[a][b][m][n] = (f32x4){0.f, 0.f, 0.f, 0.f};
    bf16x8 At[4][2], B0[2][2], B1[2][2];
    const char* cA = (const char*)g.A + (size_t)cur.pm * tstep; const char* cB = (const char*)g.Bt + (size_t)cur.e * g.estride + (size_t)cur.pn * tstep;
    S.a_ready(cur);
    if constexpr (SP2) {
        PG8_STAGE(PG8_SB(0, 0), cB, voffB); PG8_STAGE(PG8_SB(0, 1), cB + hstep, voffB); PG8_STAGE(PG8_SA(0, 0), cA, voffA); PG8_STAGE(PG8_SA(0, 1), cA + hstep, voffA);
        if (wr == 1) PG8_BAR;
        PG8_WAIT_V(2); PG8_BAR;
        PG8_STAGE(PG8_SB(1, 0), cB + kstep, voffB); PG8_STAGE(PG8_SA(1, 0), cA + kstep, voffA); PG8_STAGE(PG8_SB(1, 1), cB + hstep + kstep, voffB);
        PG8_WAIT_V(6); PG8_BAR;
    } else {
        PG8_STAGE(PG8_SB(0, 0), cB, voffB); PG8_STAGE(PG8_SA(0, 0), cA, voffA); PG8_STAGE(PG8_SB(0, 1), cB + hstep, voffB); PG8_STAGE(PG8_SA(0, 1), cA + hstep, voffA);
        if (wr == 1) PG8_BAR;
        PG8_WAIT_V(4); PG8_BAR;
        PG8_STAGE(PG8_SB(1, 0), cB + kstep, voffB); PG8_STAGE(PG8_SA(1, 0), cA + kstep, voffA); PG8_STAGE(PG8_SB(1, 1), cB + hstep + kstep, voffB);
        PG8_WAIT_V(6); PG8_BAR;
    }
    for (;;) {
        const bool has_next = S.next(ui + 1, nxt);
        const char* nA = has_next ? (const char*)g.A + (size_t)nxt.pm * tstep : cA; const char* nB = has_next ? (const char*)g.Bt + (size_t)nxt.e * g.estride + (size_t)nxt.pn * tstep : cB;
        for (int t = 0; t < nt; t += 2) {
            const bool last = (t == nt - 2);
            const char* a1 = cA + (size_t)(t + 1) * kstep;
            const char* a2 = last ? nA : cA + (size_t)(t + 2) * kstep; const char* b2 = last ? nB : cB + (size_t)(t + 2) * kstep;
            const char* a3 = a2 + kstep; const char* b3 = b2 + kstep;
            if (last && has_next) S.a_ready(nxt);
            if constexpr (SP2) {
            PG8_LDB(B0, 0, 0); PG8_LDB(B1, 0, 1); PG8_SCHED; PG8_LDA(At, 0, 0); PG8_STAGE(PG8_SA(1, 1), a1 + hstep, voffA);
            PG8_WAIT_V(8); PG8_WAIT_L(0); PG8_BAR; PG8_MMA(0, 0, At, B0); PG8_MMA(0, 1, At, B1); PG8_BAR; PG8_SCHED;
            PG8_LDA(At, 0, 1); PG8_STAGE(PG8_SB(0, 0), b2, voffB); PG8_STAGE(PG8_SB(0, 1), b2 + hstep, voffB); PG8_STAGE(PG8_SA(0, 0), a2, voffA);
            PG8_WAIT_V(8); PG8_WAIT_L(0); PG8_BAR; PG8_MMA(1, 0, At, B0); PG8_MMA(1, 1, At, B1); PG8_BAR; PG8_SCHED;
            PG8_LDB(B0, 1, 0); PG8_LDB(B1, 1, 1); PG8_SCHED; PG8_LDA(At, 1, 0); PG8_STAGE(PG8_SA(0, 1), a2 + hstep, voffA);
            PG8_WAIT_V(8); PG8_WAIT_L(0); PG8_BAR; PG8_MMA(0, 0, At, B0); PG8_MMA(0, 1, At, B1); PG8_BAR; PG8_SCHED;
            PG8_LDA(At, 1, 1); PG8_STAGE(PG8_SB(1, 0), b3, voffB); PG8_STAGE(PG8_SB(1, 1), b3 + hstep, voffB); PG8_STAGE(PG8_SA(1, 0), a3, voffA);
            PG8_WAIT_V(8); PG8_WAIT_L(0); PG8_BAR; PG8_MMA(1, 0, At, B0); PG8_MMA(1, 1, At, B1); PG8_BAR; PG8_SCHED;
            } else {
            PG8_LDB(B0, 0, 0); PG8_SCHED; PG8_LDA(At, 0, 0); PG8_STAGE(PG8_SA(1, 1), a1 + hstep, voffA);
            PG8_WAIT_L(8); PG8_BAR; PG8_WAIT_L(0); PG8_MMA(0, 0, At, B0); PG8_BAR; PG8_SCHED;
            PG8_LDB(B1, 0, 1); PG8_STAGE(PG8_SB(0, 0), b2, voffB);
            PG8_BAR; PG8_WAIT_L(0); PG8_MMA(0, 1, At, B1); PG8_BAR;
            PG8_LDA(At, 0, 1); PG8_STAGE(PG8_SA(0, 0), a2, voffA);
            PG8_BAR; PG8_WAIT_L(0); PG8_MMA(1, 0, At, B0); PG8_BAR; PG8_SCHED;
            PG8_STAGE(PG8_SB(0, 1), b2 + hstep, voffB);
            PG8_WAIT_V(6); PG8_BAR; PG8_MMA(1, 1, At, B1); PG8_BAR;
            PG8_LDB(B0, 1, 0); PG8_SCHED; PG8_LDA(At, 1, 0); PG8_STAGE(PG8_SA(0, 1), a2 + hstep, voffA);
            PG8_WAIT_L(8); PG8_BAR; PG8_WAIT_L(0); PG8_MMA(0, 0, At, B0); PG8_BAR; PG8_SCHED;
            PG8_LDB(B1, 1, 1); PG8_STAGE(PG8_SB(1, 0), b3, voffB);
            PG8_BAR; PG8_WAIT_L(0); PG8_MMA(0, 1, At, B1); PG8_BAR;
            PG8_LDA(At, 1, 1); PG8_STAGE(PG8_SA(1, 0), a3, voffA);
            PG8_BAR; PG8_WAIT_L(0); PG8_MMA(1, 0, At, B0); PG8_BAR; PG8_SCHED;
            PG8_STAGE(PG8_SB(1, 1), b3 + hstep, voffB);
            PG8_WAIT_V(6); PG8_BAR; PG8_MMA(1, 1, At, B1); PG8_BAR;
            }
        }
        if constexpr (ALIGN_EPI) { if (wr == 0) PG8_BAR; }
        if constexpr (!Epi::AFTER_DRAIN) { E(acc, cur, wr, wc, fr, fq); S.done(cur); }
        if (!has_next) break;
#pragma unroll
        for (int a = 0; a < 2; ++a)
#pragma unroll
            for (int b = 0; b < 2; ++b)
#pragma unroll
                for (int m = 0; m < 4; ++m)
#pragma unroll
                    for (int n = 0; n < 2; ++n) acc[a][b][m][n] = (f32x4){0.f, 0.f, 0.f, 0.f};
        cur = nxt; cA = nA; cB = nB; ++ui;
        if constexpr (ALIGN_EPI) { if (wr == 1) PG8_BAR; }
    }
    PG8_WAIT_V(0);
    if constexpr (!ALIGN_EPI) { if (wr == 0) PG8_BAR; }
    PG8_BAR;
    if constexpr (Epi::AFTER_DRAIN) { E.fused(acc, cur, wr, wc, fr, fq, lds, wid, lane); S.done(cur); }
#undef PG8_SA
#undef PG8_SB
#undef PG8_STAGE
#undef PG8_LDA
#undef PG8_LDB
#undef PG8_MMA
#undef PG8_WAIT_V
#undef PG8_WAIT_L
#undef PG8_BAR
#undef PG8_SCHED
}
}
#include <hip/hip_bf16.h>
#include <cmath>
namespace attn_body {
using bf16=__hip_bfloat16;
using bf16x8=__attribute__((ext_vector_type(8)))short;
using s16x4=__attribute__((ext_vector_type(4)))short;
using f32x16=__attribute__((ext_vector_type(16)))float;
using u32x4=__attribute__((ext_vector_type(4)))unsigned;
constexpr int D=64;
#ifndef TBATCH
#define TBATCH 16
#endif
constexpr int NW=8,QBLK=32,QB=QBLK*NW,KVBLK=64;
constexpr int ATTN_UNIT_ROWS=QB;
__device__ __forceinline__ int crow(int r,int hi){return (r&3)+8*(r>>2)+4*hi;}
#define SBAR() __builtin_amdgcn_sched_barrier(0)
__device__ __forceinline__ void cmask(f32x16&p0,f32x16&p1,int jb,int qrel,int hi){
  const float NEG=-INFINITY; int kb=64*jb+4*hi;
  #pragma unroll
  for(int r=0;r<16;++r){int kv=kb+(r&3)+8*(r>>2); if(kv>qrel)p0[r]=NEG; if(kv+32>qrel)p1[r]=NEG;}
}

constexpr int NSLOT=3, SLOTB=8192;
constexpr int LDS_K=0, LDS_V=NSLOT*SLOTB, LDS_WS=2*NSLOT*SLOTB, LDS_OST=LDS_WS+NW*64*4, LDS_TBL=LDS_OST+NW*4096, TBL_N=1344, LDS_BYTES=LDS_TBL+8*TBL_N*4;
constexpr float C2=0.125f*1.4426950408889634f;
__device__ __forceinline__ void glds16(const void*gsrc,unsigned lds_dst){unsigned keep;
  asm volatile("s_mov_b32 %0, m0\n\ts_mov_b32 m0, %2\n\ts_nop 0\n\tglobal_load_lds_dwordx4 %1, off\n\ts_mov_b32 m0, %0":"=&s"(keep):"v"(gsrc),"s"(lds_dst):"memory");}
__device__ __forceinline__ float max3f(float a,float b,float c){float r;asm("v_max3_f32 %0, %1, %2, %3":"=v"(r):"v"(a),"v"(b),"v"(c));return r;}
__device__ __forceinline__ float max2f(float a,float b){float r;asm("v_max_f32_e32 %0, %1, %2":"=v"(r):"v"(a),"v"(b));return r;}
__device__ __forceinline__ float fadd_s(float a,float b){float r;asm("v_add_f32_e32 %0, %1, %2":"=v"(r):"v"(a),"v"(b));return r;}
__device__ __forceinline__ float fsub_s(float a,float b){float r;asm("v_sub_f32_e32 %0, %1, %2":"=v"(r):"v"(a),"v"(b));return r;}
typedef float f32x2_t __attribute__((ext_vector_type(2))); typedef __bf16 bf16x2_t __attribute__((ext_vector_type(2)));
__device__ __forceinline__ unsigned cvtpk_s(float lo,float hi){f32x2_t v={lo,hi};bf16x2_t b=__builtin_convertvector(v,bf16x2_t);return __builtin_bit_cast(unsigned,b);}
#define WAIT_BAR(N) asm volatile("s_waitcnt vmcnt(" #N ") lgkmcnt(0)\n\ts_barrier":::"memory")

__device__ __forceinline__ void qkt(f32x16&p0,f32x16&p1,const char*Kslot,const bf16x8*qr,const f32x16&negm,int r32,int hi){
  const char*kb=Kslot+hi*1024+r32*16;
  #pragma unroll
  for(int d0=0;d0<4;++d0){
    const bf16x8 b0=*reinterpret_cast<const bf16x8*>(kb+d0*2048);
    const bf16x8 b1=*reinterpret_cast<const bf16x8*>(kb+d0*2048+512);
    if(d0==0){p0=__builtin_amdgcn_mfma_f32_32x32x16_bf16(b0,qr[0],negm,0,0,0);p1=__builtin_amdgcn_mfma_f32_32x32x16_bf16(b1,qr[0],negm,0,0,0);}
    else{p0=__builtin_amdgcn_mfma_f32_32x32x16_bf16(b0,qr[d0],p0,0,0,0);p1=__builtin_amdgcn_mfma_f32_32x32x16_bf16(b1,qr[d0],p1,0,0,0);}}
}
typedef __attribute__((address_space(3))) const char* lds_cptr;
typedef short v4i16_t __attribute__((ext_vector_type(4)));
__device__ __forceinline__ void kload8(bf16x8*kf,lds_cptr kp){
  kf[0]=*(const __attribute__((address_space(3))) bf16x8*)(kp);      kf[1]=*(const __attribute__((address_space(3))) bf16x8*)(kp+512);
  kf[2]=*(const __attribute__((address_space(3))) bf16x8*)(kp+2048); kf[3]=*(const __attribute__((address_space(3))) bf16x8*)(kp+2560);
  kf[4]=*(const __attribute__((address_space(3))) bf16x8*)(kp+4096); kf[5]=*(const __attribute__((address_space(3))) bf16x8*)(kp+4608);
  kf[6]=*(const __attribute__((address_space(3))) bf16x8*)(kp+6144); kf[7]=*(const __attribute__((address_space(3))) bf16x8*)(kp+6656);
}
__device__ __forceinline__ void kload2(bf16x8*kf,lds_cptr kp,int j){ kf[2*j]=*(const __attribute__((address_space(3))) bf16x8*)(kp+j*2048); kf[2*j+1]=*(const __attribute__((address_space(3))) bf16x8*)(kp+j*2048+512); }
__device__ __forceinline__ s16x4 vtr(lds_cptr p){ return __builtin_bit_cast(s16x4,__builtin_amdgcn_ds_read_tr16_b64_v4i16((__attribute__((address_space(3))) v4i16_t*)p)); }
__device__ __forceinline__ float rowmax(const f32x16&p0,const f32x16&p1){
  float a=max3f(p0[0],p0[1],p1[0]),b=max3f(p0[2],p0[3],p1[1]);a=max3f(a,p1[2],p1[3]);
  #pragma unroll
  for(int r=4;r<16;r+=4){a=max3f(a,p0[r],p0[r+1]);b=max3f(b,p0[r+2],p0[r+3]);a=max3f(a,p1[r],p1[r+1]);b=max3f(b,p1[r+2],p1[r+3]);}
  const float m=max2f(a,b);
  auto rr=__builtin_amdgcn_permlane32_swap(__float_as_uint(m),__float_as_uint(m),false,false);
  return max2f(__uint_as_float(rr[0]),__uint_as_float(rr[1]));
}
__device__ __forceinline__ void pv(f32x16*o,int vb,bf16x8 pa0,bf16x8 pa1,bf16x8 pa2,bf16x8 pa3){
  #pragma unroll
  for(int d0=0;d0<2;++d0){s16x4 lo[4],hi[4];
    #pragma unroll
    for(int ks=0;ks<4;++ks){
      asm volatile("ds_read_b64_tr_b16 %0,%1 offset:%c2":"=&v"(lo[ks]):"v"(vb),"i"(d0*4096+ks*1024):"memory");
      asm volatile("ds_read_b64_tr_b16 %0,%1 offset:%c2":"=&v"(hi[ks]):"v"(vb),"i"(d0*4096+ks*1024+512):"memory");}
    asm volatile("s_waitcnt lgkmcnt(0)":::"memory");SBAR();
    #define PK(k) (bf16x8){lo[k][0],lo[k][1],lo[k][2],lo[k][3],hi[k][0],hi[k][1],hi[k][2],hi[k][3]}
    o[d0]=__builtin_amdgcn_mfma_f32_32x32x16_bf16(pa0,PK(0),o[d0],0,0,0);
    o[d0]=__builtin_amdgcn_mfma_f32_32x32x16_bf16(pa1,PK(1),o[d0],0,0,0);
    o[d0]=__builtin_amdgcn_mfma_f32_32x32x16_bf16(pa2,PK(2),o[d0],0,0,0);
    o[d0]=__builtin_amdgcn_mfma_f32_32x32x16_bf16(pa3,PK(3),o[d0],0,0,0);
    #undef PK
  }
}

#ifndef ATTN_STORE16
#define ATTN_STORE16(p,v) __builtin_nontemporal_store((v),(u32x4*)(p))
#endif
__device__ __forceinline__ void attn_build_tables(int tid,const float*tb,char*shm){
  typedef __attribute__((address_space(3))) float lds_f32;
  lds_f32*T=(lds_f32*)((__attribute__((address_space(3))) char*)shm+LDS_TBL);
  for(int i=tid;i<8*TBL_N;i+=NW*64){ const int hh=i/TBL_N, d=i-hh*TBL_N-256; float v=0.f; if(d<0)v=-INFINITY; else if(d<1024)v=tb[hh*1024+d]-tb[hh*1024+1023]; T[i]=v; }
}
template<int THRL,bool MOBA,bool USE_NEGM> __device__ __forceinline__ void attn_unit(int tid,int qb,const bf16*Qb,int qpitch,const bf16*__restrict__ Kb,int kpitch,const bf16*__restrict__ Vb,int vpitch,bf16*Ob,int opitch,int hh,const float*kmean,char*shm){
  const int lane=tid&63,r32=lane&31,hi=lane>>5; const int wid=__builtin_amdgcn_readfirstlane(tid>>6);
  const int q0=qb*QB;
  const bf16*Qw=Qb+(long)(q0+wid*QBLK)*qpitch;
  const bf16*Kh=Kb,*Vh=Vb;
  const int qpos=q0+wid*QBLK+r32;
  typedef __attribute__((address_space(3))) float lds_f32;
  const lds_f32*Tl=(const lds_f32*)((__attribute__((address_space(3))) char*)shm+LDS_TBL)+hh*TBL_N;
  unsigned selmask=0xffffffffu;
  if(MOBA){
    float qf[64];
    { const uint4*qp=(const uint4*)(Qw+(long)r32*qpitch);
      _Pragma("unroll") for(int c=0;c<8;++c){ const uint4 u=qp[c]; qf[8*c]=__uint_as_float(u.x<<16);qf[8*c+1]=__uint_as_float(u.x&0xffff0000u);qf[8*c+2]=__uint_as_float(u.y<<16);qf[8*c+3]=__uint_as_float(u.y&0xffff0000u);
        qf[8*c+4]=__uint_as_float(u.z<<16);qf[8*c+5]=__uint_as_float(u.z&0xffff0000u);qf[8*c+6]=__uint_as_float(u.w<<16);qf[8*c+7]=__uint_as_float(u.w&0xffff0000u);} }
    float v1=-INFINITY,v2=-INFINITY,v3=-INFINITY; int i1=31,i2=31,i3=31;
    for(int n=0;n<qb;++n){ const float*km=kmean+n*64; float g=0.f;
      _Pragma("unroll") for(int i=0;i<64;++i)g+=qf[i]*km[i];
      if(g>v1){v3=v2;i3=i2;v2=v1;i2=i1;v1=g;i1=n;} else if(g>v2){v3=v2;i3=i2;v2=g;i2=n;} else if(g>v3){v3=g;i3=n;} }
    selmask=(1u<<qb); if(i1<31)selmask|=1u<<i1; if(i2<31)selmask|=1u<<i2; if(i3<31)selmask|=1u<<i3; }
  #define TMAP(t) (MOBA?(((t)<4)?(NT-4+(t)):((t)-4)):(t))
  const unsigned lds0=(unsigned)(uintptr_t)shm;
  float*wsf=(float*)(shm+LDS_WS)+wid*64;
  const bf16*ksrc=Kh+(long)lane*kpitch+wid*8;
  const bf16*vsrc=Vh+(long)(16*(wid&3)+(lane>>2))*vpitch+(wid>>2)*32+(lane&3)*8;
  const unsigned kdst=lds0+LDS_K+wid*1024, vdst=lds0+LDS_V+wid*1024;
  #define DMA_K(t,slot) glds16(ksrc+(long)TMAP(t)*KVBLK*kpitch,(unsigned)__builtin_amdgcn_readfirstlane(kdst+(slot)))
  #define DMA_V(t,slot) glds16(vsrc+(long)TMAP(t)*KVBLK*vpitch,(unsigned)__builtin_amdgcn_readfirstlane(vdst+(slot)))
  const int vb0=(int)(lds0+LDS_V)+((lane>>4)&1)*32+(lane&3)*8+(4*hi+((lane&15)>>2))*64;
  const char*Kbase=shm+LDS_K; bf16x8 kf[8];
  const lds_cptr shm3=(lds_cptr)shm; const lds_cptr kp0=shm3+LDS_K+hi*1024+r32*16; const lds_cptr vp0=shm3+LDS_V+((lane>>4)&1)*32+(lane&3)*8+(4*hi+((lane&15)>>2))*64;
  const int NT=(q0+QB)/KVBLK;
  DMA_K(0,0);DMA_V(0,0);DMA_K(1,SLOTB);
  bf16x8 qr[4];
  #pragma unroll
  for(int d0=0;d0<4;++d0)qr[d0]=*reinterpret_cast<const bf16x8*>(&Qw[(long)r32*qpitch+d0*16+hi*8]);
  float mhat=0.f,l_reg=0.f;f32x16 o[2];o[0]=f32x16{};o[1]=f32x16{};f32x16 negm=f32x16{}; if(USE_NEGM){asm volatile("":"+v"(negm));}
  #define NEGMC (USE_NEGM?negm:f32x16{})
  #define CMASK(P0,P1,t) do{ int D0_=qpos-64*TMAP(t)-4*hi; D0_=D0_<1083?D0_:1083; int bi_=D0_+(256-59); \
      if(MOBA){ if(!((selmask>>(TMAP(t)>>2))&1u))bi_=64; } const volatile lds_f32*tp_=Tl+bi_; \
      { float tb_[TBATCH]; _Pragma("unroll") for(int b0_=0;b0_<16;b0_+=TBATCH){ _Pragma("unroll") for(int r=0;r<TBATCH;++r)tb_[r]=tp_[59-(((b0_+r)&3)+8*((b0_+r)>>2))]; _Pragma("unroll") for(int r=0;r<TBATCH;++r)P0[b0_+r]=fadd_s(P0[b0_+r],tb_[r]); } \
        _Pragma("unroll") for(int b0_=0;b0_<16;b0_+=TBATCH){ _Pragma("unroll") for(int r=0;r<TBATCH;++r)tb_[r]=tp_[27-(((b0_+r)&3)+8*((b0_+r)>>2))]; _Pragma("unroll") for(int r=0;r<TBATCH;++r)P1[b0_+r]=fadd_s(P1[b0_+r],tb_[r]); } } }while(0)
  bool resc=false,mnz=false;
  #define START(P0,P1) do{ const float rm=rowmax(P0,P1); resc=false; \
    if(__any(rm>(float)THRL)){ const float dl=__builtin_fmaxf(rm,0.f); mhat=fadd_s(mhat,dl); mnz=true; \
      _Pragma("unroll") for(int r=0;r<16;++r){P0[r]=fsub_s(P0[r],dl);P1[r]=fsub_s(P1[r],dl);} \
      if(USE_NEGM){ _Pragma("unroll") for(int r=0;r<16;++r)negm[r]=-mhat; asm volatile("":"+v"(negm)); } } \
    _Pragma("unroll") for(int r=0;r<16;++r)P0[r]=__builtin_amdgcn_exp2f(P0[r]); }while(0)
  #define RESC() do{ if(resc){ asm volatile("s_waitcnt lgkmcnt(0)":::"memory"); \
      _Pragma("unroll") for(int d_=0;d_<2;++d_) _Pragma("unroll") for(int r=0;r<16;++r)o[d_][r]*=wsf[crow(r,hi)]; } }while(0)
  f32x16 pA0,pA1,pB0,pB1;
  int sl_prev=0,sl_cur=0,sl_next=SLOTB;
  #define ROT() do{sl_prev=sl_cur;sl_cur=sl_next;sl_next=(sl_next==(NSLOT-1)*SLOTB)?0:sl_next+SLOTB;}while(0)
  DMA_K(2,2*SLOTB);
  WAIT_BAR(3);
  qkt(pA0,pA1,Kbase,qr,negm,r32,hi);asm volatile("s_nop 15\n\ts_nop 7":"+v"(pA0),"+v"(pA1));CMASK(pA0,pA1,0);
  START(pA0,pA1);
  _Pragma("unroll") for(int r=0;r<16;++r)pA1[r]=__builtin_amdgcn_exp2f(pA1[r]);
  WAIT_BAR(0);
  DMA_K(3,0);DMA_V(1,SLOTB);
  ROT();
  kload8(kf,kp0+sl_cur);
  WAIT_BAR(2);
  s16x4 vlo[8],vhi[8]; u32x4 pw0,pw1,pw2,pw3;
  #define PKW(P,B) cvtpk_s(P[B],P[B+1])
  #define PAF(k) __builtin_bit_cast(bf16x8,pw##k)
  #define VFR(i) (bf16x8){vlo[i][0],vlo[i][1],vlo[i][2],vlo[i][3],vhi[i][0],vhi[i][1],vhi[i][2],vhi[i][3]}
  #define PIN(x) asm volatile("":"+v"(x))
  #define MX3(a,b,c) __builtin_fmaxf(__builtin_fmaxf((a),(b)),(c))
  #define GAPA(MF,A0,A1,A2,A3,W0,W1,PW) do{ MF; sacc+=A0; sacc+=A1; sacc+=A2; sacc+=A3; PIN(sacc); W0; W1; PIN(PW); SBAR(); }while(0)
  #define EX(v) __builtin_amdgcn_exp2f(v)
  #define GAPB(MF,X,B) do{ MF; X[B]=EX(X[B]); X[B+1]=EX(X[B+1]); X[B+2]=EX(X[B+2]); X[B+3]=EX(X[B+3]); PIN(X); SBAR(); }while(0)
  #define VRD(i) do{ vlo[i]=vtr(vp_+(((i)>>2)*4096+((i)&3)*1024)); vhi[i]=vtr(vp_+(((i)>>2)*4096+((i)&3)*1024+512)); }while(0)
  #define KRD(G,j) do{ if(G){ kload2(kf,kp0+sl_next,j); SBAR(); } }while(0)
  #define STEP(C0,C1,P0,P1,t,GK,GV,GL) do{ SBAR(); \
    const lds_cptr vp_=vp0+sl_prev; \
    VRD(0); SBAR(); float sacc=(P0[0]+P0[1]); \
    GAPA(C0=__builtin_amdgcn_mfma_f32_32x32x16_bf16(kf[0],qr[0],NEGMC,0,0,0), P0[2],P0[3],P0[4],P0[5],     pw0[0]=PKW(P0,0), pw0[1]=PKW(P0,2), pw0); \
    VRD(4); SBAR(); GAPA(C1=__builtin_amdgcn_mfma_f32_32x32x16_bf16(kf[1],qr[0],NEGMC,0,0,0), P0[6],P0[7],P0[8],P0[9],     pw0[2]=PKW(P0,4), pw0[3]=PKW(P0,6), pw0); \
    VRD(1); SBAR(); GAPA(C0=__builtin_amdgcn_mfma_f32_32x32x16_bf16(kf[2],qr[1],C0,0,0,0),   P0[10],P0[11],P0[12],P0[13], pw1[0]=PKW(P0,8), pw1[1]=PKW(P0,10), pw1); \
    VRD(5); SBAR(); GAPA(C1=__builtin_amdgcn_mfma_f32_32x32x16_bf16(kf[3],qr[1],C1,0,0,0),   P0[14],P0[15],P1[0],P1[1],   pw1[2]=PKW(P0,12),pw1[3]=PKW(P0,14), pw1); \
    VRD(2); SBAR(); GAPA(C0=__builtin_amdgcn_mfma_f32_32x32x16_bf16(kf[4],qr[2],C0,0,0,0),   P1[2],P1[3],P1[4],P1[5],     pw2[0]=PKW(P1,0), pw2[1]=PKW(P1,2), pw2); \
    VRD(6); SBAR(); GAPA(C1=__builtin_amdgcn_mfma_f32_32x32x16_bf16(kf[5],qr[2],C1,0,0,0),   P1[6],P1[7],P1[8],P1[9],     pw2[2]=PKW(P1,4), pw2[3]=PKW(P1,6), pw2); \
    VRD(3); SBAR(); GAPA(C0=__builtin_amdgcn_mfma_f32_32x32x16_bf16(kf[6],qr[3],C0,0,0,0),   P1[10],P1[11],P1[12],P1[13], pw3[0]=PKW(P1,8), pw3[1]=PKW(P1,10), pw3); \
    VRD(7); SBAR(); GAPA(C1=__builtin_amdgcn_mfma_f32_32x32x16_bf16(kf[7],qr[3],C1,0,0,0),   P1[14],P1[15],0.f,0.f,       pw3[2]=PKW(P1,12),pw3[3]=PKW(P1,14), pw3); \
    l_reg+=sacc; \
    if(GK){DMA_K((t)+3,sl_cur);} if(GV){DMA_V((t)+1,sl_next);} \
    { const float d_=__builtin_fmaxf(C0[15],C1[15]); asm volatile(""::"v"(d_)); asm volatile("":"+v"(C0),"+v"(C1)); } \
    if(!USE_NEGM&&mnz){ _Pragma("unroll") for(int r=0;r<16;++r){C0[r]=fsub_s(C0[r],mhat);C1[r]=fsub_s(C1[r],mhat);} } \
    CMASK(C0,C1,t); \
    { float a=MX3(C0[0],C0[1],C1[0]),b=MX3(C0[2],C0[3],C1[1]); a=MX3(a,C1[2],C1[3]); \
      _Pragma("unroll") for(int r=4;r<16;r+=4){a=MX3(a,C0[r],C0[r+1]);b=MX3(b,C0[r+2],C0[r+3]);a=MX3(a,C1[r],C1[r+1]);b=MX3(b,C1[r+2],C1[r+3]);} \
      float rm=__builtin_fmaxf(a,b); { auto rr=__builtin_amdgcn_permlane32_swap(__float_as_uint(rm),__float_as_uint(rm),false,false); rm=__builtin_fmaxf(__uint_as_float(rr[0]),__uint_as_float(rr[1])); } \
      resc=false; \
      if(__builtin_expect(__any(rm>(float)THRL),0)){ const float dl=__builtin_fmaxf(rm,0.f); mhat+=dl; mnz=true; \
        _Pragma("unroll") for(int r=0;r<16;++r){C0[r]=fsub_s(C0[r],dl);C1[r]=fsub_s(C1[r],dl);} \
        if(USE_NEGM){ _Pragma("unroll") for(int r=0;r<16;++r)negm[r]=-mhat; asm volatile("":"+v"(negm)); } \
        const float f=__builtin_amdgcn_exp2f(-dl); l_reg*=f; if(hi==0)wsf[r32]=f; resc=true; } } \
    SBAR(); \
    GAPB(o[0]=__builtin_amdgcn_mfma_f32_32x32x16_bf16(PAF(0),VFR(0),o[0],0,0,0), C0,0); \
    GAPB(o[1]=__builtin_amdgcn_mfma_f32_32x32x16_bf16(PAF(0),VFR(4),o[1],0,0,0), C0,4); \
    KRD(GL,0); GAPB(o[0]=__builtin_amdgcn_mfma_f32_32x32x16_bf16(PAF(1),VFR(1),o[0],0,0,0), C0,8); \
    KRD(GL,1); GAPB(o[1]=__builtin_amdgcn_mfma_f32_32x32x16_bf16(PAF(1),VFR(5),o[1],0,0,0), C0,12); \
    KRD(GL,2); GAPB(o[0]=__builtin_amdgcn_mfma_f32_32x32x16_bf16(PAF(2),VFR(2),o[0],0,0,0), C1,0); \
    KRD(GL,3); GAPB(o[1]=__builtin_amdgcn_mfma_f32_32x32x16_bf16(PAF(2),VFR(6),o[1],0,0,0), C1,4); \
    GAPB(o[0]=__builtin_amdgcn_mfma_f32_32x32x16_bf16(PAF(3),VFR(3),o[0],0,0,0), C1,8); \
    GAPB(o[1]=__builtin_amdgcn_mfma_f32_32x32x16_bf16(PAF(3),VFR(7),o[1],0,0,0), C1,12); \
    }while(0)
  int t=1;
  #undef CMASK
  #define CMASK(P0,P1,t) do{}while(0)
  const int t_tbl=MOBA?0:((q0>=853)?((q0-853)/64+1):0);
  for(;t+5<NT&&t+1<t_tbl;t+=2){
    STEP(pB0,pB1,pA0,pA1,t,true,true,true);     WAIT_BAR(2); RESC(); ROT();
    STEP(pA0,pA1,pB0,pB1,t+1,true,true,true);   WAIT_BAR(2); RESC(); ROT();
  }
  #undef CMASK
  #define CMASK(P0,P1,t) do{ int D0_=qpos-64*TMAP(t)-4*hi; D0_=D0_<1083?D0_:1083; int bi_=D0_+(256-59); \
      if(MOBA){ if(!((selmask>>(TMAP(t)>>2))&1u))bi_=64; } const volatile lds_f32*tp_=Tl+bi_; \
      { float tb_[TBATCH]; _Pragma("unroll") for(int b0_=0;b0_<16;b0_+=TBATCH){ _Pragma("unroll") for(int r=0;r<TBATCH;++r)tb_[r]=tp_[59-(((b0_+r)&3)+8*((b0_+r)>>2))]; _Pragma("unroll") for(int r=0;r<TBATCH;++r)P0[b0_+r]=fadd_s(P0[b0_+r],tb_[r]); } \
        _Pragma("unroll") for(int b0_=0;b0_<16;b0_+=TBATCH){ _Pragma("unroll") for(int r=0;r<TBATCH;++r)tb_[r]=tp_[27-(((b0_+r)&3)+8*((b0_+r)>>2))]; _Pragma("unroll") for(int r=0;r<TBATCH;++r)P1[b0_+r]=fadd_s(P1[b0_+r],tb_[r]); } } }while(0)
  #define ENDW(tt) do{ if((tt)+3<NT){WAIT_BAR(2);} else if((tt)+2<NT){WAIT_BAR(1);} else {WAIT_BAR(0);} }while(0)
  for(;t+1<NT;t+=2){
    STEP(pB0,pB1,pA0,pA1,t,(t+3<NT),(t+1<NT),(t+1<NT));       ENDW(t);   RESC(); ROT();
    STEP(pA0,pA1,pB0,pB1,t+1,(t+4<NT),(t+2<NT),(t+2<NT));     ENDW(t+1); RESC(); ROT();
  }
  STEP(pB0,pB1,pA0,pA1,NT-1,false,false,false); RESC();
  { float sacc=pB0[0]+pB0[1]; _Pragma("unroll") for(int r=2;r<16;++r)sacc+=pB0[r]; _Pragma("unroll") for(int r=0;r<16;++r)sacc+=pB1[r]; l_reg+=sacc;
    pw0=(u32x4){PKW(pB0,0),PKW(pB0,2),PKW(pB0,4),PKW(pB0,6)};pw1=(u32x4){PKW(pB0,8),PKW(pB0,10),PKW(pB0,12),PKW(pB0,14)};pw2=(u32x4){PKW(pB1,0),PKW(pB1,2),PKW(pB1,4),PKW(pB1,6)};pw3=(u32x4){PKW(pB1,8),PKW(pB1,10),PKW(pB1,12),PKW(pB1,14)};
    SBAR(); pv(o,vb0+sl_cur,PAF(0),PAF(1),PAF(2),PAF(3)); }
  #undef PKW
  #undef PAF
  #undef VFR
  #undef PIN
  #undef MX3
  #undef GAPA
  #undef GAPB
  #undef EX
  #undef VRD
  #undef KRD
  #undef STEP
  #undef ENDW
  {auto rr=__builtin_amdgcn_permlane32_swap(__float_as_uint(l_reg),__float_as_uint(l_reg),false,false);l_reg=__uint_as_float(rr[0])+__uint_as_float(rr[1]);}
  if(hi==0)wsf[32+r32]=l_reg;asm volatile("s_waitcnt lgkmcnt(0)":::"memory");
  float rli[16];
  #pragma unroll
  for(int r=0;r<16;++r)rli[r]=__builtin_amdgcn_rcpf(wsf[32+crow(r,hi)]);
  bf16*Ow=Ob+(long)(q0+wid*QBLK)*opitch;
  { bf16*stg=(bf16*)(shm+LDS_OST)+wid*2048;
    #pragma unroll
    for(int r=0;r<16;++r){const int orow=crow(r,hi);
      #pragma unroll
      for(int d0=0;d0<2;++d0)stg[orow*64+d0*32+r32]=__float2bfloat16(o[d0][r]*rli[r]);}
    asm volatile("s_waitcnt lgkmcnt(0)":::"memory");
    #pragma unroll
    for(int i=0;i<4;++i){const int row=i*8+(lane>>3),ch=lane&7; const u32x4 v=*(const u32x4*)(stg+row*64+ch*8); ATTN_STORE16(Ow+(long)row*opitch+ch*8,v);} }
  asm volatile("s_waitcnt lgkmcnt(0)\n\ts_barrier":::"memory");
  #undef DMA_K
  #undef DMA_V
  #undef TMAP
  #undef NEGMC
  #undef CMASK
  #undef START
  #undef RESC
  #undef ROT
}

constexpr int DV_K=0, DV_V=NSLOT*SLOTB, DV_VSLOT=2*SLOTB, DV_WS=DV_V+NSLOT*DV_VSLOT, DV_OST=0;
static_assert(DV_WS+NW*64*4<=LDS_TBL && NW*8192<=DV_WS, "dv unit LDS layout");
template<int THRL> __device__ __forceinline__ void attn_unit_dv(int tid,int qb,const bf16*Qb,int qpitch,const bf16*__restrict__ Kb,int kpitch,const bf16*__restrict__ Vb,int vpitch,bf16*Ob,int opitch,int hh,char*shm){
  const int lane=tid&63,r32=lane&31,hi=lane>>5; const int wid=__builtin_amdgcn_readfirstlane(tid>>6);
  const int q0=qb*QB;
  const bf16*Qw=Qb+(long)(q0+wid*QBLK)*qpitch;
  const int qpos=q0+wid*QBLK+r32;
  typedef __attribute__((address_space(3))) float lds_f32;
  const lds_cptr shm3=(lds_cptr)shm;
  const lds_f32*Tl=(const lds_f32*)(shm3+LDS_TBL)+hh*TBL_N;
  lds_f32*wsf=(lds_f32*)(shm3+DV_WS)+wid*64;
  const unsigned lds0=(unsigned)(uintptr_t)shm;
  const bf16*ksrc=Kb+(long)lane*kpitch+wid*8;
  const bf16*vsrc=Vb+(long)(16*(wid&3)+(lane>>2))*vpitch+(wid>>2)*32+(lane&3)*8;
  const unsigned kdst=lds0+DV_K+wid*1024, vdst=lds0+DV_V+wid*1024;
  #define DVK(t,slot) glds16(ksrc+(long)(t)*KVBLK*kpitch,(unsigned)__builtin_amdgcn_readfirstlane(kdst+(slot)))
  #define DVV(t,slot) do{ glds16(vsrc+(long)(t)*KVBLK*vpitch,(unsigned)__builtin_amdgcn_readfirstlane(vdst+2*(slot))); glds16(vsrc+(long)(t)*KVBLK*vpitch+64,(unsigned)__builtin_amdgcn_readfirstlane(vdst+2*(slot)+8192)); }while(0)
  const lds_cptr kp0=shm3+DV_K+hi*1024+r32*16; const lds_cptr vp0=shm3+DV_V+((lane>>4)&1)*32+(lane&3)*8+(4*hi+((lane&15)>>2))*64;
  const int NT=(q0+QB)/KVBLK;
  DVK(0,0);DVV(0,0);DVK(1,SLOTB);
  bf16x8 qr[4];
  #pragma unroll
  for(int d0=0;d0<4;++d0)qr[d0]=*reinterpret_cast<const bf16x8*>(&Qw[(long)r32*qpitch+d0*16+hi*8]);
  float mhat=0.f,l_reg=0.f; f32x16 o[4]; o[0]=f32x16{};o[1]=f32x16{};o[2]=f32x16{};o[3]=f32x16{};
  const int t_tbl=(q0>=853)?((q0-853)/64+1):0;
  #define DV_CMASK(P0,P1,t) do{ int D0_=qpos-64*(t)-4*hi; D0_=D0_<1083?D0_:1083; const volatile lds_f32*tp_=Tl+(D0_+(256-59)); \
      { float tb_[8]; _Pragma("unroll") for(int b0_=0;b0_<16;b0_+=8){ _Pragma("unroll") for(int r=0;r<8;++r)tb_[r]=tp_[59-(((b0_+r)&3)+8*((b0_+r)>>2))]; _Pragma("unroll") for(int r=0;r<8;++r)P0[b0_+r]=fadd_s(P0[b0_+r],tb_[r]); } \
        _Pragma("unroll") for(int b0_=0;b0_<16;b0_+=8){ _Pragma("unroll") for(int r=0;r<8;++r)tb_[r]=tp_[27-(((b0_+r)&3)+8*((b0_+r)>>2))]; _Pragma("unroll") for(int r=0;r<8;++r)P1[b0_+r]=fadd_s(P1[b0_+r],tb_[r]); } } }while(0)
  #define DV_MX3(a,b,c) __builtin_fmaxf(__builtin_fmaxf((a),(b)),(c))
  #define DV_ROWMAX(rm,C0,C1) do{ float a=DV_MX3(C0[0],C0[1],C1[0]),b=DV_MX3(C0[2],C0[3],C1[1]); a=DV_MX3(a,C1[2],C1[3]); \
      _Pragma("unroll") for(int r=4;r<16;r+=4){a=DV_MX3(a,C0[r],C0[r+1]);b=DV_MX3(b,C0[r+2],C0[r+3]);a=DV_MX3(a,C1[r],C1[r+1]);b=DV_MX3(b,C1[r+2],C1[r+3]);} \
      rm=__builtin_fmaxf(a,b); { auto rr=__builtin_amdgcn_permlane32_swap(__float_as_uint(rm),__float_as_uint(rm),false,false); rm=__builtin_fmaxf(__uint_as_float(rr[0]),__uint_as_float(rr[1])); } }while(0)
  u32x4 pw0,pw1,pw2,pw3;
  #define DV_PKW(P,B) cvtpk_s(P[B],P[B+1])
  #define DV_SUM_PACK(C0,C1) do{ float sa_=fadd_s(C0[0],C0[1]),sb_=fadd_s(C1[0],C1[1]); _Pragma("unroll") for(int r=2;r<16;++r){ sa_=fadd_s(sa_,C0[r]); sb_=fadd_s(sb_,C1[r]); } l_reg+=fadd_s(sa_,sb_); \
      pw0=(u32x4){DV_PKW(C0,0),DV_PKW(C0,2),DV_PKW(C0,4),DV_PKW(C0,6)};pw1=(u32x4){DV_PKW(C0,8),DV_PKW(C0,10),DV_PKW(C0,12),DV_PKW(C0,14)}; \
      pw2=(u32x4){DV_PKW(C1,0),DV_PKW(C1,2),DV_PKW(C1,4),DV_PKW(C1,6)};pw3=(u32x4){DV_PKW(C1,8),DV_PKW(C1,10),DV_PKW(C1,12),DV_PKW(C1,14)}; }while(0)
  #define DV_PAF(k) __builtin_bit_cast(bf16x8,pw##k)
  #define DV_VFR(i) (bf16x8){vlo[i][0],vlo[i][1],vlo[i][2],vlo[i][3],vhi[i][0],vhi[i][1],vhi[i][2],vhi[i][3]}
  #define DV_VRD(n) do{ vlo[(n)&3]=vtr(vp_+((2*((n)>>3)+((n)&1))*4096+(((n)&7)>>1)*1024)); vhi[(n)&3]=vtr(vp_+((2*((n)>>3)+((n)&1))*4096+(((n)&7)>>1)*1024+512)); }while(0)
  #define DV_PIN(x) asm volatile("":"+v"(x))
  #define DV_KRD(j) do{ if(gv){ kload2(kf,kp0+sl_next,j); } }while(0)
  #define DV_EX(v) __builtin_amdgcn_exp2f(v)
  #define DV_GAP(n,X,B,RD) do{ o[2*((n)>>3)+((n)&1)]=__builtin_amdgcn_mfma_f32_32x32x16_bf16((((n)&7)>>1)==0?DV_PAF(0):((((n)&7)>>1)==1?DV_PAF(1):((((n)&7)>>1)==2?DV_PAF(2):DV_PAF(3))),DV_VFR((n)&3),o[2*((n)>>3)+((n)&1)],0,0,0); \
      X[B]=DV_EX(X[B]); X[B+1]=DV_EX(X[B+1]); DV_PIN(X); RD; SBAR(); }while(0)
  #define DV_SOFT1(C0,C1,t) do{ { const float d_=__builtin_fmaxf(C0[15],C1[15]); asm volatile(""::"v"(d_)); asm volatile("":"+v"(C0),"+v"(C1)); }     \
      if(mnz){ _Pragma("unroll") for(int r=0;r<16;++r){C0[r]=fsub_s(C0[r],mhat);C1[r]=fsub_s(C1[r],mhat);} } \
      if((t)>=t_tbl) DV_CMASK(C0,C1,t); \
      { float rm; DV_ROWMAX(rm,C0,C1); resc=false; \
        if(__builtin_expect(__any(rm>(float)THRL),0)){ const float dl=__builtin_fmaxf(rm,0.f); mhat+=dl; \
          _Pragma("unroll") for(int r=0;r<16;++r){C0[r]=fsub_s(C0[r],dl);C1[r]=fsub_s(C1[r],dl);} \
          const float f=__builtin_amdgcn_exp2f(-dl); l_reg*=f; if(hi==0)wsf[r32]=f; resc=true; mnz=true; } } }while(0)
  #define DV_RESC() do{ if(resc){ asm volatile("s_waitcnt lgkmcnt(0)":::"memory"); \
      _Pragma("unroll") for(int r=0;r<16;++r){ const float fr_=wsf[crow(r,hi)]; o[0][r]*=fr_;o[1][r]*=fr_;o[2][r]*=fr_;o[3][r]*=fr_; } asm volatile("s_waitcnt lgkmcnt(0)":::"memory"); } }while(0)
  int sl_prev=0,sl_cur=0,sl_next=SLOTB;
  #define DV_ROT() do{sl_prev=sl_cur;sl_cur=sl_next;sl_next=(sl_next==(NSLOT-1)*SLOTB)?0:sl_next+SLOTB;}while(0)
  DVK(2,2*SLOTB);
  WAIT_BAR(3);
  f32x16 pA0,pA1,pB0,pB1; bf16x8 kf[8]; s16x4 vlo[4],vhi[4]; bool resc=false,mnz=false;
  { const f32x16 z=f32x16{}; qkt(pA0,pA1,shm+DV_K,qr,z,r32,hi);
    DV_SOFT1(pA0,pA1,0);
    _Pragma("unroll") for(int r=0;r<16;++r){pA0[r]=DV_EX(pA0[r]);pA1[r]=DV_EX(pA1[r]);} }
  WAIT_BAR(0);
  DVK(3,0);DVV(1,SLOTB);
  DV_ROT();
  kload8(kf,kp0+sl_cur);
  WAIT_BAR(3);
  #define DV_GAPA(MF,A0,A1,A2,A3,W0,W1,PW) do{ MF; sacc+=A0; sacc+=A1; sacc+=A2; sacc+=A3; DV_PIN(sacc); W0; W1; DV_PIN(PW); SBAR(); }while(0)
  #define DV_Z f32x16{}
  #define DV_STEP(C0,C1,P0,P1,t) do{ const bool gk=((t)+3<NT), gv=((t)+1<NT); const lds_cptr vp_=vp0+2*sl_prev; SBAR(); \
    float sacc=(P0[0]+P0[1]); \
    DV_VRD(0); SBAR(); DV_GAPA(C0=__builtin_amdgcn_mfma_f32_32x32x16_bf16(kf[0],qr[0],DV_Z,0,0,0), P0[2],P0[3],P0[4],P0[5],     pw0[0]=DV_PKW(P0,0), pw0[1]=DV_PKW(P0,2), pw0); \
    DV_VRD(1); SBAR(); DV_GAPA(C1=__builtin_amdgcn_mfma_f32_32x32x16_bf16(kf[1],qr[0],DV_Z,0,0,0), P0[6],P0[7],P0[8],P0[9],     pw0[2]=DV_PKW(P0,4), pw0[3]=DV_PKW(P0,6), pw0); \
    DV_VRD(2); SBAR(); DV_GAPA(C0=__builtin_amdgcn_mfma_f32_32x32x16_bf16(kf[2],qr[1],C0,0,0,0),   P0[10],P0[11],P0[12],P0[13], pw1[0]=DV_PKW(P0,8), pw1[1]=DV_PKW(P0,10), pw1); \
    DV_VRD(3); SBAR(); DV_GAPA(C1=__builtin_amdgcn_mfma_f32_32x32x16_bf16(kf[3],qr[1],C1,0,0,0),   P0[14],P0[15],P1[0],P1[1],   pw1[2]=DV_PKW(P0,12),pw1[3]=DV_PKW(P0,14), pw1); \
    DV_GAPA(C0=__builtin_amdgcn_mfma_f32_32x32x16_bf16(kf[4],qr[2],C0,0,0,0),   P1[2],P1[3],P1[4],P1[5],     pw2[0]=DV_PKW(P1,0), pw2[1]=DV_PKW(P1,2), pw2); \
    DV_GAPA(C1=__builtin_amdgcn_mfma_f32_32x32x16_bf16(kf[5],qr[2],C1,0,0,0),   P1[6],P1[7],P1[8],P1[9],     pw2[2]=DV_PKW(P1,4), pw2[3]=DV_PKW(P1,6), pw2); \
    DV_GAPA(C0=__builtin_amdgcn_mfma_f32_32x32x16_bf16(kf[6],qr[3],C0,0,0,0),   P1[10],P1[11],P1[12],P1[13], pw3[0]=DV_PKW(P1,8), pw3[1]=DV_PKW(P1,10), pw3); \
    DV_GAPA(C1=__builtin_amdgcn_mfma_f32_32x32x16_bf16(kf[7],qr[3],C1,0,0,0),   P1[14],P1[15],0.f,0.f,       pw3[2]=DV_PKW(P1,12),pw3[3]=DV_PKW(P1,14), pw3); \
    l_reg+=sacc; \
    if(gk){DVK((t)+3,sl_cur);} if(gv){DVV((t)+1,sl_next);} \
    DV_SOFT1(C0,C1,t); \
    SBAR(); \
    DV_GAP(0,C0,0,  DV_VRD(4));   DV_GAP(1,C0,2,  DV_VRD(5));   DV_GAP(2,C0,4,  DV_VRD(6));   DV_GAP(3,C0,6,  DV_VRD(7)); \
    DV_GAP(4,C0,8,  DV_VRD(8));   DV_GAP(5,C0,10, DV_VRD(9));   DV_GAP(6,C0,12, DV_VRD(10));  DV_GAP(7,C0,14, DV_VRD(11)); \
    DV_GAP(8,C1,0,  DV_VRD(12); DV_KRD(0));  DV_GAP(9,C1,2,  DV_VRD(13); DV_KRD(1));  DV_GAP(10,C1,4, DV_VRD(14); DV_KRD(2));  DV_GAP(11,C1,6, DV_VRD(15); DV_KRD(3)); \
    DV_GAP(12,C1,8, (void)0);     DV_GAP(13,C1,10,(void)0);     DV_GAP(14,C1,12,(void)0);     DV_GAP(15,C1,14,(void)0); \
    DV_RESC(); \
    if((t)+1<NT){ if((t)+3<NT){WAIT_BAR(3);} else if((t)+2<NT){WAIT_BAR(2);} else {WAIT_BAR(0);} DV_ROT(); } }while(0)
  { int t=1;
    for(;t+1<NT;t+=2){ DV_STEP(pB0,pB1,pA0,pA1,t); DV_STEP(pA0,pA1,pB0,pB1,t+1); }
    DV_STEP(pB0,pB1,pA0,pA1,t); }
  #undef DV_GAPA
  #undef DV_Z
  #undef DV_STEP
  DV_SUM_PACK(pB0,pB1);
  { const lds_cptr vp_=vp0+2*sl_cur;
    _Pragma("unroll") for(int n0=0;n0<16;n0+=4){
      _Pragma("unroll") for(int q=0;q<4;++q) DV_VRD(n0+q);
      _Pragma("unroll") for(int q=0;q<4;++q){ const int n=n0+q, kg=(n&7)>>1; const bf16x8 pa_=kg==0?DV_PAF(0):(kg==1?DV_PAF(1):(kg==2?DV_PAF(2):DV_PAF(3)));
        o[2*(n>>3)+(n&1)]=__builtin_amdgcn_mfma_f32_32x32x16_bf16(pa_,DV_VFR(n&3),o[2*(n>>3)+(n&1)],0,0,0); } } }
  asm volatile("s_waitcnt lgkmcnt(0)\n\ts_barrier":::"memory");
  {auto rr=__builtin_amdgcn_permlane32_swap(__float_as_uint(l_reg),__float_as_uint(l_reg),false,false);l_reg=__uint_as_float(rr[0])+__uint_as_float(rr[1]);}
  if(hi==0)wsf[32+r32]=l_reg;asm volatile("s_waitcnt lgkmcnt(0)":::"memory");
  float rli[16];
  #pragma unroll
  for(int r=0;r<16;++r)rli[r]=__builtin_amdgcn_rcpf(wsf[32+crow(r,hi)]);
  bf16*Ow=Ob+(long)(q0+wid*QBLK)*opitch;
  { bf16*stg=(bf16*)(shm+DV_OST)+wid*4096;
    #pragma unroll
    for(int r=0;r<16;++r){const int orow=crow(r,hi);
      #pragma unroll
      for(int d0=0;d0<4;++d0)stg[orow*128+d0*32+r32]=__float2bfloat16(o[d0][r]*rli[r]);}
    asm volatile("s_waitcnt lgkmcnt(0)":::"memory");
    #pragma unroll
    for(int i=0;i<8;++i){const int row=i*4+(lane>>4),ch=lane&15; const u32x4 v=*(const u32x4*)(stg+row*128+ch*8); ATTN_STORE16(Ow+(long)row*opitch+ch*8,v);} }
  asm volatile("s_waitcnt lgkmcnt(0)\n\ts_barrier":::"memory");
  #undef DVK
  #undef DVV
  #undef DV_CMASK
  #undef DV_MX3
  #undef DV_ROWMAX
  #undef DV_PKW
  #undef DV_SUM_PACK
  #undef DV_VFR
  #undef DV_VRD
  #undef DV_PIN
  #undef DV_EX
  #undef DV_GAP
  #undef DV_KRD
  #undef DV_SOFT1
  #undef DV_RESC
  #undef DV_PAF
  #undef DV_ROT
}
constexpr int ATTN_LDS_BYTES=LDS_BYTES;
#undef SBAR
#undef WAIT_BAR
}
#define GAS __attribute__((address_space(1)))
#define LAS __attribute__((address_space(3)))
typedef unsigned short bf16;
typedef unsigned v4u __attribute__((ext_vector_type(4)));
typedef float f32x4 __attribute__((ext_vector_type(4)));
typedef short bf16x8 __attribute__((ext_vector_type(8)));
typedef GAS unsigned gu32;
typedef GAS unsigned long long gu64;
#define RLX_AGENT __ATOMIC_RELAXED, __HIP_MEMORY_SCOPE_AGENT
#define LDS_WAIT() asm volatile("s_waitcnt lgkmcnt(0)" ::: "memory")
#define VM_WAIT() asm volatile("s_waitcnt vmcnt(0)" ::: "memory")
__device__ __forceinline__ unsigned long long rt() { return __builtin_amdgcn_s_memrealtime(); }
__device__ __forceinline__ unsigned f2bf(float f) { unsigned u = __builtin_bit_cast(unsigned, f); return (u + 0x7fffu + ((u >> 16) & 1u)) >> 16; }
__device__ __forceinline__ unsigned pk2(float lo, float hi) { return f2bf(lo) | (f2bf(hi) << 16); }

#define XB_TMO      128
#define XB_XCNT(j)  (256  + 64 * (j))
#define XB_XSUB(j)  (1280 + 64 * (j))
#define XB_XGEN(j)  (2304 + 64 * (j))
#define XB_TOP      3328
#define XB_TOPGEN   3392
#define XB_LSUB(j)  (3456 + 64 * (j))
#define XB_LGEN(j)  (4480 + 64 * (j))
#define XB_CSUB(j)  (5504 + 64 * (j))
#define XB_CDONE    6528
#define XCD_BAR_WORDS 6592
#define XB_SPIN_CAP (1u << 25)

__device__ __forceinline__ unsigned xb_ld(unsigned* p)              { return __hip_atomic_load(p, __ATOMIC_RELAXED, __HIP_MEMORY_SCOPE_AGENT); }
__device__ __forceinline__ unsigned xb_add(unsigned* p, unsigned v) { return __hip_atomic_fetch_add(p, v, __ATOMIC_RELAXED, __HIP_MEMORY_SCOPE_AGENT); }
__device__ __forceinline__ unsigned xb_xcc_id() { return (unsigned)__builtin_amdgcn_s_getreg((3 << 11) | 20) & 0xFu; }
#define XB_SPIN(cond, bar) do { unsigned _sp = 0; while (cond) { __builtin_amdgcn_s_sleep(1); \
    if ((++_sp & 255u) == 0u) { if (xb_ld(&(bar)[XB_TMO])) break; if (_sp > XB_SPIN_CAP) { atomicAdd(&(bar)[XB_TMO], 1u); break; } } } } while (0)

struct XcdBarrier {
    unsigned* bar; unsigned x;
    volatile LAS unsigned* st;
};

__device__ __forceinline__ XcdBarrier xcd_barrier_post(unsigned* bar, volatile LAS unsigned* st) {
    XcdBarrier b; b.bar = bar; b.x = xb_xcc_id(); b.st = st;
    if (threadIdx.x == 0) st[2] = xb_add(&bar[XB_XCNT(b.x)], 1u);
    return b;
}
__device__ __forceinline__ void xcd_barrier_complete(unsigned* bar, unsigned x, unsigned& nloc, unsigned& nx) {
    const unsigned G = gridDim.x * gridDim.y * gridDim.z;
    unsigned sum, cnt, mine, sp = 0u;
    for (;;) {
        sum = 0u; cnt = 0u; mine = 0u;
#pragma nounroll
        for (unsigned j = 0; j < 16; ++j) { const unsigned c = xb_ld(&bar[XB_XCNT(j)]); sum += c; cnt += (c > 0u) ? 1u : 0u; mine = (j == x) ? c : mine; }
        if (sum == G) break;
        __builtin_amdgcn_s_sleep(1);
        if ((++sp & 255u) == 0u) { if (xb_ld(&bar[XB_TMO])) break; if (sp > XB_SPIN_CAP) { atomicAdd(&bar[XB_TMO], 1u); break; } }
    }
    nloc = mine > 0u ? mine : 1u; nx = cnt > 0u ? cnt : 1u;
}

__device__ __forceinline__ void xcd_barrier(const XcdBarrier& b) {
    asm volatile("s_waitcnt vmcnt(0)" ::: "memory");
    __syncthreads();
    if (threadIdx.x == 0) {
        unsigned* bar; { GAS unsigned* bl_ = (GAS unsigned*)b.bar; asm volatile("" : "+s"(bl_)); bar = (unsigned*)bl_; } unsigned bx_ = b.x; asm volatile("" : "+s"(bx_));
        __builtin_amdgcn_s_waitcnt(0);
        unsigned nloc = b.st[0], nx = b.st[1];
        if (nloc == 0u) { xcd_barrier_complete(bar, bx_, nloc, nx); b.st[0] = nloc; b.st[1] = nx; }
        const unsigned old = xb_add(&bar[XB_XSUB(bx_)], 1u);
        const unsigned gen = old / nloc;
        if (old + 1u == (gen + 1u) * nloc) {
            __builtin_amdgcn_fence(__ATOMIC_RELEASE, "agent");
            asm volatile("s_waitcnt vmcnt(0)" ::: "memory");
            const unsigned og = xb_add(&bar[XB_TOP], 1u);
            const unsigned tg = og / nx;
            if (og + 1u == (tg + 1u) * nx) xb_add(&bar[XB_TOPGEN], 1u);
            else XB_SPIN(xb_ld(&bar[XB_TOPGEN]) == tg, bar);
            __builtin_amdgcn_fence(__ATOMIC_ACQUIRE, "agent");
            xb_add(&bar[XB_XGEN(bx_)], 1u);
            asm volatile("s_waitcnt vmcnt(0)" ::: "memory");
        } else {
            XB_SPIN(xb_ld(&bar[XB_XGEN(bx_)]) == gen, bar);
            __builtin_amdgcn_fence(__ATOMIC_ACQUIRE, "agent");
            asm volatile("s_waitcnt vmcnt(0)" ::: "memory");
        }
    }
    __syncthreads();
}

__device__ __forceinline__ void xcd_census_regular(const XcdBarrier& b) {
    if (threadIdx.x == 0) { bool reg = (gridDim.x == 256u);
#pragma nounroll
        for (unsigned j = 0; j < 16; ++j) { const unsigned c = xb_ld(&b.bar[XB_XCNT(j)]); if (c != (j < 8u ? 32u : 0u)) reg = false; }
        b.st[3] = reg ? 1u : 0u; }
    __syncthreads();
}
__device__ __forceinline__ void xcd_local_barrier(const XcdBarrier& b) {
    asm volatile("s_waitcnt vmcnt(0)" ::: "memory");
    __syncthreads();
    if (threadIdx.x == 0) {
        unsigned* bar; { GAS unsigned* bl_ = (GAS unsigned*)b.bar; asm volatile("" : "+s"(bl_)); bar = (unsigned*)bl_; } unsigned bx_ = b.x; asm volatile("" : "+s"(bx_));
        __builtin_amdgcn_s_waitcnt(0);
        const unsigned nloc = b.st[0];
        const unsigned old = xb_add(&bar[XB_LSUB(bx_)], 1u);
        const unsigned gen = old / nloc;
        if (old + 1u == (gen + 1u) * nloc) xb_add(&bar[XB_LGEN(bx_)], 1u);
        else XB_SPIN(xb_ld(&bar[XB_LGEN(bx_)]) == gen, bar);
        __builtin_amdgcn_fence(__ATOMIC_ACQUIRE, "agent");
        asm volatile("s_waitcnt vmcnt(0)" ::: "memory");
    }
    __syncthreads();
}

__device__ __forceinline__ void xcd_signal_done(const XcdBarrier& b) {
    asm volatile("s_waitcnt vmcnt(0)" ::: "memory");
    __syncthreads();
    if (threadIdx.x == 0) {
        unsigned* bar; { GAS unsigned* bl_ = (GAS unsigned*)b.bar; asm volatile("" : "+s"(bl_)); bar = (unsigned*)bl_; } unsigned bx_ = b.x; asm volatile("" : "+s"(bx_));
        __builtin_amdgcn_s_waitcnt(0);
        const unsigned nloc = b.st[0];
        const unsigned old = xb_add(&bar[XB_CSUB(bx_)], 1u);
        const unsigned gen = old / nloc;
        if (old + 1u == (gen + 1u) * nloc) { __builtin_amdgcn_fence(__ATOMIC_RELEASE, "agent"); asm volatile("s_waitcnt vmcnt(0)" ::: "memory"); xb_add(&bar[XB_CDONE], 1u); }
    }
    __syncthreads();
}
__device__ __forceinline__ void xcd_wait_done(const XcdBarrier& b, unsigned nsignals) {
    if (threadIdx.x == 0) {
        unsigned* bar; { GAS unsigned* bl_ = (GAS unsigned*)b.bar; asm volatile("" : "+s"(bl_)); bar = (unsigned*)bl_; }
        const unsigned target = b.st[1] * nsignals;
        XB_SPIN(xb_ld(&bar[XB_CDONE]) < target, bar);
        __builtin_amdgcn_fence(__ATOMIC_ACQUIRE, "agent");
        asm volatile("s_waitcnt vmcnt(0)" ::: "memory");
    }
    __syncthreads();
}
constexpr int NB = 4, SEQ = 4096, DM = 1024, M = NB * SEQ, NL = 4;
constexpr int NIN = 3328;
constexpr int NWAVES = 8;
#ifndef PG8_SP2
#define PG8_SP2 true
#endif
constexpr float LOG2E = 1.4426950408889634f;
constexpr float C2 = 0.125f * LOG2E;
constexpr int MOE_ROWS = 40960;
constexpr size_t MiB = 1u << 20;
constexpr size_t WS_CTL = 0, CTL_ZERO_BYTES = 1 * MiB;
constexpr size_t WS_MOD = 1 * MiB;
constexpr size_t WS_TB = WS_MOD + 512 * 1024;
constexpr size_t WS_LAM = WS_TB + 64 * 1024;
constexpr size_t WS_KMEAN = WS_LAM + 4096;
constexpr size_t WS_WIN = 2 * MiB;
constexpr size_t WS_WOUT = 28 * MiB;
constexpr size_t WS_W13 = 36 * MiB;
constexpr size_t WS_W2 = 292 * MiB;
constexpr size_t WS_HB = 420 * MiB;
constexpr size_t WS_XS = 452 * MiB, WS_HS = 532 * MiB, WS_YS = 572 * MiB;
constexpr size_t WS_SMALL = 652 * MiB;
constexpr size_t WS_QD = 656 * MiB, WS_KD = 672 * MiB, WS_VD = 688 * MiB, WS_QM = 704 * MiB, WS_KM = 712 * MiB, WS_VM = 720 * MiB;
constexpr size_t WS_PR = 728 * MiB;
constexpr size_t WS_MIX = 784 * MiB;
constexpr size_t WS_OD = 816 * MiB;
constexpr size_t WS_RW = 848 * MiB;
constexpr size_t WS_END = 960 * MiB;
constexpr int CW_BAR = 4096;
constexpr int CW_CNT = 16384;
constexpr int CW_CUR = 16384 + 1024;
constexpr int RING_BYTES = 131072, LDSCTL_OFF = RING_BYTES, MISC_OFF = LDSCTL_OFF + 320, TAB_OFF = LDSCTL_OFF + 1024;
constexpr int LDS_BYTES = 147456;
static_assert(WS_QD == pg8::EPI_WS_QD && WS_KD == pg8::EPI_WS_KD && WS_VD == pg8::EPI_WS_VD && WS_QM == pg8::EPI_WS_QM && WS_KM == pg8::EPI_WS_KM && WS_VM == pg8::EPI_WS_VM && WS_PR == pg8::EPI_WS_PR, "epilogue workspace map");
__device__ __forceinline__ float rl63(float v) { return __uint_as_float(__builtin_amdgcn_readlane(__float_as_uint(v), 63)); }
template <int CTRL, int ROWMASK> __device__ __forceinline__ float dpp_f(float oldv, float v) { return __int_as_float(__builtin_amdgcn_update_dpp(__float_as_int(oldv), __float_as_int(v), CTRL, ROWMASK, 0xf, false)); }
__device__ __forceinline__ float wave_sum(float v) {
    v += dpp_f<0xB1, 0xf>(0.f, v);
    v += dpp_f<0x4E, 0xf>(0.f, v);
    v += dpp_f<0x141, 0xf>(0.f, v);
    v += dpp_f<0x140, 0xf>(0.f, v);
    v += dpp_f<0x142, 0xa>(0.f, v);
    v += dpp_f<0x143, 0xc>(0.f, v);
    return rl63(v);
}
__device__ __forceinline__ float wave_max(float v) {
    v = fmaxf(v, dpp_f<0xB1, 0xf>(v, v)); v = fmaxf(v, dpp_f<0x4E, 0xf>(v, v)); v = fmaxf(v, dpp_f<0x141, 0xf>(v, v)); v = fmaxf(v, dpp_f<0x140, 0xf>(v, v));
    v = fmaxf(v, dpp_f<0x142, 0xa>(v, v)); v = fmaxf(v, dpp_f<0x143, 0xc>(v, v));
    return rl63(v);
}
__device__ __forceinline__ float bf_lo(unsigned u) { return __uint_as_float(u << 16); }
__device__ __forceinline__ float bf_hi(unsigned u) { return __uint_as_float(u & 0xffff0000u); }
__device__ __forceinline__ float bf2f(bf16 h) { return __uint_as_float((unsigned)h << 16); }
__device__ __forceinline__ float rl(float v, int i) { return __uint_as_float(__builtin_amdgcn_readlane(__float_as_uint(v), i)); }
__device__ __forceinline__ float sigmoidf_(float x) { return 1.0f / (1.0f + __expf(-x)); }

struct Frame {
    LAS unsigned char* lds; volatile LAS unsigned* MISC; gu32* ctl;
    int tid, lane, wave, vcu, G, gw, NGW;
    int xl, cf;
    float* out; unsigned char* ws;
};
__device__ __forceinline__ unsigned char* launder_ptr(unsigned char* p) {
    GAS unsigned char* g = (GAS unsigned char*)p; asm volatile("" : "+s"(g)); return (unsigned char*)g; }
#define GIN(i) ((const float*)(const GAS float*)A.in[i])
#define WSP(T, off) ((T*)(launder_ptr(F.ws) + (off)))

template <class RowMap>
__device__ __forceinline__ void tr_item(const float* W, int N, int K, bf16* WT, LAS float* scr, int k0, int n0, int lane, RowMap rm) {
#pragma unroll
    for (int i = 0; i < 8; ++i) { const int kk = 8 * i + (lane >> 3), c4 = lane & 7; const f32x4 x = *(const GAS f32x4*)(W + (size_t)(k0 + kk) * N + n0 + 4 * c4);
        LAS float* d = scr + kk * 33 + 4 * c4; d[0] = x.x; d[1] = x.y; d[2] = x.z; d[3] = x.w; }
    LDS_WAIT(); asm volatile("" ::: "memory");
    const int c = lane & 7;
#pragma unroll
    for (int j = 0; j < 4; ++j) { const int n = (lane >> 3) + 8 * j; const LAS float* s = scr + (8 * c) * 33 + n;
        v4u o; o.x = pk2(s[0 * 33], s[1 * 33]); o.y = pk2(s[2 * 33], s[3 * 33]); o.z = pk2(s[4 * 33], s[5 * 33]); o.w = pk2(s[6 * 33], s[7 * 33]);
        *(GAS v4u*)(WT + (size_t)rm(n0 + n) * K + k0 + 8 * c) = o; }
    LDS_WAIT(); asm volatile("" ::: "memory");
}
__device__ __forceinline__ int inproj_row(int n) {
    const int L = n < 896 ? 2304 + n : n - 896;
    const int l = L & 255;
    return (L & ~255) | (((l >> 5) & 1) << 7) | ((l >> 6) << 5) | (l & 31);
}
__device__ __forceinline__ int t5_bucket(int n) {
    if (n < 16) return n;
    const float x = (8.0f * __log2f((float)n) - 32.0f) * (1.0f / 3.0f) + 1e-4f;
    int b = 16 + (int)x; return b > 31 ? 31 : b;
}
struct TrDesc { const float* src; bf16* dst; int N, K, n0, kind; };
__device__ __forceinline__ TrDesc moe_tr_desc(KArgs& A, unsigned char* ws, int l, int r) {
    constexpr int I_W1 = 16 * 16, I_W2 = 8 * 32, N_W1 = 32 * I_W1;
    TrDesc d;
    if (r < 2 * N_W1) { const int which = r / N_W1; r %= N_W1; const int le = l * 32 + r / I_W1, q = r % I_W1, kb = q / 16, nb = q % 16;
        d.N = 512; d.K = 1024; d.n0 = 32 * nb; d.kind = which;
        d.src = (const float*)(const GAS float*)A.in[which ? 31 : 30] + (size_t)le * 1024 * 512 + (size_t)(64 * kb) * 512 + 32 * nb; d.dst = (bf16*)(ws + WS_W13) + (size_t)le * 1024 * 1024 + 64 * kb; }
    else { r -= 2 * N_W1; const int le = l * 32 + r / I_W2, q = r % I_W2, kb = q / 32, nb = q % 32;
        d.N = 1024; d.K = 512; d.n0 = 32 * nb; d.kind = 2;
        d.src = (const float*)(const GAS float*)A.in[32] + (size_t)le * 512 * 1024 + (size_t)(64 * kb) * 1024 + 32 * nb; d.dst = (bf16*)(ws + WS_W2) + (size_t)le * 1024 * 512 + 64 * kb; }
    return d;
}
__device__ __forceinline__ void moe_tr_load(const TrDesc& d, int lane, f32x4 (&x)[8]) {
#pragma unroll
    for (int i = 0; i < 8; ++i) x[i] = __builtin_nontemporal_load((const GAS f32x4*)(d.src + (size_t)(8 * i + (lane >> 3)) * d.N + 4 * (lane & 7)));
}
__device__ __forceinline__ void moe_tr_store(const TrDesc& d, int lane, const f32x4 (&x)[8], LAS float* scr) {
#pragma unroll
    for (int i = 0; i < 8; ++i) { const int kk = 8 * i + (lane >> 3), c4 = lane & 7; LAS float* p = scr + kk * 33 + 4 * c4; p[0] = x[i].x; p[1] = x[i].y; p[2] = x[i].z; p[3] = x[i].w; }
    LDS_WAIT(); asm volatile("" ::: "memory");
    const int c = lane & 7;
#pragma unroll
    for (int j = 0; j < 4; ++j) { const int n = (lane >> 3) + 8 * j; const LAS float* s = scr + (8 * c) * 33 + n;
        v4u o; o.x = pk2(s[0 * 33], s[1 * 33]); o.y = pk2(s[2 * 33], s[3 * 33]); o.z = pk2(s[4 * 33], s[5 * 33]); o.w = pk2(s[6 * 33], s[7 * 33]);
        const int nn = d.n0 + n, row = d.kind == 2 ? nn : 8 * (nn >> 2) + 4 * d.kind + (nn & 3);
        __builtin_nontemporal_store(o, (GAS v4u*)(d.dst + (size_t)row * d.K + 8 * c)); }
    LDS_WAIT(); asm volatile("" ::: "memory");
}
__device__ __forceinline__ void moe_convert_ticket(Frame& F, KArgs& A, int l, int ct) {
    int lane_ = F.lane, wv_ = F.wave; asm volatile("" : "+v"(lane_), "+s"(wv_));
    LAS float* scr = (LAS float*)(F.lds + wv_ * 8448);
    const int r0 = ct * 64 + wv_ * 8;
    f32x4 x0[8], x1[8], x2[8], x3[8];
    TrDesc d0 = moe_tr_desc(A, F.ws, l, r0), d1 = moe_tr_desc(A, F.ws, l, r0 + 1), d2 = moe_tr_desc(A, F.ws, l, r0 + 2), d3 = moe_tr_desc(A, F.ws, l, r0 + 3);
    moe_tr_load(d0, lane_, x0); moe_tr_load(d1, lane_, x1); moe_tr_load(d2, lane_, x2); moe_tr_load(d3, lane_, x3);
    moe_tr_store(d0, lane_, x0, scr); d0 = moe_tr_desc(A, F.ws, l, r0 + 4); moe_tr_load(d0, lane_, x0);
    moe_tr_store(d1, lane_, x1, scr); d1 = moe_tr_desc(A, F.ws, l, r0 + 5); moe_tr_load(d1, lane_, x1);
    moe_tr_store(d2, lane_, x2, scr); d2 = moe_tr_desc(A, F.ws, l, r0 + 6); moe_tr_load(d2, lane_, x2);
    moe_tr_store(d3, lane_, x3, scr); d3 = moe_tr_desc(A, F.ws, l, r0 + 7); moe_tr_load(d3, lane_, x3);
    moe_tr_store(d0, lane_, x0, scr); moe_tr_store(d1, lane_, x1, scr); moe_tr_store(d2, lane_, x2, scr); moe_tr_store(d3, lane_, x3, scr);
}
__device__ __forceinline__ void p0_prologue(Frame& F, KArgs& A) {
    LAS float* scr = (LAS float*)(F.lds + F.wave * 16384);
    {
        constexpr int I_IN = 16 * 100, I_OUT = 16 * 32, I_W1 = 16 * 16, I_W2 = 8 * 32;
        constexpr int N_IN = NL * I_IN, N_OUT = NL * I_OUT, N_W1 = NL * 32 * I_W1, N_W2 = NL * 32 * I_W2;
        constexpr int NITEMS = N_IN + N_OUT + 2 * N_W1 + N_W2;
        for (int it = F.gw; it < N_IN + N_OUT; it += F.NGW) {
            int r = it;
            if (r < N_IN) { const int l = r / I_IN, q = r % I_IN, kb = q / 100, nb = q % 100;
                tr_item(GIN(6) + (size_t)l * 1024 * 3200, 3200, 1024, WSP(bf16, WS_WIN) + (size_t)l * NIN * 1024, scr, 64 * kb, 32 * nb, F.lane, [](int n) { return inproj_row(n); }); continue; }
            r -= N_IN;
            if (r < N_OUT) { const int l = r / I_OUT, q = r % I_OUT, kb = q / 32, nb = q % 32;
                tr_item(GIN(7) + (size_t)l * 1024 * 1024, 1024, 1024, WSP(bf16, WS_WOUT) + (size_t)l * 1024 * 1024, scr, 64 * kb, 32 * nb, F.lane, [](int n) { return n; }); continue; }
            r -= N_OUT;
            if (r < 2 * N_W1) { const int which = r / N_W1; r %= N_W1; const int le = r / I_W1, q = r % I_W1, kb = q / 16, nb = q % 16;
                const float* W = A.in[which ? 31 : 30] + (size_t)le * 1024 * 512; bf16* WT = WSP(bf16, WS_W13) + (size_t)le * 1024 * 1024;
                if (which == 0) tr_item(W, 512, 1024, WT, scr, 64 * kb, 32 * nb, F.lane, [](int n) { return 8 * (n >> 2) + (n & 3); });
                else            tr_item(W, 512, 1024, WT, scr, 64 * kb, 32 * nb, F.lane, [](int n) { return 8 * (n >> 2) + 4 + (n & 3); });
                continue; }
            r -= 2 * N_W1;
            { const int le = r / I_W2, q = r % I_W2, kb = q / 32, nb = q % 32;
                tr_item(GIN(32) + (size_t)le * 512 * 1024, 1024, 512, WSP(bf16, WS_W2) + (size_t)le * 1024 * 512, scr, 64 * kb, 32 * nb, F.lane, [](int n) { return n; }); }
        }
    }
    __syncthreads();
    {
        LAS float* cs = (LAS float*)F.lds;
        for (int i = F.tid; i < 4096; i += 512) { const float v = GIN(1)[i]; cs[i] = v / (1.0f + __expf(-v)); }
        __syncthreads();
        const int kp = F.tid >> 5, jj = F.tid & 31;
        LAS float* red = cs + 4096;
        for (int it = F.vcu; it < NL * 192; it += F.G) {
            const int l = it / 192, j = (it % 192) * 32 + jj;
            const float* w = GIN(2) + (size_t)l * 1024 * 6144 + j;
            float a0 = 0.f, a1 = 0.f, a2 = 0.f, a3 = 0.f;
#pragma unroll 16
            for (int k = kp * 64; k < kp * 64 + 64; ++k) { const float wv = w[(size_t)k * 6144]; a0 += cs[k] * wv; a1 += cs[1024 + k] * wv; a2 += cs[2048 + k] * wv; a3 += cs[3072 + k] * wv; }
            red[(kp * 4 + 0) * 32 + jj] = a0; red[(kp * 4 + 1) * 32 + jj] = a1; red[(kp * 4 + 2) * 32 + jj] = a2; red[(kp * 4 + 3) * 32 + jj] = a3;
            __syncthreads();
            if (F.tid < 128) { const int b = F.tid >> 5; float s = GIN(3)[l * 6144 + j];
#pragma unroll
                for (int q = 0; q < 16; ++q) s += red[(q * 4 + b) * 32 + jj];
                WSP(float, WS_MOD)[((size_t)l * NB + b) * 6144 + j] = s; }
            __syncthreads();
        }
    }
    for (int i = F.gw * 64 + F.lane; i < 8 * 1024; i += F.NGW * 64) { const int hh = i >> 10, d = i & 1023; WSP(float, WS_TB)[i] = GIN(25)[t5_bucket(d) * 8 + hh] * LOG2E; }
    for (int i = F.gw * 64 + F.lane; i < NL * 1024 * 48; i += F.NGW * 64) { const int c = i % 48, lk = i / 48; float v = 0.f; if (c < 4) v = GIN(26)[(size_t)lk * 4 + c]; else if (c >= 16) v = GIN(28)[(size_t)lk * 32 + (c - 16)]; WSP(float, WS_SMALL + 2 * MiB)[i] = v; }
    for (int i = F.gw * 64 + F.lane; i < NL * 4 * 9728; i += F.NGW * 64) { const int lh = i / 9728, x = i % 9728, l = lh >> 2, h = lh & 3; float v = 0.f;
        if (x < 5120) { const int mtx = x / 2560, y = x % 2560, ch = y / 40, j = y % 40; if (j < 32) v = GIN(mtx ? 12 : 10)[((size_t)l * 32 + j) * 256 + h * 64 + ch]; }
        else { const int y = x - 5120, ch = y / 72, j = y % 72; if (j < 64) v = GIN(13)[((size_t)l * 64 + j) * 256 + h * 64 + ch]; }
        WSP(bf16, WS_SMALL + 3 * MiB)[i] = (bf16)f2bf(v); }
    if (F.vcu == 0 && F.tid < NL) { const int l = F.tid; const float* lm = GIN(21) + l * 256; float s01 = 0.f, s23 = 0.f;
        for (int i = 0; i < 64; ++i) { s01 += lm[i] * lm[64 + i]; s23 += lm[128 + i] * lm[192 + i]; }
        WSP(float, WS_LAM)[l] = __expf(s01) - __expf(s23) + (0.8f - 0.6f * __expf(-0.3f * (float)l)); }
}

__device__ __forceinline__ void phase_norm1(Frame& F, KArgs& A, int l) {
    const float* xin = (l == 0) ? GIN(0) : F.out;
    const bf16* YS = WSP(bf16, WS_YS); const int* POS = WSP(int, WS_SMALL) + 4 * M;
    const int nrow_ = F.xl ? 8 : (M + F.NGW - 1) / F.NGW;
    for (int k_ = 0; k_ < nrow_; ++k_) { const int m = F.xl ? F.vcu * 64 + F.wave * 8 + k_ : F.gw + k_ * F.NGW; if (m >= M) break;
        const int b = m / SEQ;
        f32x4 v[4];
#pragma unroll
        for (int j = 0; j < 4; ++j) v[j] = __builtin_nontemporal_load((const GAS f32x4*)(xin + (size_t)m * DM) + F.lane + 64 * j);
        if (l > 0) {
            const int p0 = POS[2 * m], p1 = POS[2 * m + 1];
            const float* g2 = WSP(float, WS_MOD) + ((size_t)(l - 1) * NB + b) * 6144 + 5 * 1024;
#pragma unroll
            for (int j = 0; j < 4; ++j) { const int c = 4 * (F.lane + 64 * j);
                const uint2 ya = *(const uint2*)(YS + (size_t)p0 * DM + c), yb = *(const uint2*)(YS + (size_t)p1 * DM + c);
                const f32x4 gg = *(const f32x4*)(g2 + c);
                v[j].x += gg.x * (bf_lo(ya.x) + bf_lo(yb.x)); v[j].y += gg.y * (bf_hi(ya.x) + bf_hi(yb.x));
                v[j].z += gg.z * (bf_lo(ya.y) + bf_lo(yb.y)); v[j].w += gg.w * (bf_hi(ya.y) + bf_hi(yb.y)); }
        }
        if (l == 0 || l > 0) {
#pragma unroll
            for (int j = 0; j < 4; ++j) __builtin_nontemporal_store(v[j], (GAS f32x4*)(F.out + (size_t)m * DM) + F.lane + 64 * j);
        }
        if (l == NL) continue;
        float ss = 0.f;
#pragma unroll
        for (int j = 0; j < 4; ++j) ss += (v[j].x * v[j].x + v[j].y * v[j].y) + (v[j].z * v[j].z + v[j].w * v[j].w);
        const float rstd = 1.0f / sqrtf(wave_sum(ss) * (1.0f / DM) + 1e-6f);
        const float* mod = WSP(float, WS_MOD) + ((size_t)l * NB + b) * 6144;
        const float* ng = GIN(4) + l * DM;
        bf16* hrow = WSP(bf16, WS_HB) + (size_t)m * DM;
#pragma unroll
        for (int j = 0; j < 4; ++j) { const int c = 4 * (F.lane + 64 * j);
            const f32x4 g = *(const f32x4*)(ng + c), sh = *(const f32x4*)(mod + c), sc = *(const f32x4*)(mod + 1024 + c);
            const float h0 = v[j].x * rstd * g.x * (1.f + sc.x) + sh.x, h1 = v[j].y * rstd * g.y * (1.f + sc.y) + sh.y;
            const float h2 = v[j].z * rstd * g.z * (1.f + sc.z) + sh.z, h3 = v[j].w * rstd * g.w * (1.f + sc.w) + sh.w;
            uint2 o; o.x = pk2(h0, h1); o.y = pk2(h2, h3); *(uint2*)(hrow + c) = o; }
    }
}
constexpr size_t WS_WEG = WS_SMALL + 2 * MiB;
__device__ __forceinline__ void moe_tables(Frame& F, KArgs& A, int l) {
    LAS int* base = (LAS int*)(F.lds + TAB_OFF); LAS int* t2e = base + 64;
    const unsigned* cnt = (const unsigned*)(F.ctl + CW_CNT + l * 64);
    if (F.tid == 0) { int acc = 0; for (int e = 0; e < 32; ++e) { base[e] = acc; const int c = (int)__hip_atomic_load(cnt + e, __ATOMIC_RELAXED, __HIP_MEMORY_SCOPE_AGENT); acc += (c + 255) / 256 * 256; } base[32] = acc; }
    __syncthreads();
    if (F.tid < 160) { const int r0 = F.tid * 256; int e = 31; for (int x = 0; x < 32; ++x) if (r0 >= base[x] && r0 < base[x + 1]) e = x; t2e[F.tid] = e; }
    __syncthreads();
}
__device__ __forceinline__ void phase_router(Frame& F, KArgs& A, int l, const XcdBarrier& bar) {
    typedef float f32x4_ __attribute__((ext_vector_type(4)));
    const float* bg = GIN(27) + l * 4; const float* be = GIN(29) + l * 32;
    const float* Wc = WSP(float, WS_WEG) + (size_t)l * 1024 * 48;
    int* SLT = WSP(int, WS_SMALL) + 4 * M; float* GS = WSP(float, WS_SMALL) + 6 * M;
    unsigned* cnt = (unsigned*)(F.ctl + CW_CNT + l * 64);
    constexpr int HP = 1028;
    LAS float* H = (LAS float*)F.lds; LAS float* part = (LAS float*)(F.lds + 65792); LAS float* LG = (LAS float*)(F.lds + 90368);
    LAS int* el_ = (LAS int*)(F.lds + 93440); LAS float* gl_ = (LAS float*)(F.lds + 93440 + 512); LAS int* off_ = (LAS int*)(F.lds + 93440 + 1024); LAS int* slot_ = (LAS int*)(F.lds + 93440 + 1536);
    const float* ng = GIN(5) + l * DM;
    const int t = F.lane & 15, kq = F.lane >> 4;
    float breg[3][32];
#pragma unroll
    for (int kk = 0; kk < 32; ++kk)
#pragma unroll
        for (int ct = 0; ct < 3; ++ct) breg[ct][kk] = Wc[(size_t)(128 * F.wave + 4 * kk + kq) * 48 + 16 * ct + t];
    const int vb = F.vcu; const bool hasvb = vb < M / 64;
    typedef unsigned v2u_ __attribute__((ext_vector_type(2)));
    v2u_ hk[8][4];
#pragma unroll
    for (int r = 0; r < 8; ++r)
#pragma unroll
        for (int j = 0; j < 4; ++j) { hk[r][j].x = 0u; hk[r][j].y = 0u; }
    if (hasvb) {
        for (int grp = 0; grp < 4; ++grp) {
            f32x4 v[2][4];
#pragma unroll
            for (int u = 0; u < 2; ++u) { const int m = vb * 64 + grp * 16 + 2 * F.wave + u;
#pragma unroll
                for (int j = 0; j < 4; ++j) v[u][j] = __builtin_nontemporal_load((const GAS f32x4*)(F.out + (size_t)m * DM) + F.lane + 64 * j); }
#pragma unroll
            for (int u = 0; u < 2; ++u) {
                const int tg = 2 * F.wave + u, m = vb * 64 + grp * 16 + tg, b = m / SEQ;
                float ss = 0.f;
#pragma unroll
                for (int j = 0; j < 4; ++j) ss += (v[u][j].x * v[u][j].x + v[u][j].y * v[u][j].y) + (v[u][j].z * v[u][j].z + v[u][j].w * v[u][j].w);
                const float rstd = 1.0f / sqrtf(wave_sum(ss) * (1.0f / DM) + 1e-6f);
                const float* mod = WSP(float, WS_MOD) + ((size_t)l * NB + b) * 6144;
#pragma unroll
                for (int j = 0; j < 4; ++j) { const int c = 4 * (F.lane + 64 * j);
                    const f32x4 g = *(const GAS f32x4*)(ng + c), sh = *(const GAS f32x4*)(mod + 3072 + c), sc = *(const GAS f32x4*)(mod + 4096 + c);
                    f32x4 h; h.x = v[u][j].x * rstd * g.x * (1.f + sc.x) + sh.x; h.y = v[u][j].y * rstd * g.y * (1.f + sc.y) + sh.y; h.z = v[u][j].z * rstd * g.z * (1.f + sc.z) + sh.z; h.w = v[u][j].w * rstd * g.w * (1.f + sc.w) + sh.w;
                    v2u_ o; o.x = pk2(h.x, h.y); o.y = pk2(h.z, h.w);
#pragma unroll
                    for (int g = 0; g < 4; ++g) if (grp == g) hk[2 * g + u][j] = o;
                    *(LAS f32x4*)(H + tg * HP + c) = h; }
            }
            LDS_WAIT(); __syncthreads();
            {
                f32x4_ acc0 = {0.f, 0.f, 0.f, 0.f}, acc1 = acc0, acc2 = acc0;
                const LAS float* hp = H + t * HP + 128 * F.wave + kq;
#pragma unroll
                for (int kk = 0; kk < 32; ++kk) { const float a = hp[4 * kk];
                    acc0 = __builtin_amdgcn_mfma_f32_16x16x4f32(a, breg[0][kk], acc0, 0, 0, 0); acc1 = __builtin_amdgcn_mfma_f32_16x16x4f32(a, breg[1][kk], acc1, 0, 0, 0); acc2 = __builtin_amdgcn_mfma_f32_16x16x4f32(a, breg[2][kk], acc2, 0, 0, 0); }
#pragma unroll
                for (int r = 0; r < 4; ++r) { LAS float* pp = part + (F.wave * 16 + 4 * kq + r) * 48 + t; pp[0] = acc0[r]; pp[16] = acc1[r]; pp[32] = acc2[r]; }
            }
            LDS_WAIT(); __syncthreads();
            for (int i = F.tid; i < 16 * 48; i += NWAVES * 64) { float sum = 0.f;
#pragma unroll
                for (int q = 0; q < 8; ++q) sum += part[q * 768 + i];
                LG[i] = sum; }
            LDS_WAIT(); __syncthreads();
            if (F.tid < 16) { const LAS float* lg = LG + F.tid * 48;
                float gl[4];
#pragma unroll
                for (int g = 0; g < 4; ++g) gl[g] = lg[g] + bg[g];
                int gs = 0; float gm = gl[0];
#pragma unroll
                for (int g = 1; g < 4; ++g) if (gl[g] > gm) { gm = gl[g]; gs = g; }
                float den = 0.f;
#pragma unroll
                for (int g = 0; g < 4; ++g) den += __expf(gl[g] - gm);
                const float pg = 1.0f / den;
                float el[8];
#pragma unroll
                for (int e = 0; e < 8; ++e) el[e] = lg[16 + gs * 8 + e] + be[gs * 8 + e];
                int e1 = 0; float m1 = el[0];
#pragma unroll
                for (int e = 1; e < 8; ++e) if (el[e] > m1) { m1 = el[e]; e1 = e; }
                int e2 = -1; float m2 = -INFINITY;
#pragma unroll
                for (int e = 0; e < 8; ++e) if (e != e1 && el[e] > m2) { m2 = el[e]; e2 = e; }
                const float ex = __expf(m2 - m1); const int tl = grp * 16 + F.tid;
                el_[2 * tl] = gs * 8 + e1; el_[2 * tl + 1] = gs * 8 + e2; gl_[2 * tl] = pg / (1.f + ex); gl_[2 * tl + 1] = pg * ex / (1.f + ex); }
            LDS_WAIT(); __syncthreads();
        }
        int rank = 0, mye = 0;
        if (F.tid < 128) { mye = el_[F.tid]; for (int a = 0; a < F.tid; ++a) rank += (el_[a] == mye) ? 1 : 0; }
        else if (F.tid < 160) { const int e = F.tid - 128; int c = 0; for (int a = 0; a < 128; ++a) c += (el_[a] == e) ? 1 : 0; off_[e] = c ? (int)atomicAdd(cnt + e, (unsigned)c) : 0; }
        LDS_WAIT(); __syncthreads();
        if (F.tid < 128) slot_[F.tid] = off_[mye] + rank;
        LDS_WAIT(); __syncthreads();
    }
    xcd_barrier(bar);
    moe_tables(F, A, l);
    {
        const LAS int* base = (const LAS int*)(F.lds + TAB_OFF);
        bf16* XS = WSP(bf16, WS_XS);
        if (hasvb) {
#pragma unroll
            for (int r = 0; r < 8; ++r) { const int tl = (r >> 1) * 16 + 2 * F.wave + (r & 1), m = vb * 64 + tl;
#pragma unroll
                for (int k = 0; k < 2; ++k) { const int pos = base[el_[2 * tl + k]] + slot_[2 * tl + k];
#pragma unroll
                    for (int j = 0; j < 4; ++j) __builtin_nontemporal_store(hk[r][j], (GAS v2u_*)(XS + (size_t)pos * DM + 4 * (F.lane + 64 * j)));
                    if (F.lane == 0) { SLT[2 * m + k] = pos; GS[pos] = gl_[2 * tl + k]; } } }
        }
        for (int it = F.gw; it < 32 * 256; it += F.NGW) { const int e = it >> 8, i = it & 255; const int c = (int)cnt[e]; const int npad = (c + 255) / 256 * 256 - c;
            if (i < npad) { const int pos = base[e] + c + i; const v4u z = {0u, 0u, 0u, 0u};
#pragma unroll
                for (int j = 0; j < 2; ++j) *((GAS v4u*)(XS + (size_t)pos * DM) + F.lane + 64 * j) = z;
                if (F.lane == 0) GS[pos] = 0.f; } }
    }
}
namespace rw {
typedef short bf16x8 __attribute__((ext_vector_type(8)));
typedef float f32x16 __attribute__((ext_vector_type(16)));
constexpr int PITCH = 144;
constexpr int SLOT = 64 * PITCH;
constexpr int GAM_OFF = 14 * SLOT;
constexpr size_t ITEM_BYTES = 49152;
__device__ __forceinline__ int crow(int r, int hi) { return (r & 3) + 8 * (r >> 2) + 4 * hi; }
__device__ __forceinline__ unsigned short f2b(float f) { unsigned u = __builtin_bit_cast(unsigned, f); return (unsigned short)((u + 0x7fffu + ((u >> 16) & 1u)) >> 16); }
__device__ __forceinline__ unsigned pk(float lo, float hi) { return (unsigned)f2b(lo) | ((unsigned)f2b(hi) << 16); }
__device__ __forceinline__ f32x16 tile_nt(LAS const unsigned char* A, int arow0, LAS const unsigned char* B, int brow0, f32x16 acc, int lane) {
    const int r = lane & 31, h = lane >> 5;
    LAS const unsigned char* ap = A + (arow0 + r) * PITCH + h * 16; LAS const unsigned char* bp = B + (brow0 + r) * PITCH + h * 16;
#pragma unroll
    for (int ks = 0; ks < 4; ++ks) { const bf16x8 a = *(LAS const bf16x8*)(ap + ks * 32), b = *(LAS const bf16x8*)(bp + ks * 32); acc = __builtin_amdgcn_mfma_f32_32x32x16_bf16(a, b, acc, 0, 0, 0); }
    return acc;
}
template <int MASK> __device__ __forceinline__ float maskv(float v, int row, int col) { if (MASK == 1) return row > col ? v : 0.f; if (MASK == 2) return row >= col ? v : 0.f; return v; }
template <int MASK> __device__ __forceinline__ void store_nat(LAS unsigned char* S, int r0, int c0, const f32x16& acc, float sc, int lane) {
    const int col = c0 + (lane & 31), hi = lane >> 5;
#pragma unroll
    for (int g = 0; g < 16; ++g) { const int row = r0 + crow(g, hi); *(LAS unsigned short*)(S + row * PITCH + col * 2) = f2b(maskv<MASK>(acc[g], row, col) * sc); }
}
template <int MASK> __device__ __forceinline__ void store_tr(LAS unsigned char* S, int r0, int c0, const f32x16& acc, int lane) {
    const int col = c0 + (lane & 31), hi = lane >> 5;
#pragma unroll
    for (int g = 0; g < 16; ++g) { const int row = r0 + crow(g, hi); *(LAS unsigned short*)(S + col * PITCH + row * 2) = f2b(maskv<MASK>(acc[g], row, col)); }
}
__device__ __forceinline__ f32x16 load_nat(LAS const unsigned char* S, int r0, int c0, int lane) {
    const int col = c0 + (lane & 31), hi = lane >> 5; f32x16 a;
#pragma unroll
    for (int g = 0; g < 16; ++g) a[g] = __uint_as_float((unsigned)*(LAS const unsigned short*)(S + (r0 + crow(g, hi)) * PITCH + col * 2) << 16);
    return a;
}
}

constexpr size_t WS_LW = WS_SMALL + 3 * MiB;
constexpr int LW_BYTES = 19456, ACT_PITCH = 272, ACT_BYTES = 64 * ACT_PITCH, RES_OFF = 8 * rw::SLOT, RES_PITCH = 65, SSBUF_OFF = 131072 + 2048;
template <int CTRL, int RM> __device__ __forceinline__ float dpp0(float v) { return __int_as_float(__builtin_amdgcn_update_dpp(0, __float_as_int(v), CTRL, RM, 0xf, false)); }
__device__ __forceinline__ float wave_scan_incl(float x) {
    x += dpp0<0x111, 0xf>(x); x += dpp0<0x112, 0xf>(x); x += dpp0<0x114, 0xf>(x); x += dpp0<0x118, 0xf>(x);
    x += dpp0<0x142, 0xa>(x); x += dpp0<0x143, 0xc>(x);
    return x;
}
__device__ __forceinline__ float fast_tanh(float x) { const float e = __expf(2.f * x); return 1.f - 2.f / (1.f + e); }
__device__ __forceinline__ void phase_chunkprep(Frame& F, KArgs& A, int l) {
    using namespace rw;
    const float* PR = WSP(const float, WS_PR);
    float* RW = WSP(float, WS_RW); constexpr size_t RS = (size_t)M * 256;
    LAS unsigned char* L = F.lds;
#define SL(n) (L + (n) * SLOT)
    const int w = F.wave;
    for (int it = F.vcu; it < NB * 4 * 64; it += F.G) {
        int lane = F.lane; asm volatile("" : "+v"(lane));
        { unsigned lb_ = 0u; asm volatile("" : "+s"(lb_)); L = F.lds + lb_; }
        const int c = it & 63, bh = it >> 6, b = bh >> 2, h = bh & 3;
        unsigned char* gout = F.ws + WS_XS + (size_t)it * ITEM_BYTES;
        const size_t m0 = (size_t)b * SEQ + c * 64;
        f32x4 s1r[2], s1k[2], s1v[2], s1pr[2], s1pk[2], s1pv[2];
        { const float* cur = PR + (m0 + lane) * 896 + h * 64 + 8 * w; const bool first = (c == 0 && lane == 0);
#pragma unroll
          for (int q = 0; q < 2; ++q) { s1r[q] = *(const GAS f32x4*)(cur + 4 * q); s1k[q] = *(const GAS f32x4*)(cur + 256 + 4 * q); s1v[q] = *(const GAS f32x4*)(cur + 512 + 4 * q);
              s1pr[q] = (f32x4){0.f, 0.f, 0.f, 0.f}; s1pk[q] = s1pr[q]; s1pv[q] = s1pr[q];
              if (!first) { s1pr[q] = *(const GAS f32x4*)(cur - 896 + 4 * q); s1pk[q] = *(const GAS f32x4*)(cur - 896 + 256 + 4 * q); s1pv[q] = *(const GAS f32x4*)(cur - 896 + 512 + 4 * q); } } }
        {
            const int tid = w * 64 + lane, t = tid >> 3, jg = tid & 7;
            const float* cur = PR + (m0 + t) * 896 + 768 + 16 * jg; const float* mup = GIN(8) + l * 896 + 768 + 16 * jg;
            const bool first = (c == 0 && t == 0);
            unsigned o8[8];
#pragma unroll
            for (int q = 0; q < 4; ++q) { f32x4 x = *(const GAS f32x4*)(cur + 4 * q); const f32x4 mu = *(const GAS f32x4*)(mup + 4 * q);
                f32x4 xp = {0.f, 0.f, 0.f, 0.f}; if (!first) xp = *(const GAS f32x4*)(cur - 896 + 4 * q);
                x = x + (xp - x) * mu;
#pragma unroll
                for (int e = 0; e < 4; ++e) x[e] = jg < 2 ? fast_tanh(x[e]) : (jg < 4 ? x[e] : 1.f / (1.f + __expf(-x[e])));
                o8[2 * q] = pk(x[0], x[1]); o8[2 * q + 1] = pk(x[2], x[3]); }
            LAS v4u* dst = (LAS v4u*)(L + t * ACT_PITCH + jg * 32);
            dst[0] = (v4u){o8[0], o8[1], o8[2], o8[3]}; dst[1] = (v4u){o8[4], o8[5], o8[6], o8[7]};
            const GAS v4u* lw = (const GAS v4u*)(F.ws + WS_LW + (size_t)(l * 4 + h) * LW_BYTES);
            for (int i = tid; i < LW_BYTES / 16; i += NWAVES * 64) *(LAS v4u*)(L + ACT_BYTES + i * 16) = lw[i];
        }
        LDS_WAIT(); __syncthreads();
        for (int id = w; id < 12; id += 8) {
            const int mtx = id >> 2, tr = (id >> 1) & 1, tc = id & 1, r = lane & 31, hh = lane >> 5;
            const int koff = mtx == 0 ? 0 : (mtx == 1 ? 64 : 128), nks = mtx == 2 ? 4 : 2, bp = mtx == 2 ? 144 : 80, boff = mtx == 0 ? 0 : (mtx == 1 ? 5120 : 10240);
            LAS const unsigned char* ap = L + (32 * tr + r) * ACT_PITCH + koff + hh * 16; LAS const unsigned char* bpp = L + ACT_BYTES + boff + (32 * tc + r) * bp + hh * 16;
            f32x16 acc = f32x16{};
            for (int ks = 0; ks < nks; ++ks) { const bf16x8 a = *(LAS const bf16x8*)(ap + ks * 32), bb = *(LAS const bf16x8*)(bpp + ks * 32); acc = __builtin_amdgcn_mfma_f32_32x32x16_bf16(a, bb, acc, 0, 0, 0); }
            LAS float* res = (LAS float*)(L + RES_OFF) + mtx * 64 * RES_PITCH + (32 * tc + r) * RES_PITCH + 32 * tr;
#pragma unroll
            for (int g = 0; g < 16; ++g) res[crow(g, hh)] = acc[g];
        }
        LDS_WAIT(); __syncthreads();
        {
            const int ch0 = h * 64 + 8 * w; const size_t m = m0 + lane;
            float r_[8], k_[8], v_[8], a_[8], lw_[8], kk_[8]; float ss = 0.f;
            const LAS float* res = (const LAS float*)(L + RES_OFF) + (8 * w) * RES_PITCH + lane;
#pragma unroll
            for (int q = 0; q < 2; ++q) {
                f32x4 xr = s1r[q], xk = s1k[q], xv = s1v[q]; const f32x4 pr = s1pr[q], pk_ = s1pk[q], pv = s1pv[q];
                const float* mu = GIN(8) + l * 896 + ch0 + 4 * q;
                const f32x4 mr = *(const GAS f32x4*)mu, mk = *(const GAS f32x4*)(mu + 256), mv = *(const GAS f32x4*)(mu + 512);
                xr = xr + (pr - xr) * mr; xk = xk + (pk_ - xk) * mk; xv = xv + (pv - xv) * mv;
                const f32x4 w0 = *(const GAS f32x4*)(GIN(9) + l * 256 + ch0 + 4 * q), a0 = *(const GAS f32x4*)(GIN(11) + l * 256 + ch0 + 4 * q);
                const f32x4 kkw = *(const GAS f32x4*)(GIN(14) + l * 256 + ch0 + 4 * q), kaw = *(const GAS f32x4*)(GIN(15) + l * 256 + ch0 + 4 * q);
                f32x4 gg, k2;
#pragma unroll
                for (int e = 0; e < 4; ++e) { const int i = 4 * q + e;
                    const float xw = -(w0[e] + res[i * RES_PITCH]); const float sp = xw > 15.f ? xw : __logf(1.f + __expf(xw)); const float wv = -sp - 0.5f;
                    lw_[i] = -__expf(wv);
                    const float a = 1.f / (1.f + __expf(-(a0[e] + res[(64 + i) * RES_PITCH]))); a_[i] = a;
                    gg[e] = res[(128 + i) * RES_PITCH];
                    r_[i] = xr[e]; v_[i] = xv[e]; kk_[i] = xk[e] * kkw[e]; ss += kk_[i] * kk_[i];
                    k2[e] = xk[e] * (1.f + (a - 1.f) * kaw[e]); k_[i] = k2[e]; }
                const size_t o = m * 256 + ch0 + 4 * q;
                *(GAS f32x4*)(RW + o) = xr; *(GAS f32x4*)(RW + 2 * RS + o) = k2; *(GAS f32x4*)(RW + 3 * RS + o) = xv; *(GAS f32x4*)(RW + 6 * RS + o) = gg;
            }
            *(LAS float*)(L + SSBUF_OFF + (w * 64 + lane) * 4) = ss;
            LDS_WAIT(); __syncthreads();
            float tot = 0.f;
#pragma unroll
            for (int q = 0; q < 8; ++q) tot += *(LAS const float*)(L + SSBUF_OFF + (q * 64 + lane) * 4);
            const float inv = 1.0f / fmaxf(sqrtf(tot), 1e-12f);
            unsigned nat[4][4];
#pragma unroll
            for (int e = 0; e < 8; ++e) {
                const float kkn = kk_[e] * inv, bbv = kkn * a_[e];
                const float cum = wave_scan_incl(lw_[e]);
                const float cl = rl(cum, 63), gam = __expf(cl);
                const float e1 = __expf(cum - lw_[e]), e2 = __expf(cum), e3 = __expf(-cum);
                const float kkf = kkn * e1, rf = r_[e] * e2, bi = bbv * e3, ki = k_[e] * e3, bend = bi * gam, kend = ki * gam;
                const int i = 8 * w + e;
                if (lane == 63) *(LAS float*)(L + GAM_OFF + i * 4) = gam;
                *(LAS unsigned short*)(SL(4) + i * PITCH + lane * 2) = f2b(kkf); *(LAS unsigned short*)(SL(5) + i * PITCH + lane * 2) = f2b(v_[e]);
                *(LAS unsigned short*)(SL(6) + i * PITCH + lane * 2) = f2b(bend); *(LAS unsigned short*)(SL(7) + i * PITCH + lane * 2) = f2b(kend);
                const unsigned short q0 = f2b(kkf), q1 = f2b(rf), q2 = f2b(bi), q3 = f2b(ki);
                if (e & 1) { nat[0][e >> 1] |= (unsigned)q0 << 16; nat[1][e >> 1] |= (unsigned)q1 << 16; nat[2][e >> 1] |= (unsigned)q2 << 16; nat[3][e >> 1] |= (unsigned)q3 << 16; }
                else { nat[0][e >> 1] = q0; nat[1][e >> 1] = q1; nat[2][e >> 1] = q2; nat[3][e >> 1] = q3; }
            }
#pragma unroll
            for (int mm = 0; mm < 4; ++mm) { v4u x; x.x = nat[mm][0]; x.y = nat[mm][1]; x.z = nat[mm][2]; x.w = nat[mm][3]; *(LAS v4u*)(SL(mm) + lane * PITCH + w * 16) = x; }
        }
        LDS_WAIT(); __syncthreads();
        const f32x16 Z = f32x16{};
#pragma unroll
        for (int q = 0; q < 2; ++q) { const int tile = 2 * w + q, p = tile >> 2, tr = (tile >> 1) & 1, tc = tile & 1;
            f32x16 acc = Z;
            if (!(tr == 0 && tc == 1)) acc = tile_nt(SL(p < 2 ? 0 : 1), 32 * tr, SL((p & 1) ? 3 : 2), 32 * tc, Z, lane);
            if (p == 0) { store_nat<1>(SL(8), 32 * tr, 32 * tc, acc, 1.f, lane); store_tr<1>(SL(12), 32 * tr, 32 * tc, acc, lane);
                const int col = 32 * tc + (lane & 31), hi = lane >> 5;
#pragma unroll
                for (int g = 0; g < 16; ++g) { const int row = 32 * tr + crow(g, hi); const float v = (row == col ? 1.f : 0.f) - (row > col ? acc[g] : 0.f); *(LAS unsigned short*)(SL(13) + row * PITCH + col * 2) = f2b(v); } }
            else if (p == 1) store_nat<1>(SL(9), 32 * tr, 32 * tc, acc, 1.f, lane);
            else if (p == 2) store_nat<2>(SL(10), 32 * tr, 32 * tc, acc, 1.f, lane);
            else store_nat<2>(SL(11), 32 * tr, 32 * tc, acc, 1.f, lane); }
        LDS_WAIT(); __syncthreads();
        const int tr = (w >> 1) & 1, tc = w & 1;
        {
            if (w < 4) { f32x16 acc = Z; if (!(tr == 0 && tc == 1)) acc = tile_nt(SL(8), 32 * tr, SL(12), 32 * tc, Z, lane); store_nat<0>(SL(0), 32 * tr, 32 * tc, acc, 1.f, lane); store_tr<0>(SL(2), 32 * tr, 32 * tc, acc, lane); }
            LDS_WAIT(); __syncthreads();
        }
#pragma nounroll
        for (int k = 1; k <= 5; ++k) {
            const int lpn = (k & 1) ? 0 : 8, lpt = (k & 1) ? 2 : 12, lpn2 = (k & 1) ? 8 : 0, lpt2 = (k & 1) ? 12 : 2, pin = (k & 1) ? 13 : 3, pout = (k & 1) ? 3 : 13;
            if (w < 4) { f32x16 acc = load_nat(SL(pin), 32 * tr, 32 * tc, lane); if (!(tr == 0 && tc == 1)) acc = tile_nt(SL(pin), 32 * tr, SL(lpt), 32 * tc, acc, lane); store_nat<0>(SL(pout), 32 * tr, 32 * tc, acc, 1.f, lane); }
            else if (k < 5) { f32x16 acc = Z; if (!(tr == 0 && tc == 1)) acc = tile_nt(SL(lpn), 32 * tr, SL(lpt), 32 * tc, Z, lane); store_nat<0>(SL(lpn2), 32 * tr, 32 * tc, acc, 1.f, lane); store_tr<0>(SL(lpt2), 32 * tr, 32 * tc, acc, lane); }
            LDS_WAIT(); __syncthreads();
        }
        if (w < 4) { const f32x16 acc = tile_nt(SL(4), 32 * tr, SL(3), 32 * tc, Z, lane); store_nat<0>(SL(0), 32 * tr, 32 * tc, acc, 1.f, lane); }
        else { const f32x16 acc = tile_nt(SL(5), 32 * tr, SL(9), 32 * tc, Z, lane); store_nat<0>(SL(2), 32 * tr, 32 * tc, acc, 1.f, lane); }
        LDS_WAIT(); __syncthreads();
        if (w < 4) { const f32x16 acc = tile_nt(SL(2), 32 * tr, SL(3), 32 * tc, Z, lane); store_nat<0>(SL(8), 32 * tr, 32 * tc, acc, -1.f, lane); }
        else {
            const int hi = lane >> 5, cl = lane & 31;
            { const f32x16 acc = tile_nt(SL(0), 32 * tr, SL(6), 32 * tc, Z, lane);
              const float gam = *(LAS const float*)(L + GAM_OFF + (32 * tc + cl) * 4);
#pragma unroll
              for (int sp = 0; sp < 2; ++sp) { float o[8];
#pragma unroll
                  for (int j = 0; j < 8; ++j) { const int g = 8 * sp + j; o[j] = ((tr == tc && crow(g, hi) == cl) ? gam : 0.f) - acc[g]; }
                  v4u x; x.x = pk(o[0], o[1]); x.y = pk(o[2], o[3]); x.z = pk(o[4], o[5]); x.w = pk(o[6], o[7]);
                  *(GAS v4u*)(gout + ((size_t)(tc * 4 + 2 * tr + sp) * 64 + lane) * 16) = x; } }
            { const f32x16 acc = tile_nt(SL(0), 32 * tr, SL(10), 32 * tc, Z, lane);
#pragma unroll
              for (int sp = 0; sp < 2; ++sp) { float o[8];
#pragma unroll
                  for (int j = 0; j < 8; ++j) { const int g = 8 * sp + j; const int i = 32 * tr + crow(g, hi), t = 32 * tc + cl;
                      o[j] = __uint_as_float((unsigned)*(LAS const unsigned short*)(SL(1) + t * PITCH + i * 2) << 16) - acc[g]; }
                  v4u x; x.x = pk(o[0], o[1]); x.y = pk(o[2], o[3]); x.z = pk(o[4], o[5]); x.w = pk(o[6], o[7]);
                  *(GAS v4u*)(gout + 8192 + ((size_t)(tc * 4 + 2 * tr + sp) * 64 + lane) * 16) = x; } }
        }
        LDS_WAIT(); __syncthreads();
        {
            f32x16 acc;
            if (w < 4) { acc = tile_nt(SL(7), 32 * tr, SL(5), 32 * tc, Z, lane); acc = tile_nt(SL(6), 32 * tr, SL(8), 32 * tc, acc, lane); }
            else { acc = tile_nt(SL(11), 32 * tr, SL(5), 32 * tc, Z, lane); acc = tile_nt(SL(10), 32 * tr, SL(8), 32 * tc, acc, lane); }
            float* o = (float*)(gout + (w < 4 ? 16384 : 32768)) + (size_t)(tr * 2 + tc) * 1024 + lane;
#pragma unroll
            for (int g = 0; g < 16; ++g) *(GAS float*)(o + g * 64) = acc[g];
        }
        LDS_WAIT(); __syncthreads();
    }
#undef SL
    if (F.wave == 0) { const bf16* KM = WSP(bf16, WS_KM); float* KMEAN = WSP(float, WS_KMEAN);
      for (int it = F.vcu; it < NB * 16 * 4; it += F.G) { const int hh = it & 3, n = (it >> 2) & 15, b = it >> 6; const int co = F.lane >> 3, rg = F.lane & 7;
          const bf16* p = KM + ((size_t)b * SEQ + n * 256 + rg * 32) * 256 + hh * 64 + co * 8; float s[8] = {0.f, 0.f, 0.f, 0.f, 0.f, 0.f, 0.f, 0.f};
#pragma unroll 16
          for (int t = 0; t < 32; ++t) { const v4u x = *(const GAS v4u*)(p + (size_t)t * 256);
              s[0] += bf_lo(x.x); s[1] += bf_hi(x.x); s[2] += bf_lo(x.y); s[3] += bf_hi(x.y); s[4] += bf_lo(x.z); s[5] += bf_hi(x.z); s[6] += bf_lo(x.w); s[7] += bf_hi(x.w); }
#pragma unroll
          for (int e = 0; e < 8; ++e) { float x = s[e]; x += dpp0<0xB1, 0xf>(x); x += dpp0<0x4E, 0xf>(x); x += dpp0<0x141, 0xf>(x); s[e] = x * (1.0f / 256.0f); }
          if (rg == 0) { float* o = KMEAN + (((size_t)b * 4 + hh) * 16 + n) * 64 + co * 8; *(GAS f32x4*)o = (f32x4){s[0], s[1], s[2], s[3]}; *(GAS f32x4*)(o + 4) = (f32x4){s[4], s[5], s[6], s[7]}; } } }
}

constexpr size_t WS_SB = WS_HS;
__device__ __forceinline__ void rwkv_chain_wave(Frame& F, int bh, int tv) {
    using namespace rw;
    const int lane = F.lane;
    f32x16 S0 = f32x16{}, S1 = f32x16{};
    const unsigned char* gin = F.ws + WS_XS + (size_t)bh * 64 * ITEM_BYTES;
    unsigned char* sb = F.ws + WS_SB + ((size_t)bh * 64 * 2 + tv) * 4096 + lane * 16;
    bf16x8 Ga[8]; f32x16 H0, H1;
#define RW_LOAD(G_, H0_, H1_, gp_) do { _Pragma("unroll") for (int q_ = 0; q_ < 8; ++q_) G_[q_] = *(const GAS bf16x8*)((gp_) + ((size_t)q_ * 64 + lane) * 16); \
        const float* hp_ = (const float*)((gp_) + 16384) + (size_t)tv * 1024 + lane; _Pragma("unroll") for (int g_ = 0; g_ < 16; ++g_) { H0_[g_] = *(const GAS float*)(hp_ + g_ * 64); H1_[g_] = *(const GAS float*)(hp_ + 2048 + g_ * 64); } } while (0)
    RW_LOAD(Ga, H0, H1, gin);
    for (int c = 0; c < 64; ++c) {
        bf16x8 Gn[8]; f32x16 Hn0, Hn1;
        const unsigned char* gnx = gin + (size_t)(c < 63 ? c + 1 : c) * ITEM_BYTES;
        RW_LOAD(Gn, Hn0, Hn1, gnx);
        bf16x8 Bf[4];
#pragma unroll
        for (int s = 0; s < 4; ++s) { const f32x16& X = (s < 2) ? S0 : S1; const int o = 8 * (s & 1); v4u x; x.x = pk(X[o], X[o + 1]); x.y = pk(X[o + 2], X[o + 3]); x.z = pk(X[o + 4], X[o + 5]); x.w = pk(X[o + 6], X[o + 7]); Bf[s] = __builtin_bit_cast(bf16x8, x);
            *(GAS v4u*)(sb + (size_t)c * 8192 + s * 1024) = x; }
#pragma unroll
        for (int s = 0; s < 4; ++s) { H0 = __builtin_amdgcn_mfma_f32_32x32x16_bf16(Ga[s], Bf[s], H0, 0, 0, 0); H1 = __builtin_amdgcn_mfma_f32_32x32x16_bf16(Ga[4 + s], Bf[s], H1, 0, 0, 0); }
        S0 = H0; S1 = H1;
#pragma unroll
        for (int q = 0; q < 8; ++q) Ga[q] = Gn[q];
        H0 = Hn0; H1 = Hn1;
    }
#undef RW_LOAD
}
__device__ __forceinline__ void rwkv_y_item(Frame& F, KArgs& A, int l, int item2) {
    using namespace rw;
    const int lane = F.lane, hi = lane >> 5, cl = lane & 31;
    const int tt = item2 & 1, item = item2 >> 1, c = item & 63, bh = item >> 6, b = bh >> 2, h = bh & 3;
    const unsigned char* gin = F.ws + WS_XS + (size_t)item * ITEM_BYTES;
    const unsigned char* sb = F.ws + WS_SB + ((size_t)item * 2) * 4096 + lane * 16;
    LAS float* yl = (LAS float*)(F.lds + F.wave * 8192);
#pragma unroll
    for (int tv = 0; tv < 2; ++tv) {
        f32x16 acc; const float* y0 = (const float*)(gin + 32768) + (size_t)(tt * 2 + tv) * 1024 + lane;
#pragma unroll
        for (int g = 0; g < 16; ++g) acc[g] = *(const GAS float*)(y0 + g * 64);
#pragma unroll
        for (int s = 0; s < 4; ++s) { const bf16x8 a = *(const GAS bf16x8*)(gin + 8192 + ((size_t)(tt * 4 + s) * 64 + lane) * 16), bfr = *(const GAS bf16x8*)(sb + tv * 4096 + s * 1024);
            acc = __builtin_amdgcn_mfma_f32_32x32x16_bf16(a, bfr, acc, 0, 0, 0); }
#pragma unroll
        for (int g = 0; g < 16; ++g) yl[crow(g, hi) * 64 + 32 * tv + cl] = acc[g];
    }
    LDS_WAIT();
    const float* RWp = WSP(const float, WS_RW); constexpr size_t RS = (size_t)M * 256;
    const int ch = h * 64 + lane;
    const float rk = GIN(16)[l * 256 + ch], lng = GIN(17)[l * 256 + ch], lnb = GIN(18)[l * 256 + ch];
    const size_t row0 = (size_t)b * SEQ + c * 64 + 32 * tt;
#pragma unroll 8
    for (int t = 0; t < 32; ++t) { const size_t o = (row0 + t) * 256 + ch;
        const float y = yl[t * 64 + lane], r = RWp[o], k = RWp[2 * RS + o], v = RWp[3 * RS + o], g = RWp[6 * RS + o];
        const float mean = wave_sum(y) * (1.0f / 64.0f); const float d = y - mean; const float var = wave_sum(d * d) * (1.0f / 64.0f);
        const float bonus = wave_sum(r * k * rk) * v;
        WSP(bf16, WS_MIX)[(row0 + t) * 1024 + ch] = (bf16)f2bf((d * (1.0f / sqrtf(var + 64e-5f)) * lng + lnb + bonus) * g); }
    LDS_WAIT();
}
#ifndef ATT_NEGM
#define ATT_NEGM false
#endif
constexpr int CW_TIX = 16384 + 2048;
__device__ __forceinline__ void phase_attention(Frame& F, KArgs& A, int l, int rep, const XcdBarrier& bar) {
    constexpr int NSTREAM = 48, NUNITS = NSTREAM * 16, NCONV = 192, NTICKETS = NUNITS + NCONV;
    static_assert(4 * NCONV == NUNITS && 2 * NCONV * 64 == 3 * 32 * 256, "ticket interleave");
    unsigned* ctr = (unsigned*)(F.ctl + CW_TIX + l * 64 + rep * 16);
    volatile LAS unsigned* tix = F.MISC + 16;
    attn_body::attn_build_tables(F.tid, WSP(float, WS_TB), (char*)F.lds);
    asm volatile("s_waitcnt vmcnt(0) lgkmcnt(0)\n\ts_barrier" ::: "memory");
    bool chok = !F.xl;
    if (F.vcu < 4) { if (!chok) { xcd_wait_done(bar, (unsigned)(l + 1)); chok = true; } rwkv_chain_wave(F, (F.vcu * 8 + F.wave) >> 1, F.wave & 1); }
    int iter_ = 0;
    for (;;) {
#ifdef ATT_STATIC
        if (threadIdx.x == 0) tix[0] = (unsigned)(iter_ * F.G + (int)blockIdx.x);
#else
        if (threadIdx.x == 0) tix[0] = atomicAdd(ctr, 1u);
#endif
        ++iter_;
        asm volatile("s_waitcnt vmcnt(0) lgkmcnt(0)\n\ts_barrier" ::: "memory");
        const int ticket = (int)tix[0];
        asm volatile("s_waitcnt lgkmcnt(0)\n\ts_barrier" ::: "memory");
        if (ticket >= NTICKETS) break;
        if (ticket % 5 == 4) { moe_convert_ticket(F, A, l, ticket / 5); continue; }
        const int au = 4 * (ticket / 5) + ticket % 5;
        const int qb = 15 - au / NSTREAM, s = au % NSTREAM;
        int tid_u = threadIdx.x; asm volatile("" : "+v"(tid_u));
        if (s < 32) {
            const int b = s >> 3, h = (s >> 1) & 3, c = s & 1; const size_t r0 = (size_t)b * SEQ;
            attn_body::attn_unit_dv<16>(tid_u, qb,
                (const attn_body::bf16*)(WSP(bf16, WS_QD) + r0 * 512 + (h * 2 + c) * 64), 512,
                (const attn_body::bf16*)(WSP(bf16, WS_KD) + r0 * 512 + (h * 2 + c) * 64), 512,
                (const attn_body::bf16*)(WSP(bf16, WS_VD) + r0 * 512 + h * 128), 512,
                (attn_body::bf16*)(WSP(bf16, WS_OD) + r0 * 1024 + (h * 2 + c) * 128), 1024,
                h, (char*)F.lds);
        } else {
            if (!chok) { xcd_wait_done(bar, (unsigned)(l + 1)); chok = true; }
            const int b = (s - 32) >> 2, h = (s - 32) & 3; const size_t r0 = (size_t)b * SEQ;
            attn_body::attn_unit<16, true, ATT_NEGM>(tid_u, qb,
                (const attn_body::bf16*)(WSP(bf16, WS_QM) + r0 * 256 + h * 64), 256,
                (const attn_body::bf16*)(WSP(bf16, WS_KM) + r0 * 256 + h * 64), 256,
                (const attn_body::bf16*)(WSP(bf16, WS_VM) + r0 * 256 + h * 64), 256,
                (attn_body::bf16*)(WSP(bf16, WS_MIX) + r0 * 1024 + 768 + h * 64), 1024,
                4 + h, WSP(float, WS_KMEAN) + ((size_t)(b * 4 + h) * 16) * 64, (char*)F.lds);
        }
    }
}
__device__ __forceinline__ void phase_postmix(Frame& F, KArgs& A, int l) {
    const float lam = WSP(float, WS_LAM)[l]; const float li = 0.8f - 0.6f * __expf(-0.3f * (float)l);
    const float* sg = GIN(22) + l * 128;
    const int nit_ = F.xl ? 9 : (2048 + M + F.NGW - 1) / F.NGW;
    for (int k_ = 0; k_ < nit_; ++k_) {
        int it;
        if (F.xl) { if (k_ == 0) { rwkv_y_item(F, A, l, ((((F.vcu >> 6) * 4 + (F.wave >> 1)) * 64 + (F.vcu & 63)) << 1) | (F.wave & 1)); continue; } it = 2048 + F.vcu * 64 + F.wave * 8 + (k_ - 1); }
        else { it = F.gw + k_ * F.NGW; if (it >= 2048 + M) break; if (it < 2048) { rwkv_y_item(F, A, l, it); continue; } }
        const int m = it - 2048; const int h = F.lane >> 4, j = F.lane & 15;
        const bf16* od = WSP(bf16, WS_OD) + (size_t)m * 1024 + h * 256 + 8 * j;
        const v4u a = __builtin_nontemporal_load((const GAS v4u*)od), b2 = __builtin_nontemporal_load((const GAS v4u*)(od + 128));
        float o[8];
        o[0] = bf_lo(a.x) - lam * bf_lo(b2.x); o[1] = bf_hi(a.x) - lam * bf_hi(b2.x); o[2] = bf_lo(a.y) - lam * bf_lo(b2.y); o[3] = bf_hi(a.y) - lam * bf_hi(b2.y);
        o[4] = bf_lo(a.z) - lam * bf_lo(b2.z); o[5] = bf_hi(a.z) - lam * bf_hi(b2.z); o[6] = bf_lo(a.w) - lam * bf_lo(b2.w); o[7] = bf_hi(a.w) - lam * bf_hi(b2.w);
        float ss = 0.f;
#pragma unroll
        for (int i = 0; i < 8; ++i) ss += o[i] * o[i];
        ss += __shfl_xor(ss, 1); ss += __shfl_xor(ss, 2); ss += __shfl_xor(ss, 4); ss += __shfl_xor(ss, 8);
        const float rs = (1.f - li) / sqrtf(ss * (1.0f / 128.0f) + 1e-6f);
        const f32x4 g0 = *(const f32x4*)(sg + 8 * j), g1 = *(const f32x4*)(sg + 8 * j + 4);
        v4u w; w.x = pk2(o[0] * rs * g0.x, o[1] * rs * g0.y); w.y = pk2(o[2] * rs * g0.z, o[3] * rs * g0.w); w.z = pk2(o[4] * rs * g1.x, o[5] * rs * g1.y); w.w = pk2(o[6] * rs * g1.z, o[7] * rs * g1.w);
        *(GAS v4u*)(WSP(bf16, WS_MIX) + (size_t)m * 1024 + 256 + h * 128 + 8 * j) = w;
    }
}
__global__ void __launch_bounds__(NWAVES * 64, 2) mega_fwd(Args Araw) {
    extern __shared__ __attribute__((aligned(16))) unsigned char lds[];
    Frame F;
    F.lds = (LAS unsigned char*)lds; F.MISC = (volatile LAS unsigned*)(F.lds + MISC_OFF);
    F.tid = threadIdx.x; F.lane = F.tid & 63; F.wave = __builtin_amdgcn_readfirstlane(F.tid >> 6);
    F.G = gridDim.x; { const int bx = blockIdx.x; F.vcu = (F.G % 8 == 0) ? (bx % 8) * (F.G / 8) + bx / 8 : bx; }
    F.gw = F.vcu * NWAVES + F.wave; F.NGW = F.G * NWAVES;
    F.out = Araw.out; F.ws = Araw.ws; F.ctl = (gu32*)(Araw.ws + WS_CTL); F.xl = 0; F.cf = (int)blockIdx.x;
    for (int u = F.tid; u < (LDS_BYTES - LDSCTL_OFF) / 4; u += NWAVES * 64) ((LAS unsigned*)(F.lds + LDSCTL_OFF))[u] = 0u;
    __syncthreads();
    XcdBarrier bar = xcd_barrier_post((unsigned*)(F.ctl + CW_BAR), F.MISC + 8);
#define GRID_BAR() xcd_barrier(bar)

    constexpr int NPH = 9; constexpr int NSTEP = 1 + NL * NPH + 1;
    int reps_ = 0;
    {
        KArgs* Ap_ = (KArgs*)__builtin_amdgcn_kernarg_segment_ptr(); asm volatile("" : "+s"(Ap_)); KArgs& A = *Ap_;
        { unsigned lb_ = 0u; asm volatile("" : "+s"(lb_)); F.lds = (LAS unsigned char*)lds + lb_; F.MISC = (volatile LAS unsigned*)(F.lds + MISC_OFF); }
        { GAS unsigned char* w_ = (GAS unsigned char*)Araw.ws; GAS float* o_ = (GAS float*)Araw.out; asm volatile("" : "+s"(w_), "+s"(o_)); F.ws = (unsigned char*)w_; F.out = (float*)o_; F.ctl = (gu32*)(w_ + WS_CTL); }
        { int t_ = threadIdx.x; asm volatile("" : "+v"(t_)); F.tid = t_; F.lane = t_ & 63; F.wave = __builtin_amdgcn_readfirstlane(t_ >> 6); F.gw = F.vcu * NWAVES + F.wave; }
#ifndef SK_P0
        p0_prologue(F, A);
#endif
        GRID_BAR();
        xcd_census_regular(bar);
        { const int xl_ = __builtin_amdgcn_readfirstlane((int)F.MISC[11]), rk_ = __builtin_amdgcn_readfirstlane((int)F.MISC[10]);
          if (xl_) { F.xl = 1; F.vcu = (int)bar.x * 32 + rk_; F.cf = rk_ * 8 + (int)bar.x; } }
    }
    for (int step = 1; step < NSTEP; ++step) {
        const int l = (step - 1) / NPH, idx_ = (step - 1) % NPH;
        const int ph = ((step == NSTEP - 1) ? 99 : (idx_ < 2 ? idx_ : (idx_ == 2 ? 10 : (idx_ < 7 ? idx_ : idx_ + 1))));
        KArgs* Ap_ = (KArgs*)__builtin_amdgcn_kernarg_segment_ptr(); asm volatile("" : "+s"(Ap_)); KArgs& A = *Ap_;
        { unsigned lb_ = 0u; asm volatile("" : "+s"(lb_)); F.lds = (LAS unsigned char*)lds + lb_; F.MISC = (volatile LAS unsigned*)(F.lds + MISC_OFF); }
        { GAS unsigned char* w_ = (GAS unsigned char*)Araw.ws; GAS float* o_ = (GAS float*)Araw.out; asm volatile("" : "+s"(w_), "+s"(o_)); F.ws = (unsigned char*)w_; F.out = (float*)o_; F.ctl = (gu32*)(w_ + WS_CTL); }
        { int t_ = threadIdx.x; asm volatile("" : "+v"(t_)); F.tid = t_; F.lane = t_ & 63; F.wave = __builtin_amdgcn_readfirstlane(t_ >> 6); F.gw = F.vcu * NWAVES + F.wave; }
#ifdef AMP_MASK
        const unsigned long long amp_t0 = __builtin_amdgcn_s_memrealtime();
#endif
        switch (ph) {
        case 0:
#ifndef SK_N1
            phase_norm1(F, A, l);
#endif
            break;
        case 1: {
#ifndef SK_GIN
            pg8::Gemm g{WSP(bf16, WS_HB), WSP(bf16, WS_WIN) + (size_t)l * NIN * 1024, M, NIN, DM, 0};
            pg8::StaticOrder S; S.init(M, NIN, F.G, F.cf);
            pg8::EpiInProj E{F.ws, Ap_, l, C2};
            pg8::gemm_phase<pg8::EpiInProj, pg8::StaticOrder, true, PG8_SP2>(F.lds, g, S, E);
            if (F.cf >= 64) moe_convert_ticket(F, A, l, 192 + (F.cf - 64) % 192);
#endif
            break; }
        case 10:
            phase_chunkprep(F, A, l);
            break;
        case 3:
#ifndef SK_MX
            phase_attention(F, A, l, reps_, bar);
#endif
            break;
        case 4:
#ifndef SK_PM
            phase_postmix(F, A, l);
#endif
            break;
        case 5: {
#ifndef SK_GOUT
            pg8::Gemm g{WSP(bf16, WS_MIX), WSP(bf16, WS_WOUT) + (size_t)l * 1024 * 1024, M, DM, DM, 0};
            pg8::StaticOrder S; S.init(M, DM, F.G, F.cf);
            pg8::EpiResid E{F.out, WSP(float, WS_MOD) + (size_t)l * NB * 6144 + 2048, SEQ, 6144};
            pg8::gemm_phase<pg8::EpiResid, pg8::StaticOrder, true, PG8_SP2>(F.lds, g, S, E);
#endif
            break; }
        case 6:
#ifndef SK_R1
            phase_router(F, A, l, bar);
#endif
            break;
        case 8: {
#ifndef SK_MOE
            moe_tables(F, A, l);
            const LAS int* base = (const LAS int*)(F.lds + TAB_OFF);
            pg8::MoeOrder S{base + 64, base[32] / 256, 4, F.G, F.vcu};
            pg8::Gemm g1{WSP(bf16, WS_XS), WSP(bf16, WS_W13) + (size_t)l * 32 * 1024 * 1024, MOE_ROWS, 1024, 1024, (size_t)1024 * 1024 * 2};
            pg8::EpiSwiGLU E1{WSP(bf16, WS_HS)};
            pg8::gemm_phase<pg8::EpiSwiGLU, pg8::MoeOrder, true, PG8_SP2>(F.lds, g1, S, E1);
#endif
            break; }
        case 9: {
#ifndef SK_MOE
            moe_tables(F, A, l);
            const LAS int* base = (const LAS int*)(F.lds + TAB_OFF);
            pg8::MoeOrder S{base + 64, base[32] / 256, 4, F.G, F.vcu};
            pg8::Gemm g2{WSP(bf16, WS_HS), WSP(bf16, WS_W2) + (size_t)l * 32 * 1024 * 512, MOE_ROWS, 1024, 512, (size_t)1024 * 512 * 2};
            pg8::EpiMoeOut E2{WSP(bf16, WS_YS), WSP(float, WS_SMALL) + 6 * M};
            pg8::gemm_phase<pg8::EpiMoeOut, pg8::MoeOrder, true, PG8_SP2>(F.lds, g2, S, E2);
#endif
            break; }
        default:
            phase_norm1(F, A, NL);
            break;
        }
#ifdef AMP_MASK
        { const int bit_ = ph == -1 ? 15 : (ph == 99 ? 14 : ph); if ((AMP_MASK >> bit_) & 1) { asm volatile("s_waitcnt vmcnt(0) lgkmcnt(0)" ::: "memory"); const unsigned long long t1_ = __builtin_amdgcn_s_memrealtime(); while (__builtin_amdgcn_s_memrealtime() - t1_ < t1_ - amp_t0) __builtin_amdgcn_s_sleep(8); } }
#endif
        if (step + 1 < NSTEP) {
            if (F.xl && (ph == 0 || ph == 4 || ph == 5 || ph == 8)) xcd_local_barrier(bar);
            else if (F.xl && ph == 10) xcd_signal_done(bar);
            else GRID_BAR();
        }
#ifdef REP_PH
        if (ph == REP_PH && reps_ == 0) { reps_ = 1; --step; } else reps_ = 0;
#endif
    }
}

extern "C" void kernel_launch(void* const* d_in, const int* in_sizes, int n_in, void* d_out, int out_size, void* d_ws, size_t ws_size, hipStream_t stream) {
    static int grid = 0;
    if (grid == 0) {
        if (n_in != 33 || out_size != M * DM || ws_size < WS_END) { fprintf(stderr, "kernel_launch: unexpected shapes (n_in %d, out %d, ws %zu < %zu)\n", n_in, out_size, ws_size, (size_t)WS_END); grid = -1; return; }
        int dev = 0, cus = 0;
        if (hipGetDevice(&dev) != hipSuccess || hipDeviceGetAttribute(&cus, hipDeviceAttributeMultiprocessorCount, dev) != hipSuccess) { grid = -1; return; }
        if (hipFuncSetAttribute((const void*)mega_fwd, hipFuncAttributeMaxDynamicSharedMemorySize, LDS_BYTES) != hipSuccess) { fprintf(stderr, "kernel_launch: hipFuncSetAttribute failed\n"); grid = -1; return; }
        int per_cu = 0;
        if (hipOccupancyMaxActiveBlocksPerMultiprocessor(&per_cu, (const void*)mega_fwd, NWAVES * 64, LDS_BYTES) != hipSuccess || per_cu < 1) fprintf(stderr, "kernel_launch: occupancy query says %d\n", per_cu);
        (void)hipGetLastError();
        if (cus != M / 64) { fprintf(stderr, "kernel_launch: built for %d CUs (found %d)\n", M / 64, cus); grid = -1; return; }
        grid = cus;
    }
    if (grid < 0) return;
    if (hipMemsetAsync((char*)d_ws + WS_CTL, 0, CTL_ZERO_BYTES, stream) != hipSuccess) { fprintf(stderr, "kernel_launch: memset failed\n"); return; }
    Args a{};
    for (int i = 0; i < 33; ++i) a.in[i] = (const float*)d_in[i];
    a.out = (float*)d_out; a.ws = (unsigned char*)d_ws;
    hipLaunchKernelGGL(mega_fwd, dim3(grid), dim3(NWAVES * 64), LDS_BYTES, stream, a);
}
```
